# Optimizing an MI355X kernel written in HIP

```python
import math
import jax, jax.numpy as jnp
from jax import lax
import numpy as np

D_MODEL = 1024
BATCH = 8
SEQ = 4096
DEPTH = 2

N_MIXERS = 2
N_ATTN_LAYERS = (DEPTH + 1) // 2
N_SSM_LAYERS = DEPTH // 2
DIL_GROUPS = ((128, 1), (512, 4), (2048, 16))
N_DIL_GROUPS = len(DIL_GROUPS)
SUB_WIN = 128
ATTN_HEAD_DIM = 128
ATTN_HEADS_PER_GROUP = D_MODEL // ATTN_HEAD_DIM
ATTN_PROJ = N_DIL_GROUPS * 3 * ATTN_HEADS_PER_GROUP * ATTN_HEAD_DIM
ROT_DIM = ATTN_HEAD_DIM // 4
ROPE_THETA = 500000.0
SSM_D_INNER = 2 * D_MODEL
SSM_HEAD_DIM = 64
SSM_HEADS = SSM_D_INNER // SSM_HEAD_DIM
SSM_GROUPS = 4
SSM_HEADS_PER_GROUP = SSM_HEADS // SSM_GROUPS
SSM_D_STATE = 128
SSM_CONV = 4
SSM_CHUNK = 128
SSM_CONV_DIM = SSM_D_INNER + 2 * SSM_GROUPS * SSM_D_STATE
SSM_PROJ = 2 * SSM_D_INNER + 2 * SSM_GROUPS * SSM_D_STATE + SSM_HEADS
N_EXPERTS = 32
TOP_K = 4
D_FF = D_MODEL
SWIGLU_LIMIT = 7.0
SWIGLU_ALPHA = 1.702
MOE_BLOCK = 256
DEEPNORM_ALPHA = (2 * DEPTH) ** 0.25
DEEPNORM_BETA = (8 * DEPTH) ** -0.25
LN_EPS = 1e-5
RMS_EPS = 1e-5

kernel_name = "hybrid_dilated_attn_mamba2_moe_deepnorm"


def layer_norm(x, g, b):
    xf = x.astype(jnp.float32)
    mu = jnp.mean(xf, axis=-1, keepdims=True)
    var = jnp.mean(jnp.square(xf - mu), axis=-1, keepdims=True)
    return ((xf - mu) * lax.rsqrt(var + LN_EPS)).astype(x.dtype) * g + b


def rope_tables(positions, dtype):
    inv_freq = ROPE_THETA ** (-jnp.arange(0, ROT_DIM, 2, dtype=jnp.float32) / ROT_DIM)
    ang = positions.astype(jnp.float32)[..., None] * inv_freq
    return jnp.cos(ang)[:, :, None, :].astype(dtype), jnp.sin(ang)[:, :, None, :].astype(dtype)


def rope_partial(t, cos, sin):
    half = ROT_DIM // 2
    r1, r2, rest = t[..., :half], t[..., half:ROT_DIM], t[..., ROT_DIM:]
    return jnp.concatenate([r1 * cos - r2 * sin, r2 * cos + r1 * sin, rest], axis=-1)


def dilated_group_attn(q, k, v, dil):
    bsz, seq, nh, dh = q.shape
    span = dil * SUB_WIN
    total = -(-seq // span) * span
    padw = ((0, 0), (0, total - seq), (0, 0), (0, 0))
    nb = total // span
    split = lambda a: jnp.pad(a, padw).reshape(bsz, nb, SUB_WIN, dil, nh, dh)
    qb, kb, vb = split(q), split(k), split(v)
    band = lambda a: jnp.concatenate(
        [jnp.concatenate([jnp.zeros_like(a[:, :1]), a[:, :-1]], axis=1), a], axis=2)
    k_band, v_band = band(kb), band(vb)
    s = jnp.einsum('bnqrhd,bnkrhd->bnrhqk', qb, k_band,
                   preferred_element_type=jnp.float32) * (1.0 / math.sqrt(dh))
    blk = jnp.arange(nb)[:, None, None]
    qi = jnp.arange(SUB_WIN)[None, :, None]
    kj = jnp.arange(2 * SUB_WIN)[None, None, :]
    valid = (kj >= qi) & (kj <= qi + SUB_WIN) & ((kj >= SUB_WIN) | (blk > 0))
    s = jnp.where(valid[None, :, None, None, :, :], s, -jnp.inf)
    m = jnp.max(s, axis=-1, keepdims=True)
    p = jnp.exp(s - m)
    l = jnp.sum(p, axis=-1)
    o = jnp.einsum('bnrhqk,bnkrhd->bnqrhd', p, v_band.astype(jnp.float32))
    l_t = jnp.transpose(l, (0, 1, 4, 2, 3))
    o = o / l_t[..., None]
    lse = jnp.transpose(m[..., 0], (0, 1, 4, 2, 3)) + jnp.log(l_t)
    o = o.reshape(bsz, total, nh, dh)[:, :seq]
    lse = lse.reshape(bsz, total, nh)[:, :seq]
    return o, lse


def dilated_attention(x, cos, sin, w_in, w_out):
    bsz, seq, _ = x.shape
    proj = jnp.matmul(x, w_in).reshape(bsz, seq, N_DIL_GROUPS, 3, ATTN_HEADS_PER_GROUP, ATTN_HEAD_DIM)
    outs, lses = [], []
    for g, (win, dil) in enumerate(DIL_GROUPS):
        q = rope_partial(proj[:, :, g, 0], cos, sin)
        k = rope_partial(proj[:, :, g, 1], cos, sin)
        o, lse = dilated_group_attn(q, k, proj[:, :, g, 2], dil)
        outs.append(o)
        lses.append(lse)
    w = jax.nn.softmax(jnp.stack(lses, axis=0), axis=0)
    o = jnp.sum(w[..., None] * jnp.stack(outs, axis=0), axis=0).astype(x.dtype)
    return jnp.matmul(o.reshape(bsz, seq, ATTN_HEADS_PER_GROUP * ATTN_HEAD_DIM), w_out)


def ssd_chunked(xh, dt, a, bm, cm, d_skip):
    bsz, seq = xh.shape[:2]
    nc, Q, G, R = seq // SSM_CHUNK, SSM_CHUNK, SSM_GROUPS, SSM_HEADS_PER_GROUP
    f32 = jnp.float32
    x = xh.astype(f32).reshape(bsz, nc, Q, G, R, SSM_HEAD_DIM)
    dt = dt.reshape(bsz, nc, Q, G, R)
    bm = bm.astype(f32).reshape(bsz, nc, Q, G, SSM_D_STATE)
    cm = cm.astype(f32).reshape(bsz, nc, Q, G, SSM_D_STATE)
    a_cum = jnp.cumsum(dt * a.reshape(G, R), axis=2)
    xdt = x * dt[..., None]
    causal = (jnp.arange(Q)[:, None] >= jnp.arange(Q)[None, :])[None, None, :, :, None, None]
    diff = a_cum[:, :, :, None] - a_cum[:, :, None, :]
    lmat = jnp.exp(jnp.where(causal, diff, -jnp.inf))
    cb = jnp.einsum('bclgn,bcsgn->bclsg', cm, bm)
    y_diag = jnp.einsum('bclsgr,bcsgrp->bclgrp', cb[..., None] * lmat, xdt)
    decay_states = jnp.exp(a_cum[:, :, -1:] - a_cum)
    states = jnp.einsum('bcsgn,bcsgrp->bcgrpn', bm, decay_states[..., None] * xdt)
    chunk_decay = jnp.exp(a_cum[:, :, -1])

    def step(h, inp):
        st, dec = inp
        return h * dec[..., None, None] + st, h

    h0 = jnp.zeros((bsz, G, R, SSM_HEAD_DIM, SSM_D_STATE), f32)
    _, prev = lax.scan(step, h0, (jnp.moveaxis(states, 1, 0), jnp.moveaxis(chunk_decay, 1, 0)))
    prev = jnp.moveaxis(prev, 0, 1)
    y_off = jnp.einsum('bclgn,bcgrpn->bclgrp', cm, prev) * jnp.exp(a_cum)[..., None]
    y = y_diag + y_off + x * d_skip.astype(f32).reshape(G, R)[:, :, None]
    return y.reshape(bsz, seq, SSM_D_INNER)


def mamba2_mixer(x, w_in, conv_w, conv_b, dt_bias, a_log, d_skip, norm_w, w_out):
    bsz, seq, _ = x.shape
    zxbcdt = jnp.matmul(x, w_in)
    z = zxbcdt[..., :SSM_D_INNER]
    xbc = zxbcdt[..., SSM_D_INNER:SSM_D_INNER + SSM_CONV_DIM]
    dt = zxbcdt[..., SSM_D_INNER + SSM_CONV_DIM:]
    xbc = lax.conv_general_dilated(xbc, conv_w[:, None, :].astype(xbc.dtype), window_strides=(1,),
                                   padding=[(SSM_CONV - 1, 0)], dimension_numbers=('NWC', 'WIO', 'NWC'),
                                   feature_group_count=SSM_CONV_DIM)
    xbc = jax.nn.silu(xbc + conv_b)
    gn = SSM_GROUPS * SSM_D_STATE
    xs = xbc[..., :SSM_D_INNER].reshape(bsz, seq, SSM_HEADS, SSM_HEAD_DIM)
    bm = xbc[..., SSM_D_INNER:SSM_D_INNER + gn].reshape(bsz, seq, SSM_GROUPS, SSM_D_STATE)
    cm = xbc[..., SSM_D_INNER + gn:].reshape(bsz, seq, SSM_GROUPS, SSM_D_STATE)
    dt = jax.nn.softplus((dt + dt_bias).astype(jnp.float32))
    a = -jnp.exp(a_log.astype(jnp.float32))
    y = ssd_chunked(xs, dt, a, bm, cm, d_skip)
    yg = (y * jax.nn.silu(z.astype(jnp.float32))).reshape(bsz, seq, SSM_GROUPS, SSM_D_INNER // SSM_GROUPS)
    yg = yg * lax.rsqrt(jnp.mean(jnp.square(yg), axis=-1, keepdims=True) + RMS_EPS)
    yg = yg.reshape(bsz, seq, SSM_D_INNER).astype(x.dtype) * norm_w
    return jnp.matmul(yg, w_out)


def moe_ffn(x, w_router, b_router, w_up, b_up, w_down, b_down):
    bsz, seq, d = x.shape
    xt = x.reshape(-1, d)
    n_tok = xt.shape[0]
    n_assign = n_tok * TOP_K
    logits = jnp.matmul(xt, w_router, preferred_element_type=jnp.float32) + b_router.astype(jnp.float32)
    top_logits, top_idx = lax.top_k(logits, TOP_K)
    gates = jax.nn.softmax(top_logits, axis=-1).astype(x.dtype)
    flat_e = top_idx.reshape(-1)
    order = jnp.argsort(flat_e, stable=True)
    sorted_e = flat_e[order]
    counts = jnp.bincount(flat_e, length=N_EXPERTS)
    starts = jnp.cumsum(counts) - counts
    rank = jnp.arange(n_assign) - starts[sorted_e]
    padded = (counts + MOE_BLOCK - 1) // MOE_BLOCK * MOE_BLOCK
    pad_ends = jnp.cumsum(padded)
    pad_starts = pad_ends - padded
    dest = jnp.zeros((n_assign,), jnp.int32).at[order].set((pad_starts[sorted_e] + rank).astype(jnp.int32))
    n_blocks = -(-n_assign // MOE_BLOCK) + N_EXPERTS
    x_rows = jnp.zeros((n_blocks * MOE_BLOCK, d), x.dtype).at[dest].set(jnp.repeat(xt, TOP_K, axis=0))
    block_e = jnp.minimum(jnp.searchsorted(pad_ends, jnp.arange(n_blocks) * MOE_BLOCK, side='right'),
                          N_EXPERTS - 1)

    def expert_block(args):
        xb, e = args
        h = jnp.matmul(xb, w_up[e]) + b_up[e]
        gate = jnp.minimum(h[:, :D_FF], SWIGLU_LIMIT)
        up = jnp.clip(h[:, D_FF:], -SWIGLU_LIMIT, SWIGLU_LIMIT)
        glu = gate * jax.nn.sigmoid(SWIGLU_ALPHA * gate)
        return jnp.matmul((up + 1.0) * glu, w_down[e]) + b_down[e]

    y_rows = lax.map(expert_block, (x_rows.reshape(n_blocks, MOE_BLOCK, d), block_e))
    y = y_rows.reshape(-1, d)[dest].reshape(n_tok, TOP_K, d)
    return jnp.einsum('tk,tkd->td', gates, y).reshape(bsz, seq, d)


def setup_inputs(seed: int = 0) -> dict:
    key = jax.random.key(seed)
    ks = jax.random.split(key, 24)
    nrm = lambda k, shape, scale: jax.random.normal(k, shape, jnp.float32) * scale
    x = jax.random.normal(ks[0], (BATCH, SEQ, D_MODEL), jnp.float32)
    offs = jax.random.randint(ks[1], (BATCH, 1), 0, 1024, dtype=jnp.int32)
    positions = jnp.arange(SEQ, dtype=jnp.int32)[None, :] + offs
    attn_w_in = nrm(ks[2], (N_ATTN_LAYERS, D_MODEL, ATTN_PROJ), D_MODEL ** -0.5)
    attn_w_out = nrm(ks[3], (N_ATTN_LAYERS, ATTN_HEADS_PER_GROUP * ATTN_HEAD_DIM, D_MODEL),
                     DEEPNORM_BETA * (ATTN_HEADS_PER_GROUP * ATTN_HEAD_DIM) ** -0.5)
    ssm_w_in = nrm(ks[4], (N_SSM_LAYERS, D_MODEL, SSM_PROJ), D_MODEL ** -0.5)
    ssm_conv_w = nrm(ks[5], (N_SSM_LAYERS, SSM_CONV, SSM_CONV_DIM), SSM_CONV ** -0.5)
    ssm_conv_b = nrm(ks[6], (N_SSM_LAYERS, SSM_CONV_DIM), 0.02)
    dt0 = jnp.exp(jax.random.uniform(ks[7], (N_SSM_LAYERS, SSM_HEADS), jnp.float32,
                                     math.log(1e-3), math.log(1e-1)))
    ssm_dt_bias = dt0 + jnp.log(-jnp.expm1(-dt0))
    ssm_a_log = jnp.log(jax.random.uniform(ks[8], (N_SSM_LAYERS, SSM_HEADS), jnp.float32, 1.0, 16.0))
    ssm_d = 1.0 + nrm(ks[9], (N_SSM_LAYERS, SSM_HEADS), 0.1)
    ssm_norm_w = 1.0 + nrm(ks[10], (N_SSM_LAYERS, SSM_D_INNER), 0.1)
    ssm_w_out = nrm(ks[11], (N_SSM_LAYERS, SSM_D_INNER, D_MODEL), DEEPNORM_BETA * SSM_D_INNER ** -0.5)
    moe_w_router = nrm(ks[12], (DEPTH, D_MODEL, N_EXPERTS), D_MODEL ** -0.5)
    moe_b_router = nrm(ks[13], (DEPTH, N_EXPERTS), 0.01)
    moe_w_up = nrm(ks[14], (DEPTH, N_EXPERTS, D_MODEL, 2 * D_FF), D_MODEL ** -0.5)
    moe_b_up = nrm(ks[15], (DEPTH, N_EXPERTS, 2 * D_FF), 0.02)
    moe_w_down = nrm(ks[16], (DEPTH, N_EXPERTS, D_FF, D_MODEL), DEEPNORM_BETA * D_FF ** -0.5)
    moe_b_down = nrm(ks[17], (DEPTH, N_EXPERTS, D_MODEL), 0.02)
    ln_mix_g = 1.0 + nrm(ks[18], (DEPTH, D_MODEL), 0.1)
    ln_mix_b = nrm(ks[19], (DEPTH, D_MODEL), 0.02)
    ln_ffn_g = 1.0 + nrm(ks[20], (DEPTH, D_MODEL), 0.1)
    ln_ffn_b = nrm(ks[21], (DEPTH, D_MODEL), 0.02)
    return {"x": x, "positions": positions, "attn_w_in": attn_w_in, "attn_w_out": attn_w_out,
            "ssm_w_in": ssm_w_in, "ssm_conv_w": ssm_conv_w, "ssm_conv_b": ssm_conv_b,
            "ssm_dt_bias": ssm_dt_bias, "ssm_a_log": ssm_a_log, "ssm_d": ssm_d,
            "ssm_norm_w": ssm_norm_w, "ssm_w_out": ssm_w_out,
            "moe_w_router": moe_w_router, "moe_b_router": moe_b_router, "moe_w_up": moe_w_up,
            "moe_b_up": moe_b_up, "moe_w_down": moe_w_down, "moe_b_down": moe_b_down,
            "ln_mix_g": ln_mix_g, "ln_mix_b": ln_mix_b, "ln_ffn_g": ln_ffn_g, "ln_ffn_b": ln_ffn_b}


def reference(x, positions, attn_w_in, attn_w_out, ssm_w_in, ssm_conv_w, ssm_conv_b, ssm_dt_bias,
              ssm_a_log, ssm_d, ssm_norm_w, ssm_w_out, moe_w_router, moe_b_router, moe_w_up,
              moe_b_up, moe_w_down, moe_b_down, ln_mix_g, ln_mix_b, ln_ffn_g, ln_ffn_b):
    cos, sin = rope_tables(positions, x.dtype)
    for i in range(DEPTH):
        j = i // N_MIXERS
        if i % N_MIXERS == 0:
            mix = dilated_attention(x, cos, sin, attn_w_in[j], attn_w_out[j])
        else:
            mix = mamba2_mixer(x, ssm_w_in[j], ssm_conv_w[j], ssm_conv_b[j], ssm_dt_bias[j],
                               ssm_a_log[j], ssm_d[j], ssm_norm_w[j], ssm_w_out[j])
        x = layer_norm(DEEPNORM_ALPHA * x + mix, ln_mix_g[i], ln_mix_b[i])
        ffn = moe_ffn(x, moe_w_router[i], moe_b_router[i], moe_w_up[i], moe_b_up[i],
                      moe_w_down[i], moe_b_down[i])
        x = layer_norm(DEEPNORM_ALPHA * x + ffn, ln_ffn_g[i], ln_ffn_b[i])
    return x
```

```cpp
#include <hip/hip_runtime.h>
#include <cstdio>
#include <cstdint>

#ifndef MK_PER_PHASE
#define MK_PER_PHASE 0
#endif

#define GAS __attribute__((address_space(1)))
#define LAS __attribute__((address_space(3)))
typedef unsigned short bf16;
typedef short bf16x8 __attribute__((ext_vector_type(8)));
typedef float f32x4 __attribute__((ext_vector_type(4)));
typedef float f32x2 __attribute__((ext_vector_type(2)));
typedef unsigned u32x4 __attribute__((ext_vector_type(4)));
typedef unsigned u32x2 __attribute__((ext_vector_type(2)));

constexpr int BATCH = 8, SEQ = 4096, DM = 1024, T = BATCH * SEQ;
constexpr int NQKV = 9216;
constexpr int NZX = 5120, SSM_PITCH = 5152, DI = 2048;
constexpr int NE = 32;
constexpr float LN_EPS = 1e-5f, RMS_EPS = 1e-5f, ALPHA = 1.41421356237309505f;
constexpr float QSCALE = 0.12751743082459868f;
constexpr float LN2F = 0.6931471805599453f;

constexpr size_t MiB = 1u << 20;
constexpr size_t WS_CTL = 0, CTL_ZERO_BYTES = 128 * 1024;
constexpr size_t WS_ROPE = 1 * MiB;
constexpr size_t WS_GATES = 5 * MiB;
constexpr size_t WS_DT = 6 * MiB;
constexpr size_t WS_LIST = 10 * MiB;
constexpr size_t WS_LSE = 14 * MiB;
constexpr size_t WS_WQKV = 18 * MiB;
constexpr size_t WS_WAO = 36 * MiB;
constexpr size_t WS_WSI = 38 * MiB;
constexpr size_t WS_WSO = 48 * MiB;
constexpr size_t WS_WUP = 52 * MiB;
constexpr size_t WS_XQ = 180 * MiB;
constexpr size_t WS_XQ0 = 212 * MiB;
constexpr size_t WS_WDN = 308 * MiB;
constexpr size_t WS_XBA = 436 * MiB;
constexpr size_t WS_XBB = 500 * MiB;
constexpr size_t WS_X1 = 564 * MiB;
constexpr size_t WS_BIG = 692 * MiB;
constexpr size_t WS_XA = 1012 * MiB;
constexpr size_t WS_CBG = 1204 * MiB;
constexpr size_t WS_HB = WS_BIG;
constexpr size_t WS_YS = 964 * MiB;
constexpr size_t WS_OG = 1268 * MiB;
constexpr size_t WS_OB = 1460 * MiB;
constexpr size_t WS_END = 1524 * MiB;
constexpr int CW_BAR = 4096;
constexpr int CW_CNT = 16384;
constexpr int CW_CVT = 20000;
#ifndef CVT_Q_UP
#define CVT_Q_UP 5
#endif
#ifndef CVT_Q_DN
#define CVT_Q_DN 5
#endif

constexpr int LDS_AUX = 131072;
constexpr int LDS_TAB = 131072 + 17 * 512;
constexpr int LDS_SLOT = LDS_TAB + 2688;
constexpr int LDS_SM = 147456;
constexpr int LDS_MISC = 155648;
constexpr int LDS_BYTES = 156672;

__device__ __forceinline__ float bf2f(unsigned short b) { return __uint_as_float(((unsigned)b) << 16); }
__device__ __forceinline__ float bflo(unsigned w) { return __uint_as_float(w << 16); }
__device__ __forceinline__ float bfhi(unsigned w) { return __uint_as_float(w & 0xffff0000u); }
typedef __bf16 bf16x2_t __attribute__((ext_vector_type(2)));
constexpr float Q8_X = 8.0f, Q8_W = 256.0f, Q8_H = 8.0f, Q8_O = 32.0f, Q8_Y = 32.0f, Q8_Q = 64.0f, Q8_K = 8.0f, Q8_V = 8.0f, Q8_YS = 16.0f;
__device__ __forceinline__ unsigned pk4_f8(float a, float b, float c, float d, float sc) {
    a = __builtin_fminf(__builtin_fmaxf(a * sc, -448.f), 448.f); b = __builtin_fminf(__builtin_fmaxf(b * sc, -448.f), 448.f);
    c = __builtin_fminf(__builtin_fmaxf(c * sc, -448.f), 448.f); d = __builtin_fminf(__builtin_fmaxf(d * sc, -448.f), 448.f);
    int p = __builtin_amdgcn_cvt_pk_fp8_f32(a, b, 0, false); p = __builtin_amdgcn_cvt_pk_fp8_f32(c, d, p, true); return (unsigned)p; }
__device__ __forceinline__ unsigned pk2(float lo, float hi) { const f32x2 v = {lo, hi}; const bf16x2_t b = __builtin_convertvector(v, bf16x2_t); return __builtin_bit_cast(unsigned, b); }
__device__ __forceinline__ float wave_sum(float v) {
#pragma unroll
    for (int o = 1; o < 64; o <<= 1) v += __shfl_xor(v, o);
    return v;
}
constexpr int P256 = 272, P512 = 528;
__device__ __forceinline__ int swz256(int row, int bc) { return row * P256 + bc; }
__device__ __forceinline__ int swz512(int row, int bc) { return row * P512 + bc; }
__device__ __forceinline__ bf16x8 as_bf16x8(u32x4 v) { return __builtin_bit_cast(bf16x8, v); }
__device__ __forceinline__ f32x4 mfma16(bf16x8 a, bf16x8 b, f32x4 c) { return __builtin_amdgcn_mfma_f32_16x16x32_bf16(a, b, c, 0, 0, 0); }
__device__ __forceinline__ void lds_barrier() { asm volatile("s_waitcnt lgkmcnt(0)" ::: "memory"); __builtin_amdgcn_s_barrier(); asm volatile("" ::: "memory"); }
__device__ __forceinline__ float silu_f(float v) { return v * __builtin_amdgcn_rcpf(1.0f + __expf(-v)); }

#define XB_TMO      128
#define XB_XCNT(j)  (256  + 64 * (j))
#define XB_XSUB(j)  (1280 + 64 * (j))
#define XB_XGEN(j)  (2304 + 64 * (j))
#define XB_TOP      3328
#define XB_TOPGEN   3392
#define XCD_BAR_WORDS 3456
#define XB_SPIN_CAP (1u << 18)
__device__ __forceinline__ unsigned xb_ld(unsigned* p)              { return __hip_atomic_load(p, __ATOMIC_RELAXED, __HIP_MEMORY_SCOPE_AGENT); }
__device__ __forceinline__ unsigned xb_add(unsigned* p, unsigned v) { return __hip_atomic_fetch_add(p, v, __ATOMIC_RELAXED, __HIP_MEMORY_SCOPE_AGENT); }
__device__ __forceinline__ unsigned xb_xcc_id() { return (unsigned)__builtin_amdgcn_s_getreg((3 << 11) | 20) & 0xFu; }
#define XB_SPIN(cond, bar) do { unsigned _sp = 0; while (cond) { __builtin_amdgcn_s_sleep(1); \
    if ((++_sp & 255u) == 0u) { if (xb_ld(&(bar)[XB_TMO])) break; if (_sp > XB_SPIN_CAP) { atomicAdd(&(bar)[XB_TMO], 1u); break; } } } } while (0)
struct XcdBarrier { unsigned* bar; unsigned x; volatile LAS unsigned* st; };
__device__ __forceinline__ XcdBarrier xcd_barrier_post(unsigned* bar, volatile LAS unsigned* st) {
    XcdBarrier b; b.bar = bar; b.x = xb_xcc_id(); b.st = st;
    if (threadIdx.x == 0) (void)xb_add(&bar[XB_XCNT(b.x)], 1u);
    return b;
}
__device__ __forceinline__ void xcd_barrier_complete(unsigned* bar, unsigned x, unsigned& nloc, unsigned& nx) {
    const unsigned G = gridDim.x * gridDim.y * gridDim.z;
    unsigned sum, cnt, mine, sp = 0u;
    for (;;) {
        sum = 0u; cnt = 0u; mine = 0u;
#pragma unroll
        for (unsigned j = 0; j < 16; ++j) { const unsigned c = xb_ld(&bar[XB_XCNT(j)]); sum += c; cnt += (c > 0u) ? 1u : 0u; mine = (j == x) ? c : mine; }
        if (sum == G) break;
        __builtin_amdgcn_s_sleep(1);
        if ((++sp & 255u) == 0u) { if (xb_ld(&bar[XB_TMO])) break; if (sp > XB_SPIN_CAP) { atomicAdd(&bar[XB_TMO], 1u); break; } }
    }
    nloc = mine > 0u ? mine : 1u; nx = cnt > 0u ? cnt : 1u;
}
__device__ __forceinline__ void xcd_barrier(const XcdBarrier& b) {
    asm volatile("s_waitcnt vmcnt(0)" ::: "memory");
    __syncthreads();
    if (threadIdx.x == 0) {
        unsigned* bar = b.bar;
        __builtin_amdgcn_s_waitcnt(0);
        unsigned nloc = b.st[0], nx = b.st[1];
        if (nloc == 0u) { xcd_barrier_complete(bar, b.x, nloc, nx); b.st[0] = nloc; b.st[1] = nx; }
        const unsigned old = xb_add(&bar[XB_XSUB(b.x)], 1u);
        const unsigned gen = old / nloc;
        if (old + 1u == (gen + 1u) * nloc) {
            __builtin_amdgcn_fence(__ATOMIC_RELEASE, "agent");
            asm volatile("s_waitcnt vmcnt(0)" ::: "memory");
            const unsigned og = xb_add(&bar[XB_TOP], 1u);
            const unsigned tg = og / nx;
            if (og + 1u == (tg + 1u) * nx) xb_add(&bar[XB_TOPGEN], 1u);
            else XB_SPIN(xb_ld(&bar[XB_TOPGEN]) == tg, bar);
            __builtin_amdgcn_fence(__ATOMIC_ACQUIRE, "agent");
            xb_add(&bar[XB_XGEN(b.x)], 1u);
            asm volatile("s_waitcnt vmcnt(0)" ::: "memory");
        } else {
            XB_SPIN(xb_ld(&bar[XB_XGEN(b.x)]) == gen, bar);
            __builtin_amdgcn_fence(__ATOMIC_ACQUIRE, "agent");
            asm volatile("s_waitcnt vmcnt(0)" ::: "memory");
        }
    }
    __syncthreads();
}

namespace pg8 {
constexpr int BM = 256, BK = 64, HALF = 128, HTB = HALF * BK * 2, STAGE_BYTES = 8 * HTB, NXCD = 8, WGM = 4;
__host__ __device__ __forceinline__ int lds_byte(int r, int c) { const int st = (r >> 4) * 2 + (c >> 5), rr = r & 15, cc = c & 31, ob = rr * 64 + cc * 2; return st * 1024 + (ob ^ (((ob >> 9) & 1) << 5)); }
__host__ __device__ __forceinline__ void stage_rc(int b, int& R, int& C) { const int st = b / 1024, sb = b % 1024, swz = sb ^ (((sb >> 9) & 1) << 5); R = (st >> 1) * 16 + swz / 64; C = (st & 1) * 32 + (swz % 64) / 2; }
__host__ __device__ __forceinline__ int perm32(int rho) { const int n = rho >> 4, i = rho & 15; return 8 * (i >> 2) + 4 * n + (i & 3); }

struct Unit { int pm, pn, e, r0, cnt, ord; };
typedef int i32x8_t __attribute__((ext_vector_type(8))); typedef int i32x4_t __attribute__((ext_vector_type(4)));
__device__ __forceinline__ i32x8_t cat8(const bf16x8& a, const bf16x8& b) { return __builtin_shufflevector(__builtin_bit_cast(i32x4_t, a), __builtin_bit_cast(i32x4_t, b), 0, 1, 2, 3, 4, 5, 6, 7); }

struct DenseOrder {
    static constexpr bool GATHER_A = false;
    const char* A; const char* Bt; int K, nM, nN, nwg, G, c;
    __device__ __forceinline__ void init(const void* A_, const void* Bt_, int M, int N, int K_, int G_, int c_) { A = (const char*)A_; Bt = (const char*)Bt_; K = K_; nM = M / BM; nN = N / BM; nwg = nM * nN; G = G_; c = c_; }
    __device__ __forceinline__ bool next(int i, Unit& u) const {
        const long L = (long)i * G + c; if (L >= nwg) return false;
        int wgid = (int)L; { const int q = nwg / NXCD, r = nwg % NXCD, xcd = wgid % NXCD, off = wgid / NXCD; wgid = (xcd < r ? xcd * (q + 1) : r * (q + 1) + (xcd - r) * q) + off; }
        const int nig = WGM * nN, gid = wgid / nig, fm = gid * WGM, gsz = (nM - fm) < WGM ? (nM - fm) : WGM;
        u.pm = fm + ((wgid % nig) % gsz); u.pn = (wgid % nig) / gsz; u.e = 0; u.r0 = 0; u.cnt = 0; u.ord = i; return true;
    }
    __device__ __forceinline__ const char* a_base(const Unit& u) const { return A + (size_t)u.pm * ((size_t)BM * K * 2); }
    __device__ __forceinline__ const char* b_base(const Unit& u) const { return Bt + (size_t)u.pn * ((size_t)BM * K * 2); }
    __device__ __forceinline__ void a_offs(const Unit&, unsigned (&v)[2][2]) const {
#pragma unroll
        for (int i = 0; i < 2; ++i) { int R, C; stage_rc((int)threadIdx.x * 16 + i * 8192, R, C);
#pragma unroll
            for (int h = 0; h < 2; ++h) v[h][i] = (unsigned)((h * HALF + R) * K + C) * 2u; }
    }
};
template <bool GATHER> struct MoeOrder {
    static constexpr bool GATHER_A = GATHER;
    const char* A; const char* Bt; int K, N, nN, G, c, NU; const LAS int* tab; const LAS unsigned short* toks;
    __device__ __forceinline__ bool next(int i, Unit& u) const {
        const int L = i * G + c; if (L >= NU) return false;
        const int rb = L / nN; u.pn = L - rb * nN; u.pm = rb;
        const int e = __builtin_amdgcn_readfirstlane(tab[128 + rb]); u.e = e;
        u.r0 = (rb - __builtin_amdgcn_readfirstlane(tab[e])) * 256; u.cnt = __builtin_amdgcn_readfirstlane(tab[64 + e]); u.ord = i; return true;
    }
    __device__ __forceinline__ const char* a_base(const Unit& u) const { return GATHER ? A : A + (size_t)u.pm * ((size_t)BM * K * 2); }
    __device__ __forceinline__ const char* b_base(const Unit& u) const { return Bt + ((size_t)u.e * N + (size_t)u.pn * BM) * ((size_t)K * 2); }
    __device__ __forceinline__ void a_offs(const Unit& u, unsigned (&v)[2][2]) const {
#pragma unroll
        for (int i = 0; i < 2; ++i) { int R, C; stage_rc((int)threadIdx.x * 16 + i * 8192, R, C);
#pragma unroll
            for (int h = 0; h < 2; ++h) {
                if (GATHER) { const unsigned tok = toks[u.ord * 256 + h * HALF + R]; v[h][i] = (tok * (unsigned)K + (unsigned)C) * 2u; }
                else v[h][i] = (unsigned)((h * HALF + R) * K + C) * 2u; } }
    }
};


struct HostNone { struct Regs {}; __device__ __forceinline__ void issue(int, Regs&, f32x4 (&)[2][2][4][2]) const {} __device__ __forceinline__ void finish(const Regs&, const f32x4 (&)[2][2][4][2]) const {} };
struct HostCvt {
    const float* w_up; const float* w_dn; unsigned char* wt_up; unsigned char* wt_dn;
    int base, limit, G, c;
    struct Regs { unsigned char* dst; bool active; };
    __device__ __forceinline__ void issue(int ord, Regs& R, f32x4 (&acc)[2][2][4][2]) const {
        const int w = __builtin_amdgcn_readfirstlane((int)threadIdx.x >> 6), lane = threadIdx.x & 63, kq = lane >> 4, nq = lane & 15;
        const int hi = __builtin_amdgcn_readfirstlane(base + (ord * G + c) * 8 + w);
        R.active = hi < limit; R.dst = nullptr;
        if (R.active) {
            const float* W; int pitch, k0, n0, drow; unsigned char* WT;
            if (hi < 32768) { const int mat = hi >> 10, q = hi & 1023, kb = q >> 5, nb = q & 31; n0 = nb * 64; k0 = kb * 32; pitch = 2048; W = w_up + (size_t)mat * 1024 * 2048; WT = wt_up + (size_t)mat * 2048 * 1024;
                drow = ((n0 & 1023) >> 7) * 256 + (n0 >> 10) * 128 + (n0 & 127); }
            else { const int r = hi - 32768, mat = r >> 9, q = r & 511, kb = q >> 4, nb = q & 15; n0 = nb * 64; k0 = kb * 32; pitch = 1024; W = w_dn + (size_t)mat * 1024 * 1024; WT = wt_dn + (size_t)mat * 1024 * 1024; drow = n0; }
            const char* src = (const char*)(W + (size_t)k0 * pitch + n0); const unsigned voff = (unsigned)(kq * pitch + 4 * nq) * 4u;
#pragma unroll
            for (int i = 0; i < 8; ++i) acc[0][0][i >> 1][i & 1] = __builtin_nontemporal_load((const f32x4*)(src + (size_t)(4 * i) * pitch * 4 + voff));
            R.dst = WT + (size_t)(drow + 4 * nq + kq) * 1024 + k0;
        }
    }
    __device__ __forceinline__ void finish(const Regs& R, const f32x4 (&acc)[2][2][4][2]) const {
        if (R.active) {
            const int lane = threadIdx.x & 63;
            const unsigned sel1 = (lane & 16) ? 0x07030501u : 0x06020400u, sel2 = (lane & 32) ? 0x07060302u : 0x05040100u;
            unsigned o[8];
#pragma unroll
            for (int i = 0; i < 8; ++i) { const f32x4 v = acc[0][0][i >> 1][i & 1]; const unsigned d = pk4_f8(v[0], v[1], v[2], v[3], Q8_W);
                const u32x2 s1 = __builtin_amdgcn_permlane16_swap(d, d, false, false);
                const unsigned t1 = __builtin_amdgcn_perm(s1.y, s1.x, sel1);
                const u32x2 s2 = __builtin_amdgcn_permlane32_swap(t1, t1, false, false);
                o[i] = __builtin_amdgcn_perm(s2.y, s2.x, sel2); }
            *(u32x4*)R.dst = (u32x4){o[0], o[1], o[2], o[3]}; *(u32x4*)(R.dst + 16) = (u32x4){o[4], o[5], o[6], o[7]};
        }
    }
};

template <bool F8 = false, class Epi, class Sched, class Host>
__device__ __forceinline__ void gemm_phase(LAS unsigned char* lds, const int K, const Sched& S, const Epi& E, const Host& H) {
    const int tid = threadIdx.x, wid = __builtin_amdgcn_readfirstlane(tid >> 6), lane = tid & 63, wr = wid >> 2, wc = wid & 3, fr = lane & 15, fq = lane >> 4;
    const int nt = K / BK;
    unsigned voffB[2];
#pragma unroll
    for (int i = 0; i < 2; ++i) { int R, C; stage_rc(tid * 16 + i * 8192, R, C); const int Rb = Epi::PERM ? ((R & ~31) + perm32(R & 31)) : R; voffB[i] = (unsigned)(Rb * K + C) * 2u; }
    const size_t kstep = (size_t)(BK * 2);
    const size_t hstep = (size_t)HALF * K * 2;
    const unsigned ldsw = (unsigned)wid * 1024u;
    const int aoff = lds_byte(wr * 64 + fr, fq * 8), boff = lds_byte(wc * 32 + fr, fq * 8);
#define PG8_SA(b, h) (((b) * 2 + (h)) * HTB)
#define PG8_SB(b, h) ((4 + (b) * 2 + (h)) * HTB)
#define PG8_STAGE(bufoff, gbase, voff) do { _Pragma("unroll") for (int _i = 0; _i < 2; ++_i) \
        __builtin_amdgcn_global_load_lds((const unsigned*)((const char*)(gbase) + (voff)[_i]), (LAS unsigned*)(lds + (bufoff) + ldsw + _i * 8192), 16, 0, 0); } while (0)
#define PG8_LDA(dst, b, h) do { _Pragma("unroll") for (int m = 0; m < 4; ++m) _Pragma("unroll") for (int k = 0; k < 2; ++k) dst[m][k] = *(const LAS bf16x8*)(lds + PG8_SA(b, h) + aoff + m * 2048 + k * 1024); } while (0)
#define PG8_LDB(dst, b, h) do { _Pragma("unroll") for (int n = 0; n < 2; ++n) _Pragma("unroll") for (int k = 0; k < 2; ++k) dst[n][k] = *(const LAS bf16x8*)(lds + PG8_SB(b, h) + boff + n * 2048 + k * 1024); } while (0)
#define PG8_MMA(ai, bj, At, Bt) do { __builtin_amdgcn_s_setprio(1); _Pragma("unroll") for (int m = 0; m < 4; ++m) _Pragma("unroll") for (int n = 0; n < 2; ++n) { \
        if constexpr (F8) { const i32x8_t b8_ = cat8(Bt[n][0], Bt[n][1]), a8_ = cat8(At[m][0], At[m][1]); asm volatile("v_mfma_f32_16x16x128_f8f6f4 %0, %1, %2, %0" : "+v"(acc[ai][bj][m][n]) : "v"(b8_), "v"(a8_)); } \
        else { _Pragma("unroll") for (int k = 0; k < 2; ++k) acc[ai][bj][m][n] = __builtin_amdgcn_mfma_f32_16x16x32_bf16(Bt[n][k], At[m][k], acc[ai][bj][m][n], 0, 0, 0); } } __builtin_amdgcn_s_setprio(0); } while (0)
#define PG8_WAIT_V(n) asm volatile("s_waitcnt vmcnt(" #n ")" ::: "memory")
#define PG8_WAIT_L(n) asm volatile("s_waitcnt lgkmcnt(" #n ")" ::: "memory")
#define PG8_BAR __builtin_amdgcn_s_barrier()
#define PG8_SCHED __builtin_amdgcn_sched_barrier(0)
    Unit cur, nxt; int ui = 0;
    if (!S.next(0, cur)) return;
    f32x4 acc[2][2][4][2];
#pragma unroll
    for (int a = 0; a < 2; ++a)
#pragma unroll
        for (int b = 0; b < 2; ++b)
#pragma unroll
            for (int m = 0; m < 4; ++m)
#pragma unroll
                for (int n = 0; n < 2; ++n) acc[a][b][m][n] = (f32x4){0.f, 0.f, 0.f, 0.f};
    bf16x8 At[4][2], B0[2][2], B1[2][2];
    constexpr bool GA = Sched::GATHER_A;
    unsigned vA[2][2], nvA[2][2];
    S.a_offs(cur, vA);
    const size_t ah = GA ? 0 : hstep;
#define PG8_VA1 (GA ? vA[1] : vA[0])
    const char* cA = S.a_base(cur); const char* cB = S.b_base(cur);
    PG8_STAGE(PG8_SB(0, 0), cB, voffB); PG8_STAGE(PG8_SB(0, 1), cB + hstep, voffB); PG8_STAGE(PG8_SA(0, 0), cA, vA[0]); PG8_STAGE(PG8_SA(0, 1), cA + ah, PG8_VA1);
    if (wr == 1) PG8_BAR;
    PG8_WAIT_V(2); PG8_BAR;
    PG8_STAGE(PG8_SB(1, 0), cB + kstep, voffB); PG8_STAGE(PG8_SA(1, 0), cA + kstep, vA[0]); PG8_STAGE(PG8_SB(1, 1), cB + hstep + kstep, voffB);
    PG8_WAIT_V(6); PG8_BAR;
    for (;;) {
        const bool has_next = S.next(ui + 1, nxt);
        const char* nA = cA; const char* nB = cB;
#pragma unroll
        for (int h = 0; h < 2; ++h)
#pragma unroll
            for (int i = 0; i < 2; ++i) nvA[h][i] = vA[h][i];
        if (has_next) { nA = S.a_base(nxt); nB = S.b_base(nxt); if constexpr (GA) S.a_offs(nxt, nvA); }
        constexpr int NGRP = Epi::RESCALE ? 4 : 1; const int tper = nt / NGRP;
        for (int gq = 0; gq < NGRP; ++gq) {
        if constexpr (Epi::RESCALE) { if (gq > 0) { if constexpr (F8) asm volatile("s_nop 15\n\ts_nop 15" ::: "memory"); E.rescale(acc, cur, gq, wr, fr); } }
#pragma unroll 1
        for (int t = gq * tper; t < (gq + 1) * tper; t += 2) {
            const bool last = (t == nt - 2);
            const char* a1 = cA + (size_t)(t + 1) * kstep;
            const char* a2 = last ? nA : cA + (size_t)(t + 2) * kstep; const char* b2 = last ? nB : cB + (size_t)(t + 2) * kstep;
            const char* a3 = a2 + kstep; const char* b3 = b2 + kstep;
            unsigned w0[2], w1[2];
#pragma unroll
            for (int i = 0; i < 2; ++i) { if constexpr (GA) { w0[i] = last ? nvA[0][i] : vA[0][i]; w1[i] = last ? nvA[1][i] : vA[1][i]; } else { w0[i] = vA[0][i]; w1[i] = vA[0][i]; } }
            PG8_LDB(B0, 0, 0); PG8_LDB(B1, 0, 1); PG8_SCHED; PG8_LDA(At, 0, 0); PG8_STAGE(PG8_SA(1, 1), a1 + ah, PG8_VA1);
            PG8_WAIT_V(8); PG8_WAIT_L(0); PG8_BAR; PG8_MMA(0, 0, At, B0); PG8_MMA(0, 1, At, B1); PG8_BAR; PG8_SCHED;
            PG8_LDA(At, 0, 1); PG8_STAGE(PG8_SB(0, 0), b2, voffB); PG8_STAGE(PG8_SB(0, 1), b2 + hstep, voffB); PG8_STAGE(PG8_SA(0, 0), a2, w0);
            PG8_WAIT_V(8); PG8_WAIT_L(0); PG8_BAR; PG8_MMA(1, 0, At, B0); PG8_MMA(1, 1, At, B1); PG8_BAR; PG8_SCHED;
            PG8_LDB(B0, 1, 0); PG8_LDB(B1, 1, 1); PG8_SCHED; PG8_LDA(At, 1, 0); PG8_STAGE(PG8_SA(0, 1), a2 + ah, w1);
            PG8_WAIT_V(8); PG8_WAIT_L(0); PG8_BAR; PG8_MMA(0, 0, At, B0); PG8_MMA(0, 1, At, B1); PG8_BAR; PG8_SCHED;
            PG8_LDA(At, 1, 1); PG8_STAGE(PG8_SB(1, 0), b3, voffB); PG8_STAGE(PG8_SB(1, 1), b3 + hstep, voffB); PG8_STAGE(PG8_SA(1, 0), a3, w0);
            PG8_WAIT_V(8); PG8_WAIT_L(0); PG8_BAR; PG8_MMA(1, 0, At, B0); PG8_MMA(1, 1, At, B1); PG8_BAR; PG8_SCHED;
        }
        }
        if (wr == 0) PG8_BAR;
        if constexpr (F8) asm volatile("s_nop 15\n\ts_nop 15" ::: "memory");
        E(acc, cur, wr, wc, fr, fq, 0);
        __builtin_amdgcn_sched_barrier(0); asm volatile("" ::: "memory");
        typename Host::Regs hr; H.issue(cur.ord, hr, acc);
        __builtin_amdgcn_sched_barrier(0); asm volatile("" ::: "memory");
        E(acc, cur, wr, wc, fr, fq, 1);
        __builtin_amdgcn_sched_barrier(0);
        H.finish(hr, acc);
        if (!has_next) break;
#pragma unroll
        for (int a = 0; a < 2; ++a)
#pragma unroll
            for (int b = 0; b < 2; ++b)
#pragma unroll
                for (int m = 0; m < 4; ++m)
#pragma unroll
                    for (int n = 0; n < 2; ++n) acc[a][b][m][n] = (f32x4){0.f, 0.f, 0.f, 0.f};
        cur = nxt; cA = nA; cB = nB; ++ui;
#pragma unroll
        for (int h = 0; h < 2; ++h)
#pragma unroll
            for (int i = 0; i < 2; ++i) vA[h][i] = nvA[h][i];
        if (wr == 1) PG8_BAR;
    }
    PG8_WAIT_V(0);
    PG8_BAR;
#undef PG8_VA1
#undef PG8_SA
#undef PG8_SB
#undef PG8_STAGE
#undef PG8_LDA
#undef PG8_LDB
#undef PG8_MMA
#undef PG8_WAIT_V
#undef PG8_WAIT_L
#undef PG8_BAR
#undef PG8_SCHED
}

struct EpiF32 {
    static constexpr bool PERM = false; static constexpr bool RESCALE = false;
    float* C; int ldc;
    __device__ __forceinline__ void operator()(const f32x4 (&acc)[2][2][4][2], const Unit& u, int wr, int wc, int fr, int fq, const int ai) const {
        const int row0 = u.pm * BM + wr * 64 + fr, col0 = u.pn * BM + wc * 32 + 4 * fq;

#pragma unroll
            for (int m = 0; m < 4; ++m) { float* rowp = C + (size_t)(row0 + ai * HALF + m * 16) * ldc + col0;
#pragma unroll
                for (int bj = 0; bj < 2; ++bj)
#pragma unroll
                    for (int n = 0; n < 2; ++n) *(f32x4*)(rowp + bj * HALF + n * 16) = acc[ai][bj][m][n]; }
    }
};
struct EpiBf16 {
    static constexpr bool PERM = true; static constexpr bool RESCALE = false;
    bf16* O; int ldc; float sc;
    __device__ __forceinline__ void operator()(const f32x4 (&acc)[2][2][4][2], const Unit& u, int wr, int wc, int fr, int fq, const int ai) const {
        const int row0 = u.pm * BM + wr * 64 + fr, col0 = u.pn * BM + wc * 32 + 8 * fq;

#pragma unroll
            for (int m = 0; m < 4; ++m) { bf16* rowp = O + (size_t)(row0 + ai * HALF + m * 16) * ldc + col0;
#pragma unroll
                for (int bj = 0; bj < 2; ++bj) { const f32x4 v0 = acc[ai][bj][m][0] * sc, v1 = acc[ai][bj][m][1] * sc;
                    u32x4 w; w.x = pk2(v0[0], v0[1]); w.y = pk2(v0[2], v0[3]); w.z = pk2(v1[0], v1[1]); w.w = pk2(v1[2], v1[3]);
                    __builtin_nontemporal_store(w, (u32x4*)(rowp + bj * HALF)); } }
    }
};
struct EpiRms {
    static constexpr bool PERM = true; static constexpr bool RESCALE = true;
    bf16* O; int ldc; const LAS float* stab;
    __device__ __forceinline__ void rescale(f32x4 (&acc)[2][2][4][2], const Unit& u, int g, int wr, int fr) const {
        const LAS float* tb = stab + (u.ord * 256 + wr * 64 + fr) * 4 + g;
#pragma unroll
        for (int ai = 0; ai < 2; ++ai)
#pragma unroll
            for (int m = 0; m < 4; ++m) { const LAS float* p = tb + (ai * HALF + m * 16) * 4; const float ratio = p[-1] * __builtin_amdgcn_rcpf(p[0]);
#pragma unroll
                for (int bj = 0; bj < 2; ++bj)
#pragma unroll
                    for (int n = 0; n < 2; ++n) acc[ai][bj][m][n] = acc[ai][bj][m][n] * ratio; }
    }
    __device__ __forceinline__ void operator()(const f32x4 (&acc)[2][2][4][2], const Unit& u, int wr, int wc, int fr, int fq, const int ai) const {
        const int row0 = u.pm * BM + wr * 64 + fr, col0 = u.pn * BM + wc * 32 + 8 * fq;
        const LAS float* tb = stab + (u.ord * 256 + wr * 64 + fr) * 4 + 3;

#pragma unroll
            for (int m = 0; m < 4; ++m) { const int row = row0 + ai * HALF + m * 16; const float s3 = tb[(ai * HALF + m * 16) * 4]; bf16* rowp = (bf16*)((char*)O + (unsigned)((row * ldc + col0) * 2));
#pragma unroll
                for (int bj = 0; bj < 2; ++bj) { const f32x4 v0 = acc[ai][bj][m][0] * s3, v1 = acc[ai][bj][m][1] * s3;
                    u32x4 w; w.x = pk2(v0[0], v0[1]); w.y = pk2(v0[2], v0[3]); w.z = pk2(v1[0], v1[1]); w.w = pk2(v1[2], v1[3]);
                    __builtin_nontemporal_store(w, (u32x4*)(rowp + bj * HALF)); } }
    }
};
struct EpiQKV {
    static constexpr bool PERM = true; static constexpr bool RESCALE = false;
    unsigned char* O; const float* rope; float ds;
    __device__ __forceinline__ void operator()(const f32x4 (&acc)[2][2][4][2], const Unit& u, int wr, int wc, int fr, int fq, const int ai) const {
        const int row0 = u.pm * BM + wr * 64 + fr;
        const int col_t = u.pn * BM;
        const int s = (col_t % 3072) >> 10;
        const float sc = ((s == 0) ? QSCALE * Q8_Q : ((s == 1) ? Q8_K : Q8_V)) * ds;
        const int gq = col_t / 3072, lg = 2 * gq, dlm = (1 << lg) - 1, mat0 = gq * 24 + s * 8 + ((col_t & 1023) >> 7);
        const bool rot = (s < 2) && (fq == 0);
        {
#pragma unroll
            for (int m = 0; m < 4; ++m) {
                const int row = row0 + ai * HALF + m * 16;
                const int tt = row & (SEQ - 1), rowp = (row & ~(SEQ - 1)) + ((tt & (dlm)) << (12 - lg)) + (tt >> lg);
                f32x4 cs = (f32x4){1.f, 1.f, 1.f, 1.f}, sn = (f32x4){0.f, 0.f, 0.f, 0.f};
                if (rot) { const float* rp = rope + (size_t)row * 32 + 4 * wc; cs = *(const f32x4*)rp; sn = *(const f32x4*)(rp + 16); }
#pragma unroll
                for (int bj = 0; bj < 2; ++bj) {
                    f32x4 v0 = acc[ai][bj][m][0], v1 = acc[ai][bj][m][1];
                    if (rot) { const f32x4 a0 = v0 * cs - v1 * sn, a1 = v1 * cs + v0 * sn; v0 = a0; v1 = a1; }
                    u32x2 w; w.x = pk4_f8(v0[0], v0[1], v0[2], v0[3], sc); w.y = pk4_f8(v1[0], v1[1], v1[2], v1[3], sc);
                    *(u32x2*)(O + ((size_t)(mat0 + bj) * T + rowp) * 128 + wc * 32 + 8 * fq) = w;
                }
            }
        }
    }
};
struct EpiUp {
    static constexpr bool PERM = true; static constexpr bool RESCALE = false;
    unsigned char* HB; const LAS unsigned* btab;
    __device__ __forceinline__ void operator()(const f32x4 (&acc)[2][2][4][2], const Unit& u, int wr, int wc, int fr, int fq, const int ai) const {
        const int row0 = u.pm * BM + wr * 64 + fr, col0 = u.pn * HALF + wc * 32 + 8 * fq;
        const LAS unsigned* bp = btab + u.ord * 128 + (wc * 32 + 8 * fq) / 2;
        const u32x4 gw = *(const LAS u32x4*)bp, uw = *(const LAS u32x4*)(bp + 64);
        f32x2 bg[4], bu[4];
#pragma unroll
        for (int i = 0; i < 4; ++i) { bg[i] = (f32x2){bflo(gw[i]), bfhi(gw[i])}; bu[i] = (f32x2){bflo(uw[i]), bfhi(uw[i])}; }
        constexpr float DS = 1.0f / (Q8_X * Q8_W), KE = -1.702f * 1.4426950408889634f;

#pragma unroll
            for (int m = 0; m < 4; ++m) {
                f32x2 o[4];
#pragma unroll
                for (int i = 0; i < 4; ++i) { const int n = i >> 1, j = 2 * (i & 1);
                    f32x2 gt = (f32x2){acc[ai][0][m][n][j], acc[ai][0][m][n][j + 1]} * DS + bg[i];
                    f32x2 up = (f32x2){acc[ai][1][m][n][j], acc[ai][1][m][n][j + 1]} * DS + bu[i];
                    gt[0] = fminf(gt[0], 7.0f); gt[1] = fminf(gt[1], 7.0f);
                    up[0] = __builtin_amdgcn_fmed3f(up[0], -7.0f, 7.0f); up[1] = __builtin_amdgcn_fmed3f(up[1], -7.0f, 7.0f);
                    f32x2 e = gt * KE; e[0] = __builtin_amdgcn_exp2f(e[0]); e[1] = __builtin_amdgcn_exp2f(e[1]);
                    e = e + 1.0f; e[0] = __builtin_amdgcn_rcpf(e[0]); e[1] = __builtin_amdgcn_rcpf(e[1]);
                    o[i] = (up * Q8_H + Q8_H) * (gt * e); }
                u32x2 w;
                { int p0 = __builtin_amdgcn_cvt_pk_fp8_f32(o[0][0], o[0][1], 0, false); p0 = __builtin_amdgcn_cvt_pk_fp8_f32(o[1][0], o[1][1], p0, true);
                  int p1 = __builtin_amdgcn_cvt_pk_fp8_f32(o[2][0], o[2][1], 0, false); p1 = __builtin_amdgcn_cvt_pk_fp8_f32(o[3][0], o[3][1], p1, true); w.x = (unsigned)p0; w.y = (unsigned)p1; }
                *(u32x2*)(HB + (size_t)(row0 + ai * HALF + m * 16) * 1024 + col0) = w;
            }
    }
};
struct EpiDown {
    static constexpr bool PERM = true; static constexpr bool RESCALE = false;
    unsigned char* YS; const LAS unsigned* btab; const LAS int* slots;
    __device__ __forceinline__ void operator()(const f32x4 (&acc)[2][2][4][2], const Unit& u, int wr, int wc, int fr, int fq, const int ai) const {
        const int col0 = u.pn * BM + wc * 32 + 8 * fq;
        const LAS unsigned* bp = btab + u.ord * 128 + (wc * 32 + 8 * fq) / 2;
        f32x4 bv[2][2];
#pragma unroll
        for (int bj = 0; bj < 2; ++bj) { const u32x4 bw = *(const LAS u32x4*)(bp + bj * 64);
            bv[bj][0] = (f32x4){bflo(bw.x), bfhi(bw.x), bflo(bw.y), bfhi(bw.y)}; bv[bj][1] = (f32x4){bflo(bw.z), bfhi(bw.z), bflo(bw.w), bfhi(bw.w)}; }

#pragma unroll
            for (int m = 0; m < 4; ++m) {
                const int slot = slots[u.ord * 256 + ai * HALF + wr * 64 + m * 16 + fr];
                if (slot >= 0) {
                    unsigned char* rowp = YS + (size_t)slot * 1024 + col0;
#pragma unroll
                    for (int bj = 0; bj < 2; ++bj) { const f32x4 v0 = acc[ai][bj][m][0] * (1.0f / (Q8_H * Q8_W)) + bv[bj][0], v1 = acc[ai][bj][m][1] * (1.0f / (Q8_H * Q8_W)) + bv[bj][1];
                        u32x2 w; w.x = pk4_f8(v0[0], v0[1], v0[2], v0[3], Q8_Y); w.y = pk4_f8(v1[0], v1[1], v1[2], v1[3], Q8_Y);
                        *(u32x2*)(rowp + bj * HALF) = w; }
                }
            }
    }
};
}

struct TrItem { const float* W; const float* kscale; bf16* WT; int pitch, K, k0, n0, dstrow0, q8, hperm; };
__device__ __forceinline__ void tr_load(const TrItem& d, f32x4 (&ld)[16], int lane) {
    const int kq = lane >> 4, nq = lane & 15;
    const float* src = d.W + (size_t)(d.k0 + kq) * d.pitch + d.n0 + 4 * nq;
#pragma unroll
    for (int i = 0; i < 16; ++i) ld[i] = __builtin_nontemporal_load((const f32x4*)(src + (size_t)(4 * i) * d.pitch));
}
__device__ __forceinline__ void tr_finish(const TrItem& d, const f32x4 (&ld)[16], LAS float* scr, int lane) {
    const int kq = lane >> 4, nq = lane & 15;
#pragma unroll
    for (int i = 0; i < 16; ++i) { f32x4 v = ld[i]; if (d.kscale) v = v * d.kscale[d.k0 + 4 * i + kq]; LAS float* p = scr + (4 * i + kq) * 65 + 4 * nq; p[0] = v[0]; p[1] = v[1]; p[2] = v[2]; p[3] = v[3]; }
    asm volatile("s_waitcnt lgkmcnt(0)" ::: "memory");
    const int c = lane & 7;
    if (d.q8) {
#pragma unroll
        for (int j = 0; j < 8; ++j) { const int n = j * 8 + (lane >> 3); const LAS float* s = scr + (8 * c) * 65 + n;
            u32x2 o; o.x = pk4_f8(s[0 * 65], s[1 * 65], s[2 * 65], s[3 * 65], Q8_W); o.y = pk4_f8(s[4 * 65], s[5 * 65], s[6 * 65], s[7 * 65], Q8_W);
            int row = d.dstrow0 + n;
            if (d.hperm) { const int ng = d.n0 + n; if (((ng % 3072) >> 10) < 2) { const int dd = ng & 127;
                    const int pp = (dd < 32) ? (((dd & 15) >> 2) * 32 + (dd & 3) + 4 * (dd >> 4)) : (((dd - 32) / 24) * 32 + 8 + (dd - 32) % 24); row = (ng & ~127) + pp; } }
            *(u32x2*)((unsigned char*)d.WT + (size_t)row * d.K + d.k0 + 8 * c) = o; }
    } else {
#pragma unroll
    for (int j = 0; j < 8; ++j) { const int n = j * 8 + (lane >> 3); const LAS float* s = scr + (8 * c) * 65 + n;
        u32x4 o; o.x = pk2(s[0 * 65], s[1 * 65]); o.y = pk2(s[2 * 65], s[3 * 65]); o.z = pk2(s[4 * 65], s[5 * 65]); o.w = pk2(s[6 * 65], s[7 * 65]);
        *(u32x4*)(d.WT + (size_t)(d.dstrow0 + n) * d.K + d.k0 + 8 * c) = o; }
    }
    asm volatile("s_waitcnt lgkmcnt(0)" ::: "memory");
}
__constant__ float c_inv_freq[16] = {1.000000000e+00f, 4.403665960e-01f, 1.939227432e-01f, 8.539710194e-02f, 3.760603070e-02f, 1.656044088e-02f, 7.292664610e-03f, 3.211446106e-03f,
                                     1.414213562e-03f, 6.227724371e-04f, 2.742481884e-04f, 1.207697351e-04f, 5.318295734e-05f, 2.341999971e-05f, 1.031338525e-05f, 4.541670478e-06f};
__device__ __forceinline__ void sincos_reduced(float ang, float& sn, float& cs) {
    const double a = (double)ang;
    const double k = __builtin_rint(a * 0.15915494309189535);
    const double r = __builtin_fma(-k, 6.283185307179586, a) - k * 2.4492935982947064e-16;
    const float rf = (float)r;
    sn = __sinf(rf); cs = __cosf(rf);
}
struct Ptrs {
    const float *x; const int* pos; const float *attn_w_in, *attn_w_out, *ssm_w_in, *conv_w, *conv_b, *dt_bias, *a_log, *d_skip, *norm_w, *ssm_w_out;
    const float *w_router, *b_router, *w_up, *b_up, *w_dn, *b_dn, *ln_mix_g, *ln_mix_b, *ln_ffn_g, *ln_ffn_b;
};
constexpr int N1_UP = 32 * 16 * 32, N1_DN = 32 * 16 * 16, N1_ITEMS = N1_UP + N1_DN;
constexpr int HOSTED_ITEMS = 18432;
__device__ __forceinline__ TrItem moe1_item(const Ptrs& P, unsigned char* ws, int idx, int lay = 1) {
    TrItem d; d.kscale = nullptr; d.K = 1024; d.q8 = 1; d.hperm = 0;
    if (idx < N1_UP) { const int mat = 32 * lay + (idx >> 9), q = idx & 511, kb = q >> 5, nb = q & 31; const int n0 = nb * 64; const int bj = n0 >> 10, pn = (n0 & 1023) >> 7, cc = n0 & 127;
        d.W = P.w_up + (size_t)mat * 1024 * 2048; d.pitch = 2048; d.WT = (bf16*)(ws + WS_WUP + (size_t)mat * 2048 * 1024); d.k0 = kb * 64; d.n0 = n0; d.dstrow0 = pn * 256 + bj * 128 + cc; }
    else { const int r = idx - N1_UP, mat = 32 * lay + (r >> 8), q = r & 255, kb = q >> 4, nb = q & 15;
        d.W = P.w_dn + (size_t)mat * 1024 * 1024; d.pitch = 1024; d.WT = (bf16*)(ws + WS_WDN + (size_t)mat * 1024 * 1024); d.k0 = kb * 64; d.n0 = nb * 64; d.dstrow0 = nb * 64; }
    return d;
}
__device__ __forceinline__ void cvt_static(LAS unsigned char* lds, const Ptrs& P, unsigned char* ws, int first, int stride, int cnt) {
    const int lane = threadIdx.x & 63, w = __builtin_amdgcn_readfirstlane((int)threadIdx.x >> 6);
    LAS float* scr = (LAS float*)(lds + w * (65 * 64 * 4));
    if (cnt <= 0 || first >= N1_ITEMS) return;
    f32x4 la[16], lb[16]; TrItem da = moe1_item(P, ws, first), db = da; tr_load(da, la, lane);
    for (int i = 0;; i += 2) {
        const int ib = first + (i + 1) * stride; const bool hb = (i + 1 < cnt) && (ib < N1_ITEMS);
        if (hb) { db = moe1_item(P, ws, ib); tr_load(db, lb, lane); }
        tr_finish(da, la, scr, lane);
        if (!hb) break;
        const int ia = first + (i + 2) * stride; const bool ha = (i + 2 < cnt) && (ia < N1_ITEMS);
        if (ha) { da = moe1_item(P, ws, ia); tr_load(da, la, lane); }
        tr_finish(db, lb, scr, lane);
        if (!ha) break;
    }
}
__device__ __forceinline__ void cvt_plan(int NB, int G, int& rem_up, int& P_up, int& rem_dn, int& P_dn) {
    rem_up = (NB * 8) % G; const int n_iu = rem_up ? (G - rem_up) : 0; P_up = n_iu * 8 * CVT_Q_UP; if (P_up > N1_ITEMS) P_up = N1_ITEMS;
    rem_dn = (NB * 4) % G; const int n_id = rem_dn ? (G - rem_dn) : 0; P_dn = P_up + n_id * 8 * CVT_Q_DN; if (P_dn > N1_ITEMS) P_dn = N1_ITEMS;
}
__device__ __forceinline__ void p0_prologue(LAS unsigned char* lds, const Ptrs& P, unsigned char* ws, int G, int vcu) {
    const int tid = threadIdx.x, lane = tid & 63, w = __builtin_amdgcn_readfirstlane(tid >> 6);
    LAS float* scr = (LAS float*)(lds + w * (65 * 64 * 4));
    const int gw = vcu * 8 + w, NGW = G * 8;
    bf16* Wqkv = (bf16*)(ws + WS_WQKV); bf16* Wao = (bf16*)(ws + WS_WAO); bf16* Wsi = (bf16*)(ws + WS_WSI); bf16* Wso = (bf16*)(ws + WS_WSO);
    constexpr int I0 = 16 * 144, I1 = 16 * 16, I2 = 16 * 80, I3 = 32 * 16, I4 = 32 * 16 * 32, I5 = 32 * 16 * 16;
    constexpr int NITEMS = I0 + I1 + I2 + I3 + (N1_ITEMS - HOSTED_ITEMS);
    auto decode = [&](int it) -> TrItem {
        TrItem d; int r = it; d.kscale = nullptr; d.q8 = 0; d.hperm = 0;
        if (r < I0) { const int kb = r / 144, nb = r % 144; d.q8 = 1; d.hperm = 1; d.W = P.attn_w_in; d.pitch = NQKV; d.K = 1024; d.WT = Wqkv; d.k0 = kb * 64; d.n0 = nb * 64; d.dstrow0 = nb * 64; return d; } r -= I0;
        if (r < I1) { const int kb = r / 16, nb = r % 16; d.q8 = 1; d.W = P.attn_w_out; d.pitch = 1024; d.K = 1024; d.WT = Wao; d.k0 = kb * 64; d.n0 = nb * 64; d.dstrow0 = nb * 64; return d; } r -= I1;
        if (r < I2) { const int kb = r / 80, nb = r % 80; d.q8 = 1; d.W = P.ssm_w_in; d.pitch = SSM_PITCH; d.K = 1024; d.WT = Wsi; d.k0 = kb * 64; d.n0 = nb * 64; d.dstrow0 = nb * 64; return d; } r -= I2;
        if (r < I3) { const int kb = r / 16, nb = r % 16; d.W = P.ssm_w_out; d.pitch = 1024; d.K = 2048; d.kscale = P.norm_w; d.WT = Wso; d.k0 = kb * 64; d.n0 = nb * 64; d.dstrow0 = nb * 64; return d; } r -= I3;
        return moe1_item(P, ws, r + HOSTED_ITEMS, 0);
    };
    if (gw < NITEMS) {
        f32x4 la[16], lb[16];
        TrItem da = decode(gw), db = da; tr_load(da, la, lane);
        for (int it = gw; it < NITEMS; it += 2 * NGW) {
            const bool hb = it + NGW < NITEMS;
            if (hb) { db = decode(it + NGW); tr_load(db, lb, lane); }
            tr_finish(da, la, scr, lane);
            if (!hb) break;
            const bool ha = it + 2 * NGW < NITEMS;
            if (ha) { da = decode(it + 2 * NGW); tr_load(da, la, lane); }
            tr_finish(db, lb, scr, lane);
            if (!ha) break;
        }
    }
    bf16* XBA = (bf16*)(ws + WS_XBA);
    for (int m0 = gw * 4; m0 < T; m0 += NGW * 4) {
        f32x4 v[4][4];
#pragma unroll
        for (int rr = 0; rr < 4; ++rr) { const f32x4* xr = (const f32x4*)(P.x + (size_t)(m0 + rr) * DM) + lane;
#pragma unroll
            for (int j = 0; j < 4; ++j) v[rr][j] = xr[64 * j]; }
#pragma unroll
        for (int rr = 0; rr < 4; ++rr) { u32x2* o = (u32x2*)(XBA + (size_t)(m0 + rr) * DM) + lane;
#pragma unroll
            for (int j = 0; j < 4; ++j) {
                *(unsigned*)(ws + WS_XQ0 + (size_t)(m0 + rr) * DM + 4 * lane + 256 * j) = pk4_f8(v[rr][j][0], v[rr][j][1], v[rr][j][2], v[rr][j][3], Q8_X); } }
    }
    float* rope = (float*)(ws + WS_ROPE);
    for (int idx = (vcu * 512 + tid); idx < T * 16; idx += G * 512) {
        const int tok = idx >> 4, i = idx & 15;
        const float ang = (float)P.pos[tok] * c_inv_freq[i];
        float sn, cs; sincos_reduced(ang, sn, cs);
        rope[(size_t)tok * 32 + i] = cs; rope[(size_t)tok * 32 + 16 + i] = sn;
    }
}

constexpr size_t PKOFF = (size_t)8 * T * 128;
__device__ __forceinline__ void attn_phase(LAS unsigned char* lds, const unsigned char* __restrict__ PROJ, unsigned char* __restrict__ OG, float* __restrict__ LSE, const int G, const int vcu) {
    const int tid = threadIdx.x, lane0 = tid & 63, w = __builtin_amdgcn_readfirstlane(tid >> 6);
    LAS unsigned char* Ks = lds; LAS unsigned char* Vt = lds + 2 * 128 * P256;
    constexpr int NU = BATCH * 3 * 8 * 32;
    const int per = (NU + G - 1) / G;
    const int u0 = vcu * per, u1 = (u0 + per < NU) ? (u0 + per) : NU;
    if (u0 >= u1) return;
    u32x4 kreg[2], vreg[2]; u32x4 qn[2];
    constexpr int PK8 = 144;
    unsigned long long mA = 0ull, mB = 0ull;
    { const int r16 = lane0 & 15, q4 = lane0 >> 4;
#pragma unroll
        for (int kt = 0; kt < 9; ++kt)
#pragma unroll
            for (int jj = 0; jj < 4; ++jj) { const int jr = 16 * kt + 4 * q4 + jj; const bool va = (jr >= r16) & (jr <= r16 + 128); const bool vb = va & (jr + 16 * w >= 128);
                mA |= (unsigned long long)va << (4 * kt + jj); mB |= (unsigned long long)vb << (4 * kt + jj); } }
    int pc = 0;
#define ATT_DECODE(U) const int bgh = (U) >> 5, sub = (U) & 31, h = bgh & 7, bg = bgh >> 3, g = bg % 3, b = bg / 3; \
        const int lg = (g == 0) ? 0 : ((g == 1) ? 2 : 4), dl = 1 << lg, nblk = 32 >> lg, r = sub >> (5 - lg), blk = sub & (nblk - 1); \
        const unsigned char* base_r = PROJ + ((size_t)(g * 24 + h) * T + (size_t)b * SEQ + (size_t)r * (SEQ >> lg)) * 128;
#define ATT_W2(X) pk2(X[0], X[1])
#define ATT_K16(V, LO, HI) do { _Pragma("unroll") for (int i_ = 0; i_ < 4; ++i_) { const f32x2 a_ = __builtin_amdgcn_cvt_pk_f32_fp8((int)(V)[i_], false), b_ = __builtin_amdgcn_cvt_pk_f32_fp8((int)(V)[i_], true); \
        if (i_ < 2) { (LO)[2 * i_] = ATT_W2(a_); (LO)[2 * i_ + 1] = ATT_W2(b_); } else { (HI)[2 * i_ - 4] = ATT_W2(a_); (HI)[2 * i_ - 3] = ATT_W2(b_); } } } while (0)
#define ATT_VT(V0, V1, C, JP, HALFSEL) do { _Pragma("unroll") for (int i_ = 0; i_ < 4; ++i_) { \
        const f32x2 a0_ = __builtin_amdgcn_cvt_pk_f32_fp8((int)(V0)[i_], false), b0_ = __builtin_amdgcn_cvt_pk_f32_fp8((int)(V0)[i_], true), a1_ = __builtin_amdgcn_cvt_pk_f32_fp8((int)(V1)[i_], false), b1_ = __builtin_amdgcn_cvt_pk_f32_fp8((int)(V1)[i_], true); \
        *(LAS unsigned*)(Vt + swz512(16 * (C) + 4 * i_ + 0, 256 * (HALFSEL) + 4 * (JP))) = pk2(a0_[0], a1_[0]); *(LAS unsigned*)(Vt + swz512(16 * (C) + 4 * i_ + 1, 256 * (HALFSEL) + 4 * (JP))) = pk2(a0_[1], a1_[1]); \
        *(LAS unsigned*)(Vt + swz512(16 * (C) + 4 * i_ + 2, 256 * (HALFSEL) + 4 * (JP))) = pk2(b0_[0], b1_[0]); *(LAS unsigned*)(Vt + swz512(16 * (C) + 4 * i_ + 3, 256 * (HALFSEL) + 4 * (JP))) = pk2(b0_[1], b1_[1]); } } while (0)
    {
        ATT_DECODE(u0)
        const int lane = lane0;
        const int jpv = 16 * (w >> 1) + (lane & 15), cv = 4 * (w & 1) + (lane >> 4);
        if (blk > 0) {
#pragma unroll
            for (int it = 0; it < 2; ++it) { const int item = it * 512 + tid, j = item >> 3, c = item & 7; const int ts = (blk - 1) * 128 + j;
                *(LAS u32x4*)(Ks + j * PK8 + 16 * c) = *(const u32x4*)(base_r + (size_t)ts * 128 + PKOFF + 16 * c); }
            { const int ts = (blk - 1) * 128 + 2 * jpv;
                const u32x4 v0 = *(const u32x4*)(base_r + (size_t)ts * 128 + 2 * PKOFF + 16 * cv), v1 = *(const u32x4*)(base_r + (size_t)(ts + 1) * 128 + 2 * PKOFF + 16 * cv);
                ATT_VT(v0, v1, cv, jpv, 0); }
        }
#pragma unroll
        for (int it = 0; it < 2; ++it) { const int item = it * 512 + tid, j = item >> 3, c = item & 7; kreg[it] = *(const u32x4*)(base_r + (size_t)(blk * 128 + j) * 128 + PKOFF + 16 * c); }
        { const int ts = blk * 128 + 2 * jpv;
            vreg[0] = *(const u32x4*)(base_r + (size_t)ts * 128 + 2 * PKOFF + 16 * cv); vreg[1] = *(const u32x4*)(base_r + (size_t)(ts + 1) * 128 + 2 * PKOFF + 16 * cv); }
        const int tq = blk * 128 + 16 * w + (lane & 15);
#pragma unroll
        for (int kk = 0; kk < 2; ++kk) qn[kk] = *(const u32x4*)(base_r + (size_t)tq * 128 + 64 * kk + 16 * (lane >> 4));
    }
    for (int u = u0; u < u1; ++u) {
        int lane = lane0; asm volatile("" : "+v"(lane));
        const int r16 = lane & 15, q4 = lane >> 4;
        ATT_DECODE(u)
        const int pp = pc; pc ^= 1;
        if (blk == 0) {
#pragma unroll
            for (int it = 0; it < 4; ++it) { const int item = it * 512 + tid, dd = item >> 4, c = item & 15; *(LAS u32x4*)(Vt + swz512(dd, 256 * pp + 16 * c)) = (u32x4){0u, 0u, 0u, 0u}; }
        }
#pragma unroll
        for (int it = 0; it < 2; ++it) { const int item = it * 512 + tid, j = item >> 3, c = item & 7; *(LAS u32x4*)(Ks + pc * (128 * P256) + j * PK8 + 16 * c) = kreg[it]; }
        { const int jpv = 16 * (w >> 1) + (lane & 15), cv = 4 * (w & 1) + (lane >> 4); ATT_VT(vreg[0], vreg[1], cv, jpv, pc); }
        const pg8::i32x8_t qf = __builtin_shufflevector(__builtin_bit_cast(pg8::i32x4_t, qn[0]), __builtin_bit_cast(pg8::i32x4_t, qn[1]), 0, 1, 2, 3, 4, 5, 6, 7);
        lds_barrier();
        if (u + 1 < u1) {
            const int un = u + 1;
            const int bgh2 = un >> 5, sub2 = un & 31, h2 = bgh2 & 7, bg2 = bgh2 >> 3, g2 = bg2 % 3, b2 = bg2 / 3;
            const int lg2 = (g2 == 0) ? 0 : ((g2 == 1) ? 2 : 4), nblk2 = 32 >> lg2, r2 = sub2 >> (5 - lg2), blk2 = sub2 & (nblk2 - 1);
            const unsigned char* base2 = PROJ + ((size_t)(g2 * 24 + h2) * T + (size_t)b2 * SEQ + (size_t)r2 * (SEQ >> lg2)) * 128;
#pragma unroll
            for (int it = 0; it < 2; ++it) { const int item = it * 512 + tid, j = item >> 3, c = item & 7; kreg[it] = *(const u32x4*)(base2 + (size_t)(blk2 * 128 + j) * 128 + PKOFF + 16 * c); }
            { const int jpv = 16 * (w >> 1) + (lane & 15), cv = 4 * (w & 1) + (lane >> 4); const int ts = blk2 * 128 + 2 * jpv;
                vreg[0] = *(const u32x4*)(base2 + (size_t)ts * 128 + 2 * PKOFF + 16 * cv); vreg[1] = *(const u32x4*)(base2 + (size_t)(ts + 1) * 128 + 2 * PKOFF + 16 * cv); }
            const int tq2 = blk2 * 128 + 16 * w + r16;
#pragma unroll
            for (int kk = 0; kk < 2; ++kk) qn[kk] = *(const u32x4*)(base2 + (size_t)tq2 * 128 + 64 * kk + 16 * q4);
        }
        f32x4 s[9];
#pragma unroll
        for (int kt = 0; kt < 9; ++kt) {
            const int ka = w + kt; const int hoff = ((ka < 8) ? pp : pc) * (128 * P256); const int row = 16 * (ka & 7) + r16;
            const u32x4 k0 = *(const LAS u32x4*)(Ks + hoff + row * PK8 + 16 * q4), k1 = *(const LAS u32x4*)(Ks + hoff + row * PK8 + 64 + 16 * q4);
            const pg8::i32x8_t kf = __builtin_shufflevector(__builtin_bit_cast(pg8::i32x4_t, k0), __builtin_bit_cast(pg8::i32x4_t, k1), 0, 1, 2, 3, 4, 5, 6, 7);
            s[kt] = __builtin_amdgcn_mfma_scale_f32_16x16x128_f8f6f4(kf, qf, (f32x4){0.f, 0.f, 0.f, 0.f}, 0, 0, 0, 0, 0, 0); }
        float mx = -INFINITY;
        const unsigned long long mk = (blk > 0) ? mA : mB; const unsigned mlo = (unsigned)mk, mhi = (unsigned)(mk >> 32);
#pragma unroll
        for (int kt = 0; kt < 9; ++kt)
#pragma unroll
            for (int jj = 0; jj < 4; ++jj) { const int bit = 4 * kt + jj; const bool valid = bit < 32 ? ((mlo >> bit) & 1u) : ((mhi >> (bit - 32)) & 1u);
                s[kt][jj] = valid ? s[kt][jj] : -INFINITY; mx = fmaxf(mx, s[kt][jj]); }
        mx = fmaxf(mx, __shfl_xor(mx, 16)); mx = fmaxf(mx, __shfl_xor(mx, 32));
        float ls = 0.f;
#pragma unroll
        for (int kt = 0; kt < 9; ++kt)
#pragma unroll
            for (int jj = 0; jj < 4; ++jj) { const float p = __builtin_amdgcn_exp2f((s[kt][jj] - mx) * (1.0f / (Q8_Q * Q8_K))); s[kt][jj] = p; ls += p; }
        ls += __shfl_xor(ls, 16); ls += __shfl_xor(ls, 32);
        f32x4 o[8];
#pragma unroll
        for (int dt = 0; dt < 8; ++dt) o[dt] = (f32x4){0.f, 0.f, 0.f, 0.f};
#pragma unroll
        for (int kp = 0; kp < 5; ++kp) {
            u32x4 pw; pw.x = pk2(s[2 * kp][0], s[2 * kp][1]); pw.y = pk2(s[2 * kp][2], s[2 * kp][3]);
            if (kp < 4) { pw.z = pk2(s[2 * kp + 1][0], s[2 * kp + 1][1]); pw.w = pk2(s[2 * kp + 1][2], s[2 * kp + 1][3]); } else { pw.z = 0u; pw.w = 0u; }
            const bf16x8 pf = as_bf16x8(pw);
            const int ka0 = w + 2 * kp, ka1 = ka0 + 1;
            const int c0 = 256 * ((ka0 < 8) ? pp : pc) + 2 * (16 * (ka0 & 7) + 4 * q4), c1 = 256 * ((ka1 < 8) ? pp : pc) + 2 * (16 * (ka1 & 7) + 4 * q4);
#pragma unroll
            for (int dt = 0; dt < 8; ++dt) { const int dd = 16 * dt + r16;
                const u32x2 lo = *(const LAS u32x2*)(Vt + swz512(dd, c0));
                u32x2 hi = (u32x2){0u, 0u}; if (kp < 4) hi = *(const LAS u32x2*)(Vt + swz512(dd, c1));
                const u32x4 av = (u32x4){lo.x, lo.y, hi.x, hi.y};
                o[dt] = mfma16(as_bf16x8(av), pf, o[dt]); }
        }
        const float inv = Q8_O / (ls * Q8_V);
        const int tq = blk * 128 + 16 * w + r16;
        const size_t tokq = (size_t)b * SEQ + (size_t)tq * dl + r;
        unsigned char* op = OG + ((size_t)g * T + tokq) * DM + h * 128 + 4 * q4;
#pragma unroll
        for (int dt = 0; dt < 8; ++dt) *(unsigned*)(op + 16 * dt) = pk4_f8(o[dt][0], o[dt][1], o[dt][2], o[dt][3], inv);
        if (q4 == 0) LSE[((size_t)g * T + tokq) * 8 + h] = (mx * (1.0f / (Q8_Q * Q8_K)) + __builtin_amdgcn_logf(ls)) * LN2F;
        lds_barrier();
    }
#undef ATT_DECODE
#undef ATT_W2
#undef ATT_K16
#undef ATT_VT
}

__device__ __forceinline__ void combine_phase(const unsigned char* __restrict__ OG, const float* __restrict__ LSE, unsigned char* __restrict__ OB, int G, int vcu) {
    const int tid = threadIdx.x, lane = tid & 63, w = tid >> 6;
    const int gw = vcu * 8 + w, NGW = G * 8;
    for (int row = gw; row < T; row += NGW) {
#pragma unroll
        for (int j = 0; j < 2; ++j) { const int col = 8 * lane + 512 * j, head = col >> 7;
            const float l0 = LSE[((size_t)0 * T + row) * 8 + head], l1 = LSE[((size_t)1 * T + row) * 8 + head], l2 = LSE[((size_t)2 * T + row) * 8 + head];
            const float m = fmaxf(l0, fmaxf(l1, l2)); float w0 = __expf(l0 - m), w1 = __expf(l1 - m), w2 = __expf(l2 - m); const float inv = 1.0f / (w0 + w1 + w2); w0 *= inv; w1 *= inv; w2 *= inv;
            const u32x2 a0 = *(const u32x2*)(OG + ((size_t)0 * T + row) * DM + col), a1 = *(const u32x2*)(OG + ((size_t)1 * T + row) * DM + col), a2 = *(const u32x2*)(OG + ((size_t)2 * T + row) * DM + col);
            float ov[8];
#pragma unroll
            for (int wd = 0; wd < 2; ++wd) {
                const f32x2 x0 = __builtin_amdgcn_cvt_pk_f32_fp8((int)a0[wd], false), x1 = __builtin_amdgcn_cvt_pk_f32_fp8((int)a1[wd], false), x2 = __builtin_amdgcn_cvt_pk_f32_fp8((int)a2[wd], false);
                const f32x2 y0 = __builtin_amdgcn_cvt_pk_f32_fp8((int)a0[wd], true), y1 = __builtin_amdgcn_cvt_pk_f32_fp8((int)a1[wd], true), y2 = __builtin_amdgcn_cvt_pk_f32_fp8((int)a2[wd], true);
                ov[4 * wd] = w0 * x0[0] + w1 * x1[0] + w2 * x2[0]; ov[4 * wd + 1] = w0 * x0[1] + w1 * x1[1] + w2 * x2[1]; ov[4 * wd + 2] = w0 * y0[0] + w1 * y1[0] + w2 * y2[0]; ov[4 * wd + 3] = w0 * y0[1] + w1 * y1[1] + w2 * y2[1]; }
            u32x2 o; o.x = pk4_f8(ov[0], ov[1], ov[2], ov[3], 1.0f); o.y = pk4_f8(ov[4], ov[5], ov[6], ov[7], 1.0f);
            *(u32x2*)(OB + (size_t)row * DM + col) = o; }
    }
}

template <int MIXSRC, int POST, bool WRITE_B, bool WRITE_F, bool XF32 = false>
__device__ __forceinline__ void ln_phase(LAS unsigned char* lds, const bf16* __restrict__ xres, const bf16* __restrict__ mixf, const unsigned char* __restrict__ YS, const float* __restrict__ gates_in,
                                         const float* __restrict__ gamma, const float* __restrict__ beta, float* outf, bf16* __restrict__ outb,
                                         const float* __restrict__ W32, int wpitch, const float* __restrict__ bias32, float* __restrict__ gates_out, int* __restrict__ lists, unsigned* counts, float* __restrict__ DTout,
                                         int G, int vcu, unsigned char* __restrict__ outq = nullptr) {
    const int tid = threadIdx.x, lane = tid & 63, w = __builtin_amdgcn_readfirstlane(tid >> 6);
    LAS float* wl = (LAS float*)lds;
    LAS int* sel_e = (LAS int*)(lds + LDS_SM); LAS int* sel_rk = sel_e + 512; LAS int* lcnt = sel_e + 1024; LAS int* gbase = sel_e + 1056;
    if (POST) {
#pragma unroll 8
        for (int it = 0; it < 64; ++it) { const int idx = it * 512 + tid, k = idx >> 5, e = idx & 31; const int slot = (((k >> 8) * 4 + (k & 3)) * 64) + ((k >> 2) & 63);
            wl[slot * 36 + e] = W32[(size_t)k * wpitch + e]; }
        if (POST == 1 && tid < 32) lcnt[tid] = 0;
        __syncthreads();
    }
    int ebr = 0;
#pragma unroll
    for (int bb = 0; bb < 5; ++bb) ebr |= ((lane >> bb) & 1) << (4 - bb);
    float mybias = 0.f; if (POST) mybias = bias32[ebr];
    for (int chunk = vcu; chunk < T / 128; chunk += G) {
        u32x2 nxr[4], nmx[4]; f32x4 nxf[XF32 ? 4 : 1]; unsigned nys[4][4]; f32x4 ngv = (f32x4){0.f, 0.f, 0.f, 0.f};
        { const size_t row = (size_t)chunk * 128 + w * 16;
            if (MIXSRC == 1) ngv = *(const f32x4*)(gates_in + row * 4);
#pragma unroll
            for (int j = 0; j < 4; ++j) { if (XF32) nxf[XF32 ? j : 0] = *(const f32x4*)((const float*)xres + row * DM + 4 * lane + 256 * j); else nxr[j] = *(const u32x2*)(xres + row * DM + 4 * lane + 256 * j);
                if (MIXSRC == 0) nmx[j] = *(const u32x2*)(mixf + row * DM + 4 * lane + 256 * j);
                else {
#pragma unroll
                    for (int k = 0; k < 4; ++k) nys[j][k] = __builtin_nontemporal_load((const unsigned*)(YS + (row * 4 + k) * DM + 4 * lane + 256 * j)); } } }
        for (int pass = 0; pass < 16; ++pass) {
            const int rl = w * 16 + pass; const size_t row = (size_t)chunk * 128 + rl;
            asm volatile("" ::: "memory");
            int lo = lane; asm volatile("" : "+v"(lo));
            float xv[16];
            {
                f32x4 v[4]; float s = 0.f;
                const f32x4 gv = ngv * (MIXSRC == 1 ? 1.0f / Q8_Y : 1.0f);
#pragma unroll
                for (int j = 0; j < 4; ++j) {
                    f32x4 mix;
                    if (MIXSRC == 0) mix = (f32x4){bflo(nmx[j].x), bfhi(nmx[j].x), bflo(nmx[j].y), bfhi(nmx[j].y)};
                    else { mix = (f32x4){0.f, 0.f, 0.f, 0.f};
#pragma unroll
                        for (int k = 0; k < 4; ++k) { const f32x2 ylo = __builtin_amdgcn_cvt_pk_f32_fp8((int)nys[j][k], false), yhi = __builtin_amdgcn_cvt_pk_f32_fp8((int)nys[j][k], true);
                            mix[0] += gv[k] * ylo[0]; mix[1] += gv[k] * ylo[1]; mix[2] += gv[k] * yhi[0]; mix[3] += gv[k] * yhi[1]; } }
                    const f32x4 xr = XF32 ? nxf[XF32 ? j : 0] : (f32x4){bflo(nxr[j].x), bfhi(nxr[j].x), bflo(nxr[j].y), bfhi(nxr[j].y)};
                    v[j] = xr * ALPHA + mix; s += (v[j][0] + v[j][1]) + (v[j][2] + v[j][3]);
                }
                if (pass < 15) { const size_t nrow = row + 1;
                    if (MIXSRC == 1) ngv = *(const f32x4*)(gates_in + nrow * 4);
#pragma unroll
                    for (int j = 0; j < 4; ++j) { if (XF32) nxf[XF32 ? j : 0] = *(const f32x4*)((const float*)xres + nrow * DM + 4 * lo + 256 * j); else nxr[j] = *(const u32x2*)(xres + nrow * DM + 4 * lo + 256 * j);
                        if (MIXSRC == 0) nmx[j] = *(const u32x2*)(mixf + nrow * DM + 4 * lo + 256 * j);
                        else {
#pragma unroll
                            for (int k = 0; k < 4; ++k) nys[j][k] = __builtin_nontemporal_load((const unsigned*)(YS + (nrow * 4 + k) * DM + 4 * lo + 256 * j)); } } }
                const float mean = wave_sum(s) * (1.0f / DM); float s2 = 0.f;
#pragma unroll
                for (int j = 0; j < 4; ++j) { v[j] = v[j] - mean; s2 += (v[j][0] * v[j][0] + v[j][1] * v[j][1]) + (v[j][2] * v[j][2] + v[j][3] * v[j][3]); }
                const float rstd = 1.0f / sqrtf(wave_sum(s2) * (1.0f / DM) + LN_EPS);
#pragma unroll
                for (int j = 0; j < 4; ++j) { const f32x4 gm = *(const f32x4*)(gamma + 4 * lo + 256 * j), bt = *(const f32x4*)(beta + 4 * lo + 256 * j);
                    const f32x4 y = v[j] * rstd * gm + bt;
                    if (WRITE_F) __builtin_nontemporal_store(y, (f32x4*)(outf + row * DM + 4 * lo + 256 * j));
                    if (WRITE_B) { u32x2 q; q.x = pk2(y[0], y[1]); q.y = pk2(y[2], y[3]); *(u32x2*)(outb + row * DM + 4 * lo + 256 * j) = q; }
                    if (POST) *(unsigned*)(outq + row * DM + 4 * lo + 256 * j) = pk4_f8(y[0], y[1], y[2], y[3], Q8_X);
                    xv[4 * j + 0] = y[0]; xv[4 * j + 1] = y[1]; xv[4 * j + 2] = y[2]; xv[4 * j + 3] = y[3]; }
            }
            if (POST) {
                f32x2 acc2[16];
#pragma unroll
                for (int e = 0; e < 16; ++e) acc2[e] = (f32x2){0.f, 0.f};
#pragma unroll
                for (int jj = 0; jj < 16; ++jj) { const LAS float* wrow = wl + (jj * 64 + lane) * 36;
                    if ((jj & 1) == 0) asm volatile("" ::: "memory");
                    const f32x2 xx = (f32x2){xv[jj], xv[jj]};
#pragma unroll
                    for (int e4 = 0; e4 < 8; ++e4) { const f32x4 wv = *(const LAS f32x4*)(wrow + 4 * e4);
                        acc2[2 * e4] = acc2[2 * e4] + xx * (f32x2){wv[0], wv[1]}; acc2[2 * e4 + 1] = acc2[2 * e4 + 1] + xx * (f32x2){wv[2], wv[3]}; } }
                float acc0[32];
#pragma unroll
                for (int e = 0; e < 32; ++e) acc0[e] = acc2[e >> 1][e & 1];
#pragma unroll
                for (int bb = 0; bb < 5; ++bb) { const int hh = 16 >> bb; const unsigned um = ((lane >> bb) & 1) ? 0xffffffffu : 0u;
#pragma unroll
                    for (int i = 0; i < hh; ++i) { const unsigned l0 = __float_as_uint(acc0[i]), h0 = __float_as_uint(acc0[i + hh]);
                        const float k0 = __uint_as_float((h0 & um) | (l0 & ~um)), s0 = __uint_as_float((l0 & um) | (h0 & ~um)); acc0[i] = k0 + __shfl_xor(s0, 1 << bb); } }
                const float lg0 = acc0[0] + __shfl_xor(acc0[0], 32) + mybias;
                if (POST == 1) {
                    const unsigned ub = __float_as_uint(lg0); const unsigned uo = (ub & 0x80000000u) ? ~ub : (ub | 0x80000000u);
                    unsigned key = (uo & ~31u) | (unsigned)(31 - ebr);
                    float top0 = 0.f, myv = 0.f, esum = 0.f; int ek = 0;
#pragma unroll
                    for (int k = 0; k < 4; ++k) { unsigned bk = key;
#pragma unroll
                        for (int off = 1; off < 32; off <<= 1) { const unsigned ok = (unsigned)__shfl_xor((int)bk, off); bk = ok > bk ? ok : bk; }
                        const int be = 31 - (int)(__builtin_amdgcn_readfirstlane(bk) & 31u);
                        int wl_ = 0;
#pragma unroll
                        for (int bb = 0; bb < 5; ++bb) wl_ |= ((be >> bb) & 1) << (4 - bb);
                        const float bv = __uint_as_float(__builtin_amdgcn_readlane(__float_as_uint(lg0), wl_));
                        if (k == 0) top0 = bv;
                        const float ex = __expf(bv - top0); esum += ex;
                        myv = (lane == k) ? ex : myv; ek = (lane == k) ? be : ek; key = (ebr == be) ? 0u : key; }
                    if (lane < 4) {
                        gates_out[row * 4 + lane] = myv / esum;
                        const int rk = __hip_atomic_fetch_add(lcnt + ek, 1, __ATOMIC_RELAXED, __HIP_MEMORY_SCOPE_WORKGROUP);
                        sel_e[rl * 4 + lane] = ek; sel_rk[rl * 4 + lane] = rk; }
                } else {
                    if (lane < 32) { const float xx = lg0; const float y = __expf(-fabsf(xx)); const float l1p = (y < 1e-3f) ? (y - 0.5f * y * y) : __logf(1.0f + y);
                        DTout[row * 32 + ebr] = fmaxf(xx, 0.f) + l1p; }
                }
            }
        }
        if (POST == 1) {
            __syncthreads();
            if (tid < 32) gbase[tid] = (int)__hip_atomic_fetch_add(counts + tid, (unsigned)lcnt[tid], __ATOMIC_RELAXED, __HIP_MEMORY_SCOPE_AGENT);
            __syncthreads();
            { const int e = sel_e[tid]; lists[(size_t)e * 32768 + gbase[e] + sel_rk[tid]] = (chunk * 128 + (tid >> 2)) * 4 + (tid & 3); }
            __syncthreads();
            if (tid < 32) lcnt[tid] = 0;
            __syncthreads();
        }
    }
}

__device__ __forceinline__ void conv_item(const bf16* __restrict__ ZX, const float* __restrict__ conv_w, const float* __restrict__ conv_b, int tok0, int ch, u32x4 (&q)[8]) {
    const int sl = tok0 & (SEQ - 1);
    u32x4 raw[11];
#pragma unroll
    for (int i = 0; i < 11; ++i) { if (sl - 3 + i >= 0) raw[i] = *(const u32x4*)(ZX + (size_t)(tok0 - 3 + i) * NZX + 2048 + ch); else raw[i] = (u32x4){0u, 0u, 0u, 0u}; }
    f32x2 cw[4][4], cb[4];
#pragma unroll
    for (int k = 0; k < 4; ++k)
#pragma unroll
        for (int p = 0; p < 4; ++p) cw[k][p] = *(const f32x2*)(conv_w + (size_t)k * 3072 + ch + 2 * p);
#pragma unroll
    for (int p = 0; p < 4; ++p) cb[p] = *(const f32x2*)(conv_b + ch + 2 * p);
    f32x2 xin[11][4];
#pragma unroll
    for (int i = 0; i < 11; ++i)
#pragma unroll
        for (int p = 0; p < 4; ++p) xin[i][p] = (f32x2){bflo(raw[i][p]), bfhi(raw[i][p])};
#pragma unroll
    for (int t = 0; t < 8; ++t)
#pragma unroll
        for (int p = 0; p < 4; ++p) { f32x2 a = cb[p];
#pragma unroll
            for (int k = 0; k < 4; ++k) a = a + cw[k][p] * xin[t + k][p];
            q[t][p] = pk2(silu_f(a[0]), silu_f(a[1])); }
}
__device__ __forceinline__ void convcb_phase(LAS unsigned char* lds, const bf16* __restrict__ ZX, const float* __restrict__ conv_w, const float* __restrict__ conv_b, bf16* __restrict__ XA, bf16* __restrict__ CBG, int G, int vcu) {
    const int tid = threadIdx.x, lane = tid & 63, w = __builtin_amdgcn_readfirstlane(tid >> 6), r16 = lane & 15, q4 = lane >> 4;
    LAS unsigned char *Cs = lds, *Bs = lds + 128 * P256;
    for (int u = vcu; u < BATCH * 32; u += G) {
        const int tokc = u * 128;
        for (int it = 0; it < 8; ++it) { const int item = it * 512 + tid, cg = item & 255, tb = item >> 8;
            u32x4 q[8]; conv_item(ZX, conv_w, conv_b, tokc + 8 * tb, 8 * cg, q);
#pragma unroll
            for (int t = 0; t < 8; ++t) *(u32x4*)(XA + (size_t)(tokc + 8 * tb + t) * 3072 + 8 * cg) = q[t]; }
        for (int g = 0; g < 4; ++g) {
            { const int cgl = tid & 31, tb = tid >> 5; const int ch = (cgl < 16) ? (2048 + g * 128 + 8 * cgl) : (2560 + g * 128 + 8 * (cgl - 16));
                u32x4 q[8]; conv_item(ZX, conv_w, conv_b, tokc + 8 * tb, ch, q);
                LAS unsigned char* dst = (cgl < 16) ? Bs : Cs;
#pragma unroll
                for (int t = 0; t < 8; ++t) { *(u32x4*)(XA + (size_t)(tokc + 8 * tb + t) * 3072 + ch) = q[t]; *(LAS u32x4*)(dst + swz256(8 * tb + t, 16 * (cgl & 15))) = q[t]; } }
            __syncthreads();
            bf16x8 cf[4];
#pragma unroll
            for (int kk = 0; kk < 4; ++kk) cf[kk] = *(const LAS bf16x8*)(Cs + swz256(16 * w + r16, 64 * kk + 16 * q4));
            bf16* outp = CBG + ((size_t)u * 4 + g) * 16384 + (size_t)(16 * w + r16) * 128 + 4 * q4;
#pragma unroll
            for (int st = 0; st < 8; ++st) { f32x4 m = (f32x4){0.f, 0.f, 0.f, 0.f};
#pragma unroll
                for (int kk = 0; kk < 4; ++kk) { const bf16x8 a = *(const LAS bf16x8*)(Bs + swz256(16 * st + r16, 64 * kk + 16 * q4)); m = mfma16(a, cf[kk], m); }
                u32x2 q; q.x = pk2(m[0], m[1]); q.y = pk2(m[2], m[3]); *(u32x2*)(outp + 16 * st) = q; }
            __syncthreads();
        }
    }
}
__device__ __forceinline__ void ssd_phase(LAS unsigned char* lds, const bf16* __restrict__ ZX, const bf16* __restrict__ XA, const bf16* __restrict__ CBG, const float* __restrict__ DT,
                                          const float* __restrict__ a_log, const float* __restrict__ d_skip, bf16* __restrict__ Y, float* SSQ, int G, int vcu) {
    const int tid = threadIdx.x, lane = tid & 63, w = __builtin_amdgcn_readfirstlane(tid >> 6), r16_0 = lane & 15, q4_0 = lane >> 4;
    constexpr int SZ_BT = 128 * P256, SZ_XT = 64 * P256, O_XT = 2 * SZ_BT, O_PR = O_XT + 2 * SZ_XT, O_FA = O_PR + 2 * SZ_XT;
    LAS float* fa = (LAS float*)(lds + O_FA);
    for (int u = vcu; u < BATCH * 32; u += G) {
        const int b = u >> 5, h = u & 31, g = h >> 3;
        const float Ah = -__expf(a_log[h]); const float Dh = d_skip[h];
        f32x4 st[4];
#pragma unroll
        for (int pt = 0; pt < 4; ++pt) st[pt] = (f32x4){0.f, 0.f, 0.f, 0.f};
        const int jp = 16 * (w & 3) + (lane & 15);
        const unsigned voff = (unsigned)jp * 12288u + (unsigned)(lane >> 4) * 16u;
        int chb[3];
#pragma unroll
        for (int it = 0; it < 3; ++it) { const int gq = 2 * it + (w >> 2); chb[it] = 2 * ((it == 0) ? (h * 64 + 32 * gq) : (2048 + g * 128 + 32 * (gq - 2))); }
        const char* xab = (const char*)XA + (size_t)b * SEQ * 6144;
        const bf16* cbb = CBG + ((size_t)(b * 32) * 4 + g) * 16384;
        u32x4 pre[3][2]; float dn0 = 0.f, dn1 = 0.f; u32x2 cbr[8]; u32x4 cfr[4];
        {
#pragma unroll
            for (int it = 0; it < 3; ++it) { const char* sb = xab + chb[it]; pre[it][0] = *(const u32x4*)(sb + voff); pre[it][1] = *(const u32x4*)(sb + voff + 6144); }
            if (w == 0) { dn0 = DT[((size_t)b * SEQ + 2 * lane) * 32 + h]; dn1 = DT[((size_t)b * SEQ + 2 * lane + 1) * 32 + h]; }
        }
        for (int c = 0; c <= 32; ++c) {
            const int r16 = r16_0, q4 = q4_0;
            const int sb_ = c & 1;
            LAS unsigned char* BTn = lds + sb_ * SZ_BT; LAS unsigned char* xTn = lds + O_XT + sb_ * SZ_XT; LAS unsigned char* prn = lds + O_PR + sb_ * SZ_XT; LAS float* fan = fa + sb_ * 512;
            if (c >= 1) {
                const int cc = c - 1, cb_ = cc & 1; const int tok0 = b * SEQ + cc * 128;
                LAS unsigned char* BTs = lds + cb_ * SZ_BT; LAS unsigned char* xTs = lds + O_XT + cb_ * SZ_XT; LAS unsigned char* prevs = lds + O_PR + cb_ * SZ_XT;
                LAS float* acum = fa + cb_ * 512; LAS float* dtv = acum + 128; LAS float* wdec = acum + 256;
                const int l = 16 * w + r16;
                u32x2 zz[4];
#pragma unroll
                for (int pt = 0; pt < 4; ++pt) zz[pt] = *(const u32x2*)(ZX + ((size_t)tok0 + l) * NZX + h * 64 + 16 * pt + 4 * q4);
                const float al = acum[l];
                bf16x8 pf[4];
#pragma unroll
                for (int kp = 0; kp < 4; ++kp) {
                    const f32x4 as0 = *(const LAS f32x4*)(acum + 32 * kp + 4 * q4), ds0 = *(const LAS f32x4*)(dtv + 32 * kp + 4 * q4), as1 = *(const LAS f32x4*)(acum + 32 * kp + 16 + 4 * q4), ds1 = *(const LAS f32x4*)(dtv + 32 * kp + 16 + 4 * q4);
                    const u32x2 c0 = cbr[2 * kp], c1 = cbr[2 * kp + 1];
                    const float m0[4] = {bflo(c0.x), bfhi(c0.x), bflo(c0.y), bfhi(c0.y)}, m1[4] = {bflo(c1.x), bfhi(c1.x), bflo(c1.y), bfhi(c1.y)};
                    float mm[8];
#pragma unroll
                    for (int jj = 0; jj < 4; ++jj) { const int s_0 = 32 * kp + 4 * q4 + jj, s_1 = s_0 + 16;
                        mm[jj] = (s_0 <= l) ? m0[jj] * __expf(fminf(al - as0[jj], 0.f)) * ds0[jj] : 0.f; mm[4 + jj] = (s_1 <= l) ? m1[jj] * __expf(fminf(al - as1[jj], 0.f)) * ds1[jj] : 0.f; }
                    u32x4 pw; pw.x = pk2(mm[0], mm[1]); pw.y = pk2(mm[2], mm[3]); pw.z = pk2(mm[4], mm[5]); pw.w = pk2(mm[6], mm[7]); pf[kp] = as_bf16x8(pw); }
                f32x4 y[4];
#pragma unroll
                for (int pt = 0; pt < 4; ++pt) { y[pt] = (f32x4){0.f, 0.f, 0.f, 0.f};
#pragma unroll
                    for (int kk = 0; kk < 4; ++kk) { const bf16x8 a = *(const LAS bf16x8*)(prevs + swz256(16 * pt + r16, 64 * kk + 16 * q4)); y[pt] = mfma16(a, as_bf16x8(cfr[kk]), y[pt]); } }
                const float el = __expf(al);
#pragma unroll
                for (int pt = 0; pt < 4; ++pt) y[pt] = y[pt] * el;
#pragma unroll
                for (int kp = 0; kp < 4; ++kp)
#pragma unroll
                    for (int pt = 0; pt < 4; ++pt) { const u32x2 lo = *(const LAS u32x2*)(xTs + swz256(16 * pt + r16, 64 * kp + 8 * q4)), hi = *(const LAS u32x2*)(xTs + swz256(16 * pt + r16, 64 * kp + 32 + 8 * q4));
                        const u32x4 av = (u32x4){lo.x, lo.y, hi.x, hi.y}; y[pt] = mfma16(as_bf16x8(av), pf[kp], y[pt]); }
                if (c < 32) { const bf16* cp = cbb + (size_t)c * 65536 + (size_t)(16 * w + r16) * 128 + 4 * q4;
#pragma unroll
                    for (int i = 0; i < 8; ++i) cbr[i] = *(const u32x2*)(cp + 16 * i);
                    const bf16* ccp = XA + ((size_t)b * SEQ + c * 128 + 16 * w + r16) * 3072 + 2560 + g * 128 + 8 * q4;
#pragma unroll
                    for (int kk = 0; kk < 4; ++kk) cfr[kk] = *(const u32x4*)(ccp + 32 * kk); }
                { const size_t tok = (size_t)tok0 + l; float ssq = 0.f;
#pragma unroll
                    for (int pt = 0; pt < 4; ++pt) { const int p0 = 16 * pt + 4 * q4;
                        float ov[4];
#pragma unroll
                        for (int jj = 0; jj < 4; ++jj) { const float xvv = bf2f(*(const LAS unsigned short*)(xTs + swz256(p0 + jj, 2 * l)));
                            const unsigned zw = (jj < 2) ? zz[pt].x : zz[pt].y; const float zf = (jj & 1) ? bfhi(zw) : bflo(zw);
                            ov[jj] = (y[pt][jj] + Dh * xvv) * silu_f(zf); }
                        ssq += (ov[0] * ov[0] + ov[1] * ov[1]) + (ov[2] * ov[2] + ov[3] * ov[3]);
                        u32x2 q; q.x = pk2(ov[0], ov[1]); q.y = pk2(ov[2], ov[3]); *(u32x2*)(Y + tok * DI + h * 64 + p0) = q; }
                    ssq += __shfl_xor(ssq, 16); ssq += __shfl_xor(ssq, 32);
                    if (q4 == 0) SSQ[tok * 32 + h] = ssq; }
                { const float dec = __expf(acum[384]);
#pragma unroll
                    for (int pt = 0; pt < 4; ++pt) st[pt] = st[pt] * dec;
#pragma unroll
                    for (int kk = 0; kk < 4; ++kk) { const u32x4 a = *(const LAS u32x4*)(BTs + swz256(16 * w + r16, 64 * kk + 16 * q4));
                        const f32x4 w0 = *(const LAS f32x4*)(wdec + 32 * kk + 8 * q4), w1 = *(const LAS f32x4*)(wdec + 32 * kk + 8 * q4 + 4);
                        u32x4 aw; aw.x = pk2(bflo(a.x) * w0[0], bfhi(a.x) * w0[1]); aw.y = pk2(bflo(a.y) * w0[2], bfhi(a.y) * w0[3]); aw.z = pk2(bflo(a.z) * w1[0], bfhi(a.z) * w1[1]); aw.w = pk2(bflo(a.w) * w1[2], bfhi(a.w) * w1[3]);
#pragma unroll
                        for (int pt = 0; pt < 4; ++pt) { const bf16x8 bfr = *(const LAS bf16x8*)(xTs + swz256(16 * pt + r16, 64 * kk + 16 * q4)); st[pt] = mfma16(as_bf16x8(aw), bfr, st[pt]); } } }
            } else {
                const bf16* cp = cbb + (size_t)(16 * w + r16) * 128 + 4 * q4;
#pragma unroll
                for (int i = 0; i < 8; ++i) cbr[i] = *(const u32x2*)(cp + 16 * i);
                const bf16* ccp = XA + ((size_t)b * SEQ + 16 * w + r16) * 3072 + 2560 + g * 128 + 8 * q4;
#pragma unroll
                for (int kk = 0; kk < 4; ++kk) cfr[kk] = *(const u32x4*)(ccp + 32 * kk);
            }
            if (c < 32) {
#pragma unroll
                for (int pt = 0; pt < 4; ++pt) { u32x2 q; q.x = pk2(st[pt][0], st[pt][1]); q.y = pk2(st[pt][2], st[pt][3]); *(LAS u32x2*)(prn + swz256(16 * pt + r16, 2 * (16 * w + 4 * q4))) = q; }
                if (w == 0) { const int t0 = 2 * lane; const float d0 = dn0, d1 = dn1;
                    const float a0 = d0 * Ah, a1 = d1 * Ah; const float sm = a0 + a1; float incl = sm;
#pragma unroll
                    for (int off = 1; off < 64; off <<= 1) { const float v = __shfl_up(incl, off); if (lane >= off) incl += v; }
                    const float c0 = (incl - sm) + a0, c1 = incl; const float tot = __shfl(incl, 63);
                    fan[t0] = c0; fan[t0 + 1] = c1; fan[128 + t0] = d0; fan[128 + t0 + 1] = d1; fan[256 + t0] = d0 * __expf(tot - c0); fan[256 + t0 + 1] = d1 * __expf(tot - c1); if (lane == 63) fan[384] = tot; }
#pragma unroll
                for (int it = 0; it < 3; ++it) { const int cgi = 4 * (2 * it + (w >> 2)) + (lane >> 4);
                    LAS unsigned char* dst = (it == 0) ? xTn : BTn; const int r0 = (it == 0) ? (8 * cgi) : (8 * (cgi - 8));
#pragma unroll
                    for (int i = 0; i < 8; ++i) { const unsigned a0 = pre[it][0][i >> 1], a1 = pre[it][1][i >> 1];
                        const unsigned lo = (i & 1) ? (a0 >> 16) : (a0 & 0xffffu), hi = (i & 1) ? (a1 & 0xffff0000u) : (a1 << 16);
                        *(LAS unsigned*)(dst + swz256(r0 + i, 4 * jp)) = lo | hi; } }
                if (c < 31) {
#pragma unroll
                    for (int it = 0; it < 3; ++it) { const char* sb = xab + (size_t)(c + 1) * (128 * 6144) + chb[it]; pre[it][0] = *(const u32x4*)(sb + voff); pre[it][1] = *(const u32x4*)(sb + voff + 6144); }
                    if (w == 0) { const size_t t1 = (size_t)b * SEQ + (c + 1) * 128; dn0 = DT[(t1 + 2 * lane) * 32 + h]; dn1 = DT[(t1 + 2 * lane + 1) * 32 + h]; }
                }
            }
            lds_barrier();
        }
    }
}
__device__ __forceinline__ void rmsnorm_phase(bf16* Y, int G, int vcu) {
    const int tid = threadIdx.x, lane = tid & 63, w = tid >> 6;
    const int gw = vcu * 8 + w, NGW = G * 8;
    for (int row = gw; row < T; row += NGW) {
        u32x4* rp = (u32x4*)(Y + (size_t)row * DI) + lane;
#pragma unroll
        for (int j = 0; j < 4; ++j) { const u32x4 a = rp[64 * j]; float f[8]; float ss = 0.f;
#pragma unroll
            for (int i = 0; i < 4; ++i) { f[2 * i] = bflo(a[i]); f[2 * i + 1] = bfhi(a[i]); ss += f[2 * i] * f[2 * i] + f[2 * i + 1] * f[2 * i + 1]; }
            const float sc = 1.0f / sqrtf(wave_sum(ss) * (1.0f / 512.0f) + RMS_EPS);
            u32x4 o;
#pragma unroll
            for (int i = 0; i < 4; ++i) o[i] = pk2(f[2 * i] * sc, f[2 * i + 1] * sc);
            rp[64 * j] = o; }
    }
}

__device__ __forceinline__ int moe_tables(LAS unsigned char* lds, const unsigned* counts) {
    const int tid = threadIdx.x;
    LAS int* tab = (LAS int*)(lds + LDS_TAB);
    if (tid < 32) tab[64 + tid] = (int)__hip_atomic_load(counts + tid, __ATOMIC_RELAXED, __HIP_MEMORY_SCOPE_AGENT);
    __syncthreads();
    if (tid == 0) { int pre = 0; for (int e = 0; e < 32; ++e) { tab[e] = pre; pre += (tab[64 + e] + 255) >> 8; } tab[32] = pre; }
    __syncthreads();
    const int NB = tab[32];
    for (int rb = tid; rb < NB; rb += 512) { int e = 0; while (e < 31 && tab[e + 1] <= rb) ++e; tab[128 + rb] = e; }
    __syncthreads();
    return NB;
}

struct Args { const void* in[22]; float* out; unsigned char* ws; int ph_lo, ph_hi; };
__global__ void __launch_bounds__(512, 2) fwd_kernel(Args args) {
    extern __shared__ __attribute__((aligned(16))) unsigned char lds_raw[];
    LAS unsigned char* lds = (LAS unsigned char*)lds_raw;
    const int tid = threadIdx.x;
    const int G = gridDim.x; const int bx = blockIdx.x; const int vcu = (G % 8 == 0) ? (bx % 8) * (G / 8) + bx / 8 : bx;
    unsigned char* ws = args.ws;
    unsigned* ctl = (unsigned*)(ws + WS_CTL);
    Ptrs P;
    P.x = (const float*)args.in[0]; P.pos = (const int*)args.in[1]; P.attn_w_in = (const float*)args.in[2]; P.attn_w_out = (const float*)args.in[3]; P.ssm_w_in = (const float*)args.in[4];
    P.conv_w = (const float*)args.in[5]; P.conv_b = (const float*)args.in[6]; P.dt_bias = (const float*)args.in[7]; P.a_log = (const float*)args.in[8]; P.d_skip = (const float*)args.in[9];
    P.norm_w = (const float*)args.in[10]; P.ssm_w_out = (const float*)args.in[11]; P.w_router = (const float*)args.in[12]; P.b_router = (const float*)args.in[13]; P.w_up = (const float*)args.in[14];
    P.b_up = (const float*)args.in[15]; P.w_dn = (const float*)args.in[16]; P.b_dn = (const float*)args.in[17]; P.ln_mix_g = (const float*)args.in[18]; P.ln_mix_b = (const float*)args.in[19];
    P.ln_ffn_g = (const float*)args.in[20]; P.ln_ffn_b = (const float*)args.in[21];
    volatile LAS unsigned* misc = (volatile LAS unsigned*)(lds + LDS_MISC);
    if (tid < 64) misc[tid] = 0u;
    __syncthreads();
    XcdBarrier bar; bar.bar = ctl + CW_BAR; bar.x = 0; bar.st = misc;
    if (!MK_PER_PHASE) bar = xcd_barrier_post(ctl + CW_BAR, misc);
    const int lo = args.ph_lo, hi = args.ph_hi;
#ifndef PH_MASK
#define PH_MASK 0x1FFFF
#endif
#define IN(k) ((((PH_MASK) >> (k)) & 1) && lo <= (k) && (k) < hi)
#define SEAM(k) do { if (IN(k) && IN((k) + 1)) xcd_barrier(bar); } while (0)

    bf16* Wqkv = (bf16*)(ws + WS_WQKV); bf16* Wao = (bf16*)(ws + WS_WAO); bf16* Wsi = (bf16*)(ws + WS_WSI); bf16* Wso = (bf16*)(ws + WS_WSO);
    bf16* XBA = (bf16*)(ws + WS_XBA); bf16* XBB = (bf16*)(ws + WS_XBB); bf16* MIXB = (bf16*)(ws + WS_X1);
    unsigned char* PROJ = ws + WS_BIG; bf16* ZX = (bf16*)(ws + WS_BIG); bf16* XA = (bf16*)(ws + WS_XA); bf16* CBG = (bf16*)(ws + WS_CBG); unsigned char* HB8 = ws + WS_HB; unsigned char* XQ = ws + WS_XQ; unsigned char* YS = ws + WS_YS;
    unsigned char* OG = ws + WS_OG; bf16* YB = (bf16*)(ws + WS_OG);
    float* rope = (float*)(ws + WS_ROPE); float* gates = (float*)(ws + WS_GATES); float* DT = (float*)(ws + WS_DT); int* lists = (int*)(ws + WS_LIST); float* LSE = (float*)(ws + WS_LSE); float* SSQ = (float*)(ws + WS_LSE);

    if (IN(0)) { p0_prologue(lds, P, ws, G, vcu); }
    SEAM(0);


#define MOE_BLOCK(LAYER, PB) do { \
    unsigned* counts = ctl + CW_CNT + 64 * (LAYER); \
    if (IN((PB) + 0)) { \
        if ((LAYER) == 0) ln_phase<0, 1, true, false, true>(lds, (const bf16*)P.x, MIXB, nullptr, nullptr, P.ln_mix_g, P.ln_mix_b, nullptr, XBB, P.w_router, NE, P.b_router, gates, lists, counts, nullptr, G, vcu, XQ);   \
        else ln_phase<0, 1, true, false>(lds, XBA, MIXB, nullptr, nullptr, P.ln_mix_g + (LAYER) * DM, P.ln_mix_b + (LAYER) * DM, nullptr, XBB, \
                             P.w_router + (size_t)(LAYER) * DM * NE, NE, P.b_router + (LAYER) * NE, gates, lists, counts, nullptr, G, vcu, XQ); } \
    SEAM((PB) + 0); \
    if (IN((PB) + 1)) { \
        const int NB = moe_tables(lds, counts); \
        LAS int* tab = (LAS int*)(lds + LDS_TAB); LAS unsigned short* toks = (LAS unsigned short*)(lds + LDS_AUX); \
        const int NU = NB * 8; \
        const int nun = (vcu < NU) ? ((NU - vcu + G - 1) / G) : 0; \
        for (int idx = tid; idx < nun * 256 && idx < 17 * 256; idx += 512) { const int i = idx >> 8, row = idx & 255; const int L = i * G + vcu; const int rb = L >> 3; const int e = tab[128 + rb]; \
            const int r0 = (rb - tab[e]) * 256, cnt = tab[64 + e]; int si = r0 + row; si = si < cnt ? si : cnt - 1; toks[idx] = (unsigned short)(lists[(size_t)e * 32768 + si] >> 2); } \
        LAS unsigned* btab = (LAS unsigned*)(lds + LDS_SLOT); \
        for (int idx = tid; idx < nun * 128 && idx < 17 * 128; idx += 512) { const int i = idx >> 7, cp = idx & 127; const int L = i * G + vcu; const int rb = L >> 3, pn = L & 7; const int e = tab[128 + rb]; \
            const float* bsrc = P.b_up + ((size_t)(LAYER) * 32 + e) * 2048 + ((cp < 64) ? (pn * 128 + 2 * cp) : (1024 + pn * 128 + 2 * (cp - 64))); btab[idx] = pk2(bsrc[0], bsrc[1]); } \
        __syncthreads(); \
        pg8::MoeOrder<true> S; S.A = (const char*)XQ; S.Bt = (const char*)(ws + WS_WUP + (size_t)(LAYER) * 32 * 2048 * 1024); S.K = DM / 2;   S.N = 2048; S.nN = 8; S.G = G; S.c = vcu; S.NU = NU; S.tab = tab; S.toks = toks; \
        pg8::EpiUp E{HB8, btab}; \
        if ((LAYER) == 0) { pg8::HostCvt H; H.w_up = P.w_up + (size_t)32 * 1024 * 2048; H.w_dn = P.w_dn + (size_t)32 * 1024 * 1024; H.wt_up = ws + WS_WUP + (size_t)32 * 2048 * 1024; H.wt_dn = ws + WS_WDN + (size_t)32 * 1024 * 1024; \
            H.base = 0; H.limit = 49152; H.G = G; H.c = vcu;   \
            pg8::gemm_phase<true>(lds, DM / 2, S, E, H); } \
        else { pg8::HostNone H; pg8::gemm_phase<true>(lds, DM / 2, S, E, H); } } \
    SEAM((PB) + 1); \
    if (IN((PB) + 2)) { \
        const int NB = moe_tables(lds, counts); \
        LAS int* tab = (LAS int*)(lds + LDS_TAB); LAS int* slots = (LAS int*)(lds + LDS_SLOT); LAS unsigned* dbtab = (LAS unsigned*)(lds + LDS_AUX); \
        { const int NU = NB * 4; const int nun = (vcu < NU) ? ((NU - vcu + G - 1) / G) : 0; \
          for (int idx = tid; idx < nun * 256 && idx < 9 * 256; idx += 512) { const int i = idx >> 8, row = idx & 255; const int L = i * G + vcu; const int rb = L >> 2; const int e = tab[128 + rb]; \
              const int si = (rb - tab[e]) * 256 + row; slots[idx] = (si < tab[64 + e]) ? lists[(size_t)e * 32768 + si] : -1; } \
          for (int idx = tid; idx < nun * 128 && idx < 9 * 128; idx += 512) { const int i = idx >> 7, cp = idx & 127; const int L = i * G + vcu; const int rb = L >> 2, pn = L & 3; const int e = tab[128 + rb]; \
              const float* bsrc = P.b_dn + ((size_t)(LAYER) * 32 + e) * 1024 + pn * 256 + 2 * cp; dbtab[idx] = pk2(bsrc[0], bsrc[1]); } \
          __syncthreads(); } \
        pg8::MoeOrder<false> S; S.A = (const char*)HB8; S.Bt = (const char*)(ws + WS_WDN + (size_t)(LAYER) * 32 * 1024 * 1024); S.K = DM / 2; S.N = 1024; S.nN = 4; S.G = G; S.c = vcu; S.NU = NB * 4; S.tab = tab; S.toks = nullptr; \
        pg8::EpiDown E{YS, dbtab, slots}; \
        if ((LAYER) == 0) { pg8::HostCvt H; H.w_up = P.w_up + (size_t)32 * 1024 * 2048; H.w_dn = P.w_dn + (size_t)32 * 1024 * 1024; H.wt_up = ws + WS_WUP + (size_t)32 * 2048 * 1024; H.wt_dn = ws + WS_WDN + (size_t)32 * 1024 * 1024; \
            H.base = NB * 64; H.limit = 49152; H.G = G; H.c = vcu;   \
            pg8::gemm_phase<true>(lds, DM / 2, S, E, H); } \
        else { pg8::HostNone H; pg8::gemm_phase<true>(lds, DM / 2, S, E, H); } } \
    SEAM((PB) + 2); \
    if (IN((PB) + 3)) { \
        if ((LAYER) == 0) ln_phase<1, 2, true, false>(lds, XBB, nullptr, YS, gates, P.ln_ffn_g, P.ln_ffn_b, nullptr, XBA, P.ssm_w_in + NZX, SSM_PITCH, P.dt_bias, nullptr, nullptr, nullptr, DT, G, vcu, ws + WS_XQ0); \
        else ln_phase<1, 0, false, true>(lds, XBB, nullptr, YS, gates, P.ln_ffn_g + DM, P.ln_ffn_b + DM, args.out, nullptr, nullptr, 0, nullptr, nullptr, nullptr, nullptr, nullptr, G, vcu); } \
    } while (0)

    if (IN(1)) { pg8::DenseOrder S; S.init(ws + WS_XQ0, Wqkv, T, NQKV, DM / 2, G, bx); pg8::EpiQKV E{PROJ, rope, 1.0f / (Q8_X * Q8_W)};
        pg8::HostCvt H; H.w_up = P.w_up; H.w_dn = P.w_dn; H.wt_up = ws + WS_WUP; H.wt_dn = ws + WS_WDN; H.base = 0; H.limit = 2 * HOSTED_ITEMS; H.G = G; H.c = bx;
        pg8::gemm_phase<true>(lds, DM / 2, S, E, H); }
    SEAM(1);
    if (IN(2)) attn_phase(lds, PROJ, OG, LSE, G, vcu);
    SEAM(2);
    if (IN(3)) combine_phase(OG, LSE, ws + WS_OB, G, vcu);
    SEAM(3);
    if (IN(4)) { pg8::DenseOrder S; S.init(ws + WS_OB, Wao, T, DM, DM / 2, G, bx); pg8::EpiBf16 E{MIXB, DM, 1.0f / (Q8_O * Q8_W)}; pg8::HostNone H; pg8::gemm_phase<true>(lds, DM / 2, S, E, H); }
    SEAM(4);
    MOE_BLOCK(0, 5);
    SEAM(8);
    if (IN(9)) { pg8::DenseOrder S; S.init(ws + WS_XQ0, Wsi, T, NZX, DM / 2, G, bx); pg8::EpiBf16 E{ZX, NZX, 1.0f / (Q8_X * Q8_W)}; pg8::HostNone H; pg8::gemm_phase<true>(lds, DM / 2, S, E, H); }
    SEAM(9);
    if (IN(10)) {
        convcb_phase(lds, ZX, P.conv_w, P.conv_b, XA, CBG, G, vcu); }
    SEAM(10);
    if (IN(11)) ssd_phase(lds, ZX, XA, CBG, DT, P.a_log, P.d_skip, YB, SSQ, G, vcu);
    SEAM(11);
    if (IN(12)) { pg8::DenseOrder S; S.init(YB, Wso, T, DM, DI, G, bx);
        LAS float* stab = (LAS float*)(lds + LDS_AUX);
        for (int i = 0; i < 4; ++i) { pg8::Unit uu; if (!S.next(i, uu)) break;
            for (int idx = tid; idx < 1024; idx += 512) { const int rl = idx >> 2, g = idx & 3; const float* sp = SSQ + (size_t)(uu.pm * 256 + rl) * 32 + g * 8;
                const f32x4 a = *(const f32x4*)sp, b4 = *(const f32x4*)(sp + 4); const float sum = ((a[0] + a[1]) + (a[2] + a[3])) + ((b4[0] + b4[1]) + (b4[2] + b4[3]));
                stab[(i * 256 + rl) * 4 + g] = __builtin_amdgcn_rsqf(sum * (1.0f / 512.0f) + RMS_EPS); } }
        __syncthreads();
        pg8::EpiRms E{MIXB, DM, stab}; pg8::HostNone H; pg8::gemm_phase(lds, DI, S, E, H); }
    SEAM(12);
    MOE_BLOCK(1, 13);
#undef IN
#undef SEAM
#undef MOE_BLOCK
}

constexpr int NPHASE = 17;
extern "C" void kernel_launch(void* const* d_in, const int* in_sizes, int n_in, void* d_out, int out_size, void* d_ws, size_t ws_size, hipStream_t stream) {
    static int grid = 0;
    if (grid == 0) {
        if (n_in != 22 || in_sizes[0] != T * DM || out_size != T * DM || ws_size < WS_END) { fprintf(stderr, "kernel_launch: unexpected shapes / workspace (n_in %d, in0 %d, out %d, ws %zu, need %zu)\n", n_in, n_in > 0 ? in_sizes[0] : -1, out_size, ws_size, (size_t)WS_END); grid = -1; return; }
        int dev = 0, cus = 0;
        if (hipGetDevice(&dev) != hipSuccess || hipDeviceGetAttribute(&cus, hipDeviceAttributeMultiprocessorCount, dev) != hipSuccess) { fprintf(stderr, "kernel_launch: device query failed\n"); grid = -1; return; }
        if (hipFuncSetAttribute((const void*)fwd_kernel, hipFuncAttributeMaxDynamicSharedMemorySize, LDS_BYTES) != hipSuccess) { fprintf(stderr, "kernel_launch: hipFuncSetAttribute failed\n"); grid = -1; return; }
        int per_cu = 0;
        if (hipOccupancyMaxActiveBlocksPerMultiprocessor(&per_cu, (const void*)fwd_kernel, 512, LDS_BYTES) != hipSuccess || per_cu < 1) fprintf(stderr, "kernel_launch: occupancy query reports %d\n", per_cu);
        (void)hipGetLastError();
        grid = cus;
        if (grid < 256) { fprintf(stderr, "kernel_launch: built for >= 256 CUs, got %d\n", grid); }
        if (grid > 256) grid = 256;
    }
    if (grid < 0) return;
    if (hipMemsetAsync((char*)d_ws + WS_CTL, 0, CTL_ZERO_BYTES, stream) != hipSuccess) { fprintf(stderr, "kernel_launch: memset failed\n"); return; }
    Args a{};
    for (int i = 0; i < 22; ++i) a.in[i] = d_in[i];
    a.out = (float*)d_out; a.ws = (unsigned char*)d_ws;
#if MK_PER_PHASE
    for (int p = 0; p < NPHASE; ++p) { a.ph_lo = p; a.ph_hi = p + 1; hipLaunchKernelGGL(fwd_kernel, dim3(grid), dim3(512), LDS_BYTES, stream, a); }
#else
    a.ph_lo = 0; a.ph_hi = NPHASE;
    hipLaunchKernelGGL(fwd_kernel, dim3(grid), dim3(512), LDS_BYTES, stream, a);
#endif
    const hipError_t le = hipPeekAtLastError();
    if (le != hipSuccess) fprintf(stderr, "kernel_launch: launch failed: %s\n", hipGetErrorName(le));
}
```

```cpp
#include <hip/hip_runtime.h>
#include <cstdio>
#include <cstdint>

#ifndef MK_PER_PHASE
#define MK_PER_PHASE 0
#endif

#define GAS __attribute__((address_space(1)))
#define LAS __attribute__((address_space(3)))
typedef unsigned short bf16;
typedef short bf16x8 __attribute__((ext_vector_type(8)));
typedef float f32x4 __attribute__((ext_vector_type(4)));
typedef float f32x2 __attribute__((ext_vector_type(2)));
typedef unsigned u32x4 __attribute__((ext_vector_type(4)));
typedef unsigned u32x2 __attribute__((ext_vector_type(2)));

constexpr int BATCH = 8, SEQ = 4096, DM = 1024, T = BATCH * SEQ;
constexpr int NQKV = 9216;
constexpr int NZX = 5120, SSM_PITCH = 5152, DI = 2048;
constexpr int NE = 32;
constexpr float LN_EPS = 1e-5f, RMS_EPS = 1e-5f, ALPHA = 1.41421356237309505f;
constexpr float QSCALE = 0.12751743082459868f;
constexpr float LN2F = 0.6931471805599453f;

constexpr size_t MiB = 1u << 20;
constexpr size_t WS_CTL = 0, CTL_ZERO_BYTES = 128 * 1024;
constexpr size_t WS_ROPE = 1 * MiB;
constexpr size_t WS_GATES = 5 * MiB;
constexpr size_t WS_DT = 6 * MiB;
constexpr size_t WS_LIST = 10 * MiB;
constexpr size_t WS_LSE = 14 * MiB;
constexpr size_t WS_WQKV = 18 * MiB;
constexpr size_t WS_WAO = 36 * MiB;
constexpr size_t WS_WSI = 38 * MiB;
constexpr size_t WS_WSO = 48 * MiB;
constexpr size_t WS_WUP = 52 * MiB;
constexpr size_t WS_XQ = 180 * MiB;
constexpr size_t WS_XQ0 = 212 * MiB;
constexpr size_t WS_WDN = 308 * MiB;
constexpr size_t WS_XBA = 436 * MiB;
constexpr size_t WS_XBB = 500 * MiB;
constexpr size_t WS_X1 = 564 * MiB;
constexpr size_t WS_BIG = 692 * MiB;
constexpr size_t WS_XA = 1012 * MiB;
constexpr size_t WS_CBG = 1204 * MiB;
constexpr size_t WS_HB = WS_BIG;
constexpr size_t WS_YS = 964 * MiB;
constexpr size_t WS_OG = 1268 * MiB;
constexpr size_t WS_OB = 1460 * MiB;
constexpr size_t WS_END = 1524 * MiB;
constexpr int CW_BAR = 4096;
constexpr int CW_CNT = 16384;
constexpr int CW_CVT = 20000;
#ifndef CVT_Q_UP
#define CVT_Q_UP 5
#endif
#ifndef CVT_Q_DN
#define CVT_Q_DN 5
#endif

constexpr int LDS_AUX = 131072;
constexpr int LDS_TAB = 131072 + 17 * 512;
constexpr int LDS_SLOT = LDS_TAB + 2688;
constexpr int LDS_SM = 147456;
constexpr int LDS_MISC = 155648;
constexpr int LDS_BYTES = 156672;

__device__ __forceinline__ float bf2f(unsigned short b) { return __uint_as_float(((unsigned)b) << 16); }
__device__ __forceinline__ float bflo(unsigned w) { return __uint_as_float(w << 16); }
__device__ __forceinline__ float bfhi(unsigned w) { return __uint_as_float(w & 0xffff0000u); }
typedef __bf16 bf16x2_t __attribute__((ext_vector_type(2)));
constexpr float Q8_X = 8.0f, Q8_W = 256.0f, Q8_H = 8.0f, Q8_O = 32.0f, Q8_Y = 32.0f, Q8_Q = 64.0f, Q8_K = 8.0f, Q8_V = 8.0f, Q8_YS = 16.0f;
__device__ __forceinline__ unsigned pk4_f8(float a, float b, float c, float d, float sc) {
    a = __builtin_fminf(__builtin_fmaxf(a * sc, -448.f), 448.f); b = __builtin_fminf(__builtin_fmaxf(b * sc, -448.f), 448.f);
    c = __builtin_fminf(__builtin_fmaxf(c * sc, -448.f), 448.f); d = __builtin_fminf(__builtin_fmaxf(d * sc, -448.f), 448.f);
    int p = __builtin_amdgcn_cvt_pk_fp8_f32(a, b, 0, false); p = __builtin_amdgcn_cvt_pk_fp8_f32(c, d, p, true); return (unsigned)p; }
__device__ __forceinline__ unsigned pk2(float lo, float hi) { const f32x2 v = {lo, hi}; const bf16x2_t b = __builtin_convertvector(v, bf16x2_t); return __builtin_bit_cast(unsigned, b); }
__device__ __forceinline__ float wave_sum(float v) {
#pragma unroll
    for (int o = 1; o < 64; o <<= 1) v += __shfl_xor(v, o);
    return v;
}
constexpr int P256 = 272, P512 = 528;
__device__ __forceinline__ int swz256(int row, int bc) { return row * P256 + bc; }
__device__ __forceinline__ int swz512(int row, int bc) { return row * P512 + bc; }
__device__ __forceinline__ bf16x8 as_bf16x8(u32x4 v) { return __builtin_bit_cast(bf16x8, v); }
__device__ __forceinline__ f32x4 mfma16(bf16x8 a, bf16x8 b, f32x4 c) { return __builtin_amdgcn_mfma_f32_16x16x32_bf16(a, b, c, 0, 0, 0); }
__device__ __forceinline__ void lds_barrier() { asm volatile("s_waitcnt lgkmcnt(0)" ::: "memory"); __builtin_amdgcn_s_barrier(); asm volatile("" ::: "memory"); }
__device__ __forceinline__ float silu_f(float v) { return v * __builtin_amdgcn_rcpf(1.0f + __expf(-v)); }

#define XB_TMO      128
#define XB_XCNT(j)  (256  + 64 * (j))
#define XB_XSUB(j)  (1280 + 64 * (j))
#define XB_XGEN(j)  (2304 + 64 * (j))
#define XB_TOP      3328
#define XB_TOPGEN   3392
#define XCD_BAR_WORDS 3456
#define XB_SPIN_CAP (1u << 18)
__device__ __forceinline__ unsigned xb_ld(unsigned* p)              { return __hip_atomic_load(p, __ATOMIC_RELAXED, __HIP_MEMORY_SCOPE_AGENT); }
__device__ __forceinline__ unsigned xb_add(unsigned* p, unsigned v) { return __hip_atomic_fetch_add(p, v, __ATOMIC_RELAXED, __HIP_MEMORY_SCOPE_AGENT); }
__device__ __forceinline__ unsigned xb_xcc_id() { return (unsigned)__builtin_amdgcn_s_getreg((3 << 11) | 20) & 0xFu; }
#define XB_SPIN(cond, bar) do { unsigned _sp = 0; while (cond) { __builtin_amdgcn_s_sleep(1); \
    if ((++_sp & 255u) == 0u) { if (xb_ld(&(bar)[XB_TMO])) break; if (_sp > XB_SPIN_CAP) { atomicAdd(&(bar)[XB_TMO], 1u); break; } } } } while (0)
struct XcdBarrier { unsigned* bar; unsigned x; volatile LAS unsigned* st; };
__device__ __forceinline__ XcdBarrier xcd_barrier_post(unsigned* bar, volatile LAS unsigned* st) {
    XcdBarrier b; b.bar = bar; b.x = xb_xcc_id(); b.st = st;
    if (threadIdx.x == 0) (void)xb_add(&bar[XB_XCNT(b.x)], 1u);
    return b;
}
__device__ __forceinline__ void xcd_barrier_complete(unsigned* bar, unsigned x, unsigned& nloc, unsigned& nx) {
    const unsigned G = gridDim.x * gridDim.y * gridDim.z;
    unsigned sum, cnt, mine, sp = 0u;
    for (;;) {
        sum = 0u; cnt = 0u; mine = 0u;
#pragma unroll
        for (unsigned j = 0; j < 16; ++j) { const unsigned c = xb_ld(&bar[XB_XCNT(j)]); sum += c; cnt += (c > 0u) ? 1u : 0u; mine = (j == x) ? c : mine; }
        if (sum == G) break;
        __builtin_amdgcn_s_sleep(1);
        if ((++sp & 255u) == 0u) { if (xb_ld(&bar[XB_TMO])) break; if (sp > XB_SPIN_CAP) { atomicAdd(&bar[XB_TMO], 1u); break; } }
    }
    nloc = mine > 0u ? mine : 1u; nx = cnt > 0u ? cnt : 1u;
}
__device__ __forceinline__ void xcd_barrier(const XcdBarrier& b) {
    asm volatile("s_waitcnt vmcnt(0)" ::: "memory");
    __syncthreads();
    if (threadIdx.x == 0) {
        unsigned* bar = b.bar;
        __builtin_amdgcn_s_waitcnt(0);
        unsigned nloc = b.st[0], nx = b.st[1];
        if (nloc == 0u) { xcd_barrier_complete(bar, b.x, nloc, nx); b.st[0] = nloc; b.st[1] = nx; }
        const unsigned old = xb_add(&bar[XB_XSUB(b.x)], 1u);
        const unsigned gen = old / nloc;
        if (old + 1u == (gen + 1u) * nloc) {
            __builtin_amdgcn_fence(__ATOMIC_RELEASE, "agent");
            asm volatile("s_waitcnt vmcnt(0)" ::: "memory");
            const unsigned og = xb_add(&bar[XB_TOP], 1u);
            const unsigned tg = og / nx;
            if (og + 1u == (tg + 1u) * nx) xb_add(&bar[XB_TOPGEN], 1u);
            else XB_SPIN(xb_ld(&bar[XB_TOPGEN]) == tg, bar);
            __builtin_amdgcn_fence(__ATOMIC_ACQUIRE, "agent");
            xb_add(&bar[XB_XGEN(b.x)], 1u);
            asm volatile("s_waitcnt vmcnt(0)" ::: "memory");
        } else {
            XB_SPIN(xb_ld(&bar[XB_XGEN(b.x)]) == gen, bar);
            __builtin_amdgcn_fence(__ATOMIC_ACQUIRE, "agent");
            asm volatile("s_waitcnt vmcnt(0)" ::: "memory");
        }
    }
    __syncthreads();
}

namespace pg8 {
constexpr int BM = 256, BK = 64, HALF = 128, HTB = HALF * BK * 2, STAGE_BYTES = 8 * HTB, NXCD = 8, WGM = 4;
__host__ __device__ __forceinline__ int lds_byte(int r, int c) { const int st = (r >> 4) * 2 + (c >> 5), rr = r & 15, cc = c & 31, ob = rr * 64 + cc * 2; return st * 1024 + (ob ^ (((ob >> 9) & 1) << 5)); }
__host__ __device__ __forceinline__ void stage_rc(int b, int& R, int& C) { const int st = b / 1024, sb = b % 1024, swz = sb ^ (((sb >> 9) & 1) << 5); R = (st >> 1) * 16 + swz / 64; C = (st & 1) * 32 + (swz % 64) / 2; }
__host__ __device__ __forceinline__ int perm32(int rho) { const int n = rho >> 4, i = rho & 15; return 8 * (i >> 2) + 4 * n + (i & 3); }

struct Unit { int pm, pn, e, r0, cnt, ord; };
typedef int i32x8_t __attribute__((ext_vector_type(8))); typedef int i32x4_t __attribute__((ext_vector_type(4)));
__device__ __forceinline__ i32x8_t cat8(const bf16x8& a, const bf16x8& b) { return __builtin_shufflevector(__builtin_bit_cast(i32x4_t, a), __builtin_bit_cast(i32x4_t, b), 0, 1, 2, 3, 4, 5, 6, 7); }

struct DenseOrder {
    static constexpr bool GATHER_A = false;
    const char* A; const char* Bt; int K, nM, nN, nwg, G, c;
    __device__ __forceinline__ void init(const void* A_, const void* Bt_, int M, int N, int K_, int G_, int c_) { A = (const char*)A_; Bt = (const char*)Bt_; K = K_; nM = M / BM; nN = N / BM; nwg = nM * nN; G = G_; c = c_; }
    __device__ __forceinline__ bool next(int i, Unit& u) const {
        const long L = (long)i * G + c; if (L >= nwg) return false;
        int wgid = (int)L; { const int q = nwg / NXCD, r = nwg % NXCD, xcd = wgid % NXCD, off = wgid / NXCD; wgid = (xcd < r ? xcd * (q + 1) : r * (q + 1) + (xcd - r) * q) + off; }
        const int nig = WGM * nN, gid = wgid / nig, fm = gid * WGM, gsz = (nM - fm) < WGM ? (nM - fm) : WGM;
        u.pm = fm + ((wgid % nig) % gsz); u.pn = (wgid % nig) / gsz; u.e = 0; u.r0 = 0; u.cnt = 0; u.ord = i; return true;
    }
    __device__ __forceinline__ const char* a_base(const Unit& u) const { return A + (size_t)u.pm * ((size_t)BM * K * 2); }
    __device__ __forceinline__ const char* b_base(const Unit& u) const { return Bt + (size_t)u.pn * ((size_t)BM * K * 2); }
    __device__ __forceinline__ void a_offs(const Unit&, unsigned (&v)[2][2]) const {
#pragma unroll
        for (int i = 0; i < 2; ++i) { int R, C; stage_rc((int)threadIdx.x * 16 + i * 8192, R, C);
#pragma unroll
            for (int h = 0; h < 2; ++h) v[h][i] = (unsigned)((h * HALF + R) * K + C) * 2u; }
    }
};
template <bool GATHER> struct MoeOrder {
    static constexpr bool GATHER_A = GATHER;
    const char* A; const char* Bt; int K, N, nN, G, c, NU; const LAS int* tab; const LAS unsigned short* toks;
    __device__ __forceinline__ bool next(int i, Unit& u) const {
        const int L = i * G + c; if (L >= NU) return false;
        const int rb = L / nN; u.pn = L - rb * nN; u.pm = rb;
        const int e = __builtin_amdgcn_readfirstlane(tab[128 + rb]); u.e = e;
        u.r0 = (rb - __builtin_amdgcn_readfirstlane(tab[e])) * 256; u.cnt = __builtin_amdgcn_readfirstlane(tab[64 + e]); u.ord = i; return true;
    }
    __device__ __forceinline__ const char* a_base(const Unit& u) const { return GATHER ? A : A + (size_t)u.pm * ((size_t)BM * K * 2); }
    __device__ __forceinline__ const char* b_base(const Unit& u) const { return Bt + ((size_t)u.e * N + (size_t)u.pn * BM) * ((size_t)K * 2); }
    __device__ __forceinline__ void a_offs(const Unit& u, unsigned (&v)[2][2]) const {
#pragma unroll
        for (int i = 0; i < 2; ++i) { int R, C; stage_rc((int)threadIdx.x * 16 + i * 8192, R, C);
#pragma unroll
            for (int h = 0; h < 2; ++h) {
                if (GATHER) { const unsigned tok = toks[u.ord * 256 + h * HALF + R]; v[h][i] = (tok * (unsigned)K + (unsigned)C) * 2u; }
                else v[h][i] = (unsigned)((h * HALF + R) * K + C) * 2u; } }
    }
};


struct HostNone { struct Regs {}; __device__ __forceinline__ void issue(int, Regs&, f32x4 (&)[2][2][4][2]) const {} __device__ __forceinline__ void finish(const Regs&, const f32x4 (&)[2][2][4][2]) const {} };
struct HostCvt {
    const float* w_up; const float* w_dn; unsigned char* wt_up; unsigned char* wt_dn;
    int base, limit, G, c;
    struct Regs { unsigned char* dst; bool active; };
    __device__ __forceinline__ void issue(int ord, Regs& R, f32x4 (&acc)[2][2][4][2]) const {
        const int w = __builtin_amdgcn_readfirstlane((int)threadIdx.x >> 6), lane = threadIdx.x & 63, kq = lane >> 4, nq = lane & 15;
        const int hi = __builtin_amdgcn_readfirstlane(base + (ord * G + c) * 8 + w);
        R.active = hi < limit; R.dst = nullptr;
        if (R.active) {
            const float* W; int pitch, k0, n0, drow; unsigned char* WT;
            if (hi < 32768) { const int mat = hi >> 10, q = hi & 1023, kb = q >> 5, nb = q & 31; n0 = nb * 64; k0 = kb * 32; pitch = 2048; W = w_up + (size_t)mat * 1024 * 2048; WT = wt_up + (size_t)mat * 2048 * 1024;
                drow = ((n0 & 1023) >> 7) * 256 + (n0 >> 10) * 128 + (n0 & 127); }
            else { const int r = hi - 32768, mat = r >> 9, q = r & 511, kb = q >> 4, nb = q & 15; n0 = nb * 64; k0 = kb * 32; pitch = 1024; W = w_dn + (size_t)mat * 1024 * 1024; WT = wt_dn + (size_t)mat * 1024 * 1024; drow = n0; }
            const char* src = (const char*)(W + (size_t)k0 * pitch + n0); const unsigned voff = (unsigned)(kq * pitch + 4 * nq) * 4u;
#pragma unroll
            for (int i = 0; i < 8; ++i) acc[0][0][i >> 1][i & 1] = __builtin_nontemporal_load((const f32x4*)(src + (size_t)(4 * i) * pitch * 4 + voff));
            R.dst = WT + (size_t)(drow + 4 * nq + kq) * 1024 + k0;
        }
    }
    __device__ __forceinline__ void finish(const Regs& R, const f32x4 (&acc)[2][2][4][2]) const {
        if (R.active) {
            const int lane = threadIdx.x & 63;
            const unsigned sel1 = (lane & 16) ? 0x07030501u : 0x06020400u, sel2 = (lane & 32) ? 0x07060302u : 0x05040100u;
            unsigned o[8];
#pragma unroll
            for (int i = 0; i < 8; ++i) { const f32x4 v = acc[0][0][i >> 1][i & 1]; const unsigned d = pk4_f8(v[0], v[1], v[2], v[3], Q8_W);
                const u32x2 s1 = __builtin_amdgcn_permlane16_swap(d, d, false, false);
                const unsigned t1 = __builtin_amdgcn_perm(s1.y, s1.x, sel1);
                const u32x2 s2 = __builtin_amdgcn_permlane32_swap(t1, t1, false, false);
                o[i] = __builtin_amdgcn_perm(s2.y, s2.x, sel2); }
            *(u32x4*)R.dst = (u32x4){o[0], o[1], o[2], o[3]}; *(u32x4*)(R.dst + 16) = (u32x4){o[4], o[5], o[6], o[7]};
        }
    }
};

template <bool F8 = false, class Epi, class Sched, class Host>
__device__ __forceinline__ void gemm_phase(LAS unsigned char* lds, const int K, const Sched& S, const Epi& E, const Host& H) {
    const int tid = threadIdx.x, wid = __builtin_amdgcn_readfirstlane(tid >> 6), lane = tid & 63, wr = wid >> 2, wc = wid & 3, fr = lane & 15, fq = lane >> 4;
    const int nt = K / BK;
    unsigned voffB[2];
#pragma unroll
    for (int i = 0; i < 2; ++i) { int R, C; stage_rc(tid * 16 + i * 8192, R, C); const int Rb = Epi::PERM ? ((R & ~31) + perm32(R & 31)) : R; voffB[i] = (unsigned)(Rb * K + C) * 2u; }
    const size_t kstep = (size_t)(BK * 2);
    const size_t hstep = (size_t)HALF * K * 2;
    const unsigned ldsw = (unsigned)wid * 1024u;
    const int aoff = lds_byte(wr * 64 + fr, fq * 8), boff = lds_byte(wc * 32 + fr, fq * 8);
#define PG8_SA(b, h) (((b) * 2 + (h)) * HTB)
#define PG8_SB(b, h) ((4 + (b) * 2 + (h)) * HTB)
#define PG8_STAGE(bufoff, gbase, voff) do { _Pragma("unroll") for (int _i = 0; _i < 2; ++_i) \
        __builtin_amdgcn_global_load_lds((const unsigned*)((const char*)(gbase) + (voff)[_i]), (LAS unsigned*)(lds + (bufoff) + ldsw + _i * 8192), 16, 0, 0); } while (0)
#define PG8_LDA(dst, b, h) do { _Pragma("unroll") for (int m = 0; m < 4; ++m) _Pragma("unroll") for (int k = 0; k < 2; ++k) dst[m][k] = *(const LAS bf16x8*)(lds + PG8_SA(b, h) + aoff + m * 2048 + k * 1024); } while (0)
#define PG8_LDB(dst, b, h) do { _Pragma("unroll") for (int n = 0; n < 2; ++n) _Pragma("unroll") for (int k = 0; k < 2; ++k) dst[n][k] = *(const LAS bf16x8*)(lds + PG8_SB(b, h) + boff + n * 2048 + k * 1024); } while (0)
#define PG8_MMA(ai, bj, At, Bt) do { __builtin_amdgcn_s_setprio(1); _Pragma("unroll") for (int m = 0; m < 4; ++m) _Pragma("unroll") for (int n = 0; n < 2; ++n) { \
        if constexpr (F8) { const i32x8_t b8_ = cat8(Bt[n][0], Bt[n][1]), a8_ = cat8(At[m][0], At[m][1]); asm volatile("v_mfma_f32_16x16x128_f8f6f4 %0, %1, %2, %0" : "+v"(acc[ai][bj][m][n]) : "v"(b8_), "v"(a8_)); } \
        else { _Pragma("unroll") for (int k = 0; k < 2; ++k) acc[ai][bj][m][n] = __builtin_amdgcn_mfma_f32_16x16x32_bf16(Bt[n][k], At[m][k], acc[ai][bj][m][n], 0, 0, 0); } } __builtin_amdgcn_s_setprio(0); } while (0)
#define PG8_WAIT_V(n) asm volatile("s_waitcnt vmcnt(" #n ")" ::: "memory")
#define PG8_WAIT_L(n) asm volatile("s_waitcnt lgkmcnt(" #n ")" ::: "memory")
#define PG8_BAR __builtin_amdgcn_s_barrier()
#define PG8_SCHED __builtin_amdgcn_sched_barrier(0)
    Unit cur, nxt; int ui = 0;
    if (!S.next(0, cur)) return;
    f32x4 acc[2][2][4][2];
#pragma unroll
    for (int a = 0; a < 2; ++a)
#pragma unroll
        for (int b = 0; b < 2; ++b)
#pragma unroll
            for (int m = 0; m < 4; ++m)
#pragma unroll
                for (int n = 0; n < 2; ++n) acc[a][b][m][n] = (f32x4){0.f, 0.f, 0.f, 0.f};
    bf16x8 At[4][2], B0[2][2], B1[2][2];
    constexpr bool GA = Sched::GATHER_A;
    unsigned vA[2][2], nvA[2][2];
    S.a_offs(cur, vA);
    const size_t ah = GA ? 0 : hstep;
#define PG8_VA1 (GA ? vA[1] : vA[0])
    const char* cA = S.a_base(cur); const char* cB = S.b_base(cur);
    PG8_STAGE(PG8_SB(0, 0), cB, voffB); PG8_STAGE(PG8_SB(0, 1), cB + hstep, voffB); PG8_STAGE(PG8_SA(0, 0), cA, vA[0]); PG8_STAGE(PG8_SA(0, 1), cA + ah, PG8_VA1);
    if (wr == 1) PG8_BAR;
    PG8_WAIT_V(2); PG8_BAR;
    PG8_STAGE(PG8_SB(1, 0), cB + kstep, voffB); PG8_STAGE(PG8_SA(1, 0), cA + kstep, vA[0]); PG8_STAGE(PG8_SB(1, 1), cB + hstep + kstep, voffB);
    PG8_WAIT_V(6); PG8_BAR;
    for (;;) {
        const bool has_next = S.next(ui + 1, nxt);
        const char* nA = cA; const char* nB = cB;
#pragma unroll
        for (int h = 0; h < 2; ++h)
#pragma unroll
            for (int i = 0; i < 2; ++i) nvA[h][i] = vA[h][i];
        if (has_next) { nA = S.a_base(nxt); nB = S.b_base(nxt); if constexpr (GA) S.a_offs(nxt, nvA); }
        constexpr int NGRP = Epi::RESCALE ? 4 : 1; const int tper = nt / NGRP;
        for (int gq = 0; gq < NGRP; ++gq) {
        if constexpr (Epi::RESCALE) { if (gq > 0) { if constexpr (F8) asm volatile("s_nop 15\n\ts_nop 15" ::: "memory"); E.rescale(acc, cur, gq, wr, fr); } }
#pragma unroll 1
        for (int t = gq * tper; t < (gq + 1) * tper; t += 2) {
            const bool last = (t == nt - 2);
            const char* a1 = cA + (size_t)(t + 1) * kstep;
            const char* a2 = last ? nA : cA + (size_t)(t + 2) * kstep; const char* b2 = last ? nB : cB + (size_t)(t + 2) * kstep;
            const char* a3 = a2 + kstep; const char* b3 = b2 + kstep;
            unsigned w0[2], w1[2];
#pragma unroll
            for (int i = 0; i < 2; ++i) { if constexpr (GA) { w0[i] = last ? nvA[0][i] : vA[0][i]; w1[i] = last ? nvA[1][i] : vA[1][i]; } else { w0[i] = vA[0][i]; w1[i] = vA[0][i]; } }
            PG8_LDB(B0, 0, 0); PG8_LDB(B1, 0, 1); PG8_SCHED; PG8_LDA(At, 0, 0); PG8_STAGE(PG8_SA(1, 1), a1 + ah, PG8_VA1);
            PG8_WAIT_V(8); PG8_WAIT_L(0); PG8_BAR; PG8_MMA(0, 0, At, B0); PG8_MMA(0, 1, At, B1); PG8_BAR; PG8_SCHED;
            PG8_LDA(At, 0, 1); PG8_STAGE(PG8_SB(0, 0), b2, voffB); PG8_STAGE(PG8_SB(0, 1), b2 + hstep, voffB); PG8_STAGE(PG8_SA(0, 0), a2, w0);
            PG8_WAIT_V(8); PG8_WAIT_L(0); PG8_BAR; PG8_MMA(1, 0, At, B0); PG8_MMA(1, 1, At, B1); PG8_BAR; PG8_SCHED;
            PG8_LDB(B0, 1, 0); PG8_LDB(B1, 1, 1); PG8_SCHED; PG8_LDA(At, 1, 0); PG8_STAGE(PG8_SA(0, 1), a2 + ah, w1);
            PG8_WAIT_V(8); PG8_WAIT_L(0); PG8_BAR; PG8_MMA(0, 0, At, B0); PG8_MMA(0, 1, At, B1); PG8_BAR; PG8_SCHED;
            PG8_LDA(At, 1, 1); PG8_STAGE(PG8_SB(1, 0), b3, voffB); PG8_STAGE(PG8_SB(1, 1), b3 + hstep, voffB); PG8_STAGE(PG8_SA(1, 0), a3, w0);
            PG8_WAIT_V(8); PG8_WAIT_L(0); PG8_BAR; PG8_MMA(1, 0, At, B0); PG8_MMA(1, 1, At, B1); PG8_BAR; PG8_SCHED;
        }
        }
        if (wr == 0) PG8_BAR;
        if constexpr (F8) asm volatile("s_nop 15\n\ts_nop 15" ::: "memory");
        E(acc, cur, wr, wc, fr, fq, 0);
        __builtin_amdgcn_sched_barrier(0); asm volatile("" ::: "memory");
        typename Host::Regs hr; H.issue(cur.ord, hr, acc);
        __builtin_amdgcn_sched_barrier(0); asm volatile("" ::: "memory");
        E(acc, cur, wr, wc, fr, fq, 1);
        __builtin_amdgcn_sched_barrier(0);
        H.finish(hr, acc);
        if (!has_next) break;
#pragma unroll
        for (int a = 0; a < 2; ++a)
#pragma unroll
            for (int b = 0; b < 2; ++b)
#pragma unroll
                for (int m = 0; m < 4; ++m)
#pragma unroll
                    for (int n = 0; n < 2; ++n) acc[a][b][m][n] = (f32x4){0.f, 0.f, 0.f, 0.f};
        cur = nxt; cA = nA; cB = nB; ++ui;
#pragma unroll
        for (int h = 0; h < 2; ++h)
#pragma unroll
            for (int i = 0; i < 2; ++i) vA[h][i] = nvA[h][i];
        if (wr == 1) PG8_BAR;
    }
    PG8_WAIT_V(0);
    PG8_BAR;
#undef PG8_VA1
#undef PG8_SA
#undef PG8_SB
#undef PG8_STAGE
#undef PG8_LDA
#undef PG8_LDB
#undef PG8_MMA
#undef PG8_WAIT_V
#undef PG8_WAIT_L
#undef PG8_BAR
#undef PG8_SCHED
}

struct EpiF32 {
    static constexpr bool PERM = false; static constexpr bool RESCALE = false;
    float* C; int ldc;
    __device__ __forceinline__ void operator()(const f32x4 (&acc)[2][2][4][2], const Unit& u, int wr, int wc, int fr, int fq, const int ai) const {
        const int row0 = u.pm * BM + wr * 64 + fr, col0 = u.pn * BM + wc * 32 + 4 * fq;

#pragma unroll
            for (int m = 0; m < 4; ++m) { float* rowp = C + (size_t)(row0 + ai * HALF + m * 16) * ldc + col0;
#pragma unroll
                for (int bj = 0; bj < 2; ++bj)
#pragma unroll
                    for (int n = 0; n < 2; ++n) *(f32x4*)(rowp + bj * HALF + n * 16) = acc[ai][bj][m][n]; }
    }
};
struct EpiBf16 {
    static constexpr bool PERM = true; static constexpr bool RESCALE = false;
    bf16* O; int ldc; float sc;
    __device__ __forceinline__ void operator()(const f32x4 (&acc)[2][2][4][2], const Unit& u, int wr, int wc, int fr, int fq, const int ai) const {
        const int row0 = u.pm * BM + wr * 64 + fr, col0 = u.pn * BM + wc * 32 + 8 * fq;

#pragma unroll
            for (int m = 0; m < 4; ++m) { bf16* rowp = O + (size_t)(row0 + ai * HALF + m * 16) * ldc + col0;
#pragma unroll
                for (int bj = 0; bj < 2; ++bj) { const f32x4 v0 = acc[ai][bj][m][0] * sc, v1 = acc[ai][bj][m][1] * sc;
                    u32x4 w; w.x = pk2(v0[0], v0[1]); w.y = pk2(v0[2], v0[3]); w.z = pk2(v1[0], v1[1]); w.w = pk2(v1[2], v1[3]);
                    __builtin_nontemporal_store(w, (u32x4*)(rowp + bj * HALF)); } }
    }
};
struct EpiRms {
    static constexpr bool PERM = true; static constexpr bool RESCALE = true;
    bf16* O; int ldc; const LAS float* stab;
    __device__ __forceinline__ void rescale(f32x4 (&acc)[2][2][4][2], const Unit& u, int g, int wr, int fr) const {
        const LAS float* tb = stab + (u.ord * 256 + wr * 64 + fr) * 4 + g;
#pragma unroll
        for (int ai = 0; ai < 2; ++ai)
#pragma unroll
            for (int m = 0; m < 4; ++m) { const LAS float* p = tb + (ai * HALF + m * 16) * 4; const float ratio = p[-1] * __builtin_amdgcn_rcpf(p[0]);
#pragma unroll
                for (int bj = 0; bj < 2; ++bj)
#pragma unroll
                    for (int n = 0; n < 2; ++n) acc[ai][bj][m][n] = acc[ai][bj][m][n] * ratio; }
    }
    __device__ __forceinline__ void operator()(const f32x4 (&acc)[2][2][4][2], const Unit& u, int wr, int wc, int fr, int fq, const int ai) const {
        const int row0 = u.pm * BM + wr * 64 + fr, col0 = u.pn * BM + wc * 32 + 8 * fq;
        const LAS float* tb = stab + (u.ord * 256 + wr * 64 + fr) * 4 + 3;

#pragma unroll
            for (int m = 0; m < 4; ++m) { const int row = row0 + ai * HALF + m * 16; const float s3 = tb[(ai * HALF + m * 16) * 4] * (1.0f / (Q8_YS * Q8_W)); bf16* rowp = (bf16*)((char*)O + (unsigned)((row * ldc + col0) * 2));
#pragma unroll
                for (int bj = 0; bj < 2; ++bj) { const f32x4 v0 = acc[ai][bj][m][0] * s3, v1 = acc[ai][bj][m][1] * s3;
                    u32x4 w; w.x = pk2(v0[0], v0[1]); w.y = pk2(v0[2], v0[3]); w.z = pk2(v1[0], v1[1]); w.w = pk2(v1[2], v1[3]);
                    __builtin_nontemporal_store(w, (u32x4*)(rowp + bj * HALF)); } }
    }
};
struct EpiQKV {
    static constexpr bool PERM = true; static constexpr bool RESCALE = false;
    unsigned char* O; const float* rope; float ds;
    __device__ __forceinline__ void operator()(const f32x4 (&acc)[2][2][4][2], const Unit& u, int wr, int wc, int fr, int fq, const int ai) const {
        const int row0 = u.pm * BM + wr * 64 + fr;
        const int col_t = u.pn * BM;
        const int s = (col_t % 3072) >> 10;
        const float sc = ((s == 0) ? QSCALE * Q8_Q : ((s == 1) ? Q8_K : Q8_V)) * ds;
        const int gq = col_t / 3072, lg = 2 * gq, dlm = (1 << lg) - 1, mat0 = gq * 24 + s * 8 + ((col_t & 1023) >> 7);
        const bool rot = (s < 2) && (fq == 0);
        {
#pragma unroll
            for (int m = 0; m < 4; ++m) {
                const int row = row0 + ai * HALF + m * 16;
                const int tt = row & (SEQ - 1), rowp = (row & ~(SEQ - 1)) + ((tt & (dlm)) << (12 - lg)) + (tt >> lg);
                f32x4 cs = (f32x4){1.f, 1.f, 1.f, 1.f}, sn = (f32x4){0.f, 0.f, 0.f, 0.f};
                if (rot) { const float* rp = rope + (size_t)row * 32 + 4 * wc; cs = *(const f32x4*)rp; sn = *(const f32x4*)(rp + 16); }
#pragma unroll
                for (int bj = 0; bj < 2; ++bj) {
                    f32x4 v0 = acc[ai][bj][m][0], v1 = acc[ai][bj][m][1];
                    if (rot) { const f32x4 a0 = v0 * cs - v1 * sn, a1 = v1 * cs + v0 * sn; v0 = a0; v1 = a1; }
                    u32x2 w; w.x = pk4_f8(v0[0], v0[1], v0[2], v0[3], sc); w.y = pk4_f8(v1[0], v1[1], v1[2], v1[3], sc);
                    *(u32x2*)(O + ((size_t)(mat0 + bj) * T + rowp) * 128 + wc * 32 + 8 * fq) = w;
                }
            }
        }
    }
};
struct EpiUp {
    static constexpr bool PERM = true; static constexpr bool RESCALE = false;
    unsigned char* HB; const LAS unsigned* btab;
    __device__ __forceinline__ void operator()(const f32x4 (&acc)[2][2][4][2], const Unit& u, int wr, int wc, int fr, int fq, const int ai) const {
        const int row0 = u.pm * BM + wr * 64 + fr, col0 = u.pn * HALF + wc * 32 + 8 * fq;
        const LAS unsigned* bp = btab + u.ord * 128 + (wc * 32 + 8 * fq) / 2;
        const u32x4 gw = *(const LAS u32x4*)bp, uw = *(const LAS u32x4*)(bp + 64);
        f32x2 bg[4], bu[4];
#pragma unroll
        for (int i = 0; i < 4; ++i) { bg[i] = (f32x2){bflo(gw[i]), bfhi(gw[i])}; bu[i] = (f32x2){bflo(uw[i]), bfhi(uw[i])}; }
        constexpr float DS = 1.0f / (Q8_X * Q8_W), KE = -1.702f * 1.4426950408889634f;

#pragma unroll
            for (int m = 0; m < 4; ++m) {
                f32x2 o[4];
#pragma unroll
                for (int i = 0; i < 4; ++i) { const int n = i >> 1, j = 2 * (i & 1);
                    f32x2 gt = (f32x2){acc[ai][0][m][n][j], acc[ai][0][m][n][j + 1]} * DS + bg[i];
                    f32x2 up = (f32x2){acc[ai][1][m][n][j], acc[ai][1][m][n][j + 1]} * DS + bu[i];
                    gt[0] = fminf(gt[0], 7.0f); gt[1] = fminf(gt[1], 7.0f);
                    up[0] = __builtin_amdgcn_fmed3f(up[0], -7.0f, 7.0f); up[1] = __builtin_amdgcn_fmed3f(up[1], -7.0f, 7.0f);
                    f32x2 e = gt * KE; e[0] = __builtin_amdgcn_exp2f(e[0]); e[1] = __builtin_amdgcn_exp2f(e[1]);
                    e = e + 1.0f; e[0] = __builtin_amdgcn_rcpf(e[0]); e[1] = __builtin_amdgcn_rcpf(e[1]);
                    o[i] = (up * Q8_H + Q8_H) * (gt * e); }
                u32x2 w;
                { int p0 = __builtin_amdgcn_cvt_pk_fp8_f32(o[0][0], o[0][1], 0, false); p0 = __builtin_amdgcn_cvt_pk_fp8_f32(o[1][0], o[1][1], p0, true);
                  int p1 = __builtin_amdgcn_cvt_pk_fp8_f32(o[2][0], o[2][1], 0, false); p1 = __builtin_amdgcn_cvt_pk_fp8_f32(o[3][0], o[3][1], p1, true); w.x = (unsigned)p0; w.y = (unsigned)p1; }
                *(u32x2*)(HB + (size_t)(row0 + ai * HALF + m * 16) * 1024 + col0) = w;
            }
    }
};
struct EpiDown {
    static constexpr bool PERM = true; static constexpr bool RESCALE = false;
    unsigned char* YS; const LAS unsigned* btab; const LAS int* slots;
    __device__ __forceinline__ void operator()(const f32x4 (&acc)[2][2][4][2], const Unit& u, int wr, int wc, int fr, int fq, const int ai) const {
        const int col0 = u.pn * BM + wc * 32 + 8 * fq;
        const LAS unsigned* bp = btab + u.ord * 128 + (wc * 32 + 8 * fq) / 2;
        f32x4 bv[2][2];
#pragma unroll
        for (int bj = 0; bj < 2; ++bj) { const u32x4 bw = *(const LAS u32x4*)(bp + bj * 64);
            bv[bj][0] = (f32x4){bflo(bw.x), bfhi(bw.x), bflo(bw.y), bfhi(bw.y)}; bv[bj][1] = (f32x4){bflo(bw.z), bfhi(bw.z), bflo(bw.w), bfhi(bw.w)}; }

#pragma unroll
            for (int m = 0; m < 4; ++m) {
                const int slot = slots[u.ord * 256 + ai * HALF + wr * 64 + m * 16 + fr];
                if (slot >= 0) {
                    unsigned char* rowp = YS + (size_t)slot * 1024 + col0;
#pragma unroll
                    for (int bj = 0; bj < 2; ++bj) { const f32x4 v0 = acc[ai][bj][m][0] * (1.0f / (Q8_H * Q8_W)) + bv[bj][0], v1 = acc[ai][bj][m][1] * (1.0f / (Q8_H * Q8_W)) + bv[bj][1];
                        u32x2 w; w.x = pk4_f8(v0[0], v0[1], v0[2], v0[3], Q8_Y); w.y = pk4_f8(v1[0], v1[1], v1[2], v1[3], Q8_Y);
                        *(u32x2*)(rowp + bj * HALF) = w; }
                }
            }
    }
};
}

struct TrItem { const float* W; const float* kscale; bf16* WT; int pitch, K, k0, n0, dstrow0, q8, hperm; };
__device__ __forceinline__ void tr_load(const TrItem& d, f32x4 (&ld)[16], int lane) {
    const int kq = lane >> 4, nq = lane & 15;
    const float* src = d.W + (size_t)(d.k0 + kq) * d.pitch + d.n0 + 4 * nq;
#pragma unroll
    for (int i = 0; i < 16; ++i) ld[i] = __builtin_nontemporal_load((const f32x4*)(src + (size_t)(4 * i) * d.pitch));
}
__device__ __forceinline__ void tr_finish(const TrItem& d, const f32x4 (&ld)[16], LAS float* scr, int lane) {
    const int kq = lane >> 4, nq = lane & 15;
#pragma unroll
    for (int i = 0; i < 16; ++i) { f32x4 v = ld[i]; if (d.kscale) v = v * d.kscale[d.k0 + 4 * i + kq]; LAS float* p = scr + (4 * i + kq) * 65 + 4 * nq; p[0] = v[0]; p[1] = v[1]; p[2] = v[2]; p[3] = v[3]; }
    asm volatile("s_waitcnt lgkmcnt(0)" ::: "memory");
    const int c = lane & 7;
    if (d.q8) {
#pragma unroll
        for (int j = 0; j < 8; ++j) { const int n = j * 8 + (lane >> 3); const LAS float* s = scr + (8 * c) * 65 + n;
            u32x2 o; o.x = pk4_f8(s[0 * 65], s[1 * 65], s[2 * 65], s[3 * 65], Q8_W); o.y = pk4_f8(s[4 * 65], s[5 * 65], s[6 * 65], s[7 * 65], Q8_W);
            int row = d.dstrow0 + n;
            if (d.hperm) { const int ng = d.n0 + n; if (((ng % 3072) >> 10) < 2) { const int dd = ng & 127;
                    const int pp = (dd < 32) ? (((dd & 15) >> 2) * 32 + (dd & 3) + 4 * (dd >> 4)) : (((dd - 32) / 24) * 32 + 8 + (dd - 32) % 24); row = (ng & ~127) + pp; } }
            *(u32x2*)((unsigned char*)d.WT + (size_t)row * d.K + d.k0 + 8 * c) = o; }
    } else {
#pragma unroll
    for (int j = 0; j < 8; ++j) { const int n = j * 8 + (lane >> 3); const LAS float* s = scr + (8 * c) * 65 + n;
        u32x4 o; o.x = pk2(s[0 * 65], s[1 * 65]); o.y = pk2(s[2 * 65], s[3 * 65]); o.z = pk2(s[4 * 65], s[5 * 65]); o.w = pk2(s[6 * 65], s[7 * 65]);
        *(u32x4*)(d.WT + (size_t)(d.dstrow0 + n) * d.K + d.k0 + 8 * c) = o; }
    }
    asm volatile("s_waitcnt lgkmcnt(0)" ::: "memory");
}
__constant__ float c_inv_freq[16] = {1.000000000e+00f, 4.403665960e-01f, 1.939227432e-01f, 8.539710194e-02f, 3.760603070e-02f, 1.656044088e-02f, 7.292664610e-03f, 3.211446106e-03f,
                                     1.414213562e-03f, 6.227724371e-04f, 2.742481884e-04f, 1.207697351e-04f, 5.318295734e-05f, 2.341999971e-05f, 1.031338525e-05f, 4.541670478e-06f};
__device__ __forceinline__ void sincos_reduced(float ang, float& sn, float& cs) {
    const double a = (double)ang;
    const double k = __builtin_rint(a * 0.15915494309189535);
    const double r = __builtin_fma(-k, 6.283185307179586, a) - k * 2.4492935982947064e-16;
    const float rf = (float)r;
    sn = __sinf(rf); cs = __cosf(rf);
}
struct Ptrs {
    const float *x; const int* pos; const float *attn_w_in, *attn_w_out, *ssm_w_in, *conv_w, *conv_b, *dt_bias, *a_log, *d_skip, *norm_w, *ssm_w_out;
    const float *w_router, *b_router, *w_up, *b_up, *w_dn, *b_dn, *ln_mix_g, *ln_mix_b, *ln_ffn_g, *ln_ffn_b;
};
constexpr int N1_UP = 32 * 16 * 32, N1_DN = 32 * 16 * 16, N1_ITEMS = N1_UP + N1_DN;
constexpr int HOSTED_ITEMS = 18432;
__device__ __forceinline__ TrItem moe1_item(const Ptrs& P, unsigned char* ws, int idx, int lay = 1) {
    TrItem d; d.kscale = nullptr; d.K = 1024; d.q8 = 1; d.hperm = 0;
    if (idx < N1_UP) { const int mat = 32 * lay + (idx >> 9), q = idx & 511, kb = q >> 5, nb = q & 31; const int n0 = nb * 64; const int bj = n0 >> 10, pn = (n0 & 1023) >> 7, cc = n0 & 127;
        d.W = P.w_up + (size_t)mat * 1024 * 2048; d.pitch = 2048; d.WT = (bf16*)(ws + WS_WUP + (size_t)mat * 2048 * 1024); d.k0 = kb * 64; d.n0 = n0; d.dstrow0 = pn * 256 + bj * 128 + cc; }
    else { const int r = idx - N1_UP, mat = 32 * lay + (r >> 8), q = r & 255, kb = q >> 4, nb = q & 15;
        d.W = P.w_dn + (size_t)mat * 1024 * 1024; d.pitch = 1024; d.WT = (bf16*)(ws + WS_WDN + (size_t)mat * 1024 * 1024); d.k0 = kb * 64; d.n0 = nb * 64; d.dstrow0 = nb * 64; }
    return d;
}
__device__ __forceinline__ void cvt_static(LAS unsigned char* lds, const Ptrs& P, unsigned char* ws, int first, int stride, int cnt) {
    const int lane = threadIdx.x & 63, w = __builtin_amdgcn_readfirstlane((int)threadIdx.x >> 6);
    LAS float* scr = (LAS float*)(lds + w * (65 * 64 * 4));
    if (cnt <= 0 || first >= N1_ITEMS) return;
    f32x4 la[16], lb[16]; TrItem da = moe1_item(P, ws, first), db = da; tr_load(da, la, lane);
    for (int i = 0;; i += 2) {
        const int ib = first + (i + 1) * stride; const bool hb = (i + 1 < cnt) && (ib < N1_ITEMS);
        if (hb) { db = moe1_item(P, ws, ib); tr_load(db, lb, lane); }
        tr_finish(da, la, scr, lane);
        if (!hb) break;
        const int ia = first + (i + 2) * stride; const bool ha = (i + 2 < cnt) && (ia < N1_ITEMS);
        if (ha) { da = moe1_item(P, ws, ia); tr_load(da, la, lane); }
        tr_finish(db, lb, scr, lane);
        if (!ha) break;
    }
}
__device__ __forceinline__ void cvt_plan(int NB, int G, int& rem_up, int& P_up, int& rem_dn, int& P_dn) {
    rem_up = (NB * 8) % G; const int n_iu = rem_up ? (G - rem_up) : 0; P_up = n_iu * 8 * CVT_Q_UP; if (P_up > N1_ITEMS) P_up = N1_ITEMS;
    rem_dn = (NB * 4) % G; const int n_id = rem_dn ? (G - rem_dn) : 0; P_dn = P_up + n_id * 8 * CVT_Q_DN; if (P_dn > N1_ITEMS) P_dn = N1_ITEMS;
}
__device__ __forceinline__ void p0_prologue(LAS unsigned char* lds, const Ptrs& P, unsigned char* ws, int G, int vcu) {
    const int tid = threadIdx.x, lane = tid & 63, w = __builtin_amdgcn_readfirstlane(tid >> 6);
    LAS float* scr = (LAS float*)(lds + w * (65 * 64 * 4));
    const int gw = vcu * 8 + w, NGW = G * 8;
    bf16* Wqkv = (bf16*)(ws + WS_WQKV); bf16* Wao = (bf16*)(ws + WS_WAO); bf16* Wsi = (bf16*)(ws + WS_WSI); bf16* Wso = (bf16*)(ws + WS_WSO);
    constexpr int I0 = 16 * 144, I1 = 16 * 16, I2 = 16 * 80, I3 = 32 * 16, I4 = 32 * 16 * 32, I5 = 32 * 16 * 16;
    constexpr int NITEMS = I0 + I1 + I2 + I3 + (N1_ITEMS - HOSTED_ITEMS);
    auto decode = [&](int it) -> TrItem {
        TrItem d; int r = it; d.kscale = nullptr; d.q8 = 0; d.hperm = 0;
        if (r < I0) { const int kb = r / 144, nb = r % 144; d.q8 = 1; d.hperm = 1; d.W = P.attn_w_in; d.pitch = NQKV; d.K = 1024; d.WT = Wqkv; d.k0 = kb * 64; d.n0 = nb * 64; d.dstrow0 = nb * 64; return d; } r -= I0;
        if (r < I1) { const int kb = r / 16, nb = r % 16; d.q8 = 1; d.W = P.attn_w_out; d.pitch = 1024; d.K = 1024; d.WT = Wao; d.k0 = kb * 64; d.n0 = nb * 64; d.dstrow0 = nb * 64; return d; } r -= I1;
        if (r < I2) { const int kb = r / 80, nb = r % 80; d.q8 = 1; d.W = P.ssm_w_in; d.pitch = SSM_PITCH; d.K = 1024; d.WT = Wsi; d.k0 = kb * 64; d.n0 = nb * 64; d.dstrow0 = nb * 64; return d; } r -= I2;
        if (r < I3) { const int kb = r / 16, nb = r % 16; d.q8 = 1; d.W = P.ssm_w_out; d.pitch = 1024; d.K = 2048; d.kscale = P.norm_w; d.WT = Wso; d.k0 = kb * 64; d.n0 = nb * 64; d.dstrow0 = nb * 64; return d; } r -= I3;
        return moe1_item(P, ws, r + HOSTED_ITEMS, 0);
    };
    if (gw < NITEMS) {
        f32x4 la[16], lb[16];
        TrItem da = decode(gw), db = da; tr_load(da, la, lane);
        for (int it = gw; it < NITEMS; it += 2 * NGW) {
            const bool hb = it + NGW < NITEMS;
            if (hb) { db = decode(it + NGW); tr_load(db, lb, lane); }
            tr_finish(da, la, scr, lane);
            if (!hb) break;
            const bool ha = it + 2 * NGW < NITEMS;
            if (ha) { da = decode(it + 2 * NGW); tr_load(da, la, lane); }
            tr_finish(db, lb, scr, lane);
            if (!ha) break;
        }
    }
    bf16* XBA = (bf16*)(ws + WS_XBA);
    for (int m0 = gw * 4; m0 < T; m0 += NGW * 4) {
        f32x4 v[4][4];
#pragma unroll
        for (int rr = 0; rr < 4; ++rr) { const f32x4* xr = (const f32x4*)(P.x + (size_t)(m0 + rr) * DM) + lane;
#pragma unroll
            for (int j = 0; j < 4; ++j) v[rr][j] = xr[64 * j]; }
#pragma unroll
        for (int rr = 0; rr < 4; ++rr) { u32x2* o = (u32x2*)(XBA + (size_t)(m0 + rr) * DM) + lane;
#pragma unroll
            for (int j = 0; j < 4; ++j) {
                *(unsigned*)(ws + WS_XQ0 + (size_t)(m0 + rr) * DM + 4 * lane + 256 * j) = pk4_f8(v[rr][j][0], v[rr][j][1], v[rr][j][2], v[rr][j][3], Q8_X); } }
    }
    float* rope = (float*)(ws + WS_ROPE);
    for (int idx = (vcu * 512 + tid); idx < T * 16; idx += G * 512) {
        const int tok = idx >> 4, i = idx & 15;
        const float ang = (float)P.pos[tok] * c_inv_freq[i];
        float sn, cs; sincos_reduced(ang, sn, cs);
        rope[(size_t)tok * 32 + i] = cs; rope[(size_t)tok * 32 + 16 + i] = sn;
    }
}

constexpr size_t PKOFF = (size_t)8 * T * 128;
__device__ __forceinline__ void attn_phase(LAS unsigned char* lds, const unsigned char* __restrict__ PROJ, unsigned char* __restrict__ OG, float* __restrict__ LSE, const int G, const int vcu) {
    const int tid = threadIdx.x, lane0 = tid & 63, w = __builtin_amdgcn_readfirstlane(tid >> 6);
    LAS unsigned char* Ks = lds; LAS unsigned char* Vt = lds + 2 * 128 * P256;
    constexpr int NU = BATCH * 3 * 8 * 32;
    const int per = (NU + G - 1) / G;
    const int u0 = vcu * per, u1 = (u0 + per < NU) ? (u0 + per) : NU;
    if (u0 >= u1) return;
    u32x4 kreg[2], vreg[2]; u32x4 qn[2];
    constexpr int PK8 = 144;
    unsigned long long mA = 0ull, mB = 0ull;
    { const int r16 = lane0 & 15, q4 = lane0 >> 4;
#pragma unroll
        for (int kt = 0; kt < 9; ++kt)
#pragma unroll
            for (int jj = 0; jj < 4; ++jj) { const int jr = 16 * kt + 4 * q4 + jj; const bool va = (jr >= r16) & (jr <= r16 + 128); const bool vb = va & (jr + 16 * w >= 128);
                mA |= (unsigned long long)va << (4 * kt + jj); mB |= (unsigned long long)vb << (4 * kt + jj); } }
    int pc = 0;
#define ATT_DECODE(U) const int bgh = (U) >> 5, sub = (U) & 31, h = bgh & 7, bg = bgh >> 3, g = bg % 3, b = bg / 3; \
        const int lg = (g == 0) ? 0 : ((g == 1) ? 2 : 4), dl = 1 << lg, nblk = 32 >> lg, r = sub >> (5 - lg), blk = sub & (nblk - 1); \
        const unsigned char* base_r = PROJ + ((size_t)(g * 24 + h) * T + (size_t)b * SEQ + (size_t)r * (SEQ >> lg)) * 128;
#define ATT_W2(X) pk2(X[0], X[1])
#define ATT_K16(V, LO, HI) do { _Pragma("unroll") for (int i_ = 0; i_ < 4; ++i_) { const f32x2 a_ = __builtin_amdgcn_cvt_pk_f32_fp8((int)(V)[i_], false), b_ = __builtin_amdgcn_cvt_pk_f32_fp8((int)(V)[i_], true); \
        if (i_ < 2) { (LO)[2 * i_] = ATT_W2(a_); (LO)[2 * i_ + 1] = ATT_W2(b_); } else { (HI)[2 * i_ - 4] = ATT_W2(a_); (HI)[2 * i_ - 3] = ATT_W2(b_); } } } while (0)
#define ATT_VT(V0, V1, C, JP, HALFSEL) do { _Pragma("unroll") for (int i_ = 0; i_ < 4; ++i_) { \
        const f32x2 a0_ = __builtin_amdgcn_cvt_pk_f32_fp8((int)(V0)[i_], false), b0_ = __builtin_amdgcn_cvt_pk_f32_fp8((int)(V0)[i_], true), a1_ = __builtin_amdgcn_cvt_pk_f32_fp8((int)(V1)[i_], false), b1_ = __builtin_amdgcn_cvt_pk_f32_fp8((int)(V1)[i_], true); \
        *(LAS unsigned*)(Vt + swz512(16 * (C) + 4 * i_ + 0, 256 * (HALFSEL) + 4 * (JP))) = pk2(a0_[0], a1_[0]); *(LAS unsigned*)(Vt + swz512(16 * (C) + 4 * i_ + 1, 256 * (HALFSEL) + 4 * (JP))) = pk2(a0_[1], a1_[1]); \
        *(LAS unsigned*)(Vt + swz512(16 * (C) + 4 * i_ + 2, 256 * (HALFSEL) + 4 * (JP))) = pk2(b0_[0], b1_[0]); *(LAS unsigned*)(Vt + swz512(16 * (C) + 4 * i_ + 3, 256 * (HALFSEL) + 4 * (JP))) = pk2(b0_[1], b1_[1]); } } while (0)
    {
        ATT_DECODE(u0)
        const int lane = lane0;
        const int jpv = 16 * (w >> 1) + (lane & 15), cv = 4 * (w & 1) + (lane >> 4);
        if (blk > 0) {
#pragma unroll
            for (int it = 0; it < 2; ++it) { const int item = it * 512 + tid, j = item >> 3, c = item & 7; const int ts = (blk - 1) * 128 + j;
                *(LAS u32x4*)(Ks + j * PK8 + 16 * c) = *(const u32x4*)(base_r + (size_t)ts * 128 + PKOFF + 16 * c); }
            { const int ts = (blk - 1) * 128 + 2 * jpv;
                const u32x4 v0 = *(const u32x4*)(base_r + (size_t)ts * 128 + 2 * PKOFF + 16 * cv), v1 = *(const u32x4*)(base_r + (size_t)(ts + 1) * 128 + 2 * PKOFF + 16 * cv);
                ATT_VT(v0, v1, cv, jpv, 0); }
        }
#pragma unroll
        for (int it = 0; it < 2; ++it) { const int item = it * 512 + tid, j = item >> 3, c = item & 7; kreg[it] = *(const u32x4*)(base_r + (size_t)(blk * 128 + j) * 128 + PKOFF + 16 * c); }
        { const int ts = blk * 128 + 2 * jpv;
            vreg[0] = *(const u32x4*)(base_r + (size_t)ts * 128 + 2 * PKOFF + 16 * cv); vreg[1] = *(const u32x4*)(base_r + (size_t)(ts + 1) * 128 + 2 * PKOFF + 16 * cv); }
        const int tq = blk * 128 + 16 * w + (lane & 15);
#pragma unroll
        for (int kk = 0; kk < 2; ++kk) qn[kk] = *(const u32x4*)(base_r + (size_t)tq * 128 + 64 * kk + 16 * (lane >> 4));
    }
    for (int u = u0; u < u1; ++u) {
        int lane = lane0; asm volatile("" : "+v"(lane));
        const int r16 = lane & 15, q4 = lane >> 4;
        ATT_DECODE(u)
        const int pp = pc; pc ^= 1;
        if (blk == 0) {
#pragma unroll
            for (int it = 0; it < 4; ++it) { const int item = it * 512 + tid, dd = item >> 4, c = item & 15; *(LAS u32x4*)(Vt + swz512(dd, 256 * pp + 16 * c)) = (u32x4){0u, 0u, 0u, 0u}; }
        }
#pragma unroll
        for (int it = 0; it < 2; ++it) { const int item = it * 512 + tid, j = item >> 3, c = item & 7; *(LAS u32x4*)(Ks + pc * (128 * P256) + j * PK8 + 16 * c) = kreg[it]; }
        { const int jpv = 16 * (w >> 1) + (lane & 15), cv = 4 * (w & 1) + (lane >> 4); ATT_VT(vreg[0], vreg[1], cv, jpv, pc); }
        const pg8::i32x8_t qf = __builtin_shufflevector(__builtin_bit_cast(pg8::i32x4_t, qn[0]), __builtin_bit_cast(pg8::i32x4_t, qn[1]), 0, 1, 2, 3, 4, 5, 6, 7);
        lds_barrier();
        if (u + 1 < u1) {
            const int un = u + 1;
            const int bgh2 = un >> 5, sub2 = un & 31, h2 = bgh2 & 7, bg2 = bgh2 >> 3, g2 = bg2 % 3, b2 = bg2 / 3;
            const int lg2 = (g2 == 0) ? 0 : ((g2 == 1) ? 2 : 4), nblk2 = 32 >> lg2, r2 = sub2 >> (5 - lg2), blk2 = sub2 & (nblk2 - 1);
            const unsigned char* base2 = PROJ + ((size_t)(g2 * 24 + h2) * T + (size_t)b2 * SEQ + (size_t)r2 * (SEQ >> lg2)) * 128;
#pragma unroll
            for (int it = 0; it < 2; ++it) { const int item = it * 512 + tid, j = item >> 3, c = item & 7; kreg[it] = *(const u32x4*)(base2 + (size_t)(blk2 * 128 + j) * 128 + PKOFF + 16 * c); }
            { const int jpv = 16 * (w >> 1) + (lane & 15), cv = 4 * (w & 1) + (lane >> 4); const int ts = blk2 * 128 + 2 * jpv;
                vreg[0] = *(const u32x4*)(base2 + (size_t)ts * 128 + 2 * PKOFF + 16 * cv); vreg[1] = *(const u32x4*)(base2 + (size_t)(ts + 1) * 128 + 2 * PKOFF + 16 * cv); }
            const int tq2 = blk2 * 128 + 16 * w + r16;
#pragma unroll
            for (int kk = 0; kk < 2; ++kk) qn[kk] = *(const u32x4*)(base2 + (size_t)tq2 * 128 + 64 * kk + 16 * q4);
        }
        f32x4 s[9];
#pragma unroll
        for (int kt = 0; kt < 9; ++kt) {
            const int ka = w + kt; const int hoff = ((ka < 8) ? pp : pc) * (128 * P256); const int row = 16 * (ka & 7) + r16;
            const u32x4 k0 = *(const LAS u32x4*)(Ks + hoff + row * PK8 + 16 * q4), k1 = *(const LAS u32x4*)(Ks + hoff + row * PK8 + 64 + 16 * q4);
            const pg8::i32x8_t kf = __builtin_shufflevector(__builtin_bit_cast(pg8::i32x4_t, k0), __builtin_bit_cast(pg8::i32x4_t, k1), 0, 1, 2, 3, 4, 5, 6, 7);
            s[kt] = __builtin_amdgcn_mfma_scale_f32_16x16x128_f8f6f4(kf, qf, (f32x4){0.f, 0.f, 0.f, 0.f}, 0, 0, 0, 0, 0, 0); }
        float mx = -INFINITY;
        const unsigned long long mk = (blk > 0) ? mA : mB; const unsigned mlo = (unsigned)mk, mhi = (unsigned)(mk >> 32);
#pragma unroll
        for (int kt = 0; kt < 9; ++kt)
#pragma unroll
            for (int jj = 0; jj < 4; ++jj) { const int bit = 4 * kt + jj; const bool valid = bit < 32 ? ((mlo >> bit) & 1u) : ((mhi >> (bit - 32)) & 1u);
                s[kt][jj] = valid ? s[kt][jj] : -INFINITY; mx = fmaxf(mx, s[kt][jj]); }
        mx = fmaxf(mx, __shfl_xor(mx, 16)); mx = fmaxf(mx, __shfl_xor(mx, 32));
        float ls = 0.f;
#pragma unroll
        for (int kt = 0; kt < 9; ++kt)
#pragma unroll
            for (int jj = 0; jj < 4; ++jj) { const float p = __builtin_amdgcn_exp2f((s[kt][jj] - mx) * (1.0f / (Q8_Q * Q8_K))); s[kt][jj] = p; ls += p; }
        ls += __shfl_xor(ls, 16); ls += __shfl_xor(ls, 32);
        f32x4 o[8];
#pragma unroll
        for (int dt = 0; dt < 8; ++dt) o[dt] = (f32x4){0.f, 0.f, 0.f, 0.f};
#pragma unroll
        for (int kp = 0; kp < 5; ++kp) {
            u32x4 pw; pw.x = pk2(s[2 * kp][0], s[2 * kp][1]); pw.y = pk2(s[2 * kp][2], s[2 * kp][3]);
            if (kp < 4) { pw.z = pk2(s[2 * kp + 1][0], s[2 * kp + 1][1]); pw.w = pk2(s[2 * kp + 1][2], s[2 * kp + 1][3]); } else { pw.z = 0u; pw.w = 0u; }
            const bf16x8 pf = as_bf16x8(pw);
            const int ka0 = w + 2 * kp, ka1 = ka0 + 1;
            const int c0 = 256 * ((ka0 < 8) ? pp : pc) + 2 * (16 * (ka0 & 7) + 4 * q4), c1 = 256 * ((ka1 < 8) ? pp : pc) + 2 * (16 * (ka1 & 7) + 4 * q4);
#pragma unroll
            for (int dt = 0; dt < 8; ++dt) { const int dd = 16 * dt + r16;
                const u32x2 lo = *(const LAS u32x2*)(Vt + swz512(dd, c0));
                u32x2 hi = (u32x2){0u, 0u}; if (kp < 4) hi = *(const LAS u32x2*)(Vt + swz512(dd, c1));
                const u32x4 av = (u32x4){lo.x, lo.y, hi.x, hi.y};
                o[dt] = mfma16(as_bf16x8(av), pf, o[dt]); }
        }
        const float inv = Q8_O / (ls * Q8_V);
        const int tq = blk * 128 + 16 * w + r16;
        const size_t tokq = (size_t)b * SEQ + (size_t)tq * dl + r;
        unsigned char* op = OG + ((size_t)g * T + tokq) * DM + h * 128 + 4 * q4;
#pragma unroll
        for (int dt = 0; dt < 8; ++dt) *(unsigned*)(op + 16 * dt) = pk4_f8(o[dt][0], o[dt][1], o[dt][2], o[dt][3], inv);
        if (q4 == 0) LSE[((size_t)g * T + tokq) * 8 + h] = (mx * (1.0f / (Q8_Q * Q8_K)) + __builtin_amdgcn_logf(ls)) * LN2F;
        lds_barrier();
    }
#undef ATT_DECODE
#undef ATT_W2
#undef ATT_K16
#undef ATT_VT
}

__device__ __forceinline__ void combine_phase(const unsigned char* __restrict__ OG, const float* __restrict__ LSE, unsigned char* __restrict__ OB, int G, int vcu) {
    const int tid = threadIdx.x, lane = tid & 63, w = tid >> 6;
    const int gw = vcu * 8 + w, NGW = G * 8;
    for (int row = gw; row < T; row += NGW) {
#pragma unroll
        for (int j = 0; j < 2; ++j) { const int col = 8 * lane + 512 * j, head = col >> 7;
            const float l0 = LSE[((size_t)0 * T + row) * 8 + head], l1 = LSE[((size_t)1 * T + row) * 8 + head], l2 = LSE[((size_t)2 * T + row) * 8 + head];
            const float m = fmaxf(l0, fmaxf(l1, l2)); float w0 = __expf(l0 - m), w1 = __expf(l1 - m), w2 = __expf(l2 - m); const float inv = 1.0f / (w0 + w1 + w2); w0 *= inv; w1 *= inv; w2 *= inv;
            const u32x2 a0 = *(const u32x2*)(OG + ((size_t)0 * T + row) * DM + col), a1 = *(const u32x2*)(OG + ((size_t)1 * T + row) * DM + col), a2 = *(const u32x2*)(OG + ((size_t)2 * T + row) * DM + col);
            float ov[8];
#pragma unroll
            for (int wd = 0; wd < 2; ++wd) {
                const f32x2 x0 = __builtin_amdgcn_cvt_pk_f32_fp8((int)a0[wd], false), x1 = __builtin_amdgcn_cvt_pk_f32_fp8((int)a1[wd], false), x2 = __builtin_amdgcn_cvt_pk_f32_fp8((int)a2[wd], false);
                const f32x2 y0 = __builtin_amdgcn_cvt_pk_f32_fp8((int)a0[wd], true), y1 = __builtin_amdgcn_cvt_pk_f32_fp8((int)a1[wd], true), y2 = __builtin_amdgcn_cvt_pk_f32_fp8((int)a2[wd], true);
                ov[4 * wd] = w0 * x0[0] + w1 * x1[0] + w2 * x2[0]; ov[4 * wd + 1] = w0 * x0[1] + w1 * x1[1] + w2 * x2[1]; ov[4 * wd + 2] = w0 * y0[0] + w1 * y1[0] + w2 * y2[0]; ov[4 * wd + 3] = w0 * y0[1] + w1 * y1[1] + w2 * y2[1]; }
            u32x2 o; o.x = pk4_f8(ov[0], ov[1], ov[2], ov[3], 1.0f); o.y = pk4_f8(ov[4], ov[5], ov[6], ov[7], 1.0f);
            *(u32x2*)(OB + (size_t)row * DM + col) = o; }
    }
}

template <int MIXSRC, int POST, bool WRITE_B, bool WRITE_F, bool XF32 = false>
__device__ __forceinline__ void ln_phase(LAS unsigned char* lds, const bf16* __restrict__ xres, const bf16* __restrict__ mixf, const unsigned char* __restrict__ YS, const float* __restrict__ gates_in,
                                         const float* __restrict__ gamma, const float* __restrict__ beta, float* outf, bf16* __restrict__ outb,
                                         const float* __restrict__ W32, int wpitch, const float* __restrict__ bias32, float* __restrict__ gates_out, int* __restrict__ lists, unsigned* counts, float* __restrict__ DTout,
                                         int G, int vcu, unsigned char* __restrict__ outq = nullptr) {
    const int tid = threadIdx.x, lane = tid & 63, w = __builtin_amdgcn_readfirstlane(tid >> 6);
    LAS float* wl = (LAS float*)lds;
    LAS int* sel_e = (LAS int*)(lds + LDS_SM); LAS int* sel_rk = sel_e + 512; LAS int* lcnt = sel_e + 1024; LAS int* gbase = sel_e + 1056;
    if (POST) {
#pragma unroll 8
        for (int it = 0; it < 64; ++it) { const int idx = it * 512 + tid, k = idx >> 5, e = idx & 31; const int slot = (((k >> 8) * 4 + (k & 3)) * 64) + ((k >> 2) & 63);
            wl[slot * 36 + e] = W32[(size_t)k * wpitch + e]; }
        if (POST == 1 && tid < 32) lcnt[tid] = 0;
        __syncthreads();
    }
    int ebr = 0;
#pragma unroll
    for (int bb = 0; bb < 5; ++bb) ebr |= ((lane >> bb) & 1) << (4 - bb);
    float mybias = 0.f; if (POST) mybias = bias32[ebr];
    for (int chunk = vcu; chunk < T / 128; chunk += G) {
        u32x2 nxr[4], nmx[4]; f32x4 nxf[XF32 ? 4 : 1]; unsigned nys[4][4]; f32x4 ngv = (f32x4){0.f, 0.f, 0.f, 0.f};
        { const size_t row = (size_t)chunk * 128 + w * 16;
            if (MIXSRC == 1) ngv = *(const f32x4*)(gates_in + row * 4);
#pragma unroll
            for (int j = 0; j < 4; ++j) { if (XF32) nxf[XF32 ? j : 0] = *(const f32x4*)((const float*)xres + row * DM + 4 * lane + 256 * j); else nxr[j] = *(const u32x2*)(xres + row * DM + 4 * lane + 256 * j);
                if (MIXSRC == 0) nmx[j] = *(const u32x2*)(mixf + row * DM + 4 * lane + 256 * j);
                else {
#pragma unroll
                    for (int k = 0; k < 4; ++k) nys[j][k] = __builtin_nontemporal_load((const unsigned*)(YS + (row * 4 + k) * DM + 4 * lane + 256 * j)); } } }
        for (int pass = 0; pass < 16; ++pass) {
            const int rl = w * 16 + pass; const size_t row = (size_t)chunk * 128 + rl;
            asm volatile("" ::: "memory");
            int lo = lane; asm volatile("" : "+v"(lo));
            float xv[16];
            {
                f32x4 v[4]; float s = 0.f;
                const f32x4 gv = ngv * (MIXSRC == 1 ? 1.0f / Q8_Y : 1.0f);
#pragma unroll
                for (int j = 0; j < 4; ++j) {
                    f32x4 mix;
                    if (MIXSRC == 0) mix = (f32x4){bflo(nmx[j].x), bfhi(nmx[j].x), bflo(nmx[j].y), bfhi(nmx[j].y)};
                    else { mix = (f32x4){0.f, 0.f, 0.f, 0.f};
#pragma unroll
                        for (int k = 0; k < 4; ++k) { const f32x2 ylo = __builtin_amdgcn_cvt_pk_f32_fp8((int)nys[j][k], false), yhi = __builtin_amdgcn_cvt_pk_f32_fp8((int)nys[j][k], true);
                            mix[0] += gv[k] * ylo[0]; mix[1] += gv[k] * ylo[1]; mix[2] += gv[k] * yhi[0]; mix[3] += gv[k] * yhi[1]; } }
                    const f32x4 xr = XF32 ? nxf[XF32 ? j : 0] : (f32x4){bflo(nxr[j].x), bfhi(nxr[j].x), bflo(nxr[j].y), bfhi(nxr[j].y)};
                    v[j] = xr * ALPHA + mix; s += (v[j][0] + v[j][1]) + (v[j][2] + v[j][3]);
                }
                if (pass < 15) { const size_t nrow = row + 1;
                    if (MIXSRC == 1) ngv = *(const f32x4*)(gates_in + nrow * 4);
#pragma unroll
                    for (int j = 0; j < 4; ++j) { if (XF32) nxf[XF32 ? j : 0] = *(const f32x4*)((const float*)xres + nrow * DM + 4 * lo + 256 * j); else nxr[j] = *(const u32x2*)(xres + nrow * DM + 4 * lo + 256 * j);
                        if (MIXSRC == 0) nmx[j] = *(const u32x2*)(mixf + nrow * DM + 4 * lo + 256 * j);
                        else {
#pragma unroll
                            for (int k = 0; k < 4; ++k) nys[j][k] = __builtin_nontemporal_load((const unsigned*)(YS + (nrow * 4 + k) * DM + 4 * lo + 256 * j)); } } }
                const float mean = wave_sum(s) * (1.0f / DM); float s2 = 0.f;
#pragma unroll
                for (int j = 0; j < 4; ++j) { v[j] = v[j] - mean; s2 += (v[j][0] * v[j][0] + v[j][1] * v[j][1]) + (v[j][2] * v[j][2] + v[j][3] * v[j][3]); }
                const float rstd = 1.0f / sqrtf(wave_sum(s2) * (1.0f / DM) + LN_EPS);
#pragma unroll
                for (int j = 0; j < 4; ++j) { const f32x4 gm = *(const f32x4*)(gamma + 4 * lo + 256 * j), bt = *(const f32x4*)(beta + 4 * lo + 256 * j);
                    const f32x4 y = v[j] * rstd * gm + bt;
                    if (WRITE_F) __builtin_nontemporal_store(y, (f32x4*)(outf + row * DM + 4 * lo + 256 * j));
                    if (WRITE_B) { u32x2 q; q.x = pk2(y[0], y[1]); q.y = pk2(y[2], y[3]); *(u32x2*)(outb + row * DM + 4 * lo + 256 * j) = q; }
                    if (POST) *(unsigned*)(outq + row * DM + 4 * lo + 256 * j) = pk4_f8(y[0], y[1], y[2], y[3], Q8_X);
                    xv[4 * j + 0] = y[0]; xv[4 * j + 1] = y[1]; xv[4 * j + 2] = y[2]; xv[4 * j + 3] = y[3]; }
            }
            if (POST) {
                f32x2 acc2[16];
#pragma unroll
                for (int e = 0; e < 16; ++e) acc2[e] = (f32x2){0.f, 0.f};
#pragma unroll
                for (int jj = 0; jj < 16; ++jj) { const LAS float* wrow = wl + (jj * 64 + lane) * 36;
                    if ((jj & 1) == 0) asm volatile("" ::: "memory");
                    const f32x2 xx = (f32x2){xv[jj], xv[jj]};
#pragma unroll
                    for (int e4 = 0; e4 < 8; ++e4) { const f32x4 wv = *(const LAS f32x4*)(wrow + 4 * e4);
                        acc2[2 * e4] = acc2[2 * e4] + xx * (f32x2){wv[0], wv[1]}; acc2[2 * e4 + 1] = acc2[2 * e4 + 1] + xx * (f32x2){wv[2], wv[3]}; } }
                float acc0[32];
#pragma unroll
                for (int e = 0; e < 32; ++e) acc0[e] = acc2[e >> 1][e & 1];
#pragma unroll
                for (int bb = 0; bb < 5; ++bb) { const int hh = 16 >> bb; const unsigned um = ((lane >> bb) & 1) ? 0xffffffffu : 0u;
#pragma unroll
                    for (int i = 0; i < hh; ++i) { const unsigned l0 = __float_as_uint(acc0[i]), h0 = __float_as_uint(acc0[i + hh]);
                        const float k0 = __uint_as_float((h0 & um) | (l0 & ~um)), s0 = __uint_as_float((l0 & um) | (h0 & ~um)); acc0[i] = k0 + __shfl_xor(s0, 1 << bb); } }
                const float lg0 = acc0[0] + __shfl_xor(acc0[0], 32) + mybias;
                if (POST == 1) {
                    const unsigned ub = __float_as_uint(lg0); const unsigned uo = (ub & 0x80000000u) ? ~ub : (ub | 0x80000000u);
                    unsigned key = (uo & ~31u) | (unsigned)(31 - ebr);
                    float top0 = 0.f, myv = 0.f, esum = 0.f; int ek = 0;
#pragma unroll
                    for (int k = 0; k < 4; ++k) { unsigned bk = key;
#pragma unroll
                        for (int off = 1; off < 32; off <<= 1) { const unsigned ok = (unsigned)__shfl_xor((int)bk, off); bk = ok > bk ? ok : bk; }
                        const int be = 31 - (int)(__builtin_amdgcn_readfirstlane(bk) & 31u);
                        int wl_ = 0;
#pragma unroll
                        for (int bb = 0; bb < 5; ++bb) wl_ |= ((be >> bb) & 1) << (4 - bb);
                        const float bv = __uint_as_float(__builtin_amdgcn_readlane(__float_as_uint(lg0), wl_));
                        if (k == 0) top0 = bv;
                        const float ex = __expf(bv - top0); esum += ex;
                        myv = (lane == k) ? ex : myv; ek = (lane == k) ? be : ek; key = (ebr == be) ? 0u : key; }
                    if (lane < 4) {
                        gates_out[row * 4 + lane] = myv / esum;
                        const int rk = __hip_atomic_fetch_add(lcnt + ek, 1, __ATOMIC_RELAXED, __HIP_MEMORY_SCOPE_WORKGROUP);
                        sel_e[rl * 4 + lane] = ek; sel_rk[rl * 4 + lane] = rk; }
                } else {
                    if (lane < 32) { const float xx = lg0; const float y = __expf(-fabsf(xx)); const float l1p = (y < 1e-3f) ? (y - 0.5f * y * y) : __logf(1.0f + y);
                        DTout[row * 32 + ebr] = fmaxf(xx, 0.f) + l1p; }
                }
            }
        }
        if (POST == 1) {
            __syncthreads();
            if (tid < 32) gbase[tid] = (int)__hip_atomic_fetch_add(counts + tid, (unsigned)lcnt[tid], __ATOMIC_RELAXED, __HIP_MEMORY_SCOPE_AGENT);
            __syncthreads();
            { const int e = sel_e[tid]; lists[(size_t)e * 32768 + gbase[e] + sel_rk[tid]] = (chunk * 128 + (tid >> 2)) * 4 + (tid & 3); }
            __syncthreads();
            if (tid < 32) lcnt[tid] = 0;
            __syncthreads();
        }
    }
}

__device__ __forceinline__ void conv_item(const bf16* __restrict__ ZX, const float* __restrict__ conv_w, const float* __restrict__ conv_b, int tok0, int ch, u32x4 (&q)[8]) {
    const int sl = tok0 & (SEQ - 1);
    u32x4 raw[11];
#pragma unroll
    for (int i = 0; i < 11; ++i) { if (sl - 3 + i >= 0) raw[i] = *(const u32x4*)(ZX + (size_t)(tok0 - 3 + i) * NZX + 2048 + ch); else raw[i] = (u32x4){0u, 0u, 0u, 0u}; }
    f32x2 cw[4][4], cb[4];
#pragma unroll
    for (int k = 0; k < 4; ++k)
#pragma unroll
        for (int p = 0; p < 4; ++p) cw[k][p] = *(const f32x2*)(conv_w + (size_t)k * 3072 + ch + 2 * p);
#pragma unroll
    for (int p = 0; p < 4; ++p) cb[p] = *(const f32x2*)(conv_b + ch + 2 * p);
    f32x2 xin[11][4];
#pragma unroll
    for (int i = 0; i < 11; ++i)
#pragma unroll
        for (int p = 0; p < 4; ++p) xin[i][p] = (f32x2){bflo(raw[i][p]), bfhi(raw[i][p])};
#pragma unroll
    for (int t = 0; t < 8; ++t)
#pragma unroll
        for (int p = 0; p < 4; ++p) { f32x2 a = cb[p];
#pragma unroll
            for (int k = 0; k < 4; ++k) a = a + cw[k][p] * xin[t + k][p];
            q[t][p] = pk2(silu_f(a[0]), silu_f(a[1])); }
}
__device__ __forceinline__ void convcb_phase(LAS unsigned char* lds, const bf16* __restrict__ ZX, const float* __restrict__ conv_w, const float* __restrict__ conv_b, bf16* __restrict__ XA, bf16* __restrict__ CBG, int G, int vcu) {
    const int tid = threadIdx.x, lane = tid & 63, w = __builtin_amdgcn_readfirstlane(tid >> 6), r16 = lane & 15, q4 = lane >> 4;
    LAS unsigned char *Cs = lds, *Bs = lds + 128 * P256;
    for (int u = vcu; u < BATCH * 32; u += G) {
        const int tokc = u * 128;
        for (int it = 0; it < 8; ++it) { const int item = it * 512 + tid, cg = item & 255, tb = item >> 8;
            u32x4 q[8]; conv_item(ZX, conv_w, conv_b, tokc + 8 * tb, 8 * cg, q);
#pragma unroll
            for (int t = 0; t < 8; ++t) *(u32x4*)(XA + (size_t)(tokc + 8 * tb + t) * 3072 + 8 * cg) = q[t]; }
        for (int g = 0; g < 4; ++g) {
            { const int cgl = tid & 31, tb = tid >> 5; const int ch = (cgl < 16) ? (2048 + g * 128 + 8 * cgl) : (2560 + g * 128 + 8 * (cgl - 16));
                u32x4 q[8]; conv_item(ZX, conv_w, conv_b, tokc + 8 * tb, ch, q);
                LAS unsigned char* dst = (cgl < 16) ? Bs : Cs;
#pragma unroll
                for (int t = 0; t < 8; ++t) { *(u32x4*)(XA + (size_t)(tokc + 8 * tb + t) * 3072 + ch) = q[t]; *(LAS u32x4*)(dst + swz256(8 * tb + t, 16 * (cgl & 15))) = q[t]; } }
            __syncthreads();
            bf16x8 cf[4];
#pragma unroll
            for (int kk = 0; kk < 4; ++kk) cf[kk] = *(const LAS bf16x8*)(Cs + swz256(16 * w + r16, 64 * kk + 16 * q4));
            bf16* outp = CBG + ((size_t)u * 4 + g) * 16384 + (size_t)(16 * w + r16) * 128 + 4 * q4;
#pragma unroll
            for (int st = 0; st < 8; ++st) { f32x4 m = (f32x4){0.f, 0.f, 0.f, 0.f};
#pragma unroll
                for (int kk = 0; kk < 4; ++kk) { const bf16x8 a = *(const LAS bf16x8*)(Bs + swz256(16 * st + r16, 64 * kk + 16 * q4)); m = mfma16(a, cf[kk], m); }
                u32x2 q; q.x = pk2(m[0], m[1]); q.y = pk2(m[2], m[3]); *(u32x2*)(outp + 16 * st) = q; }
            __syncthreads();
        }
    }
}
__device__ __forceinline__ void ssd_phase(LAS unsigned char* lds, const bf16* __restrict__ ZX, const bf16* __restrict__ XA, const bf16* __restrict__ CBG, const float* __restrict__ DT,
                                          const float* __restrict__ a_log, const float* __restrict__ d_skip, unsigned char* __restrict__ Y, float* SSQ, int G, int vcu) {
    const int tid = threadIdx.x, lane = tid & 63, w = __builtin_amdgcn_readfirstlane(tid >> 6), r16_0 = lane & 15, q4_0 = lane >> 4;
    constexpr int SZ_BT = 128 * P256, SZ_XT = 64 * P256, O_XT = 2 * SZ_BT, O_PR = O_XT + 2 * SZ_XT, O_FA = O_PR + 2 * SZ_XT;
    LAS float* fa = (LAS float*)(lds + O_FA);
    for (int u = vcu; u < BATCH * 32; u += G) {
        const int b = u >> 5, h = u & 31, g = h >> 3;
        const float Ah = -__expf(a_log[h]); const float Dh = d_skip[h];
        f32x4 st[4];
#pragma unroll
        for (int pt = 0; pt < 4; ++pt) st[pt] = (f32x4){0.f, 0.f, 0.f, 0.f};
        const int jp = 16 * (w & 3) + (lane & 15);
        const unsigned voff = (unsigned)jp * 12288u + (unsigned)(lane >> 4) * 16u;
        int chb[3];
#pragma unroll
        for (int it = 0; it < 3; ++it) { const int gq = 2 * it + (w >> 2); chb[it] = 2 * ((it == 0) ? (h * 64 + 32 * gq) : (2048 + g * 128 + 32 * (gq - 2))); }
        const char* xab = (const char*)XA + (size_t)b * SEQ * 6144;
        const bf16* cbb = CBG + ((size_t)(b * 32) * 4 + g) * 16384;
        u32x4 pre[3][2]; float dn0 = 0.f, dn1 = 0.f; u32x2 cbr[8]; u32x4 cfr[4];
        {
#pragma unroll
            for (int it = 0; it < 3; ++it) { const char* sb = xab + chb[it]; pre[it][0] = *(const u32x4*)(sb + voff); pre[it][1] = *(const u32x4*)(sb + voff + 6144); }
            if (w == 0) { dn0 = DT[((size_t)b * SEQ + 2 * lane) * 32 + h]; dn1 = DT[((size_t)b * SEQ + 2 * lane + 1) * 32 + h]; }
        }
        for (int c = 0; c <= 32; ++c) {
            const int r16 = r16_0, q4 = q4_0;
            const int sb_ = c & 1;
            LAS unsigned char* BTn = lds + sb_ * SZ_BT; LAS unsigned char* xTn = lds + O_XT + sb_ * SZ_XT; LAS unsigned char* prn = lds + O_PR + sb_ * SZ_XT; LAS float* fan = fa + sb_ * 512;
            if (c >= 1) {
                const int cc = c - 1, cb_ = cc & 1; const int tok0 = b * SEQ + cc * 128;
                LAS unsigned char* BTs = lds + cb_ * SZ_BT; LAS unsigned char* xTs = lds + O_XT + cb_ * SZ_XT; LAS unsigned char* prevs = lds + O_PR + cb_ * SZ_XT;
                LAS float* acum = fa + cb_ * 512; LAS float* dtv = acum + 128; LAS float* wdec = acum + 256;
                const int l = 16 * w + r16;
                u32x2 zz[4];
#pragma unroll
                for (int pt = 0; pt < 4; ++pt) zz[pt] = *(const u32x2*)(ZX + ((size_t)tok0 + l) * NZX + h * 64 + 16 * pt + 4 * q4);
                const float al = acum[l];
                bf16x8 pf[4];
#pragma unroll
                for (int kp = 0; kp < 4; ++kp) {
                    const f32x4 as0 = *(const LAS f32x4*)(acum + 32 * kp + 4 * q4), ds0 = *(const LAS f32x4*)(dtv + 32 * kp + 4 * q4), as1 = *(const LAS f32x4*)(acum + 32 * kp + 16 + 4 * q4), ds1 = *(const LAS f32x4*)(dtv + 32 * kp + 16 + 4 * q4);
                    const u32x2 c0 = cbr[2 * kp], c1 = cbr[2 * kp + 1];
                    const float m0[4] = {bflo(c0.x), bfhi(c0.x), bflo(c0.y), bfhi(c0.y)}, m1[4] = {bflo(c1.x), bfhi(c1.x), bflo(c1.y), bfhi(c1.y)};
                    float mm[8];
#pragma unroll
                    for (int jj = 0; jj < 4; ++jj) { const int s_0 = 32 * kp + 4 * q4 + jj, s_1 = s_0 + 16;
                        mm[jj] = (s_0 <= l) ? m0[jj] * __expf(fminf(al - as0[jj], 0.f)) * ds0[jj] : 0.f; mm[4 + jj] = (s_1 <= l) ? m1[jj] * __expf(fminf(al - as1[jj], 0.f)) * ds1[jj] : 0.f; }
                    u32x4 pw; pw.x = pk2(mm[0], mm[1]); pw.y = pk2(mm[2], mm[3]); pw.z = pk2(mm[4], mm[5]); pw.w = pk2(mm[6], mm[7]); pf[kp] = as_bf16x8(pw); }
                f32x4 y[4];
#pragma unroll
                for (int pt = 0; pt < 4; ++pt) { y[pt] = (f32x4){0.f, 0.f, 0.f, 0.f};
#pragma unroll
                    for (int kk = 0; kk < 4; ++kk) { const bf16x8 a = *(const LAS bf16x8*)(prevs + swz256(16 * pt + r16, 64 * kk + 16 * q4)); y[pt] = mfma16(a, as_bf16x8(cfr[kk]), y[pt]); } }
                const float el = __expf(al);
#pragma unroll
                for (int pt = 0; pt < 4; ++pt) y[pt] = y[pt] * el;
#pragma unroll
                for (int kp = 0; kp < 4; ++kp)
#pragma unroll
                    for (int pt = 0; pt < 4; ++pt) { const u32x2 lo = *(const LAS u32x2*)(xTs + swz256(16 * pt + r16, 64 * kp + 8 * q4)), hi = *(const LAS u32x2*)(xTs + swz256(16 * pt + r16, 64 * kp + 32 + 8 * q4));
                        const u32x4 av = (u32x4){lo.x, lo.y, hi.x, hi.y}; y[pt] = mfma16(as_bf16x8(av), pf[kp], y[pt]); }
                if (c < 32) { const bf16* cp = cbb + (size_t)c * 65536 + (size_t)(16 * w + r16) * 128 + 4 * q4;
#pragma unroll
                    for (int i = 0; i < 8; ++i) cbr[i] = *(const u32x2*)(cp + 16 * i);
                    const bf16* ccp = XA + ((size_t)b * SEQ + c * 128 + 16 * w + r16) * 3072 + 2560 + g * 128 + 8 * q4;
#pragma unroll
                    for (int kk = 0; kk < 4; ++kk) cfr[kk] = *(const u32x4*)(ccp + 32 * kk); }
                { const size_t tok = (size_t)tok0 + l; float ssq = 0.f;
#pragma unroll
                    for (int pt = 0; pt < 4; ++pt) { const int p0 = 16 * pt + 4 * q4;
                        float ov[4];
#pragma unroll
                        for (int jj = 0; jj < 4; ++jj) { const float xvv = bf2f(*(const LAS unsigned short*)(xTs + swz256(p0 + jj, 2 * l)));
                            const unsigned zw = (jj < 2) ? zz[pt].x : zz[pt].y; const float zf = (jj & 1) ? bfhi(zw) : bflo(zw);
                            ov[jj] = (y[pt][jj] + Dh * xvv) * silu_f(zf); }
                        ssq += (ov[0] * ov[0] + ov[1] * ov[1]) + (ov[2] * ov[2] + ov[3] * ov[3]);
                        *(unsigned*)(Y + tok * DI + h * 64 + p0) = pk4_f8(ov[0], ov[1], ov[2], ov[3], Q8_YS); }
                    ssq += __shfl_xor(ssq, 16); ssq += __shfl_xor(ssq, 32);
                    if (q4 == 0) SSQ[tok * 32 + h] = ssq; }
                { const float dec = __expf(acum[384]);
#pragma unroll
                    for (int pt = 0; pt < 4; ++pt) st[pt] = st[pt] * dec;
#pragma unroll
                    for (int kk = 0; kk < 4; ++kk) { const u32x4 a = *(const LAS u32x4*)(BTs + swz256(16 * w + r16, 64 * kk + 16 * q4));
                        const f32x4 w0 = *(const LAS f32x4*)(wdec + 32 * kk + 8 * q4), w1 = *(const LAS f32x4*)(wdec + 32 * kk + 8 * q4 + 4);
                        u32x4 aw; aw.x = pk2(bflo(a.x) * w0[0], bfhi(a.x) * w0[1]); aw.y = pk2(bflo(a.y) * w0[2], bfhi(a.y) * w0[3]); aw.z = pk2(bflo(a.z) * w1[0], bfhi(a.z) * w1[1]); aw.w = pk2(bflo(a.w) * w1[2], bfhi(a.w) * w1[3]);
#pragma unroll
                        for (int pt = 0; pt < 4; ++pt) { const bf16x8 bfr = *(const LAS bf16x8*)(xTs + swz256(16 * pt + r16, 64 * kk + 16 * q4)); st[pt] = mfma16(as_bf16x8(aw), bfr, st[pt]); } } }
            } else {
                const bf16* cp = cbb + (size_t)(16 * w + r16) * 128 + 4 * q4;
#pragma unroll
                for (int i = 0; i < 8; ++i) cbr[i] = *(const u32x2*)(cp + 16 * i);
                const bf16* ccp = XA + ((size_t)b * SEQ + 16 * w + r16) * 3072 + 2560 + g * 128 + 8 * q4;
#pragma unroll
                for (int kk = 0; kk < 4; ++kk) cfr[kk] = *(const u32x4*)(ccp + 32 * kk);
            }
            if (c < 32) {
#pragma unroll
                for (int pt = 0; pt < 4; ++pt) { u32x2 q; q.x = pk2(st[pt][0], st[pt][1]); q.y = pk2(st[pt][2], st[pt][3]); *(LAS u32x2*)(prn + swz256(16 * pt + r16, 2 * (16 * w + 4 * q4))) = q; }
                if (w == 0) { const int t0 = 2 * lane; const float d0 = dn0, d1 = dn1;
                    const float a0 = d0 * Ah, a1 = d1 * Ah; const float sm = a0 + a1; float incl = sm;
#pragma unroll
                    for (int off = 1; off < 64; off <<= 1) { const float v = __shfl_up(incl, off); if (lane >= off) incl += v; }
                    const float c0 = (incl - sm) + a0, c1 = incl; const float tot = __shfl(incl, 63);
                    fan[t0] = c0; fan[t0 + 1] = c1; fan[128 + t0] = d0; fan[128 + t0 + 1] = d1; fan[256 + t0] = d0 * __expf(tot - c0); fan[256 + t0 + 1] = d1 * __expf(tot - c1); if (lane == 63) fan[384] = tot; }
#pragma unroll
                for (int it = 0; it < 3; ++it) { const int cgi = 4 * (2 * it + (w >> 2)) + (lane >> 4);
                    LAS unsigned char* dst = (it == 0) ? xTn : BTn; const int r0 = (it == 0) ? (8 * cgi) : (8 * (cgi - 8));
#pragma unroll
                    for (int i = 0; i < 8; ++i) { const unsigned a0 = pre[it][0][i >> 1], a1 = pre[it][1][i >> 1];
                        const unsigned lo = (i & 1) ? (a0 >> 16) : (a0 & 0xffffu), hi = (i & 1) ? (a1 & 0xffff0000u) : (a1 << 16);
                        *(LAS unsigned*)(dst + swz256(r0 + i, 4 * jp)) = lo | hi; } }
                if (c < 31) {
#pragma unroll
                    for (int it = 0; it < 3; ++it) { const char* sb = xab + (size_t)(c + 1) * (128 * 6144) + chb[it]; pre[it][0] = *(const u32x4*)(sb + voff); pre[it][1] = *(const u32x4*)(sb + voff + 6144); }
                    if (w == 0) { const size_t t1 = (size_t)b * SEQ + (c + 1) * 128; dn0 = DT[(t1 + 2 * lane) * 32 + h]; dn1 = DT[(t1 + 2 * lane + 1) * 32 + h]; }
                }
            }
            lds_barrier();
        }
    }
}
__device__ __forceinline__ void rmsnorm_phase(bf16* Y, int G, int vcu) {
    const int tid = threadIdx.x, lane = tid & 63, w = tid >> 6;
    const int gw = vcu * 8 + w, NGW = G * 8;
    for (int row = gw; row < T; row += NGW) {
        u32x4* rp = (u32x4*)(Y + (size_t)row * DI) + lane;
#pragma unroll
        for (int j = 0; j < 4; ++j) { const u32x4 a = rp[64 * j]; float f[8]; float ss = 0.f;
#pragma unroll
            for (int i = 0; i < 4; ++i) { f[2 * i] = bflo(a[i]); f[2 * i + 1] = bfhi(a[i]); ss += f[2 * i] * f[2 * i] + f[2 * i + 1] * f[2 * i + 1]; }
            const float sc = 1.0f / sqrtf(wave_sum(ss) * (1.0f / 512.0f) + RMS_EPS);
            u32x4 o;
#pragma unroll
            for (int i = 0; i < 4; ++i) o[i] = pk2(f[2 * i] * sc, f[2 * i + 1] * sc);
            rp[64 * j] = o; }
    }
}

__device__ __forceinline__ int moe_tables(LAS unsigned char* lds, const unsigned* counts) {
    const int tid = threadIdx.x;
    LAS int* tab = (LAS int*)(lds + LDS_TAB);
    if (tid < 32) tab[64 + tid] = (int)__hip_atomic_load(counts + tid, __ATOMIC_RELAXED, __HIP_MEMORY_SCOPE_AGENT);
    __syncthreads();
    if (tid == 0) { int pre = 0; for (int e = 0; e < 32; ++e) { tab[e] = pre; pre += (tab[64 + e] + 255) >> 8; } tab[32] = pre; }
    __syncthreads();
    const int NB = tab[32];
    for (int rb = tid; rb < NB; rb += 512) { int e = 0; while (e < 31 && tab[e + 1] <= rb) ++e; tab[128 + rb] = e; }
    __syncthreads();
    return NB;
}

struct Args { const void* in[22]; float* out; unsigned char* ws; int ph_lo, ph_hi; };
__global__ void __launch_bounds__(512, 2) fwd_kernel(Args args) {
    extern __shared__ __attribute__((aligned(16))) unsigned char lds_raw[];
    LAS unsigned char* lds = (LAS unsigned char*)lds_raw;
    const int tid = threadIdx.x;
    const int G = gridDim.x; const int bx = blockIdx.x; const int vcu = (G % 8 == 0) ? (bx % 8) * (G / 8) + bx / 8 : bx;
    unsigned char* ws = args.ws;
    unsigned* ctl = (unsigned*)(ws + WS_CTL);
    Ptrs P;
    P.x = (const float*)args.in[0]; P.pos = (const int*)args.in[1]; P.attn_w_in = (const float*)args.in[2]; P.attn_w_out = (const float*)args.in[3]; P.ssm_w_in = (const float*)args.in[4];
    P.conv_w = (const float*)args.in[5]; P.conv_b = (const float*)args.in[6]; P.dt_bias = (const float*)args.in[7]; P.a_log = (const float*)args.in[8]; P.d_skip = (const float*)args.in[9];
    P.norm_w = (const float*)args.in[10]; P.ssm_w_out = (const float*)args.in[11]; P.w_router = (const float*)args.in[12]; P.b_router = (const float*)args.in[13]; P.w_up = (const float*)args.in[14];
    P.b_up = (const float*)args.in[15]; P.w_dn = (const float*)args.in[16]; P.b_dn = (const float*)args.in[17]; P.ln_mix_g = (const float*)args.in[18]; P.ln_mix_b = (const float*)args.in[19];
    P.ln_ffn_g = (const float*)args.in[20]; P.ln_ffn_b = (const float*)args.in[21];
    volatile LAS unsigned* misc = (volatile LAS unsigned*)(lds + LDS_MISC);
    if (tid < 64) misc[tid] = 0u;
    __syncthreads();
    XcdBarrier bar; bar.bar = ctl + CW_BAR; bar.x = 0; bar.st = misc;
    if (!MK_PER_PHASE) bar = xcd_barrier_post(ctl + CW_BAR, misc);
    const int lo = args.ph_lo, hi = args.ph_hi;
#ifndef PH_MASK
#define PH_MASK 0x1FFFF
#endif
#define IN(k) ((((PH_MASK) >> (k)) & 1) && lo <= (k) && (k) < hi)
#define SEAM(k) do { if (IN(k) && IN((k) + 1)) xcd_barrier(bar); } while (0)

    bf16* Wqkv = (bf16*)(ws + WS_WQKV); bf16* Wao = (bf16*)(ws + WS_WAO); bf16* Wsi = (bf16*)(ws + WS_WSI); bf16* Wso = (bf16*)(ws + WS_WSO);
    bf16* XBA = (bf16*)(ws + WS_XBA); bf16* XBB = (bf16*)(ws + WS_XBB); bf16* MIXB = (bf16*)(ws + WS_X1);
    unsigned char* PROJ = ws + WS_BIG; bf16* ZX = (bf16*)(ws + WS_BIG); bf16* XA = (bf16*)(ws + WS_XA); bf16* CBG = (bf16*)(ws + WS_CBG); unsigned char* HB8 = ws + WS_HB; unsigned char* XQ = ws + WS_XQ; unsigned char* YS = ws + WS_YS;
    unsigned char* OG = ws + WS_OG; unsigned char* YB = ws + WS_OG;
    float* rope = (float*)(ws + WS_ROPE); float* gates = (float*)(ws + WS_GATES); float* DT = (float*)(ws + WS_DT); int* lists = (int*)(ws + WS_LIST); float* LSE = (float*)(ws + WS_LSE); float* SSQ = (float*)(ws + WS_LSE);

    if (IN(0)) { p0_prologue(lds, P, ws, G, vcu); }
    SEAM(0);


#define MOE_BLOCK(LAYER, PB) do { \
    unsigned* counts = ctl + CW_CNT + 64 * (LAYER); \
    if (IN((PB) + 0)) { \
        if ((LAYER) == 0) ln_phase<0, 1, true, false, true>(lds, (const bf16*)P.x, MIXB, nullptr, nullptr, P.ln_mix_g, P.ln_mix_b, nullptr, XBB, P.w_router, NE, P.b_router, gates, lists, counts, nullptr, G, vcu, XQ);   \
        else ln_phase<0, 1, true, false>(lds, XBA, MIXB, nullptr, nullptr, P.ln_mix_g + (LAYER) * DM, P.ln_mix_b + (LAYER) * DM, nullptr, XBB, \
                             P.w_router + (size_t)(LAYER) * DM * NE, NE, P.b_router + (LAYER) * NE, gates, lists, counts, nullptr, G, vcu, XQ); } \
    SEAM((PB) + 0); \
    if (IN((PB) + 1)) { \
        const int NB = moe_tables(lds, counts); \
        LAS int* tab = (LAS int*)(lds + LDS_TAB); LAS unsigned short* toks = (LAS unsigned short*)(lds + LDS_AUX); \
        const int NU = NB * 8; \
        const int nun = (vcu < NU) ? ((NU - vcu + G - 1) / G) : 0; \
        for (int idx = tid; idx < nun * 256 && idx < 17 * 256; idx += 512) { const int i = idx >> 8, row = idx & 255; const int L = i * G + vcu; const int rb = L >> 3; const int e = tab[128 + rb]; \
            const int r0 = (rb - tab[e]) * 256, cnt = tab[64 + e]; int si = r0 + row; si = si < cnt ? si : cnt - 1; toks[idx] = (unsigned short)(lists[(size_t)e * 32768 + si] >> 2); } \
        LAS unsigned* btab = (LAS unsigned*)(lds + LDS_SLOT); \
        for (int idx = tid; idx < nun * 128 && idx < 17 * 128; idx += 512) { const int i = idx >> 7, cp = idx & 127; const int L = i * G + vcu; const int rb = L >> 3, pn = L & 7; const int e = tab[128 + rb]; \
            const float* bsrc = P.b_up + ((size_t)(LAYER) * 32 + e) * 2048 + ((cp < 64) ? (pn * 128 + 2 * cp) : (1024 + pn * 128 + 2 * (cp - 64))); btab[idx] = pk2(bsrc[0], bsrc[1]); } \
        __syncthreads(); \
        pg8::MoeOrder<true> S; S.A = (const char*)XQ; S.Bt = (const char*)(ws + WS_WUP + (size_t)(LAYER) * 32 * 2048 * 1024); S.K = DM / 2;   S.N = 2048; S.nN = 8; S.G = G; S.c = vcu; S.NU = NU; S.tab = tab; S.toks = toks; \
        pg8::EpiUp E{HB8, btab}; \
        if ((LAYER) == 0) { pg8::HostCvt H; H.w_up = P.w_up + (size_t)32 * 1024 * 2048; H.w_dn = P.w_dn + (size_t)32 * 1024 * 1024; H.wt_up = ws + WS_WUP + (size_t)32 * 2048 * 1024; H.wt_dn = ws + WS_WDN + (size_t)32 * 1024 * 1024; \
            H.base = 0; H.limit = 49152; H.G = G; H.c = vcu;   \
            pg8::gemm_phase<true>(lds, DM / 2, S, E, H); } \
        else { pg8::HostNone H; pg8::gemm_phase<true>(lds, DM / 2, S, E, H); } } \
    SEAM((PB) + 1); \
    if (IN((PB) + 2)) { \
        const int NB = moe_tables(lds, counts); \
        LAS int* tab = (LAS int*)(lds + LDS_TAB); LAS int* slots = (LAS int*)(lds + LDS_SLOT); LAS unsigned* dbtab = (LAS unsigned*)(lds + LDS_AUX); \
        { const int NU = NB * 4; const int nun = (vcu < NU) ? ((NU - vcu + G - 1) / G) : 0; \
          for (int idx = tid; idx < nun * 256 && idx < 9 * 256; idx += 512) { const int i = idx >> 8, row = idx & 255; const int L = i * G + vcu; const int rb = L >> 2; const int e = tab[128 + rb]; \
              const int si = (rb - tab[e]) * 256 + row; slots[idx] = (si < tab[64 + e]) ? lists[(size_t)e * 32768 + si] : -1; } \
          for (int idx = tid; idx < nun * 128 && idx < 9 * 128; idx += 512) { const int i = idx >> 7, cp = idx & 127; const int L = i * G + vcu; const int rb = L >> 2, pn = L & 3; const int e = tab[128 + rb]; \
              const float* bsrc = P.b_dn + ((size_t)(LAYER) * 32 + e) * 1024 + pn * 256 + 2 * cp; dbtab[idx] = pk2(bsrc[0], bsrc[1]); } \
          __syncthreads(); } \
        pg8::MoeOrder<false> S; S.A = (const char*)HB8; S.Bt = (const char*)(ws + WS_WDN + (size_t)(LAYER) * 32 * 1024 * 1024); S.K = DM / 2; S.N = 1024; S.nN = 4; S.G = G; S.c = vcu; S.NU = NB * 4; S.tab = tab; S.toks = nullptr; \
        pg8::EpiDown E{YS, dbtab, slots}; \
        if ((LAYER) == 0) { pg8::HostCvt H; H.w_up = P.w_up + (size_t)32 * 1024 * 2048; H.w_dn = P.w_dn + (size_t)32 * 1024 * 1024; H.wt_up = ws + WS_WUP + (size_t)32 * 2048 * 1024; H.wt_dn = ws + WS_WDN + (size_t)32 * 1024 * 1024; \
            H.base = NB * 64; H.limit = 49152; H.G = G; H.c = vcu;   \
            pg8::gemm_phase<true>(lds, DM / 2, S, E, H); } \
        else { pg8::HostNone H; pg8::gemm_phase<true>(lds, DM / 2, S, E, H); } } \
    SEAM((PB) + 2); \
    if (IN((PB) + 3)) { \
        if ((LAYER) == 0) ln_phase<1, 2, true, false>(lds, XBB, nullptr, YS, gates, P.ln_ffn_g, P.ln_ffn_b, nullptr, XBA, P.ssm_w_in + NZX, SSM_PITCH, P.dt_bias, nullptr, nullptr, nullptr, DT, G, vcu, ws + WS_XQ0); \
        else ln_phase<1, 0, false, true>(lds, XBB, nullptr, YS, gates, P.ln_ffn_g + DM, P.ln_ffn_b + DM, args.out, nullptr, nullptr, 0, nullptr, nullptr, nullptr, nullptr, nullptr, G, vcu); } \
    } while (0)

    if (IN(1)) { pg8::DenseOrder S; S.init(ws + WS_XQ0, Wqkv, T, NQKV, DM / 2, G, bx); pg8::EpiQKV E{PROJ, rope, 1.0f / (Q8_X * Q8_W)};
        pg8::HostCvt H; H.w_up = P.w_up; H.w_dn = P.w_dn; H.wt_up = ws + WS_WUP; H.wt_dn = ws + WS_WDN; H.base = 0; H.limit = 2 * HOSTED_ITEMS; H.G = G; H.c = bx;
        pg8::gemm_phase<true>(lds, DM / 2, S, E, H); }
    SEAM(1);
    if (IN(2)) attn_phase(lds, PROJ, OG, LSE, G, vcu);
    SEAM(2);
    if (IN(3)) combine_phase(OG, LSE, ws + WS_OB, G, vcu);
    SEAM(3);
    if (IN(4)) { pg8::DenseOrder S; S.init(ws + WS_OB, Wao, T, DM, DM / 2, G, bx); pg8::EpiBf16 E{MIXB, DM, 1.0f / (Q8_O * Q8_W)}; pg8::HostNone H; pg8::gemm_phase<true>(lds, DM / 2, S, E, H); }
    SEAM(4);
    MOE_BLOCK(0, 5);
    SEAM(8);
    if (IN(9)) { pg8::DenseOrder S; S.init(ws + WS_XQ0, Wsi, T, NZX, DM / 2, G, bx); pg8::EpiBf16 E{ZX, NZX, 1.0f / (Q8_X * Q8_W)}; pg8::HostNone H; pg8::gemm_phase<true>(lds, DM / 2, S, E, H); }
    SEAM(9);
    if (IN(10)) {
        convcb_phase(lds, ZX, P.conv_w, P.conv_b, XA, CBG, G, vcu); }
    SEAM(10);
    if (IN(11)) ssd_phase(lds, ZX, XA, CBG, DT, P.a_log, P.d_skip, YB, SSQ, G, vcu);
    SEAM(11);
    if (IN(12)) { pg8::DenseOrder S; S.init(YB, Wso, T, DM, DI / 2, G, bx);
        LAS float* stab = (LAS float*)(lds + LDS_AUX);
        for (int i = 0; i < 4; ++i) { pg8::Unit uu; if (!S.next(i, uu)) break;
            for (int idx = tid; idx < 1024; idx += 512) { const int rl = idx >> 2, g = idx & 3; const float* sp = SSQ + (size_t)(uu.pm * 256 + rl) * 32 + g * 8;
                const f32x4 a = *(const f32x4*)sp, b4 = *(const f32x4*)(sp + 4); const float sum = ((a[0] + a[1]) + (a[2] + a[3])) + ((b4[0] + b4[1]) + (b4[2] + b4[3]));
                stab[(i * 256 + rl) * 4 + g] = __builtin_amdgcn_rsqf(sum * (1.0f / 512.0f) + RMS_EPS); } }
        __syncthreads();
        pg8::EpiRms E{MIXB, DM, stab}; pg8::HostNone H; pg8::gemm_phase<true>(lds, DI / 2, S, E, H); }
    SEAM(12);
    MOE_BLOCK(1, 13);
#undef IN
#undef SEAM
#undef MOE_BLOCK
}

constexpr int NPHASE = 17;
extern "C" void kernel_launch(void* const* d_in, const int* in_sizes, int n_in, void* d_out, int out_size, void* d_ws, size_t ws_size, hipStream_t stream) {
    static int grid = 0;
    if (grid == 0) {
        if (n_in != 22 || in_sizes[0] != T * DM || out_size != T * DM || ws_size < WS_END) { fprintf(stderr, "kernel_launch: unexpected shapes / workspace (n_in %d, in0 %d, out %d, ws %zu, need %zu)\n", n_in, n_in > 0 ? in_sizes[0] : -1, out_size, ws_size, (size_t)WS_END); grid = -1; return; }
        int dev = 0, cus = 0;
        if (hipGetDevice(&dev) != hipSuccess || hipDeviceGetAttribute(&cus, hipDeviceAttributeMultiprocessorCount, dev) != hipSuccess) { fprintf(stderr, "kernel_launch: device query failed\n"); grid = -1; return; }
        if (hipFuncSetAttribute((const void*)fwd_kernel, hipFuncAttributeMaxDynamicSharedMemorySize, LDS_BYTES) != hipSuccess) { fprintf(stderr, "kernel_launch: hipFuncSetAttribute failed\n"); grid = -1; return; }
        int per_cu = 0;
        if (hipOccupancyMaxActiveBlocksPerMultiprocessor(&per_cu, (const void*)fwd_kernel, 512, LDS_BYTES) != hipSuccess || per_cu < 1) fprintf(stderr, "kernel_launch: occupancy query reports %d\n", per_cu);
        (void)hipGetLastError();
        grid = cus;
        if (grid < 256) { fprintf(stderr, "kernel_launch: built for >= 256 CUs, got %d\n", grid); }
        if (grid > 256) grid = 256;
    }
    if (grid < 0) return;
    if (hipMemsetAsync((char*)d_ws + WS_CTL, 0, CTL_ZERO_BYTES, stream) != hipSuccess) { fprintf(stderr, "kernel_launch: memset failed\n"); return; }
    Args a{};
    for (int i = 0; i < 22; ++i) a.in[i] = d_in[i];
    a.out = (float*)d_out; a.ws = (unsigned char*)d_ws;
#if MK_PER_PHASE
    for (int p = 0; p < NPHASE; ++p) { a.ph_lo = p; a.ph_hi = p + 1; hipLaunchKernelGGL(fwd_kernel, dim3(grid), dim3(512), LDS_BYTES, stream, a); }
#else
    a.ph_lo = 0; a.ph_hi = NPHASE;
    hipLaunchKernelGGL(fwd_kernel, dim3(grid), dim3(512), LDS_BYTES, stream, a);
#endif
    const hipError_t le = hipPeekAtLastError();
    if (le != hipSuccess) fprintf(stderr, "kernel_launch: launch failed: %s\n", hipGetErrorName(le));
}
```

```cpp
#include <hip/hip_runtime.h>
#include <cstdio>
#include <cstdint>

#ifndef MK_PER_PHASE
#define MK_PER_PHASE 0
#endif

#define GAS __attribute__((address_space(1)))
#define LAS __attribute__((address_space(3)))
typedef unsigned short bf16;
typedef short bf16x8 __attribute__((ext_vector_type(8)));
typedef float f32x4 __attribute__((ext_vector_type(4)));
typedef float f32x2 __attribute__((ext_vector_type(2)));
typedef unsigned u32x4 __attribute__((ext_vector_type(4)));
typedef unsigned u32x2 __attribute__((ext_vector_type(2)));

constexpr int BATCH = 8, SEQ = 4096, DM = 1024, T = BATCH * SEQ;
constexpr int NQKV = 9216;
constexpr int NZX = 5120, SSM_PITCH = 5152, DI = 2048;
constexpr int NE = 32;
constexpr float LN_EPS = 1e-5f, RMS_EPS = 1e-5f, ALPHA = 1.41421356237309505f;
constexpr float QSCALE = 0.12751743082459868f;
constexpr float LN2F = 0.6931471805599453f;

constexpr size_t MiB = 1u << 20;
constexpr size_t WS_CTL = 0, CTL_ZERO_BYTES = 128 * 1024;
constexpr size_t WS_ROPE = 1 * MiB;
constexpr size_t WS_GATES = 5 * MiB;
constexpr size_t WS_DT = 6 * MiB;
constexpr size_t WS_LIST = 10 * MiB;
constexpr size_t WS_LSE = 14 * MiB;
constexpr size_t WS_WQKV = 18 * MiB;
constexpr size_t WS_WAO = 36 * MiB;
constexpr size_t WS_WSI = 38 * MiB;
constexpr size_t WS_WSO = 48 * MiB;
constexpr size_t WS_WUP = 52 * MiB;
constexpr size_t WS_XQ = 180 * MiB;
constexpr size_t WS_XQ0 = 212 * MiB;
constexpr size_t WS_WDN = 308 * MiB;
constexpr size_t WS_XBA = 436 * MiB;
constexpr size_t WS_XBB = 500 * MiB;
constexpr size_t WS_X1 = 564 * MiB;
constexpr size_t WS_BIG = 692 * MiB;
constexpr size_t WS_XA = 1012 * MiB;
constexpr size_t WS_CBG = 1204 * MiB;
constexpr size_t WS_HB = WS_BIG;
constexpr size_t WS_YS = 964 * MiB;
constexpr size_t WS_OG = 1268 * MiB;
constexpr size_t WS_OB = 1460 * MiB;
constexpr size_t WS_END = 1524 * MiB;
constexpr int CW_BAR = 4096;
constexpr int CW_CNT = 16384;
constexpr int CW_CVT = 20000;
#ifndef CVT_Q_UP
#define CVT_Q_UP 5
#endif
#ifndef CVT_Q_DN
#define CVT_Q_DN 5
#endif

constexpr int LDS_AUX = 131072;
constexpr int LDS_TAB = 131072 + 17 * 512;
constexpr int LDS_SLOT = LDS_TAB + 2688;
constexpr int LDS_SM = 147456;
constexpr int LDS_MISC = 155648;
constexpr int LDS_BYTES = 156672;

__device__ __forceinline__ float bf2f(unsigned short b) { return __uint_as_float(((unsigned)b) << 16); }
__device__ __forceinline__ float bflo(unsigned w) { return __uint_as_float(w << 16); }
__device__ __forceinline__ float bfhi(unsigned w) { return __uint_as_float(w & 0xffff0000u); }
typedef __bf16 bf16x2_t __attribute__((ext_vector_type(2)));
constexpr float Q8_X = 8.0f, Q8_W = 256.0f, Q8_H = 8.0f, Q8_O = 32.0f, Q8_Y = 32.0f, Q8_Q = 64.0f, Q8_K = 8.0f, Q8_V = 8.0f, Q8_YS = 16.0f;
__device__ __forceinline__ unsigned pk4_f8(float a, float b, float c, float d, float sc) {
    a = __builtin_fminf(__builtin_fmaxf(a * sc, -448.f), 448.f); b = __builtin_fminf(__builtin_fmaxf(b * sc, -448.f), 448.f);
    c = __builtin_fminf(__builtin_fmaxf(c * sc, -448.f), 448.f); d = __builtin_fminf(__builtin_fmaxf(d * sc, -448.f), 448.f);
    int p = __builtin_amdgcn_cvt_pk_fp8_f32(a, b, 0, false); p = __builtin_amdgcn_cvt_pk_fp8_f32(c, d, p, true); return (unsigned)p; }
__device__ __forceinline__ unsigned pk2(float lo, float hi) { const f32x2 v = {lo, hi}; const bf16x2_t b = __builtin_convertvector(v, bf16x2_t); return __builtin_bit_cast(unsigned, b); }
__device__ __forceinline__ float wave_sum(float v) {
#pragma unroll
    for (int o = 1; o < 64; o <<= 1) v += __shfl_xor(v, o);
    return v;
}
constexpr int P256 = 272, P512 = 528;
__device__ __forceinline__ int swz256(int row, int bc) { return row * P256 + bc; }
__device__ __forceinline__ int swz512(int row, int bc) { return row * P512 + bc; }
__device__ __forceinline__ bf16x8 as_bf16x8(u32x4 v) { return __builtin_bit_cast(bf16x8, v); }
__device__ __forceinline__ f32x4 mfma16(bf16x8 a, bf16x8 b, f32x4 c) { return __builtin_amdgcn_mfma_f32_16x16x32_bf16(a, b, c, 0, 0, 0); }
__device__ __forceinline__ void lds_barrier() { asm volatile("s_waitcnt lgkmcnt(0)" ::: "memory"); __builtin_amdgcn_s_barrier(); asm volatile("" ::: "memory"); }
__device__ __forceinline__ float silu_f(float v) { return v * __builtin_amdgcn_rcpf(1.0f + __expf(-v)); }

#define XB_TMO      128
#define XB_XCNT(j)  (256  + 64 * (j))
#define XB_XSUB(j)  (1280 + 64 * (j))
#define XB_XGEN(j)  (2304 + 64 * (j))
#define XB_TOP      3328
#define XB_TOPGEN   3392
#define XCD_BAR_WORDS 3456
#define XB_SPIN_CAP (1u << 18)
__device__ __forceinline__ unsigned xb_ld(unsigned* p)              { return __hip_atomic_load(p, __ATOMIC_RELAXED, __HIP_MEMORY_SCOPE_AGENT); }
__device__ __forceinline__ unsigned xb_add(unsigned* p, unsigned v) { return __hip_atomic_fetch_add(p, v, __ATOMIC_RELAXED, __HIP_MEMORY_SCOPE_AGENT); }
__device__ __forceinline__ unsigned xb_xcc_id() { return (unsigned)__builtin_amdgcn_s_getreg((3 << 11) | 20) & 0xFu; }
#define XB_SPIN(cond, bar) do { unsigned _sp = 0; while (cond) { __builtin_amdgcn_s_sleep(1); \
    if ((++_sp & 255u) == 0u) { if (xb_ld(&(bar)[XB_TMO])) break; if (_sp > XB_SPIN_CAP) { atomicAdd(&(bar)[XB_TMO], 1u); break; } } } } while (0)
struct XcdBarrier { unsigned* bar; unsigned x; volatile LAS unsigned* st; };
__device__ __forceinline__ XcdBarrier xcd_barrier_post(unsigned* bar, volatile LAS unsigned* st) {
    XcdBarrier b; b.bar = bar; b.x = xb_xcc_id(); b.st = st;
    if (threadIdx.x == 0) (void)xb_add(&bar[XB_XCNT(b.x)], 1u);
    return b;
}
__device__ __forceinline__ void xcd_barrier_complete(unsigned* bar, unsigned x, unsigned& nloc, unsigned& nx) {
    const unsigned G = gridDim.x * gridDim.y * gridDim.z;
    unsigned sum, cnt, mine, sp = 0u;
    for (;;) {
        sum = 0u; cnt = 0u; mine = 0u;
#pragma unroll
        for (unsigned j = 0; j < 16; ++j) { const unsigned c = xb_ld(&bar[XB_XCNT(j)]); sum += c; cnt += (c > 0u) ? 1u : 0u; mine = (j == x) ? c : mine; }
        if (sum == G) break;
        __builtin_amdgcn_s_sleep(1);
        if ((++sp & 255u) == 0u) { if (xb_ld(&bar[XB_TMO])) break; if (sp > XB_SPIN_CAP) { atomicAdd(&bar[XB_TMO], 1u); break; } }
    }
    nloc = mine > 0u ? mine : 1u; nx = cnt > 0u ? cnt : 1u;
}
__device__ __forceinline__ void xcd_barrier(const XcdBarrier& b) {
    asm volatile("s_waitcnt vmcnt(0)" ::: "memory");
    __syncthreads();
    if (threadIdx.x == 0) {
        unsigned* bar = b.bar;
        __builtin_amdgcn_s_waitcnt(0);
        unsigned nloc = b.st[0], nx = b.st[1];
        if (nloc == 0u) { xcd_barrier_complete(bar, b.x, nloc, nx); b.st[0] = nloc; b.st[1] = nx; }
        const unsigned k = b.st[2] + 1u; b.st[2] = k;
        const unsigned old = xb_add(&bar[XB_XSUB(b.x)], 1u);
        if (old + 1u == k * nloc) {
            __builtin_amdgcn_fence(__ATOMIC_RELEASE, "agent");
            asm volatile("s_waitcnt vmcnt(0)" ::: "memory");
            const unsigned og = xb_add(&bar[XB_TOP], 1u);
            if (og + 1u == k * nx) xb_add(&bar[XB_TOPGEN], 1u);
        }
        XB_SPIN(xb_ld(&bar[XB_TOPGEN]) < k, bar);
        __builtin_amdgcn_fence(__ATOMIC_ACQUIRE, "agent");
        asm volatile("s_waitcnt vmcnt(0)" ::: "memory");
    }
    __syncthreads();
}

namespace pg8 {
constexpr int BM = 256, BK = 64, HALF = 128, HTB = HALF * BK * 2, STAGE_BYTES = 8 * HTB, NXCD = 8, WGM = 4;
__host__ __device__ __forceinline__ int lds_byte(int r, int c) { const int st = (r >> 4) * 2 + (c >> 5), rr = r & 15, cc = c & 31, ob = rr * 64 + cc * 2; return st * 1024 + (ob ^ (((ob >> 9) & 1) << 5)); }
__host__ __device__ __forceinline__ void stage_rc(int b, int& R, int& C) { const int st = b / 1024, sb = b % 1024, swz = sb ^ (((sb >> 9) & 1) << 5); R = (st >> 1) * 16 + swz / 64; C = (st & 1) * 32 + (swz % 64) / 2; }
__host__ __device__ __forceinline__ int perm32(int rho) { const int n = rho >> 4, i = rho & 15; return 8 * (i >> 2) + 4 * n + (i & 3); }

struct Unit { int pm, pn, e, r0, cnt, ord; };
typedef int i32x8_t __attribute__((ext_vector_type(8))); typedef int i32x4_t __attribute__((ext_vector_type(4)));
__device__ __forceinline__ i32x8_t cat8(const bf16x8& a, const bf16x8& b) { return __builtin_shufflevector(__builtin_bit_cast(i32x4_t, a), __builtin_bit_cast(i32x4_t, b), 0, 1, 2, 3, 4, 5, 6, 7); }

struct DenseOrder {
    static constexpr bool GATHER_A = false;
    const char* A; const char* Bt; int K, nM, nN, nwg, G, c;
    __device__ __forceinline__ void init(const void* A_, const void* Bt_, int M, int N, int K_, int G_, int c_) { A = (const char*)A_; Bt = (const char*)Bt_; K = K_; nM = M / BM; nN = N / BM; nwg = nM * nN; G = G_; c = c_; }
    __device__ __forceinline__ bool next(int i, Unit& u) const {
        const long L = (long)i * G + c; if (L >= nwg) return false;
        int wgid = (int)L; { const int q = nwg / NXCD, r = nwg % NXCD, xcd = wgid % NXCD, off = wgid / NXCD; wgid = (xcd < r ? xcd * (q + 1) : r * (q + 1) + (xcd - r) * q) + off; }
        const int nig = WGM * nN, gid = wgid / nig, fm = gid * WGM, gsz = (nM - fm) < WGM ? (nM - fm) : WGM;
        u.pm = fm + ((wgid % nig) % gsz); u.pn = (wgid % nig) / gsz; u.e = 0; u.r0 = 0; u.cnt = 0; u.ord = i; return true;
    }
    __device__ __forceinline__ const char* a_base(const Unit& u) const { return A + (size_t)u.pm * ((size_t)BM * K * 2); }
    __device__ __forceinline__ const char* b_base(const Unit& u) const { return Bt + (size_t)u.pn * ((size_t)BM * K * 2); }
    __device__ __forceinline__ void a_offs(const Unit&, unsigned (&v)[2][2]) const {
#pragma unroll
        for (int i = 0; i < 2; ++i) { int R, C; stage_rc((int)threadIdx.x * 16 + i * 8192, R, C);
#pragma unroll
            for (int h = 0; h < 2; ++h) v[h][i] = (unsigned)((h * HALF + R) * K + C) * 2u; }
    }
};
template <bool GATHER> struct MoeOrder {
    static constexpr bool GATHER_A = GATHER;
    const char* A; const char* Bt; int K, N, nN, G, c, NU; const LAS int* tab; const LAS unsigned short* toks;
    __device__ __forceinline__ bool next(int i, Unit& u) const {
        const int L = i * G + c; if (L >= NU) return false;
        const int rb = L / nN; u.pn = L - rb * nN; u.pm = rb;
        const int e = __builtin_amdgcn_readfirstlane(tab[128 + rb]); u.e = e;
        u.r0 = (rb - __builtin_amdgcn_readfirstlane(tab[e])) * 256; u.cnt = __builtin_amdgcn_readfirstlane(tab[64 + e]); u.ord = i; return true;
    }
    __device__ __forceinline__ const char* a_base(const Unit& u) const { return GATHER ? A : A + (size_t)u.pm * ((size_t)BM * K * 2); }
    __device__ __forceinline__ const char* b_base(const Unit& u) const { return Bt + ((size_t)u.e * N + (size_t)u.pn * BM) * ((size_t)K * 2); }
    __device__ __forceinline__ void a_offs(const Unit& u, unsigned (&v)[2][2]) const {
#pragma unroll
        for (int i = 0; i < 2; ++i) { int R, C; stage_rc((int)threadIdx.x * 16 + i * 8192, R, C);
#pragma unroll
            for (int h = 0; h < 2; ++h) {
                if (GATHER) { const unsigned tok = toks[u.ord * 256 + h * HALF + R]; v[h][i] = (tok * (unsigned)K + (unsigned)C) * 2u; }
                else v[h][i] = (unsigned)((h * HALF + R) * K + C) * 2u; } }
    }
};


struct HostNone { struct Regs {}; __device__ __forceinline__ void issue(int, Regs&, f32x4 (&)[2][2][4][2]) const {} __device__ __forceinline__ void finish(const Regs&, const f32x4 (&)[2][2][4][2]) const {} };
struct HostCvt {
    const float* w_up; const float* w_dn; unsigned char* wt_up; unsigned char* wt_dn;
    int base, limit, G, c;
    struct Regs { unsigned char* dst; bool active; };
    __device__ __forceinline__ void issue(int ord, Regs& R, f32x4 (&acc)[2][2][4][2]) const {
        const int w = __builtin_amdgcn_readfirstlane((int)threadIdx.x >> 6), lane = threadIdx.x & 63, kq = lane >> 4, nq = lane & 15;
        const int hi = __builtin_amdgcn_readfirstlane(base + (ord * G + c) * 8 + w);
        R.active = hi < limit; R.dst = nullptr;
        if (R.active) {
            const float* W; int pitch, k0, n0, drow; unsigned char* WT;
            if (hi < 32768) { const int mat = hi >> 10, q = hi & 1023, kb = q >> 5, nb = q & 31; n0 = nb * 64; k0 = kb * 32; pitch = 2048; W = w_up + (size_t)mat * 1024 * 2048; WT = wt_up + (size_t)mat * 2048 * 1024;
                drow = ((n0 & 1023) >> 7) * 256 + (n0 >> 10) * 128 + (n0 & 127); }
            else { const int r = hi - 32768, mat = r >> 9, q = r & 511, kb = q >> 4, nb = q & 15; n0 = nb * 64; k0 = kb * 32; pitch = 1024; W = w_dn + (size_t)mat * 1024 * 1024; WT = wt_dn + (size_t)mat * 1024 * 1024; drow = n0; }
            const char* src = (const char*)(W + (size_t)k0 * pitch + n0); const unsigned voff = (unsigned)(kq * pitch + 4 * nq) * 4u;
#pragma unroll
            for (int i = 0; i < 8; ++i) acc[0][0][i >> 1][i & 1] = __builtin_nontemporal_load((const f32x4*)(src + (size_t)(4 * i) * pitch * 4 + voff));
            R.dst = WT + (size_t)(drow + 4 * nq + kq) * 1024 + k0;
        }
    }
    __device__ __forceinline__ void finish(const Regs& R, const f32x4 (&acc)[2][2][4][2]) const {
        if (R.active) {
            const int lane = threadIdx.x & 63;
            const unsigned sel1 = (lane & 16) ? 0x07030501u : 0x06020400u, sel2 = (lane & 32) ? 0x07060302u : 0x05040100u;
            unsigned o[8];
#pragma unroll
            for (int i = 0; i < 8; ++i) { const f32x4 v = acc[0][0][i >> 1][i & 1]; const unsigned d = pk4_f8(v[0], v[1], v[2], v[3], Q8_W);
                const u32x2 s1 = __builtin_amdgcn_permlane16_swap(d, d, false, false);
                const unsigned t1 = __builtin_amdgcn_perm(s1.y, s1.x, sel1);
                const u32x2 s2 = __builtin_amdgcn_permlane32_swap(t1, t1, false, false);
                o[i] = __builtin_amdgcn_perm(s2.y, s2.x, sel2); }
            *(u32x4*)R.dst = (u32x4){o[0], o[1], o[2], o[3]}; *(u32x4*)(R.dst + 16) = (u32x4){o[4], o[5], o[6], o[7]};
        }
    }
};

template <bool F8 = false, class Epi, class Sched, class Host>
__device__ __forceinline__ void gemm_phase(LAS unsigned char* lds, const int K, const Sched& S, const Epi& E, const Host& H) {
    const int tid = threadIdx.x, wid = __builtin_amdgcn_readfirstlane(tid >> 6), lane = tid & 63, wr = wid >> 2, wc = wid & 3, fr = lane & 15, fq = lane >> 4;
    const int nt = K / BK;
    unsigned voffB[2];
#pragma unroll
    for (int i = 0; i < 2; ++i) { int R, C; stage_rc(tid * 16 + i * 8192, R, C); const int Rb = Epi::PERM ? ((R & ~31) + perm32(R & 31)) : R; voffB[i] = (unsigned)(Rb * K + C) * 2u; }
    const size_t kstep = (size_t)(BK * 2);
    const size_t hstep = (size_t)HALF * K * 2;
    const unsigned ldsw = (unsigned)wid * 1024u;
    const int aoff = lds_byte(wr * 64 + fr, fq * 8), boff = lds_byte(wc * 32 + fr, fq * 8);
#define PG8_SA(b, h) (((b) * 2 + (h)) * HTB)
#define PG8_SB(b, h) ((4 + (b) * 2 + (h)) * HTB)
#define PG8_STAGE(bufoff, gbase, voff) do { _Pragma("unroll") for (int _i = 0; _i < 2; ++_i) \
        __builtin_amdgcn_global_load_lds((const unsigned*)((const char*)(gbase) + (voff)[_i]), (LAS unsigned*)(lds + (bufoff) + ldsw + _i * 8192), 16, 0, 0); } while (0)
#define PG8_LDA(dst, b, h) do { _Pragma("unroll") for (int m = 0; m < 4; ++m) _Pragma("unroll") for (int k = 0; k < 2; ++k) dst[m][k] = *(const LAS bf16x8*)(lds + PG8_SA(b, h) + aoff + m * 2048 + k * 1024); } while (0)
#define PG8_LDB(dst, b, h) do { _Pragma("unroll") for (int n = 0; n < 2; ++n) _Pragma("unroll") for (int k = 0; k < 2; ++k) dst[n][k] = *(const LAS bf16x8*)(lds + PG8_SB(b, h) + boff + n * 2048 + k * 1024); } while (0)
#define PG8_MMA(ai, bj, At, Bt) do { __builtin_amdgcn_s_setprio(1); _Pragma("unroll") for (int m = 0; m < 4; ++m) _Pragma("unroll") for (int n = 0; n < 2; ++n) { \
        if constexpr (F8) { const i32x8_t b8_ = cat8(Bt[n][0], Bt[n][1]), a8_ = cat8(At[m][0], At[m][1]); asm volatile("v_mfma_f32_16x16x128_f8f6f4 %0, %1, %2, %0" : "+v"(acc[ai][bj][m][n]) : "v"(b8_), "v"(a8_)); } \
        else { _Pragma("unroll") for (int k = 0; k < 2; ++k) acc[ai][bj][m][n] = __builtin_amdgcn_mfma_f32_16x16x32_bf16(Bt[n][k], At[m][k], acc[ai][bj][m][n], 0, 0, 0); } } __builtin_amdgcn_s_setprio(0); } while (0)
#define PG8_WAIT_V(n) asm volatile("s_waitcnt vmcnt(" #n ")" ::: "memory")
#define PG8_WAIT_L(n) asm volatile("s_waitcnt lgkmcnt(" #n ")" ::: "memory")
#define PG8_BAR __builtin_amdgcn_s_barrier()
#define PG8_SCHED __builtin_amdgcn_sched_barrier(0)
    Unit cur, nxt; int ui = 0;
    if (!S.next(0, cur)) return;
    f32x4 acc[2][2][4][2];
#pragma unroll
    for (int a = 0; a < 2; ++a)
#pragma unroll
        for (int b = 0; b < 2; ++b)
#pragma unroll
            for (int m = 0; m < 4; ++m)
#pragma unroll
                for (int n = 0; n < 2; ++n) acc[a][b][m][n] = (f32x4){0.f, 0.f, 0.f, 0.f};
    bf16x8 At[4][2], B0[2][2], B1[2][2];
    constexpr bool GA = Sched::GATHER_A;
    unsigned vA[2][2], nvA[2][2];
    S.a_offs(cur, vA);
    const size_t ah = GA ? 0 : hstep;
#define PG8_VA1 (GA ? vA[1] : vA[0])
    const char* cA = S.a_base(cur); const char* cB = S.b_base(cur);
    PG8_STAGE(PG8_SB(0, 0), cB, voffB); PG8_STAGE(PG8_SB(0, 1), cB + hstep, voffB); PG8_STAGE(PG8_SA(0, 0), cA, vA[0]); PG8_STAGE(PG8_SA(0, 1), cA + ah, PG8_VA1);
    if (wr == 1) PG8_BAR;
    PG8_WAIT_V(2); PG8_BAR;
    PG8_STAGE(PG8_SB(1, 0), cB + kstep, voffB); PG8_STAGE(PG8_SA(1, 0), cA + kstep, vA[0]); PG8_STAGE(PG8_SB(1, 1), cB + hstep + kstep, voffB);
    PG8_WAIT_V(6); PG8_BAR;
    for (;;) {
        const bool has_next = S.next(ui + 1, nxt);
        const char* nA = cA; const char* nB = cB;
#pragma unroll
        for (int h = 0; h < 2; ++h)
#pragma unroll
            for (int i = 0; i < 2; ++i) nvA[h][i] = vA[h][i];
        if (has_next) { nA = S.a_base(nxt); nB = S.b_base(nxt); if constexpr (GA) S.a_offs(nxt, nvA); }
        constexpr int NGRP = Epi::RESCALE ? 4 : 1; const int tper = nt / NGRP;
        for (int gq = 0; gq < NGRP; ++gq) {
        if constexpr (Epi::RESCALE) { if (gq > 0) { if constexpr (F8) asm volatile("s_nop 15\n\ts_nop 15" ::: "memory"); E.rescale(acc, cur, gq, wr, fr); } }
#pragma unroll 1
        for (int t = gq * tper; t < (gq + 1) * tper; t += 2) {
            const bool last = (t == nt - 2);
            const char* a1 = cA + (size_t)(t + 1) * kstep;
            const char* a2 = last ? nA : cA + (size_t)(t + 2) * kstep; const char* b2 = last ? nB : cB + (size_t)(t + 2) * kstep;
            const char* a3 = a2 + kstep; const char* b3 = b2 + kstep;
            unsigned w0[2], w1[2];
#pragma unroll
            for (int i = 0; i < 2; ++i) { if constexpr (GA) { w0[i] = last ? nvA[0][i] : vA[0][i]; w1[i] = last ? nvA[1][i] : vA[1][i]; } else { w0[i] = vA[0][i]; w1[i] = vA[0][i]; } }
            PG8_LDB(B0, 0, 0); PG8_LDB(B1, 0, 1); PG8_SCHED; PG8_LDA(At, 0, 0); PG8_STAGE(PG8_SA(1, 1), a1 + ah, PG8_VA1);
            PG8_WAIT_V(8); PG8_WAIT_L(0); PG8_BAR; PG8_MMA(0, 0, At, B0); PG8_MMA(0, 1, At, B1); PG8_BAR; PG8_SCHED;
            PG8_LDA(At, 0, 1); PG8_STAGE(PG8_SB(0, 0), b2, voffB); PG8_STAGE(PG8_SB(0, 1), b2 + hstep, voffB); PG8_STAGE(PG8_SA(0, 0), a2, w0);
            PG8_WAIT_V(8); PG8_WAIT_L(0); PG8_BAR; PG8_MMA(1, 0, At, B0); PG8_MMA(1, 1, At, B1); PG8_BAR; PG8_SCHED;
            PG8_LDB(B0, 1, 0); PG8_LDB(B1, 1, 1); PG8_SCHED; PG8_LDA(At, 1, 0); PG8_STAGE(PG8_SA(0, 1), a2 + ah, w1);
            PG8_WAIT_V(8); PG8_WAIT_L(0); PG8_BAR; PG8_MMA(0, 0, At, B0); PG8_MMA(0, 1, At, B1); PG8_BAR; PG8_SCHED;
            PG8_LDA(At, 1, 1); PG8_STAGE(PG8_SB(1, 0), b3, voffB); PG8_STAGE(PG8_SB(1, 1), b3 + hstep, voffB); PG8_STAGE(PG8_SA(1, 0), a3, w0);
            PG8_WAIT_V(8); PG8_WAIT_L(0); PG8_BAR; PG8_MMA(1, 0, At, B0); PG8_MMA(1, 1, At, B1); PG8_BAR; PG8_SCHED;
        }
        }
        if (wr == 0) PG8_BAR;
        if constexpr (F8) asm volatile("s_nop 15\n\ts_nop 15" ::: "memory");
        E(acc, cur, wr, wc, fr, fq, 0);
        __builtin_amdgcn_sched_barrier(0); asm volatile("" ::: "memory");
        typename Host::Regs hr; H.issue(cur.ord, hr, acc);
        __builtin_amdgcn_sched_barrier(0); asm volatile("" ::: "memory");
        E(acc, cur, wr, wc, fr, fq, 1);
        __builtin_amdgcn_sched_barrier(0);
        H.finish(hr, acc);
        if (!has_next) break;
#pragma unroll
        for (int a = 0; a < 2; ++a)
#pragma unroll
            for (int b = 0; b < 2; ++b)
#pragma unroll
                for (int m = 0; m < 4; ++m)
#pragma unroll
                    for (int n = 0; n < 2; ++n) acc[a][b][m][n] = (f32x4){0.f, 0.f, 0.f, 0.f};
        cur = nxt; cA = nA; cB = nB; ++ui;
#pragma unroll
        for (int h = 0; h < 2; ++h)
#pragma unroll
            for (int i = 0; i < 2; ++i) vA[h][i] = nvA[h][i];
        if (wr == 1) PG8_BAR;
    }
    PG8_WAIT_V(0);
    PG8_BAR;
#undef PG8_VA1
#undef PG8_SA
#undef PG8_SB
#undef PG8_STAGE
#undef PG8_LDA
#undef PG8_LDB
#undef PG8_MMA
#undef PG8_WAIT_V
#undef PG8_WAIT_L
#undef PG8_BAR
#undef PG8_SCHED
}

struct EpiF32 {
    static constexpr bool PERM = false; static constexpr bool RESCALE = false;
    float* C; int ldc;
    __device__ __forceinline__ void operator()(const f32x4 (&acc)[2][2][4][2], const Unit& u, int wr, int wc, int fr, int fq, const int ai) const {
        const int row0 = u.pm * BM + wr * 64 + fr, col0 = u.pn * BM + wc * 32 + 4 * fq;

#pragma unroll
            for (int m = 0; m < 4; ++m) { float* rowp = C + (size_t)(row0 + ai * HALF + m * 16) * ldc + col0;
#pragma unroll
                for (int bj = 0; bj < 2; ++bj)
#pragma unroll
                    for (int n = 0; n < 2; ++n) *(f32x4*)(rowp + bj * HALF + n * 16) = acc[ai][bj][m][n]; }
    }
};
struct EpiBf16 {
    static constexpr bool PERM = true; static constexpr bool RESCALE = false;
    bf16* O; int ldc; float sc;
    __device__ __forceinline__ void operator()(const f32x4 (&acc)[2][2][4][2], const Unit& u, int wr, int wc, int fr, int fq, const int ai) const {
        const int row0 = u.pm * BM + wr * 64 + fr, col0 = u.pn * BM + wc * 32 + 8 * fq;

#pragma unroll
            for (int m = 0; m < 4; ++m) { bf16* rowp = O + (size_t)(row0 + ai * HALF + m * 16) * ldc + col0;
#pragma unroll
                for (int bj = 0; bj < 2; ++bj) { const f32x4 v0 = acc[ai][bj][m][0] * sc, v1 = acc[ai][bj][m][1] * sc;
                    u32x4 w; w.x = pk2(v0[0], v0[1]); w.y = pk2(v0[2], v0[3]); w.z = pk2(v1[0], v1[1]); w.w = pk2(v1[2], v1[3]);
                    __builtin_nontemporal_store(w, (u32x4*)(rowp + bj * HALF)); } }
    }
};
struct EpiRms {
    static constexpr bool PERM = true; static constexpr bool RESCALE = true;
    bf16* O; int ldc; const LAS float* stab;
    __device__ __forceinline__ void rescale(f32x4 (&acc)[2][2][4][2], const Unit& u, int g, int wr, int fr) const {
        const LAS float* tb = stab + (u.ord * 256 + wr * 64 + fr) * 4 + g;
#pragma unroll
        for (int ai = 0; ai < 2; ++ai)
#pragma unroll
            for (int m = 0; m < 4; ++m) { const LAS float* p = tb + (ai * HALF + m * 16) * 4; const float ratio = p[-1] * __builtin_amdgcn_rcpf(p[0]);
#pragma unroll
                for (int bj = 0; bj < 2; ++bj)
#pragma unroll
                    for (int n = 0; n < 2; ++n) acc[ai][bj][m][n] = acc[ai][bj][m][n] * ratio; }
    }
    __device__ __forceinline__ void operator()(const f32x4 (&acc)[2][2][4][2], const Unit& u, int wr, int wc, int fr, int fq, const int ai) const {
        const int row0 = u.pm * BM + wr * 64 + fr, col0 = u.pn * BM + wc * 32 + 8 * fq;
        const LAS float* tb = stab + (u.ord * 256 + wr * 64 + fr) * 4 + 3;

#pragma unroll
            for (int m = 0; m < 4; ++m) { const int row = row0 + ai * HALF + m * 16; const float s3 = tb[(ai * HALF + m * 16) * 4] * (1.0f / (Q8_YS * Q8_W)); bf16* rowp = (bf16*)((char*)O + (unsigned)((row * ldc + col0) * 2));
#pragma unroll
                for (int bj = 0; bj < 2; ++bj) { const f32x4 v0 = acc[ai][bj][m][0] * s3, v1 = acc[ai][bj][m][1] * s3;
                    u32x4 w; w.x = pk2(v0[0], v0[1]); w.y = pk2(v0[2], v0[3]); w.z = pk2(v1[0], v1[1]); w.w = pk2(v1[2], v1[3]);
                    __builtin_nontemporal_store(w, (u32x4*)(rowp + bj * HALF)); } }
    }
};
struct EpiQKV {
    static constexpr bool PERM = true; static constexpr bool RESCALE = false;
    unsigned char* O; const float* rope; float ds;
    __device__ __forceinline__ void operator()(const f32x4 (&acc)[2][2][4][2], const Unit& u, int wr, int wc, int fr, int fq, const int ai) const {
        const int row0 = u.pm * BM + wr * 64 + fr;
        const int col_t = u.pn * BM;
        const int s = (col_t % 3072) >> 10;
        const float sc = ((s == 0) ? QSCALE * Q8_Q : ((s == 1) ? Q8_K : Q8_V)) * ds;
        const int gq = col_t / 3072, lg = 2 * gq, dlm = (1 << lg) - 1, mat0 = gq * 24 + s * 8 + ((col_t & 1023) >> 7);
        const bool rot = (s < 2) && (fq == 0);
        {
#pragma unroll
            for (int m = 0; m < 4; ++m) {
                const int row = row0 + ai * HALF + m * 16;
                const int tt = row & (SEQ - 1), rowp = (row & ~(SEQ - 1)) + ((tt & (dlm)) << (12 - lg)) + (tt >> lg);
                f32x4 cs = (f32x4){1.f, 1.f, 1.f, 1.f}, sn = (f32x4){0.f, 0.f, 0.f, 0.f};
                if (rot) { const float* rp = rope + (size_t)row * 32 + 4 * wc; cs = *(const f32x4*)rp; sn = *(const f32x4*)(rp + 16); }
#pragma unroll
                for (int bj = 0; bj < 2; ++bj) {
                    f32x4 v0 = acc[ai][bj][m][0], v1 = acc[ai][bj][m][1];
                    if (rot) { const f32x4 a0 = v0 * cs - v1 * sn, a1 = v1 * cs + v0 * sn; v0 = a0; v1 = a1; }
                    u32x2 w; w.x = pk4_f8(v0[0], v0[1], v0[2], v0[3], sc); w.y = pk4_f8(v1[0], v1[1], v1[2], v1[3], sc);
                    *(u32x2*)(O + ((size_t)(mat0 + bj) * T + rowp) * 128 + wc * 32 + 8 * fq) = w;
                }
            }
        }
    }
};
struct EpiUp {
    static constexpr bool PERM = true; static constexpr bool RESCALE = false;
    unsigned char* HB; const LAS unsigned* btab;
    __device__ __forceinline__ void operator()(const f32x4 (&acc)[2][2][4][2], const Unit& u, int wr, int wc, int fr, int fq, const int ai) const {
        const int row0 = u.pm * BM + wr * 64 + fr, col0 = u.pn * HALF + wc * 32 + 8 * fq;
        const LAS unsigned* bp = btab + u.ord * 128 + (wc * 32 + 8 * fq) / 2;
        const u32x4 gw = *(const LAS u32x4*)bp, uw = *(const LAS u32x4*)(bp + 64);
        f32x2 bg[4], bu[4];
#pragma unroll
        for (int i = 0; i < 4; ++i) { bg[i] = (f32x2){bflo(gw[i]), bfhi(gw[i])}; bu[i] = (f32x2){bflo(uw[i]), bfhi(uw[i])}; }
        constexpr float DS = 1.0f / (Q8_X * Q8_W), KE = -1.702f * 1.4426950408889634f;

#pragma unroll
            for (int m = 0; m < 4; ++m) {
                f32x2 o[4];
#pragma unroll
                for (int i = 0; i < 4; ++i) { const int n = i >> 1, j = 2 * (i & 1);
                    f32x2 gt = (f32x2){acc[ai][0][m][n][j], acc[ai][0][m][n][j + 1]} * DS + bg[i];
                    f32x2 up = (f32x2){acc[ai][1][m][n][j], acc[ai][1][m][n][j + 1]} * DS + bu[i];
                    gt[0] = fminf(gt[0], 7.0f); gt[1] = fminf(gt[1], 7.0f);
                    up[0] = __builtin_amdgcn_fmed3f(up[0], -7.0f, 7.0f); up[1] = __builtin_amdgcn_fmed3f(up[1], -7.0f, 7.0f);
                    f32x2 e = gt * KE; e[0] = __builtin_amdgcn_exp2f(e[0]); e[1] = __builtin_amdgcn_exp2f(e[1]);
                    e = e + 1.0f; e[0] = __builtin_amdgcn_rcpf(e[0]); e[1] = __builtin_amdgcn_rcpf(e[1]);
                    o[i] = (up * Q8_H + Q8_H) * (gt * e); }
                u32x2 w;
                { int p0 = __builtin_amdgcn_cvt_pk_fp8_f32(o[0][0], o[0][1], 0, false); p0 = __builtin_amdgcn_cvt_pk_fp8_f32(o[1][0], o[1][1], p0, true);
                  int p1 = __builtin_amdgcn_cvt_pk_fp8_f32(o[2][0], o[2][1], 0, false); p1 = __builtin_amdgcn_cvt_pk_fp8_f32(o[3][0], o[3][1], p1, true); w.x = (unsigned)p0; w.y = (unsigned)p1; }
                *(u32x2*)(HB + (size_t)(row0 + ai * HALF + m * 16) * 1024 + col0) = w;
            }
    }
};
struct EpiDown {
    static constexpr bool PERM = true; static constexpr bool RESCALE = false;
    unsigned char* YS; const LAS unsigned* btab; const LAS int* slots;
    __device__ __forceinline__ void operator()(const f32x4 (&acc)[2][2][4][2], const Unit& u, int wr, int wc, int fr, int fq, const int ai) const {
        const int col0 = u.pn * BM + wc * 32 + 8 * fq;
        const LAS unsigned* bp = btab + u.ord * 128 + (wc * 32 + 8 * fq) / 2;
        f32x4 bv[2][2];
#pragma unroll
        for (int bj = 0; bj < 2; ++bj) { const u32x4 bw = *(const LAS u32x4*)(bp + bj * 64);
            bv[bj][0] = (f32x4){bflo(bw.x), bfhi(bw.x), bflo(bw.y), bfhi(bw.y)}; bv[bj][1] = (f32x4){bflo(bw.z), bfhi(bw.z), bflo(bw.w), bfhi(bw.w)}; }

#pragma unroll
            for (int m = 0; m < 4; ++m) {
                const int slot = slots[u.ord * 256 + ai * HALF + wr * 64 + m * 16 + fr];
                if (slot >= 0) {
                    unsigned char* rowp = YS + (size_t)slot * 1024 + col0;
#pragma unroll
                    for (int bj = 0; bj < 2; ++bj) { const f32x4 v0 = acc[ai][bj][m][0] * (1.0f / (Q8_H * Q8_W)) + bv[bj][0], v1 = acc[ai][bj][m][1] * (1.0f / (Q8_H * Q8_W)) + bv[bj][1];
                        u32x2 w; w.x = pk4_f8(v0[0], v0[1], v0[2], v0[3], Q8_Y); w.y = pk4_f8(v1[0], v1[1], v1[2], v1[3], Q8_Y);
                        *(u32x2*)(rowp + bj * HALF) = w; }
                }
            }
    }
};
}

struct TrItem { const float* W; const float* kscale; bf16* WT; int pitch, K, k0, n0, dstrow0, q8, hperm; };
__device__ __forceinline__ void tr_load(const TrItem& d, f32x4 (&ld)[16], int lane) {
    const int kq = lane >> 4, nq = lane & 15;
    const float* src = d.W + (size_t)(d.k0 + kq) * d.pitch + d.n0 + 4 * nq;
#pragma unroll
    for (int i = 0; i < 16; ++i) ld[i] = __builtin_nontemporal_load((const f32x4*)(src + (size_t)(4 * i) * d.pitch));
}
__device__ __forceinline__ void tr_finish(const TrItem& d, const f32x4 (&ld)[16], LAS float* scr, int lane) {
    const int kq = lane >> 4, nq = lane & 15;
#pragma unroll
    for (int i = 0; i < 16; ++i) { f32x4 v = ld[i]; if (d.kscale) v = v * d.kscale[d.k0 + 4 * i + kq]; LAS float* p = scr + (4 * i + kq) * 65 + 4 * nq; p[0] = v[0]; p[1] = v[1]; p[2] = v[2]; p[3] = v[3]; }
    asm volatile("s_waitcnt lgkmcnt(0)" ::: "memory");
    const int c = lane & 7;
    if (d.q8) {
#pragma unroll
        for (int j = 0; j < 8; ++j) { const int n = j * 8 + (lane >> 3); const LAS float* s = scr + (8 * c) * 65 + n;
            u32x2 o; o.x = pk4_f8(s[0 * 65], s[1 * 65], s[2 * 65], s[3 * 65], Q8_W); o.y = pk4_f8(s[4 * 65], s[5 * 65], s[6 * 65], s[7 * 65], Q8_W);
            int row = d.dstrow0 + n;
            if (d.hperm) { const int ng = d.n0 + n; if (((ng % 3072) >> 10) < 2) { const int dd = ng & 127;
                    const int pp = (dd < 32) ? (((dd & 15) >> 2) * 32 + (dd & 3) + 4 * (dd >> 4)) : (((dd - 32) / 24) * 32 + 8 + (dd - 32) % 24); row = (ng & ~127) + pp; } }
            *(u32x2*)((unsigned char*)d.WT + (size_t)row * d.K + d.k0 + 8 * c) = o; }
    } else {
#pragma unroll
    for (int j = 0; j < 8; ++j) { const int n = j * 8 + (lane >> 3); const LAS float* s = scr + (8 * c) * 65 + n;
        u32x4 o; o.x = pk2(s[0 * 65], s[1 * 65]); o.y = pk2(s[2 * 65], s[3 * 65]); o.z = pk2(s[4 * 65], s[5 * 65]); o.w = pk2(s[6 * 65], s[7 * 65]);
        *(u32x4*)(d.WT + (size_t)(d.dstrow0 + n) * d.K + d.k0 + 8 * c) = o; }
    }
    asm volatile("s_waitcnt lgkmcnt(0)" ::: "memory");
}
__constant__ float c_inv_freq[16] = {1.000000000e+00f, 4.403665960e-01f, 1.939227432e-01f, 8.539710194e-02f, 3.760603070e-02f, 1.656044088e-02f, 7.292664610e-03f, 3.211446106e-03f,
                                     1.414213562e-03f, 6.227724371e-04f, 2.742481884e-04f, 1.207697351e-04f, 5.318295734e-05f, 2.341999971e-05f, 1.031338525e-05f, 4.541670478e-06f};
__device__ __forceinline__ void sincos_reduced(float ang, float& sn, float& cs) {
    const double a = (double)ang;
    const double k = __builtin_rint(a * 0.15915494309189535);
    const double r = __builtin_fma(-k, 6.283185307179586, a) - k * 2.4492935982947064e-16;
    const float rf = (float)r;
    sn = __sinf(rf); cs = __cosf(rf);
}
struct Ptrs {
    const float *x; const int* pos; const float *attn_w_in, *attn_w_out, *ssm_w_in, *conv_w, *conv_b, *dt_bias, *a_log, *d_skip, *norm_w, *ssm_w_out;
    const float *w_router, *b_router, *w_up, *b_up, *w_dn, *b_dn, *ln_mix_g, *ln_mix_b, *ln_ffn_g, *ln_ffn_b;
};
constexpr int N1_UP = 32 * 16 * 32, N1_DN = 32 * 16 * 16, N1_ITEMS = N1_UP + N1_DN;
constexpr int HOSTED_ITEMS = 18432;
__device__ __forceinline__ TrItem moe1_item(const Ptrs& P, unsigned char* ws, int idx, int lay = 1) {
    TrItem d; d.kscale = nullptr; d.K = 1024; d.q8 = 1; d.hperm = 0;
    if (idx < N1_UP) { const int mat = 32 * lay + (idx >> 9), q = idx & 511, kb = q >> 5, nb = q & 31; const int n0 = nb * 64; const int bj = n0 >> 10, pn = (n0 & 1023) >> 7, cc = n0 & 127;
        d.W = P.w_up + (size_t)mat * 1024 * 2048; d.pitch = 2048; d.WT = (bf16*)(ws + WS_WUP + (size_t)mat * 2048 * 1024); d.k0 = kb * 64; d.n0 = n0; d.dstrow0 = pn * 256 + bj * 128 + cc; }
    else { const int r = idx - N1_UP, mat = 32 * lay + (r >> 8), q = r & 255, kb = q >> 4, nb = q & 15;
        d.W = P.w_dn + (size_t)mat * 1024 * 1024; d.pitch = 1024; d.WT = (bf16*)(ws + WS_WDN + (size_t)mat * 1024 * 1024); d.k0 = kb * 64; d.n0 = nb * 64; d.dstrow0 = nb * 64; }
    return d;
}
__device__ __forceinline__ void cvt_static(LAS unsigned char* lds, const Ptrs& P, unsigned char* ws, int first, int stride, int cnt) {
    const int lane = threadIdx.x & 63, w = __builtin_amdgcn_readfirstlane((int)threadIdx.x >> 6);
    LAS float* scr = (LAS float*)(lds + w * (65 * 64 * 4));
    if (cnt <= 0 || first >= N1_ITEMS) return;
    f32x4 la[16], lb[16]; TrItem da = moe1_item(P, ws, first), db = da; tr_load(da, la, lane);
    for (int i = 0;; i += 2) {
        const int ib = first + (i + 1) * stride; const bool hb = (i + 1 < cnt) && (ib < N1_ITEMS);
        if (hb) { db = moe1_item(P, ws, ib); tr_load(db, lb, lane); }
        tr_finish(da, la, scr, lane);
        if (!hb) break;
        const int ia = first + (i + 2) * stride; const bool ha = (i + 2 < cnt) && (ia < N1_ITEMS);
        if (ha) { da = moe1_item(P, ws, ia); tr_load(da, la, lane); }
        tr_finish(db, lb, scr, lane);
        if (!ha) break;
    }
}
__device__ __forceinline__ void cvt_plan(int NB, int G, int& rem_up, int& P_up, int& rem_dn, int& P_dn) {
    rem_up = (NB * 8) % G; const int n_iu = rem_up ? (G - rem_up) : 0; P_up = n_iu * 8 * CVT_Q_UP; if (P_up > N1_ITEMS) P_up = N1_ITEMS;
    rem_dn = (NB * 4) % G; const int n_id = rem_dn ? (G - rem_dn) : 0; P_dn = P_up + n_id * 8 * CVT_Q_DN; if (P_dn > N1_ITEMS) P_dn = N1_ITEMS;
}
__device__ __forceinline__ void p0_prologue(LAS unsigned char* lds, const Ptrs& P, unsigned char* ws, int G, int vcu) {
    const int tid = threadIdx.x, lane = tid & 63, w = __builtin_amdgcn_readfirstlane(tid >> 6);
    LAS float* scr = (LAS float*)(lds + w * (65 * 64 * 4));
    const int gw = vcu * 8 + w, NGW = G * 8;
    bf16* Wqkv = (bf16*)(ws + WS_WQKV); bf16* Wao = (bf16*)(ws + WS_WAO); bf16* Wsi = (bf16*)(ws + WS_WSI); bf16* Wso = (bf16*)(ws + WS_WSO);
    constexpr int I0 = 16 * 144, I1 = 16 * 16, I2 = 16 * 80, I3 = 32 * 16, I4 = 32 * 16 * 32, I5 = 32 * 16 * 16;
    constexpr int NITEMS = I0 + I1 + I2 + I3 + (N1_ITEMS - HOSTED_ITEMS);
    auto decode = [&](int it) -> TrItem {
        TrItem d; int r = it; d.kscale = nullptr; d.q8 = 0; d.hperm = 0;
        if (r < I0) { const int kb = r / 144, nb = r % 144; d.q8 = 1; d.hperm = 1; d.W = P.attn_w_in; d.pitch = NQKV; d.K = 1024; d.WT = Wqkv; d.k0 = kb * 64; d.n0 = nb * 64; d.dstrow0 = nb * 64; return d; } r -= I0;
        if (r < I1) { const int kb = r / 16, nb = r % 16; d.q8 = 1; d.W = P.attn_w_out; d.pitch = 1024; d.K = 1024; d.WT = Wao; d.k0 = kb * 64; d.n0 = nb * 64; d.dstrow0 = nb * 64; return d; } r -= I1;
        if (r < I2) { const int kb = r / 80, nb = r % 80; d.q8 = 1; d.W = P.ssm_w_in; d.pitch = SSM_PITCH; d.K = 1024; d.WT = Wsi; d.k0 = kb * 64; d.n0 = nb * 64; d.dstrow0 = nb * 64; return d; } r -= I2;
        if (r < I3) { const int kb = r / 16, nb = r % 16; d.q8 = 1; d.W = P.ssm_w_out; d.pitch = 1024; d.K = 2048; d.kscale = P.norm_w; d.WT = Wso; d.k0 = kb * 64; d.n0 = nb * 64; d.dstrow0 = nb * 64; return d; } r -= I3;
        return moe1_item(P, ws, r + HOSTED_ITEMS, 0);
    };
    if (gw < NITEMS) {
        f32x4 la[16], lb[16];
        TrItem da = decode(gw), db = da; tr_load(da, la, lane);
        for (int it = gw; it < NITEMS; it += 2 * NGW) {
            const bool hb = it + NGW < NITEMS;
            if (hb) { db = decode(it + NGW); tr_load(db, lb, lane); }
            tr_finish(da, la, scr, lane);
            if (!hb) break;
            const bool ha = it + 2 * NGW < NITEMS;
            if (ha) { da = decode(it + 2 * NGW); tr_load(da, la, lane); }
            tr_finish(db, lb, scr, lane);
            if (!ha) break;
        }
    }
    bf16* XBA = (bf16*)(ws + WS_XBA);
    for (int m0 = gw * 4; m0 < T; m0 += NGW * 4) {
        f32x4 v[4][4];
#pragma unroll
        for (int rr = 0; rr < 4; ++rr) { const f32x4* xr = (const f32x4*)(P.x + (size_t)(m0 + rr) * DM) + lane;
#pragma unroll
            for (int j = 0; j < 4; ++j) v[rr][j] = xr[64 * j]; }
#pragma unroll
        for (int rr = 0; rr < 4; ++rr) { u32x2* o = (u32x2*)(XBA + (size_t)(m0 + rr) * DM) + lane;
#pragma unroll
            for (int j = 0; j < 4; ++j) {
                *(unsigned*)(ws + WS_XQ0 + (size_t)(m0 + rr) * DM + 4 * lane + 256 * j) = pk4_f8(v[rr][j][0], v[rr][j][1], v[rr][j][2], v[rr][j][3], Q8_X); } }
    }
    float* rope = (float*)(ws + WS_ROPE);
    for (int idx = (vcu * 512 + tid); idx < T * 16; idx += G * 512) {
        const int tok = idx >> 4, i = idx & 15;
        const float ang = (float)P.pos[tok] * c_inv_freq[i];
        float sn, cs; sincos_reduced(ang, sn, cs);
        rope[(size_t)tok * 32 + i] = cs; rope[(size_t)tok * 32 + 16 + i] = sn;
    }
}

constexpr size_t PKOFF = (size_t)8 * T * 128;
__device__ __forceinline__ void attn_phase(LAS unsigned char* lds, const unsigned char* __restrict__ PROJ, unsigned char* __restrict__ OG, float* __restrict__ LSE, const int G, const int vcu) {
    const int tid = threadIdx.x, lane0 = tid & 63, w = __builtin_amdgcn_readfirstlane(tid >> 6);
    LAS unsigned char* Ks = lds; LAS unsigned char* Vt = lds + 2 * 128 * P256;
    constexpr int NU = BATCH * 3 * 8 * 32;
    const int per = (NU + G - 1) / G;
    const int u0 = vcu * per, u1 = (u0 + per < NU) ? (u0 + per) : NU;
    if (u0 >= u1) return;
    u32x4 kreg[2], vreg[2]; u32x4 qn[2];
    constexpr int PK8 = 144;
    unsigned long long mA = 0ull, mB = 0ull;
    { const int r16 = lane0 & 15, q4 = lane0 >> 4;
#pragma unroll
        for (int kt = 0; kt < 9; ++kt)
#pragma unroll
            for (int jj = 0; jj < 4; ++jj) { const int jr = 16 * kt + 4 * q4 + jj; const bool va = (jr >= r16) & (jr <= r16 + 128); const bool vb = va & (jr + 16 * w >= 128);
                mA |= (unsigned long long)va << (4 * kt + jj); mB |= (unsigned long long)vb << (4 * kt + jj); } }
    int pc = 0;
#define ATT_DECODE(U) const int bgh = (U) >> 5, sub = (U) & 31, h = bgh & 7, bg = bgh >> 3, g = bg % 3, b = bg / 3; \
        const int lg = (g == 0) ? 0 : ((g == 1) ? 2 : 4), dl = 1 << lg, nblk = 32 >> lg, r = sub >> (5 - lg), blk = sub & (nblk - 1); \
        const unsigned char* base_r = PROJ + ((size_t)(g * 24 + h) * T + (size_t)b * SEQ + (size_t)r * (SEQ >> lg)) * 128;
#define ATT_W2(X) pk2(X[0], X[1])
#define ATT_K16(V, LO, HI) do { _Pragma("unroll") for (int i_ = 0; i_ < 4; ++i_) { const f32x2 a_ = __builtin_amdgcn_cvt_pk_f32_fp8((int)(V)[i_], false), b_ = __builtin_amdgcn_cvt_pk_f32_fp8((int)(V)[i_], true); \
        if (i_ < 2) { (LO)[2 * i_] = ATT_W2(a_); (LO)[2 * i_ + 1] = ATT_W2(b_); } else { (HI)[2 * i_ - 4] = ATT_W2(a_); (HI)[2 * i_ - 3] = ATT_W2(b_); } } } while (0)
#define ATT_VT(V0, V1, C, JP, HALFSEL) do { _Pragma("unroll") for (int i_ = 0; i_ < 4; ++i_) { \
        const f32x2 a0_ = __builtin_amdgcn_cvt_pk_f32_fp8((int)(V0)[i_], false), b0_ = __builtin_amdgcn_cvt_pk_f32_fp8((int)(V0)[i_], true), a1_ = __builtin_amdgcn_cvt_pk_f32_fp8((int)(V1)[i_], false), b1_ = __builtin_amdgcn_cvt_pk_f32_fp8((int)(V1)[i_], true); \
        *(LAS unsigned*)(Vt + swz512(16 * (C) + 4 * i_ + 0, 256 * (HALFSEL) + 4 * (JP))) = pk2(a0_[0], a1_[0]); *(LAS unsigned*)(Vt + swz512(16 * (C) + 4 * i_ + 1, 256 * (HALFSEL) + 4 * (JP))) = pk2(a0_[1], a1_[1]); \
        *(LAS unsigned*)(Vt + swz512(16 * (C) + 4 * i_ + 2, 256 * (HALFSEL) + 4 * (JP))) = pk2(b0_[0], b1_[0]); *(LAS unsigned*)(Vt + swz512(16 * (C) + 4 * i_ + 3, 256 * (HALFSEL) + 4 * (JP))) = pk2(b0_[1], b1_[1]); } } while (0)
    {
        ATT_DECODE(u0)
        const int lane = lane0;
        const int jpv = 16 * (w >> 1) + (lane & 15), cv = 4 * (w & 1) + (lane >> 4);
        if (blk > 0) {
#pragma unroll
            for (int it = 0; it < 2; ++it) { const int item = it * 512 + tid, j = item >> 3, c = item & 7; const int ts = (blk - 1) * 128 + j;
                *(LAS u32x4*)(Ks + j * PK8 + 16 * c) = *(const u32x4*)(base_r + (size_t)ts * 128 + PKOFF + 16 * c); }
            { const int ts = (blk - 1) * 128 + 2 * jpv;
                const u32x4 v0 = *(const u32x4*)(base_r + (size_t)ts * 128 + 2 * PKOFF + 16 * cv), v1 = *(const u32x4*)(base_r + (size_t)(ts + 1) * 128 + 2 * PKOFF + 16 * cv);
                ATT_VT(v0, v1, cv, jpv, 0); }
        }
#pragma unroll
        for (int it = 0; it < 2; ++it) { const int item = it * 512 + tid, j = item >> 3, c = item & 7; kreg[it] = *(const u32x4*)(base_r + (size_t)(blk * 128 + j) * 128 + PKOFF + 16 * c); }
        { const int ts = blk * 128 + 2 * jpv;
            vreg[0] = *(const u32x4*)(base_r + (size_t)ts * 128 + 2 * PKOFF + 16 * cv); vreg[1] = *(const u32x4*)(base_r + (size_t)(ts + 1) * 128 + 2 * PKOFF + 16 * cv); }
        const int tq = blk * 128 + 16 * w + (lane & 15);
#pragma unroll
        for (int kk = 0; kk < 2; ++kk) qn[kk] = *(const u32x4*)(base_r + (size_t)tq * 128 + 64 * kk + 16 * (lane >> 4));
    }
    for (int u = u0; u < u1; ++u) {
        int lane = lane0; asm volatile("" : "+v"(lane));
        const int r16 = lane & 15, q4 = lane >> 4;
        ATT_DECODE(u)
        const int pp = pc; pc ^= 1;
        if (blk == 0) {
#pragma unroll
            for (int it = 0; it < 4; ++it) { const int item = it * 512 + tid, dd = item >> 4, c = item & 15; *(LAS u32x4*)(Vt + swz512(dd, 256 * pp + 16 * c)) = (u32x4){0u, 0u, 0u, 0u}; }
        }
#pragma unroll
        for (int it = 0; it < 2; ++it) { const int item = it * 512 + tid, j = item >> 3, c = item & 7; *(LAS u32x4*)(Ks + pc * (128 * P256) + j * PK8 + 16 * c) = kreg[it]; }
        { const int jpv = 16 * (w >> 1) + (lane & 15), cv = 4 * (w & 1) + (lane >> 4); ATT_VT(vreg[0], vreg[1], cv, jpv, pc); }
        const pg8::i32x8_t qf = __builtin_shufflevector(__builtin_bit_cast(pg8::i32x4_t, qn[0]), __builtin_bit_cast(pg8::i32x4_t, qn[1]), 0, 1, 2, 3, 4, 5, 6, 7);
        lds_barrier();
        if (u + 1 < u1) {
            const int un = u + 1;
            const int bgh2 = un >> 5, sub2 = un & 31, h2 = bgh2 & 7, bg2 = bgh2 >> 3, g2 = bg2 % 3, b2 = bg2 / 3;
            const int lg2 = (g2 == 0) ? 0 : ((g2 == 1) ? 2 : 4), nblk2 = 32 >> lg2, r2 = sub2 >> (5 - lg2), blk2 = sub2 & (nblk2 - 1);
            const unsigned char* base2 = PROJ + ((size_t)(g2 * 24 + h2) * T + (size_t)b2 * SEQ + (size_t)r2 * (SEQ >> lg2)) * 128;
#pragma unroll
            for (int it = 0; it < 2; ++it) { const int item = it * 512 + tid, j = item >> 3, c = item & 7; kreg[it] = *(const u32x4*)(base2 + (size_t)(blk2 * 128 + j) * 128 + PKOFF + 16 * c); }
            { const int jpv = 16 * (w >> 1) + (lane & 15), cv = 4 * (w & 1) + (lane >> 4); const int ts = blk2 * 128 + 2 * jpv;
                vreg[0] = *(const u32x4*)(base2 + (size_t)ts * 128 + 2 * PKOFF + 16 * cv); vreg[1] = *(const u32x4*)(base2 + (size_t)(ts + 1) * 128 + 2 * PKOFF + 16 * cv); }
            const int tq2 = blk2 * 128 + 16 * w + r16;
#pragma unroll
            for (int kk = 0; kk < 2; ++kk) qn[kk] = *(const u32x4*)(base2 + (size_t)tq2 * 128 + 64 * kk + 16 * q4);
        }
        f32x4 s[9];
#pragma unroll
        for (int kt = 0; kt < 9; ++kt) {
            const int ka = w + kt; const int hoff = ((ka < 8) ? pp : pc) * (128 * P256); const int row = 16 * (ka & 7) + r16;
            const u32x4 k0 = *(const LAS u32x4*)(Ks + hoff + row * PK8 + 16 * q4), k1 = *(const LAS u32x4*)(Ks + hoff + row * PK8 + 64 + 16 * q4);
            const pg8::i32x8_t kf = __builtin_shufflevector(__builtin_bit_cast(pg8::i32x4_t, k0), __builtin_bit_cast(pg8::i32x4_t, k1), 0, 1, 2, 3, 4, 5, 6, 7);
            s[kt] = __builtin_amdgcn_mfma_scale_f32_16x16x128_f8f6f4(kf, qf, (f32x4){0.f, 0.f, 0.f, 0.f}, 0, 0, 0, 0, 0, 0); }
        float mx = -INFINITY;
        const unsigned long long mk = (blk > 0) ? mA : mB; const unsigned mlo = (unsigned)mk, mhi = (unsigned)(mk >> 32);
#pragma unroll
        for (int kt = 0; kt < 9; ++kt)
#pragma unroll
            for (int jj = 0; jj < 4; ++jj) { const int bit = 4 * kt + jj; const bool valid = bit < 32 ? ((mlo >> bit) & 1u) : ((mhi >> (bit - 32)) & 1u);
                s[kt][jj] = valid ? s[kt][jj] : -INFINITY; mx = fmaxf(mx, s[kt][jj]); }
        mx = fmaxf(mx, __shfl_xor(mx, 16)); mx = fmaxf(mx, __shfl_xor(mx, 32));
        float ls = 0.f;
#pragma unroll
        for (int kt = 0; kt < 9; ++kt)
#pragma unroll
            for (int jj = 0; jj < 4; ++jj) { const float p = __builtin_amdgcn_exp2f((s[kt][jj] - mx) * (1.0f / (Q8_Q * Q8_K))); s[kt][jj] = p; ls += p; }
        ls += __shfl_xor(ls, 16); ls += __shfl_xor(ls, 32);
        f32x4 o[8];
#pragma unroll
        for (int dt = 0; dt < 8; ++dt) o[dt] = (f32x4){0.f, 0.f, 0.f, 0.f};
#pragma unroll
        for (int kp = 0; kp < 5; ++kp) {
            u32x4 pw; pw.x = pk2(s[2 * kp][0], s[2 * kp][1]); pw.y = pk2(s[2 * kp][2], s[2 * kp][3]);
            if (kp < 4) { pw.z = pk2(s[2 * kp + 1][0], s[2 * kp + 1][1]); pw.w = pk2(s[2 * kp + 1][2], s[2 * kp + 1][3]); } else { pw.z = 0u; pw.w = 0u; }
            const bf16x8 pf = as_bf16x8(pw);
            const int ka0 = w + 2 * kp, ka1 = ka0 + 1;
            const int c0 = 256 * ((ka0 < 8) ? pp : pc) + 2 * (16 * (ka0 & 7) + 4 * q4), c1 = 256 * ((ka1 < 8) ? pp : pc) + 2 * (16 * (ka1 & 7) + 4 * q4);
#pragma unroll
            for (int dt = 0; dt < 8; ++dt) { const int dd = 16 * dt + r16;
                const u32x2 lo = *(const LAS u32x2*)(Vt + swz512(dd, c0));
                u32x2 hi = (u32x2){0u, 0u}; if (kp < 4) hi = *(const LAS u32x2*)(Vt + swz512(dd, c1));
                const u32x4 av = (u32x4){lo.x, lo.y, hi.x, hi.y};
                o[dt] = mfma16(as_bf16x8(av), pf, o[dt]); }
        }
        const float inv = Q8_O / (ls * Q8_V);
        const int tq = blk * 128 + 16 * w + r16;
        const size_t tokq = (size_t)b * SEQ + (size_t)tq * dl + r;
        unsigned char* op = OG + ((size_t)g * T + tokq) * DM + h * 128 + 4 * q4;
#pragma unroll
        for (int dt = 0; dt < 8; ++dt) *(unsigned*)(op + 16 * dt) = pk4_f8(o[dt][0], o[dt][1], o[dt][2], o[dt][3], inv);
        if (q4 == 0) LSE[((size_t)g * T + tokq) * 8 + h] = (mx * (1.0f / (Q8_Q * Q8_K)) + __builtin_amdgcn_logf(ls)) * LN2F;
        lds_barrier();
    }
#undef ATT_DECODE
#undef ATT_W2
#undef ATT_K16
#undef ATT_VT
}

__device__ __forceinline__ void combine_phase(const unsigned char* __restrict__ OG, const float* __restrict__ LSE, unsigned char* __restrict__ OB, int G, int vcu) {
    const int tid = threadIdx.x, lane = tid & 63, w = tid >> 6;
    const int gw = vcu * 8 + w, NGW = G * 8;
    for (int row = gw; row < T; row += NGW) {
#pragma unroll
        for (int j = 0; j < 2; ++j) { const int col = 8 * lane + 512 * j, head = col >> 7;
            const float l0 = LSE[((size_t)0 * T + row) * 8 + head], l1 = LSE[((size_t)1 * T + row) * 8 + head], l2 = LSE[((size_t)2 * T + row) * 8 + head];
            const float m = fmaxf(l0, fmaxf(l1, l2)); float w0 = __expf(l0 - m), w1 = __expf(l1 - m), w2 = __expf(l2 - m); const float inv = 1.0f / (w0 + w1 + w2); w0 *= inv; w1 *= inv; w2 *= inv;
            const u32x2 a0 = *(const u32x2*)(OG + ((size_t)0 * T + row) * DM + col), a1 = *(const u32x2*)(OG + ((size_t)1 * T + row) * DM + col), a2 = *(const u32x2*)(OG + ((size_t)2 * T + row) * DM + col);
            float ov[8];
#pragma unroll
            for (int wd = 0; wd < 2; ++wd) {
                const f32x2 x0 = __builtin_amdgcn_cvt_pk_f32_fp8((int)a0[wd], false), x1 = __builtin_amdgcn_cvt_pk_f32_fp8((int)a1[wd], false), x2 = __builtin_amdgcn_cvt_pk_f32_fp8((int)a2[wd], false);
                const f32x2 y0 = __builtin_amdgcn_cvt_pk_f32_fp8((int)a0[wd], true), y1 = __builtin_amdgcn_cvt_pk_f32_fp8((int)a1[wd], true), y2 = __builtin_amdgcn_cvt_pk_f32_fp8((int)a2[wd], true);
                ov[4 * wd] = w0 * x0[0] + w1 * x1[0] + w2 * x2[0]; ov[4 * wd + 1] = w0 * x0[1] + w1 * x1[1] + w2 * x2[1]; ov[4 * wd + 2] = w0 * y0[0] + w1 * y1[0] + w2 * y2[0]; ov[4 * wd + 3] = w0 * y0[1] + w1 * y1[1] + w2 * y2[1]; }
            u32x2 o; o.x = pk4_f8(ov[0], ov[1], ov[2], ov[3], 1.0f); o.y = pk4_f8(ov[4], ov[5], ov[6], ov[7], 1.0f);
            *(u32x2*)(OB + (size_t)row * DM + col) = o; }
    }
}

template <int MIXSRC, int POST, bool WRITE_B, bool WRITE_F, bool XF32 = false>
__device__ __forceinline__ void ln_phase(LAS unsigned char* lds, const bf16* __restrict__ xres, const bf16* __restrict__ mixf, const unsigned char* __restrict__ YS, const float* __restrict__ gates_in,
                                         const float* __restrict__ gamma, const float* __restrict__ beta, float* outf, bf16* __restrict__ outb,
                                         const float* __restrict__ W32, int wpitch, const float* __restrict__ bias32, float* __restrict__ gates_out, int* __restrict__ lists, unsigned* counts, float* __restrict__ DTout,
                                         int G, int vcu, unsigned char* __restrict__ outq = nullptr) {
    const int tid = threadIdx.x, lane = tid & 63, w = __builtin_amdgcn_readfirstlane(tid >> 6);
    LAS float* wl = (LAS float*)lds;
    LAS int* sel_e = (LAS int*)(lds + LDS_SM); LAS int* sel_rk = sel_e + 512; LAS int* lcnt = sel_e + 1024; LAS int* gbase = sel_e + 1056;
    if (POST) {
#pragma unroll 8
        for (int it = 0; it < 64; ++it) { const int idx = it * 512 + tid, k = idx >> 5, e = idx & 31; const int slot = (((k >> 8) * 4 + (k & 3)) * 64) + ((k >> 2) & 63);
            wl[slot * 36 + e] = W32[(size_t)k * wpitch + e]; }
        if (POST == 1 && tid < 32) lcnt[tid] = 0;
        __syncthreads();
    }
    int ebr = 0;
#pragma unroll
    for (int bb = 0; bb < 5; ++bb) ebr |= ((lane >> bb) & 1) << (4 - bb);
    float mybias = 0.f; if (POST) mybias = bias32[ebr];
    for (int chunk = vcu; chunk < T / 128; chunk += G) {
        u32x2 nxr[4], nmx[4]; f32x4 nxf[XF32 ? 4 : 1]; unsigned nys[4][4]; f32x4 ngv = (f32x4){0.f, 0.f, 0.f, 0.f};
        { const size_t row = (size_t)chunk * 128 + w * 16;
            if (MIXSRC == 1) ngv = *(const f32x4*)(gates_in + row * 4);
#pragma unroll
            for (int j = 0; j < 4; ++j) { if (XF32) nxf[XF32 ? j : 0] = *(const f32x4*)((const float*)xres + row * DM + 4 * lane + 256 * j); else nxr[j] = *(const u32x2*)(xres + row * DM + 4 * lane + 256 * j);
                if (MIXSRC == 0) nmx[j] = *(const u32x2*)(mixf + row * DM + 4 * lane + 256 * j);
                else {
#pragma unroll
                    for (int k = 0; k < 4; ++k) nys[j][k] = __builtin_nontemporal_load((const unsigned*)(YS + (row * 4 + k) * DM + 4 * lane + 256 * j)); } } }
        for (int pass = 0; pass < 16; ++pass) {
            const int rl = w * 16 + pass; const size_t row = (size_t)chunk * 128 + rl;
            asm volatile("" ::: "memory");
            int lo = lane; asm volatile("" : "+v"(lo));
            float xv[16];
            {
                f32x4 v[4]; float s = 0.f;
                const f32x4 gv = ngv * (MIXSRC == 1 ? 1.0f / Q8_Y : 1.0f);
#pragma unroll
                for (int j = 0; j < 4; ++j) {
                    f32x4 mix;
                    if (MIXSRC == 0) mix = (f32x4){bflo(nmx[j].x), bfhi(nmx[j].x), bflo(nmx[j].y), bfhi(nmx[j].y)};
                    else { mix = (f32x4){0.f, 0.f, 0.f, 0.f};
#pragma unroll
                        for (int k = 0; k < 4; ++k) { const f32x2 ylo = __builtin_amdgcn_cvt_pk_f32_fp8((int)nys[j][k], false), yhi = __builtin_amdgcn_cvt_pk_f32_fp8((int)nys[j][k], true);
                            mix[0] += gv[k] * ylo[0]; mix[1] += gv[k] * ylo[1]; mix[2] += gv[k] * yhi[0]; mix[3] += gv[k] * yhi[1]; } }
                    const f32x4 xr = XF32 ? nxf[XF32 ? j : 0] : (f32x4){bflo(nxr[j].x), bfhi(nxr[j].x), bflo(nxr[j].y), bfhi(nxr[j].y)};
                    v[j] = xr * ALPHA + mix; s += (v[j][0] + v[j][1]) + (v[j][2] + v[j][3]);
                }
                if (pass < 15) { const size_t nrow = row + 1;
                    if (MIXSRC == 1) ngv = *(const f32x4*)(gates_in + nrow * 4);
#pragma unroll
                    for (int j = 0; j < 4; ++j) { if (XF32) nxf[XF32 ? j : 0] = *(const f32x4*)((const float*)xres + nrow * DM + 4 * lo + 256 * j); else nxr[j] = *(const u32x2*)(xres + nrow * DM + 4 * lo + 256 * j);
                        if (MIXSRC == 0) nmx[j] = *(const u32x2*)(mixf + nrow * DM + 4 * lo + 256 * j);
                        else {
#pragma unroll
                            for (int k = 0; k < 4; ++k) nys[j][k] = __builtin_nontemporal_load((const unsigned*)(YS + (nrow * 4 + k) * DM + 4 * lo + 256 * j)); } } }
                const float mean = wave_sum(s) * (1.0f / DM); float s2 = 0.f;
#pragma unroll
                for (int j = 0; j < 4; ++j) { v[j] = v[j] - mean; s2 += (v[j][0] * v[j][0] + v[j][1] * v[j][1]) + (v[j][2] * v[j][2] + v[j][3] * v[j][3]); }
                const float rstd = 1.0f / sqrtf(wave_sum(s2) * (1.0f / DM) + LN_EPS);
#pragma unroll
                for (int j = 0; j < 4; ++j) { const f32x4 gm = *(const f32x4*)(gamma + 4 * lo + 256 * j), bt = *(const f32x4*)(beta + 4 * lo + 256 * j);
                    const f32x4 y = v[j] * rstd * gm + bt;
                    if (WRITE_F) __builtin_nontemporal_store(y, (f32x4*)(outf + row * DM + 4 * lo + 256 * j));
                    if (WRITE_B) { u32x2 q; q.x = pk2(y[0], y[1]); q.y = pk2(y[2], y[3]); *(u32x2*)(outb + row * DM + 4 * lo + 256 * j) = q; }
                    if (POST) *(unsigned*)(outq + row * DM + 4 * lo + 256 * j) = pk4_f8(y[0], y[1], y[2], y[3], Q8_X);
                    xv[4 * j + 0] = y[0]; xv[4 * j + 1] = y[1]; xv[4 * j + 2] = y[2]; xv[4 * j + 3] = y[3]; }
            }
            if (POST) {
                f32x2 acc2[16];
#pragma unroll
                for (int e = 0; e < 16; ++e) acc2[e] = (f32x2){0.f, 0.f};
#pragma unroll
                for (int jj = 0; jj < 16; ++jj) { const LAS float* wrow = wl + (jj * 64 + lane) * 36;
                    if ((jj & 1) == 0) asm volatile("" ::: "memory");
                    const f32x2 xx = (f32x2){xv[jj], xv[jj]};
#pragma unroll
                    for (int e4 = 0; e4 < 8; ++e4) { const f32x4 wv = *(const LAS f32x4*)(wrow + 4 * e4);
                        acc2[2 * e4] = acc2[2 * e4] + xx * (f32x2){wv[0], wv[1]}; acc2[2 * e4 + 1] = acc2[2 * e4 + 1] + xx * (f32x2){wv[2], wv[3]}; } }
                float acc0[32];
#pragma unroll
                for (int e = 0; e < 32; ++e) acc0[e] = acc2[e >> 1][e & 1];
#pragma unroll
                for (int bb = 0; bb < 5; ++bb) { const int hh = 16 >> bb; const unsigned um = ((lane >> bb) & 1) ? 0xffffffffu : 0u;
#pragma unroll
                    for (int i = 0; i < hh; ++i) { const unsigned l0 = __float_as_uint(acc0[i]), h0 = __float_as_uint(acc0[i + hh]);
                        const float k0 = __uint_as_float((h0 & um) | (l0 & ~um)), s0 = __uint_as_float((l0 & um) | (h0 & ~um)); acc0[i] = k0 + __shfl_xor(s0, 1 << bb); } }
                const float lg0 = acc0[0] + __shfl_xor(acc0[0], 32) + mybias;
                if (POST == 1) {
                    const unsigned ub = __float_as_uint(lg0); const unsigned uo = (ub & 0x80000000u) ? ~ub : (ub | 0x80000000u);
                    unsigned key = (uo & ~31u) | (unsigned)(31 - ebr);
                    float top0 = 0.f, myv = 0.f, esum = 0.f; int ek = 0;
#pragma unroll
                    for (int k = 0; k < 4; ++k) { unsigned bk = key;
#pragma unroll
                        for (int off = 1; off < 32; off <<= 1) { const unsigned ok = (unsigned)__shfl_xor((int)bk, off); bk = ok > bk ? ok : bk; }
                        const int be = 31 - (int)(__builtin_amdgcn_readfirstlane(bk) & 31u);
                        int wl_ = 0;
#pragma unroll
                        for (int bb = 0; bb < 5; ++bb) wl_ |= ((be >> bb) & 1) << (4 - bb);
                        const float bv = __uint_as_float(__builtin_amdgcn_readlane(__float_as_uint(lg0), wl_));
                        if (k == 0) top0 = bv;
                        const float ex = __expf(bv - top0); esum += ex;
                        myv = (lane == k) ? ex : myv; ek = (lane == k) ? be : ek; key = (ebr == be) ? 0u : key; }
                    if (lane < 4) {
                        gates_out[row * 4 + lane] = myv / esum;
                        const int rk = __hip_atomic_fetch_add(lcnt + ek, 1, __ATOMIC_RELAXED, __HIP_MEMORY_SCOPE_WORKGROUP);
                        sel_e[rl * 4 + lane] = ek; sel_rk[rl * 4 + lane] = rk; }
                } else {
                    if (lane < 32) { const float xx = lg0; const float y = __expf(-fabsf(xx)); const float l1p = (y < 1e-3f) ? (y - 0.5f * y * y) : __logf(1.0f + y);
                        DTout[row * 32 + ebr] = fmaxf(xx, 0.f) + l1p; }
                }
            }
        }
        if (POST == 1) {
            __syncthreads();
            if (tid < 32) gbase[tid] = (int)__hip_atomic_fetch_add(counts + tid, (unsigned)lcnt[tid], __ATOMIC_RELAXED, __HIP_MEMORY_SCOPE_AGENT);
            __syncthreads();
            { const int e = sel_e[tid]; lists[(size_t)e * 32768 + gbase[e] + sel_rk[tid]] = (chunk * 128 + (tid >> 2)) * 4 + (tid & 3); }
            __syncthreads();
            if (tid < 32) lcnt[tid] = 0;
            __syncthreads();
        }
    }
}

__device__ __forceinline__ void conv_item(const bf16* __restrict__ ZX, const float* __restrict__ conv_w, const float* __restrict__ conv_b, int tok0, int ch, u32x4 (&q)[8]) {
    const int sl = tok0 & (SEQ - 1);
    u32x4 raw[11];
#pragma unroll
    for (int i = 0; i < 11; ++i) { if (sl - 3 + i >= 0) raw[i] = *(const u32x4*)(ZX + (size_t)(tok0 - 3 + i) * NZX + 2048 + ch); else raw[i] = (u32x4){0u, 0u, 0u, 0u}; }
    f32x2 cw[4][4], cb[4];
#pragma unroll
    for (int k = 0; k < 4; ++k)
#pragma unroll
        for (int p = 0; p < 4; ++p) cw[k][p] = *(const f32x2*)(conv_w + (size_t)k * 3072 + ch + 2 * p);
#pragma unroll
    for (int p = 0; p < 4; ++p) cb[p] = *(const f32x2*)(conv_b + ch + 2 * p);
    f32x2 xin[11][4];
#pragma unroll
    for (int i = 0; i < 11; ++i)
#pragma unroll
        for (int p = 0; p < 4; ++p) xin[i][p] = (f32x2){bflo(raw[i][p]), bfhi(raw[i][p])};
#pragma unroll
    for (int t = 0; t < 8; ++t)
#pragma unroll
        for (int p = 0; p < 4; ++p) { f32x2 a = cb[p];
#pragma unroll
            for (int k = 0; k < 4; ++k) a = a + cw[k][p] * xin[t + k][p];
            q[t][p] = pk2(silu_f(a[0]), silu_f(a[1])); }
}
__device__ __forceinline__ void convcb_phase(LAS unsigned char* lds, const bf16* __restrict__ ZX, const float* __restrict__ conv_w, const float* __restrict__ conv_b, bf16* __restrict__ XA, bf16* __restrict__ CBG, int G, int vcu) {
    const int tid = threadIdx.x, lane = tid & 63, w = __builtin_amdgcn_readfirstlane(tid >> 6), r16 = lane & 15, q4 = lane >> 4;
    LAS unsigned char *Cs = lds, *Bs = lds + 128 * P256;
    for (int u = vcu; u < BATCH * 32; u += G) {
        const int tokc = u * 128;
        for (int it = 0; it < 8; ++it) { const int item = it * 512 + tid, cg = item & 255, tb = item >> 8;
            u32x4 q[8]; conv_item(ZX, conv_w, conv_b, tokc + 8 * tb, 8 * cg, q);
#pragma unroll
            for (int t = 0; t < 8; ++t) *(u32x4*)(XA + (size_t)(tokc + 8 * tb + t) * 3072 + 8 * cg) = q[t]; }
        for (int g = 0; g < 4; ++g) {
            { const int cgl = tid & 31, tb = tid >> 5; const int ch = (cgl < 16) ? (2048 + g * 128 + 8 * cgl) : (2560 + g * 128 + 8 * (cgl - 16));
                u32x4 q[8]; conv_item(ZX, conv_w, conv_b, tokc + 8 * tb, ch, q);
                LAS unsigned char* dst = (cgl < 16) ? Bs : Cs;
#pragma unroll
                for (int t = 0; t < 8; ++t) { *(u32x4*)(XA + (size_t)(tokc + 8 * tb + t) * 3072 + ch) = q[t]; *(LAS u32x4*)(dst + swz256(8 * tb + t, 16 * (cgl & 15))) = q[t]; } }
            __syncthreads();
            bf16x8 cf[4];
#pragma unroll
            for (int kk = 0; kk < 4; ++kk) cf[kk] = *(const LAS bf16x8*)(Cs + swz256(16 * w + r16, 64 * kk + 16 * q4));
            bf16* outp = CBG + ((size_t)u * 4 + g) * 16384 + (size_t)(16 * w + r16) * 128 + 4 * q4;
#pragma unroll
            for (int st = 0; st < 8; ++st) { f32x4 m = (f32x4){0.f, 0.f, 0.f, 0.f};
#pragma unroll
                for (int kk = 0; kk < 4; ++kk) { const bf16x8 a = *(const LAS bf16x8*)(Bs + swz256(16 * st + r16, 64 * kk + 16 * q4)); m = mfma16(a, cf[kk], m); }
                u32x2 q; q.x = pk2(m[0], m[1]); q.y = pk2(m[2], m[3]); *(u32x2*)(outp + 16 * st) = q; }
            __syncthreads();
        }
    }
}
__device__ __forceinline__ void ssd_phase(LAS unsigned char* lds, const bf16* __restrict__ ZX, const bf16* __restrict__ XA, const bf16* __restrict__ CBG, const float* __restrict__ DT,
                                          const float* __restrict__ a_log, const float* __restrict__ d_skip, unsigned char* __restrict__ Y, float* SSQ, int G, int vcu) {
    const int tid = threadIdx.x, lane = tid & 63, w = __builtin_amdgcn_readfirstlane(tid >> 6), r16_0 = lane & 15, q4_0 = lane >> 4;
    constexpr int SZ_BT = 128 * P256, SZ_XT = 64 * P256, O_XT = 2 * SZ_BT, O_PR = O_XT + 2 * SZ_XT, O_FA = O_PR + 2 * SZ_XT;
    LAS float* fa = (LAS float*)(lds + O_FA);
    for (int u = vcu; u < BATCH * 32; u += G) {
        const int b = u >> 5, h = u & 31, g = h >> 3;
        const float Ah = -__expf(a_log[h]); const float Dh = d_skip[h];
        f32x4 st[4];
#pragma unroll
        for (int pt = 0; pt < 4; ++pt) st[pt] = (f32x4){0.f, 0.f, 0.f, 0.f};
        const int jp = 16 * (w & 3) + (lane & 15);
        const unsigned voff = (unsigned)jp * 12288u + (unsigned)(lane >> 4) * 16u;
        int chb[3];
#pragma unroll
        for (int it = 0; it < 3; ++it) { const int gq = 2 * it + (w >> 2); chb[it] = 2 * ((it == 0) ? (h * 64 + 32 * gq) : (2048 + g * 128 + 32 * (gq - 2))); }
        const char* xab = (const char*)XA + (size_t)b * SEQ * 6144;
        const bf16* cbb = CBG + ((size_t)(b * 32) * 4 + g) * 16384;
        u32x4 pre[3][2]; float dn0 = 0.f, dn1 = 0.f; u32x2 cbr[8]; u32x4 cfr[4];
        {
#pragma unroll
            for (int it = 0; it < 3; ++it) { const char* sb = xab + chb[it]; pre[it][0] = *(const u32x4*)(sb + voff); pre[it][1] = *(const u32x4*)(sb + voff + 6144); }
            if (w == 0) { dn0 = DT[((size_t)b * SEQ + 2 * lane) * 32 + h]; dn1 = DT[((size_t)b * SEQ + 2 * lane + 1) * 32 + h]; }
        }
        for (int c = 0; c <= 32; ++c) {
            const int r16 = r16_0, q4 = q4_0;
            const int sb_ = c & 1;
            LAS unsigned char* BTn = lds + sb_ * SZ_BT; LAS unsigned char* xTn = lds + O_XT + sb_ * SZ_XT; LAS unsigned char* prn = lds + O_PR + sb_ * SZ_XT; LAS float* fan = fa + sb_ * 512;
            if (c >= 1) {
                const int cc = c - 1, cb_ = cc & 1; const int tok0 = b * SEQ + cc * 128;
                LAS unsigned char* BTs = lds + cb_ * SZ_BT; LAS unsigned char* xTs = lds + O_XT + cb_ * SZ_XT; LAS unsigned char* prevs = lds + O_PR + cb_ * SZ_XT;
                LAS float* acum = fa + cb_ * 512; LAS float* dtv = acum + 128; LAS float* wdec = acum + 256;
                const int l = 16 * w + r16;
                u32x2 zz[4];
#pragma unroll
                for (int pt = 0; pt < 4; ++pt) zz[pt] = *(const u32x2*)(ZX + ((size_t)tok0 + l) * NZX + h * 64 + 16 * pt + 4 * q4);
                const float al = acum[l];
                bf16x8 pf[4];
#pragma unroll
                for (int kp = 0; kp < 4; ++kp) {
                    const f32x4 as0 = *(const LAS f32x4*)(acum + 32 * kp + 4 * q4), ds0 = *(const LAS f32x4*)(dtv + 32 * kp + 4 * q4), as1 = *(const LAS f32x4*)(acum + 32 * kp + 16 + 4 * q4), ds1 = *(const LAS f32x4*)(dtv + 32 * kp + 16 + 4 * q4);
                    const u32x2 c0 = cbr[2 * kp], c1 = cbr[2 * kp + 1];
                    const float m0[4] = {bflo(c0.x), bfhi(c0.x), bflo(c0.y), bfhi(c0.y)}, m1[4] = {bflo(c1.x), bfhi(c1.x), bflo(c1.y), bfhi(c1.y)};
                    float mm[8];
#pragma unroll
                    for (int jj = 0; jj < 4; ++jj) { const int s_0 = 32 * kp + 4 * q4 + jj, s_1 = s_0 + 16;
                        mm[jj] = (s_0 <= l) ? m0[jj] * __expf(fminf(al - as0[jj], 0.f)) * ds0[jj] : 0.f; mm[4 + jj] = (s_1 <= l) ? m1[jj] * __expf(fminf(al - as1[jj], 0.f)) * ds1[jj] : 0.f; }
                    u32x4 pw; pw.x = pk2(mm[0], mm[1]); pw.y = pk2(mm[2], mm[3]); pw.z = pk2(mm[4], mm[5]); pw.w = pk2(mm[6], mm[7]); pf[kp] = as_bf16x8(pw); }
                f32x4 y[4];
#pragma unroll
                for (int pt = 0; pt < 4; ++pt) { y[pt] = (f32x4){0.f, 0.f, 0.f, 0.f};
#pragma unroll
                    for (int kk = 0; kk < 4; ++kk) { const bf16x8 a = *(const LAS bf16x8*)(prevs + swz256(16 * pt + r16, 64 * kk + 16 * q4)); y[pt] = mfma16(a, as_bf16x8(cfr[kk]), y[pt]); } }
                const float el = __expf(al);
#pragma unroll
                for (int pt = 0; pt < 4; ++pt) y[pt] = y[pt] * el;
#pragma unroll
                for (int kp = 0; kp < 4; ++kp)
#pragma unroll
                    for (int pt = 0; pt < 4; ++pt) { const u32x2 lo = *(const LAS u32x2*)(xTs + swz256(16 * pt + r16, 64 * kp + 8 * q4)), hi = *(const LAS u32x2*)(xTs + swz256(16 * pt + r16, 64 * kp + 32 + 8 * q4));
                        const u32x4 av = (u32x4){lo.x, lo.y, hi.x, hi.y}; y[pt] = mfma16(as_bf16x8(av), pf[kp], y[pt]); }
                if (c < 32) { const bf16* cp = cbb + (size_t)c * 65536 + (size_t)(16 * w + r16) * 128 + 4 * q4;
#pragma unroll
                    for (int i = 0; i < 8; ++i) cbr[i] = *(const u32x2*)(cp + 16 * i);
                    const bf16* ccp = XA + ((size_t)b * SEQ + c * 128 + 16 * w + r16) * 3072 + 2560 + g * 128 + 8 * q4;
#pragma unroll
                    for (int kk = 0; kk < 4; ++kk) cfr[kk] = *(const u32x4*)(ccp + 32 * kk); }
                { const size_t tok = (size_t)tok0 + l; float ssq = 0.f;
#pragma unroll
                    for (int pt = 0; pt < 4; ++pt) { const int p0 = 16 * pt + 4 * q4;
                        float ov[4];
#pragma unroll
                        for (int jj = 0; jj < 4; ++jj) { const float xvv = bf2f(*(const LAS unsigned short*)(xTs + swz256(p0 + jj, 2 * l)));
                            const unsigned zw = (jj < 2) ? zz[pt].x : zz[pt].y; const float zf = (jj & 1) ? bfhi(zw) : bflo(zw);
                            ov[jj] = (y[pt][jj] + Dh * xvv) * silu_f(zf); }
                        ssq += (ov[0] * ov[0] + ov[1] * ov[1]) + (ov[2] * ov[2] + ov[3] * ov[3]);
                        *(unsigned*)(Y + tok * DI + h * 64 + p0) = pk4_f8(ov[0], ov[1], ov[2], ov[3], Q8_YS); }
                    ssq += __shfl_xor(ssq, 16); ssq += __shfl_xor(ssq, 32);
                    if (q4 == 0) SSQ[tok * 32 + h] = ssq; }
                { const float dec = __expf(acum[384]);
#pragma unroll
                    for (int pt = 0; pt < 4; ++pt) st[pt] = st[pt] * dec;
#pragma unroll
                    for (int kk = 0; kk < 4; ++kk) { const u32x4 a = *(const LAS u32x4*)(BTs + swz256(16 * w + r16, 64 * kk + 16 * q4));
                        const f32x4 w0 = *(const LAS f32x4*)(wdec + 32 * kk + 8 * q4), w1 = *(const LAS f32x4*)(wdec + 32 * kk + 8 * q4 + 4);
                        u32x4 aw; aw.x = pk2(bflo(a.x) * w0[0], bfhi(a.x) * w0[1]); aw.y = pk2(bflo(a.y) * w0[2], bfhi(a.y) * w0[3]); aw.z = pk2(bflo(a.z) * w1[0], bfhi(a.z) * w1[1]); aw.w = pk2(bflo(a.w) * w1[2], bfhi(a.w) * w1[3]);
#pragma unroll
                        for (int pt = 0; pt < 4; ++pt) { const bf16x8 bfr = *(const LAS bf16x8*)(xTs + swz256(16 * pt + r16, 64 * kk + 16 * q4)); st[pt] = mfma16(as_bf16x8(aw), bfr, st[pt]); } } }
            } else {
                const bf16* cp = cbb + (size_t)(16 * w + r16) * 128 + 4 * q4;
#pragma unroll
                for (int i = 0; i < 8; ++i) cbr[i] = *(const u32x2*)(cp + 16 * i);
                const bf16* ccp = XA + ((size_t)b * SEQ + 16 * w + r16) * 3072 + 2560 + g * 128 + 8 * q4;
#pragma unroll
                for (int kk = 0; kk < 4; ++kk) cfr[kk] = *(const u32x4*)(ccp + 32 * kk);
            }
            if (c < 32) {
#pragma unroll
                for (int pt = 0; pt < 4; ++pt) { u32x2 q; q.x = pk2(st[pt][0], st[pt][1]); q.y = pk2(st[pt][2], st[pt][3]); *(LAS u32x2*)(prn + swz256(16 * pt + r16, 2 * (16 * w + 4 * q4))) = q; }
                if (w == 0) { const int t0 = 2 * lane; const float d0 = dn0, d1 = dn1;
                    const float a0 = d0 * Ah, a1 = d1 * Ah; const float sm = a0 + a1; float incl = sm;
#pragma unroll
                    for (int off = 1; off < 64; off <<= 1) { const float v = __shfl_up(incl, off); if (lane >= off) incl += v; }
                    const float c0 = (incl - sm) + a0, c1 = incl; const float tot = __shfl(incl, 63);
                    fan[t0] = c0; fan[t0 + 1] = c1; fan[128 + t0] = d0; fan[128 + t0 + 1] = d1; fan[256 + t0] = d0 * __expf(tot - c0); fan[256 + t0 + 1] = d1 * __expf(tot - c1); if (lane == 63) fan[384] = tot; }
#pragma unroll
                for (int it = 0; it < 3; ++it) { const int cgi = 4 * (2 * it + (w >> 2)) + (lane >> 4);
                    LAS unsigned char* dst = (it == 0) ? xTn : BTn; const int r0 = (it == 0) ? (8 * cgi) : (8 * (cgi - 8));
#pragma unroll
                    for (int i = 0; i < 8; ++i) { const unsigned a0 = pre[it][0][i >> 1], a1 = pre[it][1][i >> 1];
                        const unsigned lo = (i & 1) ? (a0 >> 16) : (a0 & 0xffffu), hi = (i & 1) ? (a1 & 0xffff0000u) : (a1 << 16);
                        *(LAS unsigned*)(dst + swz256(r0 + i, 4 * jp)) = lo | hi; } }
                if (c < 31) {
#pragma unroll
                    for (int it = 0; it < 3; ++it) { const char* sb = xab + (size_t)(c + 1) * (128 * 6144) + chb[it]; pre[it][0] = *(const u32x4*)(sb + voff); pre[it][1] = *(const u32x4*)(sb + voff + 6144); }
                    if (w == 0) { const size_t t1 = (size_t)b * SEQ + (c + 1) * 128; dn0 = DT[(t1 + 2 * lane) * 32 + h]; dn1 = DT[(t1 + 2 * lane + 1) * 32 + h]; }
                }
            }
            lds_barrier();
        }
    }
}
__device__ __forceinline__ void rmsnorm_phase(bf16* Y, int G, int vcu) {
    const int tid = threadIdx.x, lane = tid & 63, w = tid >> 6;
    const int gw = vcu * 8 + w, NGW = G * 8;
    for (int row = gw; row < T; row += NGW) {
        u32x4* rp = (u32x4*)(Y + (size_t)row * DI) + lane;
#pragma unroll
        for (int j = 0; j < 4; ++j) { const u32x4 a = rp[64 * j]; float f[8]; float ss = 0.f;
#pragma unroll
            for (int i = 0; i < 4; ++i) { f[2 * i] = bflo(a[i]); f[2 * i + 1] = bfhi(a[i]); ss += f[2 * i] * f[2 * i] + f[2 * i + 1] * f[2 * i + 1]; }
            const float sc = 1.0f / sqrtf(wave_sum(ss) * (1.0f / 512.0f) + RMS_EPS);
            u32x4 o;
#pragma unroll
            for (int i = 0; i < 4; ++i) o[i] = pk2(f[2 * i] * sc, f[2 * i + 1] * sc);
            rp[64 * j] = o; }
    }
}

__device__ __forceinline__ int moe_tables(LAS unsigned char* lds, const unsigned* counts) {
    const int tid = threadIdx.x;
    LAS int* tab = (LAS int*)(lds + LDS_TAB);
    if (tid < 32) tab[64 + tid] = (int)__hip_atomic_load(counts + tid, __ATOMIC_RELAXED, __HIP_MEMORY_SCOPE_AGENT);
    __syncthreads();
    if (tid == 0) { int pre = 0; for (int e = 0; e < 32; ++e) { tab[e] = pre; pre += (tab[64 + e] + 255) >> 8; } tab[32] = pre; }
    __syncthreads();
    const int NB = tab[32];
    for (int rb = tid; rb < NB; rb += 512) { int e = 0; while (e < 31 && tab[e + 1] <= rb) ++e; tab[128 + rb] = e; }
    __syncthreads();
    return NB;
}

struct Args { const void* in[22]; float* out; unsigned char* ws; int ph_lo, ph_hi; };
__global__ void __launch_bounds__(512, 2) fwd_kernel(Args args) {
    extern __shared__ __attribute__((aligned(16))) unsigned char lds_raw[];
    LAS unsigned char* lds = (LAS unsigned char*)lds_raw;
    const int tid = threadIdx.x;
    const int G = gridDim.x; const int bx = blockIdx.x; const int vcu = (G % 8 == 0) ? (bx % 8) * (G / 8) + bx / 8 : bx;
    unsigned char* ws = args.ws;
    unsigned* ctl = (unsigned*)(ws + WS_CTL);
    Ptrs P;
    P.x = (const float*)args.in[0]; P.pos = (const int*)args.in[1]; P.attn_w_in = (const float*)args.in[2]; P.attn_w_out = (const float*)args.in[3]; P.ssm_w_in = (const float*)args.in[4];
    P.conv_w = (const float*)args.in[5]; P.conv_b = (const float*)args.in[6]; P.dt_bias = (const float*)args.in[7]; P.a_log = (const float*)args.in[8]; P.d_skip = (const float*)args.in[9];
    P.norm_w = (const float*)args.in[10]; P.ssm_w_out = (const float*)args.in[11]; P.w_router = (const float*)args.in[12]; P.b_router = (const float*)args.in[13]; P.w_up = (const float*)args.in[14];
    P.b_up = (const float*)args.in[15]; P.w_dn = (const float*)args.in[16]; P.b_dn = (const float*)args.in[17]; P.ln_mix_g = (const float*)args.in[18]; P.ln_mix_b = (const float*)args.in[19];
    P.ln_ffn_g = (const float*)args.in[20]; P.ln_ffn_b = (const float*)args.in[21];
    volatile LAS unsigned* misc = (volatile LAS unsigned*)(lds + LDS_MISC);
    if (tid < 64) misc[tid] = 0u;
    __syncthreads();
    XcdBarrier bar; bar.bar = ctl + CW_BAR; bar.x = 0; bar.st = misc;
    if (!MK_PER_PHASE) bar = xcd_barrier_post(ctl + CW_BAR, misc);
    const int lo = args.ph_lo, hi = args.ph_hi;
#ifndef PH_MASK
#define PH_MASK 0x1FFFF
#endif
#define IN(k) ((((PH_MASK) >> (k)) & 1) && lo <= (k) && (k) < hi)
#define SEAM(k) do { if (IN(k) && IN((k) + 1)) xcd_barrier(bar); } while (0)

    bf16* Wqkv = (bf16*)(ws + WS_WQKV); bf16* Wao = (bf16*)(ws + WS_WAO); bf16* Wsi = (bf16*)(ws + WS_WSI); bf16* Wso = (bf16*)(ws + WS_WSO);
    bf16* XBA = (bf16*)(ws + WS_XBA); bf16* XBB = (bf16*)(ws + WS_XBB); bf16* MIXB = (bf16*)(ws + WS_X1);
    unsigned char* PROJ = ws + WS_BIG; bf16* ZX = (bf16*)(ws + WS_BIG); bf16* XA = (bf16*)(ws + WS_XA); bf16* CBG = (bf16*)(ws + WS_CBG); unsigned char* HB8 = ws + WS_HB; unsigned char* XQ = ws + WS_XQ; unsigned char* YS = ws + WS_YS;
    unsigned char* OG = ws + WS_OG; unsigned char* YB = ws + WS_OG;
    float* rope = (float*)(ws + WS_ROPE); float* gates = (float*)(ws + WS_GATES); float* DT = (float*)(ws + WS_DT); int* lists = (int*)(ws + WS_LIST); float* LSE = (float*)(ws + WS_LSE); float* SSQ = (float*)(ws + WS_LSE);

    if (IN(0)) { p0_prologue(lds, P, ws, G, vcu); }
    SEAM(0);


#define MOE_BLOCK(LAYER, PB) do { \
    unsigned* counts = ctl + CW_CNT + 64 * (LAYER); \
    if (IN((PB) + 0)) { \
        if ((LAYER) == 0) ln_phase<0, 1, true, false, true>(lds, (const bf16*)P.x, MIXB, nullptr, nullptr, P.ln_mix_g, P.ln_mix_b, nullptr, XBB, P.w_router, NE, P.b_router, gates, lists, counts, nullptr, G, vcu, XQ);   \
        else ln_phase<0, 1, true, false>(lds, XBA, MIXB, nullptr, nullptr, P.ln_mix_g + (LAYER) * DM, P.ln_mix_b + (LAYER) * DM, nullptr, XBB, \
                             P.w_router + (size_t)(LAYER) * DM * NE, NE, P.b_router + (LAYER) * NE, gates, lists, counts, nullptr, G, vcu, XQ); } \
    SEAM((PB) + 0); \
    if (IN((PB) + 1)) { \
        const int NB = moe_tables(lds, counts); \
        LAS int* tab = (LAS int*)(lds + LDS_TAB); LAS unsigned short* toks = (LAS unsigned short*)(lds + LDS_AUX); \
        const int NU = NB * 8; \
        const int nun = (vcu < NU) ? ((NU - vcu + G - 1) / G) : 0; \
        for (int idx = tid; idx < nun * 256 && idx < 17 * 256; idx += 512) { const int i = idx >> 8, row = idx & 255; const int L = i * G + vcu; const int rb = L >> 3; const int e = tab[128 + rb]; \
            const int r0 = (rb - tab[e]) * 256, cnt = tab[64 + e]; int si = r0 + row; si = si < cnt ? si : cnt - 1; toks[idx] = (unsigned short)(lists[(size_t)e * 32768 + si] >> 2); } \
        LAS unsigned* btab = (LAS unsigned*)(lds + LDS_SLOT); \
        for (int idx = tid; idx < nun * 128 && idx < 17 * 128; idx += 512) { const int i = idx >> 7, cp = idx & 127; const int L = i * G + vcu; const int rb = L >> 3, pn = L & 7; const int e = tab[128 + rb]; \
            const float* bsrc = P.b_up + ((size_t)(LAYER) * 32 + e) * 2048 + ((cp < 64) ? (pn * 128 + 2 * cp) : (1024 + pn * 128 + 2 * (cp - 64))); btab[idx] = pk2(bsrc[0], bsrc[1]); } \
        __syncthreads(); \
        pg8::MoeOrder<true> S; S.A = (const char*)XQ; S.Bt = (const char*)(ws + WS_WUP + (size_t)(LAYER) * 32 * 2048 * 1024); S.K = DM / 2;   S.N = 2048; S.nN = 8; S.G = G; S.c = vcu; S.NU = NU; S.tab = tab; S.toks = toks; \
        pg8::EpiUp E{HB8, btab}; \
        if ((LAYER) == 0) { pg8::HostCvt H; H.w_up = P.w_up + (size_t)32 * 1024 * 2048; H.w_dn = P.w_dn + (size_t)32 * 1024 * 1024; H.wt_up = ws + WS_WUP + (size_t)32 * 2048 * 1024; H.wt_dn = ws + WS_WDN + (size_t)32 * 1024 * 1024; \
            H.base = 0; H.limit = 49152; H.G = G; H.c = vcu;   \
            pg8::gemm_phase<true>(lds, DM / 2, S, E, H); } \
        else { pg8::HostNone H; pg8::gemm_phase<true>(lds, DM / 2, S, E, H); } } \
    SEAM((PB) + 1); \
    if (IN((PB) + 2)) { \
        const int NB = moe_tables(lds, counts); \
        LAS int* tab = (LAS int*)(lds + LDS_TAB); LAS int* slots = (LAS int*)(lds + LDS_SLOT); LAS unsigned* dbtab = (LAS unsigned*)(lds + LDS_AUX); \
        { const int NU = NB * 4; const int nun = (vcu < NU) ? ((NU - vcu + G - 1) / G) : 0; \
          for (int idx = tid; idx < nun * 256 && idx < 9 * 256; idx += 512) { const int i = idx >> 8, row = idx & 255; const int L = i * G + vcu; const int rb = L >> 2; const int e = tab[128 + rb]; \
              const int si = (rb - tab[e]) * 256 + row; slots[idx] = (si < tab[64 + e]) ? lists[(size_t)e * 32768 + si] : -1; } \
          for (int idx = tid; idx < nun * 128 && idx < 9 * 128; idx += 512) { const int i = idx >> 7, cp = idx & 127; const int L = i * G + vcu; const int rb = L >> 2, pn = L & 3; const int e = tab[128 + rb]; \
              const float* bsrc = P.b_dn + ((size_t)(LAYER) * 32 + e) * 1024 + pn * 256 + 2 * cp; dbtab[idx] = pk2(bsrc[0], bsrc[1]); } \
          __syncthreads(); } \
        pg8::MoeOrder<false> S; S.A = (const char*)HB8; S.Bt = (const char*)(ws + WS_WDN + (size_t)(LAYER) * 32 * 1024 * 1024); S.K = DM / 2; S.N = 1024; S.nN = 4; S.G = G; S.c = vcu; S.NU = NB * 4; S.tab = tab; S.toks = nullptr; \
        pg8::EpiDown E{YS, dbtab, slots}; \
        if ((LAYER) == 0) { pg8::HostCvt H; H.w_up = P.w_up + (size_t)32 * 1024 * 2048; H.w_dn = P.w_dn + (size_t)32 * 1024 * 1024; H.wt_up = ws + WS_WUP + (size_t)32 * 2048 * 1024; H.wt_dn = ws + WS_WDN + (size_t)32 * 1024 * 1024; \
            H.base = NB * 64; H.limit = 49152; H.G = G; H.c = vcu;   \
            pg8::gemm_phase<true>(lds, DM / 2, S, E, H); } \
        else { pg8::HostNone H; pg8::gemm_phase<true>(lds, DM / 2, S, E, H); } } \
    SEAM((PB) + 2); \
    if (IN((PB) + 3)) { \
        if ((LAYER) == 0) ln_phase<1, 2, true, false>(lds, XBB, nullptr, YS, gates, P.ln_ffn_g, P.ln_ffn_b, nullptr, XBA, P.ssm_w_in + NZX, SSM_PITCH, P.dt_bias, nullptr, nullptr, nullptr, DT, G, vcu, ws + WS_XQ0); \
        else ln_phase<1, 0, false, true>(lds, XBB, nullptr, YS, gates, P.ln_ffn_g + DM, P.ln_ffn_b + DM, args.out, nullptr, nullptr, 0, nullptr, nullptr, nullptr, nullptr, nullptr, G, vcu); } \
    } while (0)

    if (IN(1)) { pg8::DenseOrder S; S.init(ws + WS_XQ0, Wqkv, T, NQKV, DM / 2, G, bx); pg8::EpiQKV E{PROJ, rope, 1.0f / (Q8_X * Q8_W)};
        pg8::HostCvt H; H.w_up = P.w_up; H.w_dn = P.w_dn; H.wt_up = ws + WS_WUP; H.wt_dn = ws + WS_WDN; H.base = 0; H.limit = 2 * HOSTED_ITEMS; H.G = G; H.c = bx;
        pg8::gemm_phase<true>(lds, DM / 2, S, E, H); }
    SEAM(1);
    if (IN(2)) attn_phase(lds, PROJ, OG, LSE, G, vcu);
    SEAM(2);
    if (IN(3)) combine_phase(OG, LSE, ws + WS_OB, G, vcu);
    SEAM(3);
    if (IN(4)) { pg8::DenseOrder S; S.init(ws + WS_OB, Wao, T, DM, DM / 2, G, bx); pg8::EpiBf16 E{MIXB, DM, 1.0f / (Q8_O * Q8_W)}; pg8::HostNone H; pg8::gemm_phase<true>(lds, DM / 2, S, E, H); }
    SEAM(4);
    MOE_BLOCK(0, 5);
    SEAM(8);
    if (IN(9)) { pg8::DenseOrder S; S.init(ws + WS_XQ0, Wsi, T, NZX, DM / 2, G, bx); pg8::EpiBf16 E{ZX, NZX, 1.0f / (Q8_X * Q8_W)}; pg8::HostNone H; pg8::gemm_phase<true>(lds, DM / 2, S, E, H); }
    SEAM(9);
    if (IN(10)) {
        convcb_phase(lds, ZX, P.conv_w, P.conv_b, XA, CBG, G, vcu); }
    SEAM(10);
    if (IN(11)) ssd_phase(lds, ZX, XA, CBG, DT, P.a_log, P.d_skip, YB, SSQ, G, vcu);
    SEAM(11);
    if (IN(12)) { pg8::DenseOrder S; S.init(YB, Wso, T, DM, DI / 2, G, bx);
        LAS float* stab = (LAS float*)(lds + LDS_AUX);
        for (int i = 0; i < 4; ++i) { pg8::Unit uu; if (!S.next(i, uu)) break;
            for (int idx = tid; idx < 1024; idx += 512) { const int rl = idx >> 2, g = idx & 3; const float* sp = SSQ + (size_t)(uu.pm * 256 + rl) * 32 + g * 8;
                const f32x4 a = *(const f32x4*)sp, b4 = *(const f32x4*)(sp + 4); const float sum = ((a[0] + a[1]) + (a[2] + a[3])) + ((b4[0] + b4[1]) + (b4[2] + b4[3]));
                stab[(i * 256 + rl) * 4 + g] = __builtin_amdgcn_rsqf(sum * (1.0f / 512.0f) + RMS_EPS); } }
        __syncthreads();
        pg8::EpiRms E{MIXB, DM, stab}; pg8::HostNone H; pg8::gemm_phase<true>(lds, DI / 2, S, E, H); }
    SEAM(12);
    MOE_BLOCK(1, 13);
#undef IN
#undef SEAM
#undef MOE_BLOCK
}

constexpr int NPHASE = 17;
extern "C" void kernel_launch(void* const* d_in, const int* in_sizes, int n_in, void* d_out, int out_size, void* d_ws, size_t ws_size, hipStream_t stream) {
    static int grid = 0;
    if (grid == 0) {
        if (n_in != 22 || in_sizes[0] != T * DM || out_size != T * DM || ws_size < WS_END) { fprintf(stderr, "kernel_launch: unexpected shapes / workspace (n_in %d, in0 %d, out %d, ws %zu, need %zu)\n", n_in, n_in > 0 ? in_sizes[0] : -1, out_size, ws_size, (size_t)WS_END); grid = -1; return; }
        int dev = 0, cus = 0;
        if (hipGetDevice(&dev) != hipSuccess || hipDeviceGetAttribute(&cus, hipDeviceAttributeMultiprocessorCount, dev) != hipSuccess) { fprintf(stderr, "kernel_launch: device query failed\n"); grid = -1; return; }
        if (hipFuncSetAttribute((const void*)fwd_kernel, hipFuncAttributeMaxDynamicSharedMemorySize, LDS_BYTES) != hipSuccess) { fprintf(stderr, "kernel_launch: hipFuncSetAttribute failed\n"); grid = -1; return; }
        int per_cu = 0;
        if (hipOccupancyMaxActiveBlocksPerMultiprocessor(&per_cu, (const void*)fwd_kernel, 512, LDS_BYTES) != hipSuccess || per_cu < 1) fprintf(stderr, "kernel_launch: occupancy query reports %d\n", per_cu);
        (void)hipGetLastError();
        grid = cus;
        if (grid < 256) { fprintf(stderr, "kernel_launch: built for >= 256 CUs, got %d\n", grid); }
        if (grid > 256) grid = 256;
    }
    if (grid < 0) return;
    if (hipMemsetAsync((char*)d_ws + WS_CTL, 0, CTL_ZERO_BYTES, stream) != hipSuccess) { fprintf(stderr, "kernel_launch: memset failed\n"); return; }
    Args a{};
    for (int i = 0; i < 22; ++i) a.in[i] = d_in[i];
    a.out = (float*)d_out; a.ws = (unsigned char*)d_ws;
#if MK_PER_PHASE
    for (int p = 0; p < NPHASE; ++p) { a.ph_lo = p; a.ph_hi = p + 1; hipLaunchKernelGGL(fwd_kernel, dim3(grid), dim3(512), LDS_BYTES, stream, a); }
#else
    a.ph_lo = 0; a.ph_hi = NPHASE;
    hipLaunchKernelGGL(fwd_kernel, dim3(grid), dim3(512), LDS_BYTES, stream, a);
#endif
    const hipError_t le = hipPeekAtLastError();
    if (le != hipSuccess) fprintf(stderr, "kernel_launch: launch failed: %s\n", hipGetErrorName(le));
}
```

```cpp
#include <hip/hip_runtime.h>
#include <cstdio>
#include <cstdint>

#ifndef MK_PER_PHASE
#define MK_PER_PHASE 0
#endif

#define GAS __attribute__((address_space(1)))
#define LAS __attribute__((address_space(3)))
typedef unsigned short bf16;
typedef short bf16x8 __attribute__((ext_vector_type(8)));
typedef float f32x4 __attribute__((ext_vector_type(4)));
typedef float f32x2 __attribute__((ext_vector_type(2)));
typedef unsigned u32x4 __attribute__((ext_vector_type(4)));
typedef unsigned u32x2 __attribute__((ext_vector_type(2)));

constexpr int BATCH = 8, SEQ = 4096, DM = 1024, T = BATCH * SEQ;
constexpr int NQKV = 9216;
constexpr int NZX = 5120, SSM_PITCH = 5152, DI = 2048;
constexpr int NE = 32;
constexpr float LN_EPS = 1e-5f, RMS_EPS = 1e-5f, ALPHA = 1.41421356237309505f;
constexpr float QSCALE = 0.12751743082459868f;
constexpr float LN2F = 0.6931471805599453f;

constexpr size_t MiB = 1u << 20;
constexpr size_t WS_CTL = 0, CTL_ZERO_BYTES = 128 * 1024;
constexpr size_t WS_ROPE = 1 * MiB;
constexpr size_t WS_GATES = 5 * MiB;
constexpr size_t WS_DT = 6 * MiB;
constexpr size_t WS_LIST = 10 * MiB;
constexpr size_t WS_LSE = 14 * MiB;
constexpr size_t WS_WQKV = 18 * MiB;
constexpr size_t WS_WAO = 36 * MiB;
constexpr size_t WS_WSI = 38 * MiB;
constexpr size_t WS_WSO = 48 * MiB;
constexpr size_t WS_WUP = 52 * MiB;
constexpr size_t WS_XQ = 180 * MiB;
constexpr size_t WS_XQ0 = 212 * MiB;
constexpr size_t WS_WDN = 308 * MiB;
constexpr size_t WS_XBA = 436 * MiB;
constexpr size_t WS_XBB = 500 * MiB;
constexpr size_t WS_X1 = 564 * MiB;
constexpr size_t WS_BIG = 692 * MiB;
constexpr size_t WS_XA = 1012 * MiB;
constexpr size_t WS_CBG = 1204 * MiB;
constexpr size_t WS_HB = WS_BIG;
constexpr size_t WS_YS = 964 * MiB;
constexpr size_t WS_OG = 1268 * MiB;
constexpr size_t WS_OB = 1460 * MiB;
constexpr size_t WS_END = 1524 * MiB;
constexpr int CW_BAR = 4096;
constexpr int CW_CNT = 16384;
constexpr int CW_CVT = 20000;
#ifndef CVT_Q_UP
#define CVT_Q_UP 5
#endif
#ifndef CVT_Q_DN
#define CVT_Q_DN 5
#endif

constexpr int LDS_AUX = 131072;
constexpr int LDS_TAB = 131072 + 17 * 512;
constexpr int LDS_SLOT = LDS_TAB + 2688;
constexpr int LDS_SM = 147456;
constexpr int LDS_MISC = 155648;
constexpr int LDS_BYTES = 156672;

__device__ __forceinline__ float bf2f(unsigned short b) { return __uint_as_float(((unsigned)b) << 16); }
__device__ __forceinline__ float bflo(unsigned w) { return __uint_as_float(w << 16); }
__device__ __forceinline__ float bfhi(unsigned w) { return __uint_as_float(w & 0xffff0000u); }
typedef __bf16 bf16x2_t __attribute__((ext_vector_type(2)));
constexpr float Q8_X = 8.0f, Q8_W = 256.0f, Q8_H = 8.0f, Q8_O = 32.0f, Q8_Y = 32.0f, Q8_Q = 64.0f, Q8_K = 8.0f, Q8_V = 8.0f, Q8_YS = 16.0f;
__device__ __forceinline__ unsigned pk4_f8(float a, float b, float c, float d, float sc) {
    a = __builtin_fminf(__builtin_fmaxf(a * sc, -448.f), 448.f); b = __builtin_fminf(__builtin_fmaxf(b * sc, -448.f), 448.f);
    c = __builtin_fminf(__builtin_fmaxf(c * sc, -448.f), 448.f); d = __builtin_fminf(__builtin_fmaxf(d * sc, -448.f), 448.f);
    int p = __builtin_amdgcn_cvt_pk_fp8_f32(a, b, 0, false); p = __builtin_amdgcn_cvt_pk_fp8_f32(c, d, p, true); return (unsigned)p; }
__device__ __forceinline__ unsigned pk2(float lo, float hi) { const f32x2 v = {lo, hi}; const bf16x2_t b = __builtin_convertvector(v, bf16x2_t); return __builtin_bit_cast(unsigned, b); }
__device__ __forceinline__ float wave_sum(float v) {
#pragma unroll
    for (int o = 1; o < 64; o <<= 1) v += __shfl_xor(v, o);
    return v;
}
constexpr int P256 = 272, P512 = 528;
__device__ __forceinline__ int swz256(int row, int bc) { return row * P256 + bc; }
__device__ __forceinline__ int swz512(int row, int bc) { return row * P512 + bc; }
__device__ __forceinline__ bf16x8 as_bf16x8(u32x4 v) { return __builtin_bit_cast(bf16x8, v); }
__device__ __forceinline__ f32x4 mfma16(bf16x8 a, bf16x8 b, f32x4 c) { return __builtin_amdgcn_mfma_f32_16x16x32_bf16(a, b, c, 0, 0, 0); }
__device__ __forceinline__ void lds_barrier() { asm volatile("s_waitcnt lgkmcnt(0)" ::: "memory"); __builtin_amdgcn_s_barrier(); asm volatile("" ::: "memory"); }
__device__ __forceinline__ float silu_f(float v) { return v * __builtin_amdgcn_rcpf(1.0f + __expf(-v)); }

#define XB_TMO      128
#define XB_XCNT(j)  (256  + 64 * (j))
#define XB_XSUB(j)  (1280 + 64 * (j))
#define XB_XGEN(j)  (2304 + 64 * (j))
#define XB_TOP      3328
#define XB_TOPGEN   3392
#define XCD_BAR_WORDS 3456
#define XB_SPIN_CAP (1u << 18)
__device__ __forceinline__ unsigned xb_ld(unsigned* p)              { return __hip_atomic_load(p, __ATOMIC_RELAXED, __HIP_MEMORY_SCOPE_AGENT); }
__device__ __forceinline__ unsigned xb_add(unsigned* p, unsigned v) { return __hip_atomic_fetch_add(p, v, __ATOMIC_RELAXED, __HIP_MEMORY_SCOPE_AGENT); }
__device__ __forceinline__ unsigned xb_xcc_id() { return (unsigned)__builtin_amdgcn_s_getreg((3 << 11) | 20) & 0xFu; }
#define XB_SPIN(cond, bar) do { unsigned _sp = 0; while (cond) { __builtin_amdgcn_s_sleep(1); \
    if ((++_sp & 255u) == 0u) { if (xb_ld(&(bar)[XB_TMO])) break; if (_sp > XB_SPIN_CAP) { atomicAdd(&(bar)[XB_TMO], 1u); break; } } } } while (0)
struct XcdBarrier { unsigned* bar; unsigned x; volatile LAS unsigned* st; };
__device__ __forceinline__ XcdBarrier xcd_barrier_post(unsigned* bar, volatile LAS unsigned* st) {
    XcdBarrier b; b.bar = bar; b.x = xb_xcc_id(); b.st = st;
    if (threadIdx.x == 0) (void)xb_add(&bar[XB_XCNT(b.x)], 1u);
    return b;
}
__device__ __forceinline__ void xcd_barrier_complete(unsigned* bar, unsigned x, unsigned& nloc, unsigned& nx) {
    const unsigned G = gridDim.x * gridDim.y * gridDim.z;
    unsigned sum, cnt, mine, sp = 0u;
    for (;;) {
        sum = 0u; cnt = 0u; mine = 0u;
#pragma unroll
        for (unsigned j = 0; j < 16; ++j) { const unsigned c = xb_ld(&bar[XB_XCNT(j)]); sum += c; cnt += (c > 0u) ? 1u : 0u; mine = (j == x) ? c : mine; }
        if (sum == G) break;
        __builtin_amdgcn_s_sleep(1);
        if ((++sp & 255u) == 0u) { if (xb_ld(&bar[XB_TMO])) break; if (sp > XB_SPIN_CAP) { atomicAdd(&bar[XB_TMO], 1u); break; } }
    }
    nloc = mine > 0u ? mine : 1u; nx = cnt > 0u ? cnt : 1u;
}
struct NoWork { __device__ __forceinline__ void operator()() const {} };
template <class F = NoWork>
__device__ __forceinline__ void xcd_barrier(const XcdBarrier& b, const F& f = F()) {
    asm volatile("s_waitcnt vmcnt(0)" ::: "memory");
    __syncthreads();
    if (threadIdx.x >= 64) f();
    if (threadIdx.x == 0) {
        unsigned* bar = b.bar;
        __builtin_amdgcn_s_waitcnt(0);
        unsigned nloc = b.st[0], nx = b.st[1];
        if (nloc == 0u) { xcd_barrier_complete(bar, b.x, nloc, nx); b.st[0] = nloc; b.st[1] = nx; }
        const unsigned old = xb_add(&bar[XB_XSUB(b.x)], 1u);
        const unsigned gen = old / nloc;
        if (old + 1u == (gen + 1u) * nloc) {
            __builtin_amdgcn_fence(__ATOMIC_RELEASE, "agent");
            asm volatile("s_waitcnt vmcnt(0)" ::: "memory");
            const unsigned og = xb_add(&bar[XB_TOP], 1u);
            const unsigned tg = og / nx;
            if (og + 1u == (tg + 1u) * nx) xb_add(&bar[XB_TOPGEN], 1u);
            else XB_SPIN(xb_ld(&bar[XB_TOPGEN]) == tg, bar);
            __builtin_amdgcn_fence(__ATOMIC_ACQUIRE, "agent");
            xb_add(&bar[XB_XGEN(b.x)], 1u);
            asm volatile("s_waitcnt vmcnt(0)" ::: "memory");
        } else {
            XB_SPIN(xb_ld(&bar[XB_XGEN(b.x)]) == gen, bar);
            __builtin_amdgcn_fence(__ATOMIC_ACQUIRE, "agent");
            asm volatile("s_waitcnt vmcnt(0)" ::: "memory");
        }
    }
    __syncthreads();
}

namespace pg8 {
constexpr int BM = 256, BK = 64, HALF = 128, HTB = HALF * BK * 2, STAGE_BYTES = 8 * HTB, NXCD = 8, WGM = 4;
__host__ __device__ __forceinline__ int lds_byte(int r, int c) { const int st = (r >> 4) * 2 + (c >> 5), rr = r & 15, cc = c & 31, ob = rr * 64 + cc * 2; return st * 1024 + (ob ^ (((ob >> 9) & 1) << 5)); }
__host__ __device__ __forceinline__ void stage_rc(int b, int& R, int& C) { const int st = b / 1024, sb = b % 1024, swz = sb ^ (((sb >> 9) & 1) << 5); R = (st >> 1) * 16 + swz / 64; C = (st & 1) * 32 + (swz % 64) / 2; }
__host__ __device__ __forceinline__ int perm32(int rho) { const int n = rho >> 4, i = rho & 15; return 8 * (i >> 2) + 4 * n + (i & 3); }

struct Unit { int pm, pn, e, r0, cnt, ord; };
typedef int i32x8_t __attribute__((ext_vector_type(8))); typedef int i32x4_t __attribute__((ext_vector_type(4)));
__device__ __forceinline__ i32x8_t cat8(const bf16x8& a, const bf16x8& b) { return __builtin_shufflevector(__builtin_bit_cast(i32x4_t, a), __builtin_bit_cast(i32x4_t, b), 0, 1, 2, 3, 4, 5, 6, 7); }

struct DenseOrder {
    static constexpr bool GATHER_A = false;
    const char* A; const char* Bt; int K, nM, nN, nwg, G, c;
    __device__ __forceinline__ void init(const void* A_, const void* Bt_, int M, int N, int K_, int G_, int c_) { A = (const char*)A_; Bt = (const char*)Bt_; K = K_; nM = M / BM; nN = N / BM; nwg = nM * nN; G = G_; c = c_; }
    __device__ __forceinline__ bool next(int i, Unit& u) const {
        const long L = (long)i * G + c; if (L >= nwg) return false;
        int wgid = (int)L; { const int q = nwg / NXCD, r = nwg % NXCD, xcd = wgid % NXCD, off = wgid / NXCD; wgid = (xcd < r ? xcd * (q + 1) : r * (q + 1) + (xcd - r) * q) + off; }
        const int nig = WGM * nN, gid = wgid / nig, fm = gid * WGM, gsz = (nM - fm) < WGM ? (nM - fm) : WGM;
        u.pm = fm + ((wgid % nig) % gsz); u.pn = (wgid % nig) / gsz; u.e = 0; u.r0 = 0; u.cnt = 0; u.ord = i; return true;
    }
    __device__ __forceinline__ const char* a_base(const Unit& u) const { return A + (size_t)u.pm * ((size_t)BM * K * 2); }
    __device__ __forceinline__ const char* b_base(const Unit& u) const { return Bt + (size_t)u.pn * ((size_t)BM * K * 2); }
    __device__ __forceinline__ void a_offs(const Unit&, unsigned (&v)[2][2]) const {
#pragma unroll
        for (int i = 0; i < 2; ++i) { int R, C; stage_rc((int)threadIdx.x * 16 + i * 8192, R, C);
#pragma unroll
            for (int h = 0; h < 2; ++h) v[h][i] = (unsigned)((h * HALF + R) * K + C) * 2u; }
    }
};
template <bool GATHER> struct MoeOrder {
    static constexpr bool GATHER_A = GATHER;
    const char* A; const char* Bt; int K, N, nN, G, c, NU; const LAS int* tab; const LAS unsigned short* toks;
    __device__ __forceinline__ bool next(int i, Unit& u) const {
        const int L = i * G + c; if (L >= NU) return false;
        const int rb = L / nN; u.pn = L - rb * nN; u.pm = rb;
        const int e = __builtin_amdgcn_readfirstlane(tab[128 + rb]); u.e = e;
        u.r0 = (rb - __builtin_amdgcn_readfirstlane(tab[e])) * 256; u.cnt = __builtin_amdgcn_readfirstlane(tab[64 + e]); u.ord = i; return true;
    }
    __device__ __forceinline__ const char* a_base(const Unit& u) const { return GATHER ? A : A + (size_t)u.pm * ((size_t)BM * K * 2); }
    __device__ __forceinline__ const char* b_base(const Unit& u) const { return Bt + ((size_t)u.e * N + (size_t)u.pn * BM) * ((size_t)K * 2); }
    __device__ __forceinline__ void a_offs(const Unit& u, unsigned (&v)[2][2]) const {
#pragma unroll
        for (int i = 0; i < 2; ++i) { int R, C; stage_rc((int)threadIdx.x * 16 + i * 8192, R, C);
#pragma unroll
            for (int h = 0; h < 2; ++h) {
                if (GATHER) { const unsigned tok = toks[u.ord * 256 + h * HALF + R]; v[h][i] = (tok * (unsigned)K + (unsigned)C) * 2u; }
                else v[h][i] = (unsigned)((h * HALF + R) * K + C) * 2u; } }
    }
};


struct HostNone { struct Regs {}; __device__ __forceinline__ void issue(int, Regs&, f32x4 (&)[2][2][4][2]) const {} __device__ __forceinline__ void finish(const Regs&, const f32x4 (&)[2][2][4][2]) const {} };
struct HostCvt {
    const float* w_up; const float* w_dn; unsigned char* wt_up; unsigned char* wt_dn;
    int base, limit, G, c;
    struct Regs { unsigned char* dst; bool active; };
    __device__ __forceinline__ void issue(int ord, Regs& R, f32x4 (&acc)[2][2][4][2]) const {
        const int w = __builtin_amdgcn_readfirstlane((int)threadIdx.x >> 6), lane = threadIdx.x & 63, kq = lane >> 4, nq = lane & 15;
        const int hi = __builtin_amdgcn_readfirstlane(base + (ord * G + c) * 8 + w);
        R.active = hi < limit; R.dst = nullptr;
        if (R.active) {
            const float* W; int pitch, k0, n0, drow; unsigned char* WT;
            if (hi < 32768) { const int mat = hi >> 10, q = hi & 1023, kb = q >> 5, nb = q & 31; n0 = nb * 64; k0 = kb * 32; pitch = 2048; W = w_up + (size_t)mat * 1024 * 2048; WT = wt_up + (size_t)mat * 2048 * 1024;
                drow = ((n0 & 1023) >> 7) * 256 + (n0 >> 10) * 128 + (n0 & 127); }
            else { const int r = hi - 32768, mat = r >> 9, q = r & 511, kb = q >> 4, nb = q & 15; n0 = nb * 64; k0 = kb * 32; pitch = 1024; W = w_dn + (size_t)mat * 1024 * 1024; WT = wt_dn + (size_t)mat * 1024 * 1024; drow = n0; }
            const char* src = (const char*)(W + (size_t)k0 * pitch + n0); const unsigned voff = (unsigned)(kq * pitch + 4 * nq) * 4u;
#pragma unroll
            for (int i = 0; i < 8; ++i) acc[0][0][i >> 1][i & 1] = __builtin_nontemporal_load((const f32x4*)(src + (size_t)(4 * i) * pitch * 4 + voff));
            R.dst = WT + (size_t)(drow + 4 * nq + kq) * 1024 + k0;
        }
    }
    __device__ __forceinline__ void finish(const Regs& R, const f32x4 (&acc)[2][2][4][2]) const {
        if (R.active) {
            const int lane = threadIdx.x & 63;
            const unsigned sel1 = (lane & 16) ? 0x07030501u : 0x06020400u, sel2 = (lane & 32) ? 0x07060302u : 0x05040100u;
            unsigned o[8];
#pragma unroll
            for (int i = 0; i < 8; ++i) { const f32x4 v = acc[0][0][i >> 1][i & 1]; const unsigned d = pk4_f8(v[0], v[1], v[2], v[3], Q8_W);
                const u32x2 s1 = __builtin_amdgcn_permlane16_swap(d, d, false, false);
                const unsigned t1 = __builtin_amdgcn_perm(s1.y, s1.x, sel1);
                const u32x2 s2 = __builtin_amdgcn_permlane32_swap(t1, t1, false, false);
                o[i] = __builtin_amdgcn_perm(s2.y, s2.x, sel2); }
            *(u32x4*)R.dst = (u32x4){o[0], o[1], o[2], o[3]}; *(u32x4*)(R.dst + 16) = (u32x4){o[4], o[5], o[6], o[7]};
        }
    }
};

template <bool F8 = false, class Epi, class Sched, class Host>
__device__ __forceinline__ void gemm_phase(LAS unsigned char* lds, const int K, const Sched& S, const Epi& E, const Host& H) {
    const int tid = threadIdx.x, wid = __builtin_amdgcn_readfirstlane(tid >> 6), lane = tid & 63, wr = wid >> 2, wc = wid & 3, fr = lane & 15, fq = lane >> 4;
    const int nt = K / BK;
    unsigned voffB[2];
#pragma unroll
    for (int i = 0; i < 2; ++i) { int R, C; stage_rc(tid * 16 + i * 8192, R, C); const int Rb = Epi::PERM ? ((R & ~31) + perm32(R & 31)) : R; voffB[i] = (unsigned)(Rb * K + C) * 2u; }
    const size_t kstep = (size_t)(BK * 2);
    const size_t hstep = (size_t)HALF * K * 2;
    const unsigned ldsw = (unsigned)wid * 1024u;
    const int aoff = lds_byte(wr * 64 + fr, fq * 8), boff = lds_byte(wc * 32 + fr, fq * 8);
#define PG8_SA(b, h) (((b) * 2 + (h)) * HTB)
#define PG8_SB(b, h) ((4 + (b) * 2 + (h)) * HTB)
#define PG8_STAGE(bufoff, gbase, voff) do { _Pragma("unroll") for (int _i = 0; _i < 2; ++_i) \
        __builtin_amdgcn_global_load_lds((const unsigned*)((const char*)(gbase) + (voff)[_i]), (LAS unsigned*)(lds + (bufoff) + ldsw + _i * 8192), 16, 0, 0); } while (0)
#define PG8_LDA(dst, b, h) do { _Pragma("unroll") for (int m = 0; m < 4; ++m) _Pragma("unroll") for (int k = 0; k < 2; ++k) dst[m][k] = *(const LAS bf16x8*)(lds + PG8_SA(b, h) + aoff + m * 2048 + k * 1024); } while (0)
#define PG8_LDB(dst, b, h) do { _Pragma("unroll") for (int n = 0; n < 2; ++n) _Pragma("unroll") for (int k = 0; k < 2; ++k) dst[n][k] = *(const LAS bf16x8*)(lds + PG8_SB(b, h) + boff + n * 2048 + k * 1024); } while (0)
#define PG8_MMA(ai, bj, At, Bt) do { __builtin_amdgcn_s_setprio(1); _Pragma("unroll") for (int m = 0; m < 4; ++m) _Pragma("unroll") for (int n = 0; n < 2; ++n) { \
        if constexpr (F8) { const i32x8_t b8_ = cat8(Bt[n][0], Bt[n][1]), a8_ = cat8(At[m][0], At[m][1]); asm volatile("v_mfma_f32_16x16x128_f8f6f4 %0, %1, %2, %0" : "+v"(acc[ai][bj][m][n]) : "v"(b8_), "v"(a8_)); } \
        else { _Pragma("unroll") for (int k = 0; k < 2; ++k) acc[ai][bj][m][n] = __builtin_amdgcn_mfma_f32_16x16x32_bf16(Bt[n][k], At[m][k], acc[ai][bj][m][n], 0, 0, 0); } } __builtin_amdgcn_s_setprio(0); } while (0)
#define PG8_WAIT_V(n) asm volatile("s_waitcnt vmcnt(" #n ")" ::: "memory")
#define PG8_WAIT_L(n) asm volatile("s_waitcnt lgkmcnt(" #n ")" ::: "memory")
#define PG8_BAR __builtin_amdgcn_s_barrier()
#define PG8_SCHED __builtin_amdgcn_sched_barrier(0)
    Unit cur, nxt; int ui = 0;
    if (!S.next(0, cur)) return;
    f32x4 acc[2][2][4][2];
#pragma unroll
    for (int a = 0; a < 2; ++a)
#pragma unroll
        for (int b = 0; b < 2; ++b)
#pragma unroll
            for (int m = 0; m < 4; ++m)
#pragma unroll
                for (int n = 0; n < 2; ++n) acc[a][b][m][n] = (f32x4){0.f, 0.f, 0.f, 0.f};
    bf16x8 At[4][2], B0[2][2], B1[2][2];
    constexpr bool GA = Sched::GATHER_A;
    unsigned vA[2][2], nvA[2][2];
    S.a_offs(cur, vA);
    const size_t ah = GA ? 0 : hstep;
#define PG8_VA1 (GA ? vA[1] : vA[0])
    const char* cA = S.a_base(cur); const char* cB = S.b_base(cur);
    PG8_STAGE(PG8_SB(0, 0), cB, voffB); PG8_STAGE(PG8_SB(0, 1), cB + hstep, voffB); PG8_STAGE(PG8_SA(0, 0), cA, vA[0]); PG8_STAGE(PG8_SA(0, 1), cA + ah, PG8_VA1);
    if (wr == 1) PG8_BAR;
    PG8_WAIT_V(2); PG8_BAR;
    PG8_STAGE(PG8_SB(1, 0), cB + kstep, voffB); PG8_STAGE(PG8_SA(1, 0), cA + kstep, vA[0]); PG8_STAGE(PG8_SB(1, 1), cB + hstep + kstep, voffB);
    PG8_WAIT_V(6); PG8_BAR;
    for (;;) {
        const bool has_next = S.next(ui + 1, nxt);
        const char* nA = cA; const char* nB = cB;
#pragma unroll
        for (int h = 0; h < 2; ++h)
#pragma unroll
            for (int i = 0; i < 2; ++i) nvA[h][i] = vA[h][i];
        if (has_next) { nA = S.a_base(nxt); nB = S.b_base(nxt); if constexpr (GA) S.a_offs(nxt, nvA); }
        constexpr int NGRP = Epi::RESCALE ? 4 : 1; const int tper = nt / NGRP;
        for (int gq = 0; gq < NGRP; ++gq) {
        if constexpr (Epi::RESCALE) { if (gq > 0) { if constexpr (F8) asm volatile("s_nop 15\n\ts_nop 15" ::: "memory"); E.rescale(acc, cur, gq, wr, fr); } }
#pragma unroll 1
        for (int t = gq * tper; t < (gq + 1) * tper; t += 2) {
            const bool last = (t == nt - 2);
            const char* a1 = cA + (size_t)(t + 1) * kstep;
            const char* a2 = last ? nA : cA + (size_t)(t + 2) * kstep; const char* b2 = last ? nB : cB + (size_t)(t + 2) * kstep;
            const char* a3 = a2 + kstep; const char* b3 = b2 + kstep;
            unsigned w0[2], w1[2];
#pragma unroll
            for (int i = 0; i < 2; ++i) { if constexpr (GA) { w0[i] = last ? nvA[0][i] : vA[0][i]; w1[i] = last ? nvA[1][i] : vA[1][i]; } else { w0[i] = vA[0][i]; w1[i] = vA[0][i]; } }
            PG8_LDB(B0, 0, 0); PG8_LDB(B1, 0, 1); PG8_SCHED; PG8_LDA(At, 0, 0); PG8_STAGE(PG8_SA(1, 1), a1 + ah, PG8_VA1);
            PG8_WAIT_V(8); PG8_WAIT_L(0); PG8_BAR; PG8_MMA(0, 0, At, B0); PG8_MMA(0, 1, At, B1); PG8_BAR; PG8_SCHED;
            PG8_LDA(At, 0, 1); PG8_STAGE(PG8_SB(0, 0), b2, voffB); PG8_STAGE(PG8_SB(0, 1), b2 + hstep, voffB); PG8_STAGE(PG8_SA(0, 0), a2, w0);
            PG8_WAIT_V(8); PG8_WAIT_L(0); PG8_BAR; PG8_MMA(1, 0, At, B0); PG8_MMA(1, 1, At, B1); PG8_BAR; PG8_SCHED;
            PG8_LDB(B0, 1, 0); PG8_LDB(B1, 1, 1); PG8_SCHED; PG8_LDA(At, 1, 0); PG8_STAGE(PG8_SA(0, 1), a2 + ah, w1);
            PG8_WAIT_V(8); PG8_WAIT_L(0); PG8_BAR; PG8_MMA(0, 0, At, B0); PG8_MMA(0, 1, At, B1); PG8_BAR; PG8_SCHED;
            PG8_LDA(At, 1, 1); PG8_STAGE(PG8_SB(1, 0), b3, voffB); PG8_STAGE(PG8_SB(1, 1), b3 + hstep, voffB); PG8_STAGE(PG8_SA(1, 0), a3, w0);
            PG8_WAIT_V(8); PG8_WAIT_L(0); PG8_BAR; PG8_MMA(1, 0, At, B0); PG8_MMA(1, 1, At, B1); PG8_BAR; PG8_SCHED;
        }
        }
        if (wr == 0) PG8_BAR;
        if constexpr (F8) asm volatile("s_nop 15\n\ts_nop 15" ::: "memory");
        E(acc, cur, wr, wc, fr, fq, 0);
        __builtin_amdgcn_sched_barrier(0); asm volatile("" ::: "memory");
        typename Host::Regs hr; H.issue(cur.ord, hr, acc);
        __builtin_amdgcn_sched_barrier(0); asm volatile("" ::: "memory");
        E(acc, cur, wr, wc, fr, fq, 1);
        __builtin_amdgcn_sched_barrier(0);
        H.finish(hr, acc);
        if (!has_next) break;
#pragma unroll
        for (int a = 0; a < 2; ++a)
#pragma unroll
            for (int b = 0; b < 2; ++b)
#pragma unroll
                for (int m = 0; m < 4; ++m)
#pragma unroll
                    for (int n = 0; n < 2; ++n) acc[a][b][m][n] = (f32x4){0.f, 0.f, 0.f, 0.f};
        cur = nxt; cA = nA; cB = nB; ++ui;
#pragma unroll
        for (int h = 0; h < 2; ++h)
#pragma unroll
            for (int i = 0; i < 2; ++i) vA[h][i] = nvA[h][i];
        if (wr == 1) PG8_BAR;
    }
    PG8_WAIT_V(0);
    PG8_BAR;
#undef PG8_VA1
#undef PG8_SA
#undef PG8_SB
#undef PG8_STAGE
#undef PG8_LDA
#undef PG8_LDB
#undef PG8_MMA
#undef PG8_WAIT_V
#undef PG8_WAIT_L
#undef PG8_BAR
#undef PG8_SCHED
}

struct EpiF32 {
    static constexpr bool PERM = false; static constexpr bool RESCALE = false;
    float* C; int ldc;
    __device__ __forceinline__ void operator()(const f32x4 (&acc)[2][2][4][2], const Unit& u, int wr, int wc, int fr, int fq, const int ai) const {
        const int row0 = u.pm * BM + wr * 64 + fr, col0 = u.pn * BM + wc * 32 + 4 * fq;

#pragma unroll
            for (int m = 0; m < 4; ++m) { float* rowp = C + (size_t)(row0 + ai * HALF + m * 16) * ldc + col0;
#pragma unroll
                for (int bj = 0; bj < 2; ++bj)
#pragma unroll
                    for (int n = 0; n < 2; ++n) *(f32x4*)(rowp + bj * HALF + n * 16) = acc[ai][bj][m][n]; }
    }
};
struct EpiBf16 {
    static constexpr bool PERM = true; static constexpr bool RESCALE = false;
    bf16* O; int ldc; float sc;
    __device__ __forceinline__ void operator()(const f32x4 (&acc)[2][2][4][2], const Unit& u, int wr, int wc, int fr, int fq, const int ai) const {
        const int row0 = u.pm * BM + wr * 64 + fr, col0 = u.pn * BM + wc * 32 + 8 * fq;

#pragma unroll
            for (int m = 0; m < 4; ++m) { bf16* rowp = O + (size_t)(row0 + ai * HALF + m * 16) * ldc + col0;
#pragma unroll
                for (int bj = 0; bj < 2; ++bj) { const f32x4 v0 = acc[ai][bj][m][0] * sc, v1 = acc[ai][bj][m][1] * sc;
                    u32x4 w; w.x = pk2(v0[0], v0[1]); w.y = pk2(v0[2], v0[3]); w.z = pk2(v1[0], v1[1]); w.w = pk2(v1[2], v1[3]);
                    __builtin_nontemporal_store(w, (u32x4*)(rowp + bj * HALF)); } }
    }
};
struct EpiRms {
    static constexpr bool PERM = true; static constexpr bool RESCALE = true;
    bf16* O; int ldc; const LAS float* stab;
    __device__ __forceinline__ void rescale(f32x4 (&acc)[2][2][4][2], const Unit& u, int g, int wr, int fr) const {
        const LAS float* tb = stab + (u.ord * 256 + wr * 64 + fr) * 4 + g;
#pragma unroll
        for (int ai = 0; ai < 2; ++ai)
#pragma unroll
            for (int m = 0; m < 4; ++m) { const LAS float* p = tb + (ai * HALF + m * 16) * 4; const float ratio = p[-1] * __builtin_amdgcn_rcpf(p[0]);
#pragma unroll
                for (int bj = 0; bj < 2; ++bj)
#pragma unroll
                    for (int n = 0; n < 2; ++n) acc[ai][bj][m][n] = acc[ai][bj][m][n] * ratio; }
    }
    __device__ __forceinline__ void operator()(const f32x4 (&acc)[2][2][4][2], const Unit& u, int wr, int wc, int fr, int fq, const int ai) const {
        const int row0 = u.pm * BM + wr * 64 + fr, col0 = u.pn * BM + wc * 32 + 8 * fq;
        const LAS float* tb = stab + (u.ord * 256 + wr * 64 + fr) * 4 + 3;

#pragma unroll
            for (int m = 0; m < 4; ++m) { const int row = row0 + ai * HALF + m * 16; const float s3 = tb[(ai * HALF + m * 16) * 4] * (1.0f / (Q8_YS * Q8_W)); bf16* rowp = (bf16*)((char*)O + (unsigned)((row * ldc + col0) * 2));
#pragma unroll
                for (int bj = 0; bj < 2; ++bj) { const f32x4 v0 = acc[ai][bj][m][0] * s3, v1 = acc[ai][bj][m][1] * s3;
                    u32x4 w; w.x = pk2(v0[0], v0[1]); w.y = pk2(v0[2], v0[3]); w.z = pk2(v1[0], v1[1]); w.w = pk2(v1[2], v1[3]);
                    __builtin_nontemporal_store(w, (u32x4*)(rowp + bj * HALF)); } }
    }
};
struct EpiQKV {
    static constexpr bool PERM = true; static constexpr bool RESCALE = false;
    unsigned char* O; const float* rope; float ds;
    __device__ __forceinline__ void operator()(const f32x4 (&acc)[2][2][4][2], const Unit& u, int wr, int wc, int fr, int fq, const int ai) const {
        const int row0 = u.pm * BM + wr * 64 + fr;
        const int col_t = u.pn * BM;
        const int s = (col_t % 3072) >> 10;
        const float sc = ((s == 0) ? QSCALE * Q8_Q : ((s == 1) ? Q8_K : Q8_V)) * ds;
        const int gq = col_t / 3072, lg = 2 * gq, dlm = (1 << lg) - 1, mat0 = gq * 24 + s * 8 + ((col_t & 1023) >> 7);
        const bool rot = (s < 2) && (fq == 0);
        {
#pragma unroll
            for (int m = 0; m < 4; ++m) {
                const int row = row0 + ai * HALF + m * 16;
                const int tt = row & (SEQ - 1), rowp = (row & ~(SEQ - 1)) + ((tt & (dlm)) << (12 - lg)) + (tt >> lg);
                f32x4 cs = (f32x4){1.f, 1.f, 1.f, 1.f}, sn = (f32x4){0.f, 0.f, 0.f, 0.f};
                if (rot) { const float* rp = rope + (size_t)row * 32 + 4 * wc; cs = *(const f32x4*)rp; sn = *(const f32x4*)(rp + 16); }
#pragma unroll
                for (int bj = 0; bj < 2; ++bj) {
                    f32x4 v0 = acc[ai][bj][m][0], v1 = acc[ai][bj][m][1];
                    if (rot) { const f32x4 a0 = v0 * cs - v1 * sn, a1 = v1 * cs + v0 * sn; v0 = a0; v1 = a1; }
                    u32x2 w; w.x = pk4_f8(v0[0], v0[1], v0[2], v0[3], sc); w.y = pk4_f8(v1[0], v1[1], v1[2], v1[3], sc);
                    *(u32x2*)(O + ((size_t)(mat0 + bj) * T + rowp) * 128 + wc * 32 + 8 * fq) = w;
                }
            }
        }
    }
};
struct EpiUp {
    static constexpr bool PERM = true; static constexpr bool RESCALE = false;
    unsigned char* HB; const LAS unsigned* btab;
    __device__ __forceinline__ void operator()(const f32x4 (&acc)[2][2][4][2], const Unit& u, int wr, int wc, int fr, int fq, const int ai) const {
        const int row0 = u.pm * BM + wr * 64 + fr, col0 = u.pn * HALF + wc * 32 + 8 * fq;
        const LAS unsigned* bp = btab + u.ord * 128 + (wc * 32 + 8 * fq) / 2;
        const u32x4 gw = *(const LAS u32x4*)bp, uw = *(const LAS u32x4*)(bp + 64);
        f32x2 bg[4], bu[4];
#pragma unroll
        for (int i = 0; i < 4; ++i) { bg[i] = (f32x2){bflo(gw[i]), bfhi(gw[i])}; bu[i] = (f32x2){bflo(uw[i]), bfhi(uw[i])}; }
        constexpr float DS = 1.0f / (Q8_X * Q8_W), KE = -1.702f * 1.4426950408889634f;

#pragma unroll
            for (int m = 0; m < 4; ++m) {
                f32x2 o[4];
#pragma unroll
                for (int i = 0; i < 4; ++i) { const int n = i >> 1, j = 2 * (i & 1);
                    f32x2 gt = (f32x2){acc[ai][0][m][n][j], acc[ai][0][m][n][j + 1]} * DS + bg[i];
                    f32x2 up = (f32x2){acc[ai][1][m][n][j], acc[ai][1][m][n][j + 1]} * DS + bu[i];
                    gt[0] = fminf(gt[0], 7.0f); gt[1] = fminf(gt[1], 7.0f);
                    up[0] = __builtin_amdgcn_fmed3f(up[0], -7.0f, 7.0f); up[1] = __builtin_amdgcn_fmed3f(up[1], -7.0f, 7.0f);
                    f32x2 e = gt * KE; e[0] = __builtin_amdgcn_exp2f(e[0]); e[1] = __builtin_amdgcn_exp2f(e[1]);
                    e = e + 1.0f; e[0] = __builtin_amdgcn_rcpf(e[0]); e[1] = __builtin_amdgcn_rcpf(e[1]);
                    o[i] = (up * Q8_H + Q8_H) * (gt * e); }
                u32x2 w;
                { int p0 = __builtin_amdgcn_cvt_pk_fp8_f32(o[0][0], o[0][1], 0, false); p0 = __builtin_amdgcn_cvt_pk_fp8_f32(o[1][0], o[1][1], p0, true);
                  int p1 = __builtin_amdgcn_cvt_pk_fp8_f32(o[2][0], o[2][1], 0, false); p1 = __builtin_amdgcn_cvt_pk_fp8_f32(o[3][0], o[3][1], p1, true); w.x = (unsigned)p0; w.y = (unsigned)p1; }
                *(u32x2*)(HB + (size_t)(row0 + ai * HALF + m * 16) * 1024 + col0) = w;
            }
    }
};
struct EpiDown {
    static constexpr bool PERM = true; static constexpr bool RESCALE = false;
    unsigned char* YS; const LAS unsigned* btab; const LAS int* slots;
    __device__ __forceinline__ void operator()(const f32x4 (&acc)[2][2][4][2], const Unit& u, int wr, int wc, int fr, int fq, const int ai) const {
        const int col0 = u.pn * BM + wc * 32 + 8 * fq;
        const LAS unsigned* bp = btab + u.ord * 128 + (wc * 32 + 8 * fq) / 2;
        f32x4 bv[2][2];
#pragma unroll
        for (int bj = 0; bj < 2; ++bj) { const u32x4 bw = *(const LAS u32x4*)(bp + bj * 64);
            bv[bj][0] = (f32x4){bflo(bw.x), bfhi(bw.x), bflo(bw.y), bfhi(bw.y)}; bv[bj][1] = (f32x4){bflo(bw.z), bfhi(bw.z), bflo(bw.w), bfhi(bw.w)}; }

#pragma unroll
            for (int m = 0; m < 4; ++m) {
                const int slot = slots[u.ord * 256 + ai * HALF + wr * 64 + m * 16 + fr];
                if (slot >= 0) {
                    unsigned char* rowp = YS + (size_t)slot * 1024 + col0;
#pragma unroll
                    for (int bj = 0; bj < 2; ++bj) { const f32x4 v0 = acc[ai][bj][m][0] * (1.0f / (Q8_H * Q8_W)) + bv[bj][0], v1 = acc[ai][bj][m][1] * (1.0f / (Q8_H * Q8_W)) + bv[bj][1];
                        u32x2 w; w.x = pk4_f8(v0[0], v0[1], v0[2], v0[3], Q8_Y); w.y = pk4_f8(v1[0], v1[1], v1[2], v1[3], Q8_Y);
                        *(u32x2*)(rowp + bj * HALF) = w; }
                }
            }
    }
};
}

struct TrItem { const float* W; const float* kscale; bf16* WT; int pitch, K, k0, n0, dstrow0, q8, hperm; };
__device__ __forceinline__ void tr_load(const TrItem& d, f32x4 (&ld)[16], int lane) {
    const int kq = lane >> 4, nq = lane & 15;
    const float* src = d.W + (size_t)(d.k0 + kq) * d.pitch + d.n0 + 4 * nq;
#pragma unroll
    for (int i = 0; i < 16; ++i) ld[i] = __builtin_nontemporal_load((const f32x4*)(src + (size_t)(4 * i) * d.pitch));
}
__device__ __forceinline__ void tr_finish(const TrItem& d, const f32x4 (&ld)[16], LAS float* scr, int lane) {
    const int kq = lane >> 4, nq = lane & 15;
#pragma unroll
    for (int i = 0; i < 16; ++i) { f32x4 v = ld[i]; if (d.kscale) v = v * d.kscale[d.k0 + 4 * i + kq]; LAS float* p = scr + (4 * i + kq) * 65 + 4 * nq; p[0] = v[0]; p[1] = v[1]; p[2] = v[2]; p[3] = v[3]; }
    asm volatile("s_waitcnt lgkmcnt(0)" ::: "memory");
    const int c = lane & 7;
    if (d.q8) {
#pragma unroll
        for (int j = 0; j < 8; ++j) { const int n = j * 8 + (lane >> 3); const LAS float* s = scr + (8 * c) * 65 + n;
            u32x2 o; o.x = pk4_f8(s[0 * 65], s[1 * 65], s[2 * 65], s[3 * 65], Q8_W); o.y = pk4_f8(s[4 * 65], s[5 * 65], s[6 * 65], s[7 * 65], Q8_W);
            int row = d.dstrow0 + n;
            if (d.hperm) { const int ng = d.n0 + n; if (((ng % 3072) >> 10) < 2) { const int dd = ng & 127;
                    const int pp = (dd < 32) ? (((dd & 15) >> 2) * 32 + (dd & 3) + 4 * (dd >> 4)) : (((dd - 32) / 24) * 32 + 8 + (dd - 32) % 24); row = (ng & ~127) + pp; } }
            *(u32x2*)((unsigned char*)d.WT + (size_t)row * d.K + d.k0 + 8 * c) = o; }
    } else {
#pragma unroll
    for (int j = 0; j < 8; ++j) { const int n = j * 8 + (lane >> 3); const LAS float* s = scr + (8 * c) * 65 + n;
        u32x4 o; o.x = pk2(s[0 * 65], s[1 * 65]); o.y = pk2(s[2 * 65], s[3 * 65]); o.z = pk2(s[4 * 65], s[5 * 65]); o.w = pk2(s[6 * 65], s[7 * 65]);
        *(u32x4*)(d.WT + (size_t)(d.dstrow0 + n) * d.K + d.k0 + 8 * c) = o; }
    }
    asm volatile("s_waitcnt lgkmcnt(0)" ::: "memory");
}
__constant__ float c_inv_freq[16] = {1.000000000e+00f, 4.403665960e-01f, 1.939227432e-01f, 8.539710194e-02f, 3.760603070e-02f, 1.656044088e-02f, 7.292664610e-03f, 3.211446106e-03f,
                                     1.414213562e-03f, 6.227724371e-04f, 2.742481884e-04f, 1.207697351e-04f, 5.318295734e-05f, 2.341999971e-05f, 1.031338525e-05f, 4.541670478e-06f};
__device__ __forceinline__ void sincos_reduced(float ang, float& sn, float& cs) {
    const double a = (double)ang;
    const double k = __builtin_rint(a * 0.15915494309189535);
    const double r = __builtin_fma(-k, 6.283185307179586, a) - k * 2.4492935982947064e-16;
    const float rf = (float)r;
    sn = __sinf(rf); cs = __cosf(rf);
}
struct Ptrs {
    const float *x; const int* pos; const float *attn_w_in, *attn_w_out, *ssm_w_in, *conv_w, *conv_b, *dt_bias, *a_log, *d_skip, *norm_w, *ssm_w_out;
    const float *w_router, *b_router, *w_up, *b_up, *w_dn, *b_dn, *ln_mix_g, *ln_mix_b, *ln_ffn_g, *ln_ffn_b;
};
constexpr int N1_UP = 32 * 16 * 32, N1_DN = 32 * 16 * 16, N1_ITEMS = N1_UP + N1_DN;
constexpr int HOSTED_ITEMS = 18432;
__device__ __forceinline__ TrItem moe1_item(const Ptrs& P, unsigned char* ws, int idx, int lay = 1) {
    TrItem d; d.kscale = nullptr; d.K = 1024; d.q8 = 1; d.hperm = 0;
    if (idx < N1_UP) { const int mat = 32 * lay + (idx >> 9), q = idx & 511, kb = q >> 5, nb = q & 31; const int n0 = nb * 64; const int bj = n0 >> 10, pn = (n0 & 1023) >> 7, cc = n0 & 127;
        d.W = P.w_up + (size_t)mat * 1024 * 2048; d.pitch = 2048; d.WT = (bf16*)(ws + WS_WUP + (size_t)mat * 2048 * 1024); d.k0 = kb * 64; d.n0 = n0; d.dstrow0 = pn * 256 + bj * 128 + cc; }
    else { const int r = idx - N1_UP, mat = 32 * lay + (r >> 8), q = r & 255, kb = q >> 4, nb = q & 15;
        d.W = P.w_dn + (size_t)mat * 1024 * 1024; d.pitch = 1024; d.WT = (bf16*)(ws + WS_WDN + (size_t)mat * 1024 * 1024); d.k0 = kb * 64; d.n0 = nb * 64; d.dstrow0 = nb * 64; }
    return d;
}
__device__ __forceinline__ void cvt_static(LAS unsigned char* lds, const Ptrs& P, unsigned char* ws, int first, int stride, int cnt) {
    const int lane = threadIdx.x & 63, w = __builtin_amdgcn_readfirstlane((int)threadIdx.x >> 6);
    LAS float* scr = (LAS float*)(lds + w * (65 * 64 * 4));
    if (cnt <= 0 || first >= N1_ITEMS) return;
    f32x4 la[16], lb[16]; TrItem da = moe1_item(P, ws, first), db = da; tr_load(da, la, lane);
    for (int i = 0;; i += 2) {
        const int ib = first + (i + 1) * stride; const bool hb = (i + 1 < cnt) && (ib < N1_ITEMS);
        if (hb) { db = moe1_item(P, ws, ib); tr_load(db, lb, lane); }
        tr_finish(da, la, scr, lane);
        if (!hb) break;
        const int ia = first + (i + 2) * stride; const bool ha = (i + 2 < cnt) && (ia < N1_ITEMS);
        if (ha) { da = moe1_item(P, ws, ia); tr_load(da, la, lane); }
        tr_finish(db, lb, scr, lane);
        if (!ha) break;
    }
}
__device__ __forceinline__ void cvt_plan(int NB, int G, int& rem_up, int& P_up, int& rem_dn, int& P_dn) {
    rem_up = (NB * 8) % G; const int n_iu = rem_up ? (G - rem_up) : 0; P_up = n_iu * 8 * CVT_Q_UP; if (P_up > N1_ITEMS) P_up = N1_ITEMS;
    rem_dn = (NB * 4) % G; const int n_id = rem_dn ? (G - rem_dn) : 0; P_dn = P_up + n_id * 8 * CVT_Q_DN; if (P_dn > N1_ITEMS) P_dn = N1_ITEMS;
}
__device__ __forceinline__ void p0_prologue(LAS unsigned char* lds, const Ptrs& P, unsigned char* ws, int G, int vcu) {
    const int tid = threadIdx.x, lane = tid & 63, w = __builtin_amdgcn_readfirstlane(tid >> 6);
    LAS float* scr = (LAS float*)(lds + w * (65 * 64 * 4));
    const int gw = vcu * 8 + w, NGW = G * 8;
    bf16* Wqkv = (bf16*)(ws + WS_WQKV); bf16* Wao = (bf16*)(ws + WS_WAO); bf16* Wsi = (bf16*)(ws + WS_WSI); bf16* Wso = (bf16*)(ws + WS_WSO);
    constexpr int I0 = 16 * 144, I1 = 16 * 16, I2 = 16 * 80, I3 = 32 * 16, I4 = 32 * 16 * 32, I5 = 32 * 16 * 16;
    constexpr int NITEMS = I0 + I1 + I2 + I3 + (N1_ITEMS - HOSTED_ITEMS);
    auto decode = [&](int it) -> TrItem {
        TrItem d; int r = it; d.kscale = nullptr; d.q8 = 0; d.hperm = 0;
        if (r < I0) { const int kb = r / 144, nb = r % 144; d.q8 = 1; d.hperm = 1; d.W = P.attn_w_in; d.pitch = NQKV; d.K = 1024; d.WT = Wqkv; d.k0 = kb * 64; d.n0 = nb * 64; d.dstrow0 = nb * 64; return d; } r -= I0;
        if (r < I1) { const int kb = r / 16, nb = r % 16; d.q8 = 1; d.W = P.attn_w_out; d.pitch = 1024; d.K = 1024; d.WT = Wao; d.k0 = kb * 64; d.n0 = nb * 64; d.dstrow0 = nb * 64; return d; } r -= I1;
        if (r < I2) { const int kb = r / 80, nb = r % 80; d.q8 = 1; d.W = P.ssm_w_in; d.pitch = SSM_PITCH; d.K = 1024; d.WT = Wsi; d.k0 = kb * 64; d.n0 = nb * 64; d.dstrow0 = nb * 64; return d; } r -= I2;
        if (r < I3) { const int kb = r / 16, nb = r % 16; d.q8 = 1; d.W = P.ssm_w_out; d.pitch = 1024; d.K = 2048; d.kscale = P.norm_w; d.WT = Wso; d.k0 = kb * 64; d.n0 = nb * 64; d.dstrow0 = nb * 64; return d; } r -= I3;
        return moe1_item(P, ws, r + HOSTED_ITEMS, 0);
    };
    if (gw < NITEMS) {
        f32x4 la[16], lb[16];
        TrItem da = decode(gw), db = da; tr_load(da, la, lane);
        for (int it = gw; it < NITEMS; it += 2 * NGW) {
            const bool hb = it + NGW < NITEMS;
            if (hb) { db = decode(it + NGW); tr_load(db, lb, lane); }
            tr_finish(da, la, scr, lane);
            if (!hb) break;
            const bool ha = it + 2 * NGW < NITEMS;
            if (ha) { da = decode(it + 2 * NGW); tr_load(da, la, lane); }
            tr_finish(db, lb, scr, lane);
            if (!ha) break;
        }
    }
    bf16* XBA = (bf16*)(ws + WS_XBA);
    for (int m0 = gw * 4; m0 < T; m0 += NGW * 4) {
        f32x4 v[4][4];
#pragma unroll
        for (int rr = 0; rr < 4; ++rr) { const f32x4* xr = (const f32x4*)(P.x + (size_t)(m0 + rr) * DM) + lane;
#pragma unroll
            for (int j = 0; j < 4; ++j) v[rr][j] = xr[64 * j]; }
#pragma unroll
        for (int rr = 0; rr < 4; ++rr) { u32x2* o = (u32x2*)(XBA + (size_t)(m0 + rr) * DM) + lane;
#pragma unroll
            for (int j = 0; j < 4; ++j) {
                *(unsigned*)(ws + WS_XQ0 + (size_t)(m0 + rr) * DM + 4 * lane + 256 * j) = pk4_f8(v[rr][j][0], v[rr][j][1], v[rr][j][2], v[rr][j][3], Q8_X); } }
    }
    float* rope = (float*)(ws + WS_ROPE);
    for (int idx = (vcu * 512 + tid); idx < T * 16; idx += G * 512) {
        const int tok = idx >> 4, i = idx & 15;
        const float ang = (float)P.pos[tok] * c_inv_freq[i];
        float sn, cs; sincos_reduced(ang, sn, cs);
        rope[(size_t)tok * 32 + i] = cs; rope[(size_t)tok * 32 + 16 + i] = sn;
    }
}

constexpr size_t PKOFF = (size_t)8 * T * 128;
__device__ __forceinline__ void attn_phase(LAS unsigned char* lds, const unsigned char* __restrict__ PROJ, unsigned char* __restrict__ OG, float* __restrict__ LSE, const int G, const int vcu) {
    const int tid = threadIdx.x, lane0 = tid & 63, w = __builtin_amdgcn_readfirstlane(tid >> 6);
    LAS unsigned char* Ks = lds; LAS unsigned char* Vt = lds + 2 * 128 * P256;
    constexpr int NU = BATCH * 3 * 8 * 32;
    const int per = (NU + G - 1) / G;
    const int u0 = vcu * per, u1 = (u0 + per < NU) ? (u0 + per) : NU;
    if (u0 >= u1) return;
    u32x4 kreg[2], vreg[2]; u32x4 qn[2];
    constexpr int PK8 = 144;
    unsigned long long mA = 0ull, mB = 0ull;
    { const int r16 = lane0 & 15, q4 = lane0 >> 4;
#pragma unroll
        for (int kt = 0; kt < 9; ++kt)
#pragma unroll
            for (int jj = 0; jj < 4; ++jj) { const int jr = 16 * kt + 4 * q4 + jj; const bool va = (jr >= r16) & (jr <= r16 + 128); const bool vb = va & (jr + 16 * w >= 128);
                mA |= (unsigned long long)va << (4 * kt + jj); mB |= (unsigned long long)vb << (4 * kt + jj); } }
    int pc = 0;
#define ATT_DECODE(U) const int bgh = (U) >> 5, sub = (U) & 31, h = bgh & 7, bg = bgh >> 3, g = bg % 3, b = bg / 3; \
        const int lg = (g == 0) ? 0 : ((g == 1) ? 2 : 4), dl = 1 << lg, nblk = 32 >> lg, r = sub >> (5 - lg), blk = sub & (nblk - 1); \
        const unsigned char* base_r = PROJ + ((size_t)(g * 24 + h) * T + (size_t)b * SEQ + (size_t)r * (SEQ >> lg)) * 128;
#define ATT_W2(X) pk2(X[0], X[1])
#define ATT_K16(V, LO, HI) do { _Pragma("unroll") for (int i_ = 0; i_ < 4; ++i_) { const f32x2 a_ = __builtin_amdgcn_cvt_pk_f32_fp8((int)(V)[i_], false), b_ = __builtin_amdgcn_cvt_pk_f32_fp8((int)(V)[i_], true); \
        if (i_ < 2) { (LO)[2 * i_] = ATT_W2(a_); (LO)[2 * i_ + 1] = ATT_W2(b_); } else { (HI)[2 * i_ - 4] = ATT_W2(a_); (HI)[2 * i_ - 3] = ATT_W2(b_); } } } while (0)
#define ATT_VT(V0, V1, C, JP, HALFSEL) do { _Pragma("unroll") for (int i_ = 0; i_ < 4; ++i_) { \
        const f32x2 a0_ = __builtin_amdgcn_cvt_pk_f32_fp8((int)(V0)[i_], false), b0_ = __builtin_amdgcn_cvt_pk_f32_fp8((int)(V0)[i_], true), a1_ = __builtin_amdgcn_cvt_pk_f32_fp8((int)(V1)[i_], false), b1_ = __builtin_amdgcn_cvt_pk_f32_fp8((int)(V1)[i_], true); \
        *(LAS unsigned*)(Vt + swz512(16 * (C) + 4 * i_ + 0, 256 * (HALFSEL) + 4 * (JP))) = pk2(a0_[0], a1_[0]); *(LAS unsigned*)(Vt + swz512(16 * (C) + 4 * i_ + 1, 256 * (HALFSEL) + 4 * (JP))) = pk2(a0_[1], a1_[1]); \
        *(LAS unsigned*)(Vt + swz512(16 * (C) + 4 * i_ + 2, 256 * (HALFSEL) + 4 * (JP))) = pk2(b0_[0], b1_[0]); *(LAS unsigned*)(Vt + swz512(16 * (C) + 4 * i_ + 3, 256 * (HALFSEL) + 4 * (JP))) = pk2(b0_[1], b1_[1]); } } while (0)
    {
        ATT_DECODE(u0)
        const int lane = lane0;
        const int jpv = 16 * (w >> 1) + (lane & 15), cv = 4 * (w & 1) + (lane >> 4);
        if (blk > 0) {
#pragma unroll
            for (int it = 0; it < 2; ++it) { const int item = it * 512 + tid, j = item >> 3, c = item & 7; const int ts = (blk - 1) * 128 + j;
                *(LAS u32x4*)(Ks + j * PK8 + 16 * c) = *(const u32x4*)(base_r + (size_t)ts * 128 + PKOFF + 16 * c); }
            { const int ts = (blk - 1) * 128 + 2 * jpv;
                const u32x4 v0 = *(const u32x4*)(base_r + (size_t)ts * 128 + 2 * PKOFF + 16 * cv), v1 = *(const u32x4*)(base_r + (size_t)(ts + 1) * 128 + 2 * PKOFF + 16 * cv);
                ATT_VT(v0, v1, cv, jpv, 0); }
        }
#pragma unroll
        for (int it = 0; it < 2; ++it) { const int item = it * 512 + tid, j = item >> 3, c = item & 7; kreg[it] = *(const u32x4*)(base_r + (size_t)(blk * 128 + j) * 128 + PKOFF + 16 * c); }
        { const int ts = blk * 128 + 2 * jpv;
            vreg[0] = *(const u32x4*)(base_r + (size_t)ts * 128 + 2 * PKOFF + 16 * cv); vreg[1] = *(const u32x4*)(base_r + (size_t)(ts + 1) * 128 + 2 * PKOFF + 16 * cv); }
        const int tq = blk * 128 + 16 * w + (lane & 15);
#pragma unroll
        for (int kk = 0; kk < 2; ++kk) qn[kk] = *(const u32x4*)(base_r + (size_t)tq * 128 + 64 * kk + 16 * (lane >> 4));
    }
    for (int u = u0; u < u1; ++u) {
        int lane = lane0; asm volatile("" : "+v"(lane));
        const int r16 = lane & 15, q4 = lane >> 4;
        ATT_DECODE(u)
        const int pp = pc; pc ^= 1;
        if (blk == 0) {
#pragma unroll
            for (int it = 0; it < 4; ++it) { const int item = it * 512 + tid, dd = item >> 4, c = item & 15; *(LAS u32x4*)(Vt + swz512(dd, 256 * pp + 16 * c)) = (u32x4){0u, 0u, 0u, 0u}; }
        }
#pragma unroll
        for (int it = 0; it < 2; ++it) { const int item = it * 512 + tid, j = item >> 3, c = item & 7; *(LAS u32x4*)(Ks + pc * (128 * P256) + j * PK8 + 16 * c) = kreg[it]; }
        { const int jpv = 16 * (w >> 1) + (lane & 15), cv = 4 * (w & 1) + (lane >> 4); ATT_VT(vreg[0], vreg[1], cv, jpv, pc); }
        const pg8::i32x8_t qf = __builtin_shufflevector(__builtin_bit_cast(pg8::i32x4_t, qn[0]), __builtin_bit_cast(pg8::i32x4_t, qn[1]), 0, 1, 2, 3, 4, 5, 6, 7);
        lds_barrier();
        if (u + 1 < u1) {
            const int un = u + 1;
            const int bgh2 = un >> 5, sub2 = un & 31, h2 = bgh2 & 7, bg2 = bgh2 >> 3, g2 = bg2 % 3, b2 = bg2 / 3;
            const int lg2 = (g2 == 0) ? 0 : ((g2 == 1) ? 2 : 4), nblk2 = 32 >> lg2, r2 = sub2 >> (5 - lg2), blk2 = sub2 & (nblk2 - 1);
            const unsigned char* base2 = PROJ + ((size_t)(g2 * 24 + h2) * T + (size_t)b2 * SEQ + (size_t)r2 * (SEQ >> lg2)) * 128;
#pragma unroll
            for (int it = 0; it < 2; ++it) { const int item = it * 512 + tid, j = item >> 3, c = item & 7; kreg[it] = *(const u32x4*)(base2 + (size_t)(blk2 * 128 + j) * 128 + PKOFF + 16 * c); }
            { const int jpv = 16 * (w >> 1) + (lane & 15), cv = 4 * (w & 1) + (lane >> 4); const int ts = blk2 * 128 + 2 * jpv;
                vreg[0] = *(const u32x4*)(base2 + (size_t)ts * 128 + 2 * PKOFF + 16 * cv); vreg[1] = *(const u32x4*)(base2 + (size_t)(ts + 1) * 128 + 2 * PKOFF + 16 * cv); }
            const int tq2 = blk2 * 128 + 16 * w + r16;
#pragma unroll
            for (int kk = 0; kk < 2; ++kk) qn[kk] = *(const u32x4*)(base2 + (size_t)tq2 * 128 + 64 * kk + 16 * q4);
        }
        f32x4 s[9];
#pragma unroll
        for (int kt = 0; kt < 9; ++kt) {
            const int ka = w + kt; const int hoff = ((ka < 8) ? pp : pc) * (128 * P256); const int row = 16 * (ka & 7) + r16;
            const u32x4 k0 = *(const LAS u32x4*)(Ks + hoff + row * PK8 + 16 * q4), k1 = *(const LAS u32x4*)(Ks + hoff + row * PK8 + 64 + 16 * q4);
            const pg8::i32x8_t kf = __builtin_shufflevector(__builtin_bit_cast(pg8::i32x4_t, k0), __builtin_bit_cast(pg8::i32x4_t, k1), 0, 1, 2, 3, 4, 5, 6, 7);
            s[kt] = __builtin_amdgcn_mfma_scale_f32_16x16x128_f8f6f4(kf, qf, (f32x4){0.f, 0.f, 0.f, 0.f}, 0, 0, 0, 0, 0, 0); }
        float mx = -INFINITY;
        const unsigned long long mk = (blk > 0) ? mA : mB; const unsigned mlo = (unsigned)mk, mhi = (unsigned)(mk >> 32);
#pragma unroll
        for (int kt = 0; kt < 9; ++kt)
#pragma unroll
            for (int jj = 0; jj < 4; ++jj) { const int bit = 4 * kt + jj; const bool valid = bit < 32 ? ((mlo >> bit) & 1u) : ((mhi >> (bit - 32)) & 1u);
                s[kt][jj] = valid ? s[kt][jj] : -INFINITY; mx = fmaxf(mx, s[kt][jj]); }
        mx = fmaxf(mx, __shfl_xor(mx, 16)); mx = fmaxf(mx, __shfl_xor(mx, 32));
        float ls = 0.f;
#pragma unroll
        for (int kt = 0; kt < 9; ++kt)
#pragma unroll
            for (int jj = 0; jj < 4; ++jj) { const float p = __builtin_amdgcn_exp2f((s[kt][jj] - mx) * (1.0f / (Q8_Q * Q8_K))); s[kt][jj] = p; ls += p; }
        ls += __shfl_xor(ls, 16); ls += __shfl_xor(ls, 32);
        f32x4 o[8];
#pragma unroll
        for (int dt = 0; dt < 8; ++dt) o[dt] = (f32x4){0.f, 0.f, 0.f, 0.f};
#pragma unroll
        for (int kp = 0; kp < 5; ++kp) {
            u32x4 pw; pw.x = pk2(s[2 * kp][0], s[2 * kp][1]); pw.y = pk2(s[2 * kp][2], s[2 * kp][3]);
            if (kp < 4) { pw.z = pk2(s[2 * kp + 1][0], s[2 * kp + 1][1]); pw.w = pk2(s[2 * kp + 1][2], s[2 * kp + 1][3]); } else { pw.z = 0u; pw.w = 0u; }
            const bf16x8 pf = as_bf16x8(pw);
            const int ka0 = w + 2 * kp, ka1 = ka0 + 1;
            const int c0 = 256 * ((ka0 < 8) ? pp : pc) + 2 * (16 * (ka0 & 7) + 4 * q4), c1 = 256 * ((ka1 < 8) ? pp : pc) + 2 * (16 * (ka1 & 7) + 4 * q4);
#pragma unroll
            for (int dt = 0; dt < 8; ++dt) { const int dd = 16 * dt + r16;
                const u32x2 lo = *(const LAS u32x2*)(Vt + swz512(dd, c0));
                u32x2 hi = (u32x2){0u, 0u}; if (kp < 4) hi = *(const LAS u32x2*)(Vt + swz512(dd, c1));
                const u32x4 av = (u32x4){lo.x, lo.y, hi.x, hi.y};
                o[dt] = mfma16(as_bf16x8(av), pf, o[dt]); }
        }
        const float inv = Q8_O / (ls * Q8_V);
        const int tq = blk * 128 + 16 * w + r16;
        const size_t tokq = (size_t)b * SEQ + (size_t)tq * dl + r;
        unsigned char* op = OG + ((size_t)g * T + tokq) * DM + h * 128 + 4 * q4;
#pragma unroll
        for (int dt = 0; dt < 8; ++dt) *(unsigned*)(op + 16 * dt) = pk4_f8(o[dt][0], o[dt][1], o[dt][2], o[dt][3], inv);
        if (q4 == 0) LSE[((size_t)g * T + tokq) * 8 + h] = (mx * (1.0f / (Q8_Q * Q8_K)) + __builtin_amdgcn_logf(ls)) * LN2F;
        lds_barrier();
    }
#undef ATT_DECODE
#undef ATT_W2
#undef ATT_K16
#undef ATT_VT
}

__device__ __forceinline__ void combine_phase(const unsigned char* __restrict__ OG, const float* __restrict__ LSE, unsigned char* __restrict__ OB, int G, int vcu) {
    const int tid = threadIdx.x, lane = tid & 63, w = tid >> 6;
    const int gw = vcu * 8 + w, NGW = G * 8;
    for (int row = gw; row < T; row += NGW) {
#pragma unroll
        for (int j = 0; j < 2; ++j) { const int col = 8 * lane + 512 * j, head = col >> 7;
            const float l0 = LSE[((size_t)0 * T + row) * 8 + head], l1 = LSE[((size_t)1 * T + row) * 8 + head], l2 = LSE[((size_t)2 * T + row) * 8 + head];
            const float m = fmaxf(l0, fmaxf(l1, l2)); float w0 = __expf(l0 - m), w1 = __expf(l1 - m), w2 = __expf(l2 - m); const float inv = 1.0f / (w0 + w1 + w2); w0 *= inv; w1 *= inv; w2 *= inv;
            const u32x2 a0 = *(const u32x2*)(OG + ((size_t)0 * T + row) * DM + col), a1 = *(const u32x2*)(OG + ((size_t)1 * T + row) * DM + col), a2 = *(const u32x2*)(OG + ((size_t)2 * T + row) * DM + col);
            float ov[8];
#pragma unroll
            for (int wd = 0; wd < 2; ++wd) {
                const f32x2 x0 = __builtin_amdgcn_cvt_pk_f32_fp8((int)a0[wd], false), x1 = __builtin_amdgcn_cvt_pk_f32_fp8((int)a1[wd], false), x2 = __builtin_amdgcn_cvt_pk_f32_fp8((int)a2[wd], false);
                const f32x2 y0 = __builtin_amdgcn_cvt_pk_f32_fp8((int)a0[wd], true), y1 = __builtin_amdgcn_cvt_pk_f32_fp8((int)a1[wd], true), y2 = __builtin_amdgcn_cvt_pk_f32_fp8((int)a2[wd], true);
                ov[4 * wd] = w0 * x0[0] + w1 * x1[0] + w2 * x2[0]; ov[4 * wd + 1] = w0 * x0[1] + w1 * x1[1] + w2 * x2[1]; ov[4 * wd + 2] = w0 * y0[0] + w1 * y1[0] + w2 * y2[0]; ov[4 * wd + 3] = w0 * y0[1] + w1 * y1[1] + w2 * y2[1]; }
            u32x2 o; o.x = pk4_f8(ov[0], ov[1], ov[2], ov[3], 1.0f); o.y = pk4_f8(ov[4], ov[5], ov[6], ov[7], 1.0f);
            *(u32x2*)(OB + (size_t)row * DM + col) = o; }
    }
}

__device__ __forceinline__ void ln_preload(LAS unsigned char* lds, const float* __restrict__ W32, int wpitch, int t0 = 0, int nthr = 512) {
    const int tid = (int)threadIdx.x - t0; LAS float* wl = (LAS float*)lds;
#pragma unroll 4
    for (int idx = tid; idx < 32768; idx += nthr) { const int k = idx >> 5, e = idx & 31; const int slot = (((k >> 8) * 4 + (k & 3)) * 64) + ((k >> 2) & 63);
        wl[slot * 36 + e] = W32[(size_t)k * wpitch + e]; }
}
template <int MIXSRC, int POST, bool WRITE_B, bool WRITE_F, bool XF32 = false>
__device__ __forceinline__ void ln_phase(LAS unsigned char* lds, const bf16* __restrict__ xres, const bf16* __restrict__ mixf, const unsigned char* __restrict__ YS, const float* __restrict__ gates_in,
                                         const float* __restrict__ gamma, const float* __restrict__ beta, float* outf, bf16* __restrict__ outb,
                                         const float* __restrict__ W32, int wpitch, const float* __restrict__ bias32, float* __restrict__ gates_out, int* __restrict__ lists, unsigned* counts, float* __restrict__ DTout,
                                         int G, int vcu, unsigned char* __restrict__ outq = nullptr) {
    const int tid = threadIdx.x, lane = tid & 63, w = __builtin_amdgcn_readfirstlane(tid >> 6);
    LAS float* wl = (LAS float*)lds;
    LAS int* sel_e = (LAS int*)(lds + LDS_SM); LAS int* sel_rk = sel_e + 512; LAS int* lcnt = sel_e + 1024; LAS int* gbase = sel_e + 1056;
    if (POST) {
        if (MK_PER_PHASE) ln_preload(lds, W32, wpitch);
        if (POST == 1 && tid < 32) lcnt[tid] = 0;
        __syncthreads();
    }
    int ebr = 0;
#pragma unroll
    for (int bb = 0; bb < 5; ++bb) ebr |= ((lane >> bb) & 1) << (4 - bb);
    float mybias = 0.f; if (POST) mybias = bias32[ebr];
    for (int chunk = vcu; chunk < T / 128; chunk += G) {
        u32x2 nxr[4], nmx[4]; f32x4 nxf[XF32 ? 4 : 1]; unsigned nys[4][4]; f32x4 ngv = (f32x4){0.f, 0.f, 0.f, 0.f};
        { const size_t row = (size_t)chunk * 128 + w * 16;
            if (MIXSRC == 1) ngv = *(const f32x4*)(gates_in + row * 4);
#pragma unroll
            for (int j = 0; j < 4; ++j) { if (XF32) nxf[XF32 ? j : 0] = *(const f32x4*)((const float*)xres + row * DM + 4 * lane + 256 * j); else nxr[j] = *(const u32x2*)(xres + row * DM + 4 * lane + 256 * j);
                if (MIXSRC == 0) nmx[j] = *(const u32x2*)(mixf + row * DM + 4 * lane + 256 * j);
                else {
#pragma unroll
                    for (int k = 0; k < 4; ++k) nys[j][k] = __builtin_nontemporal_load((const unsigned*)(YS + (row * 4 + k) * DM + 4 * lane + 256 * j)); } } }
        for (int pass = 0; pass < 16; ++pass) {
            const int rl = w * 16 + pass; const size_t row = (size_t)chunk * 128 + rl;
            asm volatile("" ::: "memory");
            int lo = lane; asm volatile("" : "+v"(lo));
            float xv[16];
            {
                f32x4 v[4]; float s = 0.f;
                const f32x4 gv = ngv * (MIXSRC == 1 ? 1.0f / Q8_Y : 1.0f);
#pragma unroll
                for (int j = 0; j < 4; ++j) {
                    f32x4 mix;
                    if (MIXSRC == 0) mix = (f32x4){bflo(nmx[j].x), bfhi(nmx[j].x), bflo(nmx[j].y), bfhi(nmx[j].y)};
                    else { mix = (f32x4){0.f, 0.f, 0.f, 0.f};
#pragma unroll
                        for (int k = 0; k < 4; ++k) { const f32x2 ylo = __builtin_amdgcn_cvt_pk_f32_fp8((int)nys[j][k], false), yhi = __builtin_amdgcn_cvt_pk_f32_fp8((int)nys[j][k], true);
                            mix[0] += gv[k] * ylo[0]; mix[1] += gv[k] * ylo[1]; mix[2] += gv[k] * yhi[0]; mix[3] += gv[k] * yhi[1]; } }
                    const f32x4 xr = XF32 ? nxf[XF32 ? j : 0] : (f32x4){bflo(nxr[j].x), bfhi(nxr[j].x), bflo(nxr[j].y), bfhi(nxr[j].y)};
                    v[j] = xr * ALPHA + mix; s += (v[j][0] + v[j][1]) + (v[j][2] + v[j][3]);
                }
                if (pass < 15) { const size_t nrow = row + 1;
                    if (MIXSRC == 1) ngv = *(const f32x4*)(gates_in + nrow * 4);
#pragma unroll
                    for (int j = 0; j < 4; ++j) { if (XF32) nxf[XF32 ? j : 0] = *(const f32x4*)((const float*)xres + nrow * DM + 4 * lo + 256 * j); else nxr[j] = *(const u32x2*)(xres + nrow * DM + 4 * lo + 256 * j);
                        if (MIXSRC == 0) nmx[j] = *(const u32x2*)(mixf + nrow * DM + 4 * lo + 256 * j);
                        else {
#pragma unroll
                            for (int k = 0; k < 4; ++k) nys[j][k] = __builtin_nontemporal_load((const unsigned*)(YS + (nrow * 4 + k) * DM + 4 * lo + 256 * j)); } } }
                const float mean = wave_sum(s) * (1.0f / DM); float s2 = 0.f;
#pragma unroll
                for (int j = 0; j < 4; ++j) { v[j] = v[j] - mean; s2 += (v[j][0] * v[j][0] + v[j][1] * v[j][1]) + (v[j][2] * v[j][2] + v[j][3] * v[j][3]); }
                const float rstd = 1.0f / sqrtf(wave_sum(s2) * (1.0f / DM) + LN_EPS);
#pragma unroll
                for (int j = 0; j < 4; ++j) { const f32x4 gm = *(const f32x4*)(gamma + 4 * lo + 256 * j), bt = *(const f32x4*)(beta + 4 * lo + 256 * j);
                    const f32x4 y = v[j] * rstd * gm + bt;
                    if (WRITE_F) __builtin_nontemporal_store(y, (f32x4*)(outf + row * DM + 4 * lo + 256 * j));
                    if (WRITE_B) { u32x2 q; q.x = pk2(y[0], y[1]); q.y = pk2(y[2], y[3]); *(u32x2*)(outb + row * DM + 4 * lo + 256 * j) = q; }
                    if (POST) *(unsigned*)(outq + row * DM + 4 * lo + 256 * j) = pk4_f8(y[0], y[1], y[2], y[3], Q8_X);
                    xv[4 * j + 0] = y[0]; xv[4 * j + 1] = y[1]; xv[4 * j + 2] = y[2]; xv[4 * j + 3] = y[3]; }
            }
            if (POST) {
                f32x2 acc2[16];
#pragma unroll
                for (int e = 0; e < 16; ++e) acc2[e] = (f32x2){0.f, 0.f};
#pragma unroll
                for (int jj = 0; jj < 16; ++jj) { const LAS float* wrow = wl + (jj * 64 + lane) * 36;
                    if ((jj & 1) == 0) asm volatile("" ::: "memory");
                    const f32x2 xx = (f32x2){xv[jj], xv[jj]};
#pragma unroll
                    for (int e4 = 0; e4 < 8; ++e4) { const f32x4 wv = *(const LAS f32x4*)(wrow + 4 * e4);
                        acc2[2 * e4] = acc2[2 * e4] + xx * (f32x2){wv[0], wv[1]}; acc2[2 * e4 + 1] = acc2[2 * e4 + 1] + xx * (f32x2){wv[2], wv[3]}; } }
                float acc0[32];
#pragma unroll
                for (int e = 0; e < 32; ++e) acc0[e] = acc2[e >> 1][e & 1];
#pragma unroll
                for (int bb = 0; bb < 5; ++bb) { const int hh = 16 >> bb; const unsigned um = ((lane >> bb) & 1) ? 0xffffffffu : 0u;
#pragma unroll
                    for (int i = 0; i < hh; ++i) { const unsigned l0 = __float_as_uint(acc0[i]), h0 = __float_as_uint(acc0[i + hh]);
                        const float k0 = __uint_as_float((h0 & um) | (l0 & ~um)), s0 = __uint_as_float((l0 & um) | (h0 & ~um)); acc0[i] = k0 + __shfl_xor(s0, 1 << bb); } }
                const float lg0 = acc0[0] + __shfl_xor(acc0[0], 32) + mybias;
                if (POST == 1) {
                    const unsigned ub = __float_as_uint(lg0); const unsigned uo = (ub & 0x80000000u) ? ~ub : (ub | 0x80000000u);
                    unsigned key = (uo & ~31u) | (unsigned)(31 - ebr);
                    float top0 = 0.f, myv = 0.f, esum = 0.f; int ek = 0;
#pragma unroll
                    for (int k = 0; k < 4; ++k) { unsigned bk = key;
#pragma unroll
                        for (int off = 1; off < 32; off <<= 1) { const unsigned ok = (unsigned)__shfl_xor((int)bk, off); bk = ok > bk ? ok : bk; }
                        const int be = 31 - (int)(__builtin_amdgcn_readfirstlane(bk) & 31u);
                        int wl_ = 0;
#pragma unroll
                        for (int bb = 0; bb < 5; ++bb) wl_ |= ((be >> bb) & 1) << (4 - bb);
                        const float bv = __uint_as_float(__builtin_amdgcn_readlane(__float_as_uint(lg0), wl_));
                        if (k == 0) top0 = bv;
                        const float ex = __expf(bv - top0); esum += ex;
                        myv = (lane == k) ? ex : myv; ek = (lane == k) ? be : ek; key = (ebr == be) ? 0u : key; }
                    if (lane < 4) {
                        gates_out[row * 4 + lane] = myv / esum;
                        const int rk = __hip_atomic_fetch_add(lcnt + ek, 1, __ATOMIC_RELAXED, __HIP_MEMORY_SCOPE_WORKGROUP);
                        sel_e[rl * 4 + lane] = ek; sel_rk[rl * 4 + lane] = rk; }
                } else {
                    if (lane < 32) { const float xx = lg0; const float y = __expf(-fabsf(xx)); const float l1p = (y < 1e-3f) ? (y - 0.5f * y * y) : __logf(1.0f + y);
                        DTout[row * 32 + ebr] = fmaxf(xx, 0.f) + l1p; }
                }
            }
        }
        if (POST == 1) {
            __syncthreads();
            if (tid < 32) gbase[tid] = (int)__hip_atomic_fetch_add(counts + tid, (unsigned)lcnt[tid], __ATOMIC_RELAXED, __HIP_MEMORY_SCOPE_AGENT);
            __syncthreads();
            { const int e = sel_e[tid]; lists[(size_t)e * 32768 + gbase[e] + sel_rk[tid]] = (chunk * 128 + (tid >> 2)) * 4 + (tid & 3); }
            __syncthreads();
            if (tid < 32) lcnt[tid] = 0;
            __syncthreads();
        }
    }
}

__device__ __forceinline__ void conv_item(const bf16* __restrict__ ZX, const float* __restrict__ conv_w, const float* __restrict__ conv_b, int tok0, int ch, u32x4 (&q)[8]) {
    const int sl = tok0 & (SEQ - 1);
    u32x4 raw[11];
#pragma unroll
    for (int i = 0; i < 11; ++i) { if (sl - 3 + i >= 0) raw[i] = *(const u32x4*)(ZX + (size_t)(tok0 - 3 + i) * NZX + 2048 + ch); else raw[i] = (u32x4){0u, 0u, 0u, 0u}; }
    f32x2 cw[4][4], cb[4];
#pragma unroll
    for (int k = 0; k < 4; ++k)
#pragma unroll
        for (int p = 0; p < 4; ++p) cw[k][p] = *(const f32x2*)(conv_w + (size_t)k * 3072 + ch + 2 * p);
#pragma unroll
    for (int p = 0; p < 4; ++p) cb[p] = *(const f32x2*)(conv_b + ch + 2 * p);
    f32x2 xin[11][4];
#pragma unroll
    for (int i = 0; i < 11; ++i)
#pragma unroll
        for (int p = 0; p < 4; ++p) xin[i][p] = (f32x2){bflo(raw[i][p]), bfhi(raw[i][p])};
#pragma unroll
    for (int t = 0; t < 8; ++t)
#pragma unroll
        for (int p = 0; p < 4; ++p) { f32x2 a = cb[p];
#pragma unroll
            for (int k = 0; k < 4; ++k) a = a + cw[k][p] * xin[t + k][p];
            q[t][p] = pk2(silu_f(a[0]), silu_f(a[1])); }
}
__device__ __forceinline__ void convcb_phase(LAS unsigned char* lds, const bf16* __restrict__ ZX, const float* __restrict__ conv_w, const float* __restrict__ conv_b, bf16* __restrict__ XA, bf16* __restrict__ CBG, int G, int vcu) {
    const int tid = threadIdx.x, lane = tid & 63, w = __builtin_amdgcn_readfirstlane(tid >> 6), r16 = lane & 15, q4 = lane >> 4;
    LAS unsigned char *Cs = lds, *Bs = lds + 128 * P256;
    for (int u = vcu; u < BATCH * 32; u += G) {
        const int tokc = u * 128;
        for (int it = 0; it < 8; ++it) { const int item = it * 512 + tid, cg = item & 255, tb = item >> 8;
            u32x4 q[8]; conv_item(ZX, conv_w, conv_b, tokc + 8 * tb, 8 * cg, q);
#pragma unroll
            for (int t = 0; t < 8; ++t) *(u32x4*)(XA + (size_t)(tokc + 8 * tb + t) * 3072 + 8 * cg) = q[t]; }
        for (int g = 0; g < 4; ++g) {
            { const int cgl = tid & 31, tb = tid >> 5; const int ch = (cgl < 16) ? (2048 + g * 128 + 8 * cgl) : (2560 + g * 128 + 8 * (cgl - 16));
                u32x4 q[8]; conv_item(ZX, conv_w, conv_b, tokc + 8 * tb, ch, q);
                LAS unsigned char* dst = (cgl < 16) ? Bs : Cs;
#pragma unroll
                for (int t = 0; t < 8; ++t) { *(u32x4*)(XA + (size_t)(tokc + 8 * tb + t) * 3072 + ch) = q[t]; *(LAS u32x4*)(dst + swz256(8 * tb + t, 16 * (cgl & 15))) = q[t]; } }
            __syncthreads();
            bf16x8 cf[4];
#pragma unroll
            for (int kk = 0; kk < 4; ++kk) cf[kk] = *(const LAS bf16x8*)(Cs + swz256(16 * w + r16, 64 * kk + 16 * q4));
            bf16* outp = CBG + ((size_t)u * 4 + g) * 16384 + (size_t)(16 * w + r16) * 128 + 4 * q4;
#pragma unroll
            for (int st = 0; st < 8; ++st) { f32x4 m = (f32x4){0.f, 0.f, 0.f, 0.f};
#pragma unroll
                for (int kk = 0; kk < 4; ++kk) { const bf16x8 a = *(const LAS bf16x8*)(Bs + swz256(16 * st + r16, 64 * kk + 16 * q4)); m = mfma16(a, cf[kk], m); }
                u32x2 q; q.x = pk2(m[0], m[1]); q.y = pk2(m[2], m[3]); *(u32x2*)(outp + 16 * st) = q; }
            __syncthreads();
        }
    }
}
__device__ __forceinline__ void ssd_phase(LAS unsigned char* lds, const bf16* __restrict__ ZX, const bf16* __restrict__ XA, const bf16* __restrict__ CBG, const float* __restrict__ DT,
                                          const float* __restrict__ a_log, const float* __restrict__ d_skip, unsigned char* __restrict__ Y, float* SSQ, int G, int vcu) {
    const int tid = threadIdx.x, lane = tid & 63, w = __builtin_amdgcn_readfirstlane(tid >> 6), r16_0 = lane & 15, q4_0 = lane >> 4;
    constexpr int SZ_BT = 128 * P256, SZ_XT = 64 * P256, O_XT = 2 * SZ_BT, O_PR = O_XT + 2 * SZ_XT, O_FA = O_PR + 2 * SZ_XT;
    LAS float* fa = (LAS float*)(lds + O_FA);
    for (int u = vcu; u < BATCH * 32; u += G) {
        const int b = u >> 5, h = u & 31, g = h >> 3;
        const float Ah = -__expf(a_log[h]); const float Dh = d_skip[h];
        f32x4 st[4];
#pragma unroll
        for (int pt = 0; pt < 4; ++pt) st[pt] = (f32x4){0.f, 0.f, 0.f, 0.f};
        const int jp = 16 * (w & 3) + (lane & 15);
        const unsigned voff = (unsigned)jp * 12288u + (unsigned)(lane >> 4) * 16u;
        int chb[3];
#pragma unroll
        for (int it = 0; it < 3; ++it) { const int gq = 2 * it + (w >> 2); chb[it] = 2 * ((it == 0) ? (h * 64 + 32 * gq) : (2048 + g * 128 + 32 * (gq - 2))); }
        const char* xab = (const char*)XA + (size_t)b * SEQ * 6144;
        const bf16* cbb = CBG + ((size_t)(b * 32) * 4 + g) * 16384;
        u32x4 pre[3][2]; float dn0 = 0.f, dn1 = 0.f; u32x2 cbr[8]; u32x4 cfr[4];
        {
#pragma unroll
            for (int it = 0; it < 3; ++it) { const char* sb = xab + chb[it]; pre[it][0] = *(const u32x4*)(sb + voff); pre[it][1] = *(const u32x4*)(sb + voff + 6144); }
            if (w == 0) { dn0 = DT[((size_t)b * SEQ + 2 * lane) * 32 + h]; dn1 = DT[((size_t)b * SEQ + 2 * lane + 1) * 32 + h]; }
        }
        for (int c = 0; c <= 32; ++c) {
            const int r16 = r16_0, q4 = q4_0;
            const int sb_ = c & 1;
            LAS unsigned char* BTn = lds + sb_ * SZ_BT; LAS unsigned char* xTn = lds + O_XT + sb_ * SZ_XT; LAS unsigned char* prn = lds + O_PR + sb_ * SZ_XT; LAS float* fan = fa + sb_ * 512;
            if (c >= 1) {
                const int cc = c - 1, cb_ = cc & 1; const int tok0 = b * SEQ + cc * 128;
                LAS unsigned char* BTs = lds + cb_ * SZ_BT; LAS unsigned char* xTs = lds + O_XT + cb_ * SZ_XT; LAS unsigned char* prevs = lds + O_PR + cb_ * SZ_XT;
                LAS float* acum = fa + cb_ * 512; LAS float* dtv = acum + 128; LAS float* wdec = acum + 256;
                const int l = 16 * w + r16;
                u32x2 zz[4];
#pragma unroll
                for (int pt = 0; pt < 4; ++pt) zz[pt] = *(const u32x2*)(ZX + ((size_t)tok0 + l) * NZX + h * 64 + 16 * pt + 4 * q4);
                const float al = acum[l];
                bf16x8 pf[4];
#pragma unroll
                for (int kp = 0; kp < 4; ++kp) {
                    const f32x4 as0 = *(const LAS f32x4*)(acum + 32 * kp + 4 * q4), ds0 = *(const LAS f32x4*)(dtv + 32 * kp + 4 * q4), as1 = *(const LAS f32x4*)(acum + 32 * kp + 16 + 4 * q4), ds1 = *(const LAS f32x4*)(dtv + 32 * kp + 16 + 4 * q4);
                    const u32x2 c0 = cbr[2 * kp], c1 = cbr[2 * kp + 1];
                    const float m0[4] = {bflo(c0.x), bfhi(c0.x), bflo(c0.y), bfhi(c0.y)}, m1[4] = {bflo(c1.x), bfhi(c1.x), bflo(c1.y), bfhi(c1.y)};
                    float mm[8];
#pragma unroll
                    for (int jj = 0; jj < 4; ++jj) { const int s_0 = 32 * kp + 4 * q4 + jj, s_1 = s_0 + 16;
                        mm[jj] = (s_0 <= l) ? m0[jj] * __expf(fminf(al - as0[jj], 0.f)) * ds0[jj] : 0.f; mm[4 + jj] = (s_1 <= l) ? m1[jj] * __expf(fminf(al - as1[jj], 0.f)) * ds1[jj] : 0.f; }
                    u32x4 pw; pw.x = pk2(mm[0], mm[1]); pw.y = pk2(mm[2], mm[3]); pw.z = pk2(mm[4], mm[5]); pw.w = pk2(mm[6], mm[7]); pf[kp] = as_bf16x8(pw); }
                f32x4 y[4];
#pragma unroll
                for (int pt = 0; pt < 4; ++pt) { y[pt] = (f32x4){0.f, 0.f, 0.f, 0.f};
#pragma unroll
                    for (int kk = 0; kk < 4; ++kk) { const bf16x8 a = *(const LAS bf16x8*)(prevs + swz256(16 * pt + r16, 64 * kk + 16 * q4)); y[pt] = mfma16(a, as_bf16x8(cfr[kk]), y[pt]); } }
                const float el = __expf(al);
#pragma unroll
                for (int pt = 0; pt < 4; ++pt) y[pt] = y[pt] * el;
#pragma unroll
                for (int kp = 0; kp < 4; ++kp)
#pragma unroll
                    for (int pt = 0; pt < 4; ++pt) { const u32x2 lo = *(const LAS u32x2*)(xTs + swz256(16 * pt + r16, 64 * kp + 8 * q4)), hi = *(const LAS u32x2*)(xTs + swz256(16 * pt + r16, 64 * kp + 32 + 8 * q4));
                        const u32x4 av = (u32x4){lo.x, lo.y, hi.x, hi.y}; y[pt] = mfma16(as_bf16x8(av), pf[kp], y[pt]); }
                if (c < 32) { const bf16* cp = cbb + (size_t)c * 65536 + (size_t)(16 * w + r16) * 128 + 4 * q4;
#pragma unroll
                    for (int i = 0; i < 8; ++i) cbr[i] = *(const u32x2*)(cp + 16 * i);
                    const bf16* ccp = XA + ((size_t)b * SEQ + c * 128 + 16 * w + r16) * 3072 + 2560 + g * 128 + 8 * q4;
#pragma unroll
                    for (int kk = 0; kk < 4; ++kk) cfr[kk] = *(const u32x4*)(ccp + 32 * kk); }
                { const size_t tok = (size_t)tok0 + l; float ssq = 0.f;
#pragma unroll
                    for (int pt = 0; pt < 4; ++pt) { const int p0 = 16 * pt + 4 * q4;
                        float ov[4];
#pragma unroll
                        for (int jj = 0; jj < 4; ++jj) { const float xvv = bf2f(*(const LAS unsigned short*)(xTs + swz256(p0 + jj, 2 * l)));
                            const unsigned zw = (jj < 2) ? zz[pt].x : zz[pt].y; const float zf = (jj & 1) ? bfhi(zw) : bflo(zw);
                            ov[jj] = (y[pt][jj] + Dh * xvv) * silu_f(zf); }
                        ssq += (ov[0] * ov[0] + ov[1] * ov[1]) + (ov[2] * ov[2] + ov[3] * ov[3]);
                        *(unsigned*)(Y + tok * DI + h * 64 + p0) = pk4_f8(ov[0], ov[1], ov[2], ov[3], Q8_YS); }
                    ssq += __shfl_xor(ssq, 16); ssq += __shfl_xor(ssq, 32);
                    if (q4 == 0) SSQ[tok * 32 + h] = ssq; }
                { const float dec = __expf(acum[384]);
#pragma unroll
                    for (int pt = 0; pt < 4; ++pt) st[pt] = st[pt] * dec;
#pragma unroll
                    for (int kk = 0; kk < 4; ++kk) { const u32x4 a = *(const LAS u32x4*)(BTs + swz256(16 * w + r16, 64 * kk + 16 * q4));
                        const f32x4 w0 = *(const LAS f32x4*)(wdec + 32 * kk + 8 * q4), w1 = *(const LAS f32x4*)(wdec + 32 * kk + 8 * q4 + 4);
                        u32x4 aw; aw.x = pk2(bflo(a.x) * w0[0], bfhi(a.x) * w0[1]); aw.y = pk2(bflo(a.y) * w0[2], bfhi(a.y) * w0[3]); aw.z = pk2(bflo(a.z) * w1[0], bfhi(a.z) * w1[1]); aw.w = pk2(bflo(a.w) * w1[2], bfhi(a.w) * w1[3]);
#pragma unroll
                        for (int pt = 0; pt < 4; ++pt) { const bf16x8 bfr = *(const LAS bf16x8*)(xTs + swz256(16 * pt + r16, 64 * kk + 16 * q4)); st[pt] = mfma16(as_bf16x8(aw), bfr, st[pt]); } } }
            } else {
                const bf16* cp = cbb + (size_t)(16 * w + r16) * 128 + 4 * q4;
#pragma unroll
                for (int i = 0; i < 8; ++i) cbr[i] = *(const u32x2*)(cp + 16 * i);
                const bf16* ccp = XA + ((size_t)b * SEQ + 16 * w + r16) * 3072 + 2560 + g * 128 + 8 * q4;
#pragma unroll
                for (int kk = 0; kk < 4; ++kk) cfr[kk] = *(const u32x4*)(ccp + 32 * kk);
            }
            if (c < 32) {
#pragma unroll
                for (int pt = 0; pt < 4; ++pt) { u32x2 q; q.x = pk2(st[pt][0], st[pt][1]); q.y = pk2(st[pt][2], st[pt][3]); *(LAS u32x2*)(prn + swz256(16 * pt + r16, 2 * (16 * w + 4 * q4))) = q; }
                if (w == 0) { const int t0 = 2 * lane; const float d0 = dn0, d1 = dn1;
                    const float a0 = d0 * Ah, a1 = d1 * Ah; const float sm = a0 + a1; float incl = sm;
#pragma unroll
                    for (int off = 1; off < 64; off <<= 1) { const float v = __shfl_up(incl, off); if (lane >= off) incl += v; }
                    const float c0 = (incl - sm) + a0, c1 = incl; const float tot = __shfl(incl, 63);
                    fan[t0] = c0; fan[t0 + 1] = c1; fan[128 + t0] = d0; fan[128 + t0 + 1] = d1; fan[256 + t0] = d0 * __expf(tot - c0); fan[256 + t0 + 1] = d1 * __expf(tot - c1); if (lane == 63) fan[384] = tot; }
#pragma unroll
                for (int it = 0; it < 3; ++it) { const int cgi = 4 * (2 * it + (w >> 2)) + (lane >> 4);
                    LAS unsigned char* dst = (it == 0) ? xTn : BTn; const int r0 = (it == 0) ? (8 * cgi) : (8 * (cgi - 8));
#pragma unroll
                    for (int i = 0; i < 8; ++i) { const unsigned a0 = pre[it][0][i >> 1], a1 = pre[it][1][i >> 1];
                        const unsigned lo = (i & 1) ? (a0 >> 16) : (a0 & 0xffffu), hi = (i & 1) ? (a1 & 0xffff0000u) : (a1 << 16);
                        *(LAS unsigned*)(dst + swz256(r0 + i, 4 * jp)) = lo | hi; } }
                if (c < 31) {
#pragma unroll
                    for (int it = 0; it < 3; ++it) { const char* sb = xab + (size_t)(c + 1) * (128 * 6144) + chb[it]; pre[it][0] = *(const u32x4*)(sb + voff); pre[it][1] = *(const u32x4*)(sb + voff + 6144); }
                    if (w == 0) { const size_t t1 = (size_t)b * SEQ + (c + 1) * 128; dn0 = DT[(t1 + 2 * lane) * 32 + h]; dn1 = DT[(t1 + 2 * lane + 1) * 32 + h]; }
                }
            }
            lds_barrier();
        }
    }
}
__device__ __forceinline__ void rmsnorm_phase(bf16* Y, int G, int vcu) {
    const int tid = threadIdx.x, lane = tid & 63, w = tid >> 6;
    const int gw = vcu * 8 + w, NGW = G * 8;
    for (int row = gw; row < T; row += NGW) {
        u32x4* rp = (u32x4*)(Y + (size_t)row * DI) + lane;
#pragma unroll
        for (int j = 0; j < 4; ++j) { const u32x4 a = rp[64 * j]; float f[8]; float ss = 0.f;
#pragma unroll
            for (int i = 0; i < 4; ++i) { f[2 * i] = bflo(a[i]); f[2 * i + 1] = bfhi(a[i]); ss += f[2 * i] * f[2 * i] + f[2 * i + 1] * f[2 * i + 1]; }
            const float sc = 1.0f / sqrtf(wave_sum(ss) * (1.0f / 512.0f) + RMS_EPS);
            u32x4 o;
#pragma unroll
            for (int i = 0; i < 4; ++i) o[i] = pk2(f[2 * i] * sc, f[2 * i + 1] * sc);
            rp[64 * j] = o; }
    }
}

__device__ __forceinline__ int moe_tables(LAS unsigned char* lds, const unsigned* counts) {
    const int tid = threadIdx.x;
    LAS int* tab = (LAS int*)(lds + LDS_TAB);
    if (tid < 32) tab[64 + tid] = (int)__hip_atomic_load(counts + tid, __ATOMIC_RELAXED, __HIP_MEMORY_SCOPE_AGENT);
    __syncthreads();
    if (tid == 0) { int pre = 0; for (int e = 0; e < 32; ++e) { tab[e] = pre; pre += (tab[64 + e] + 255) >> 8; } tab[32] = pre; }
    __syncthreads();
    const int NB = tab[32];
    for (int rb = tid; rb < NB; rb += 512) { int e = 0; while (e < 31 && tab[e + 1] <= rb) ++e; tab[128 + rb] = e; }
    __syncthreads();
    return NB;
}

struct Args { const void* in[22]; float* out; unsigned char* ws; int ph_lo, ph_hi; };
__global__ void __launch_bounds__(512, 2) fwd_kernel(Args args) {
    extern __shared__ __attribute__((aligned(16))) unsigned char lds_raw[];
    LAS unsigned char* lds = (LAS unsigned char*)lds_raw;
    const int tid = threadIdx.x;
    const int G = gridDim.x; const int bx = blockIdx.x; const int vcu = (G % 8 == 0) ? (bx % 8) * (G / 8) + bx / 8 : bx;
    unsigned char* ws = args.ws;
    unsigned* ctl = (unsigned*)(ws + WS_CTL);
    Ptrs P;
    P.x = (const float*)args.in[0]; P.pos = (const int*)args.in[1]; P.attn_w_in = (const float*)args.in[2]; P.attn_w_out = (const float*)args.in[3]; P.ssm_w_in = (const float*)args.in[4];
    P.conv_w = (const float*)args.in[5]; P.conv_b = (const float*)args.in[6]; P.dt_bias = (const float*)args.in[7]; P.a_log = (const float*)args.in[8]; P.d_skip = (const float*)args.in[9];
    P.norm_w = (const float*)args.in[10]; P.ssm_w_out = (const float*)args.in[11]; P.w_router = (const float*)args.in[12]; P.b_router = (const float*)args.in[13]; P.w_up = (const float*)args.in[14];
    P.b_up = (const float*)args.in[15]; P.w_dn = (const float*)args.in[16]; P.b_dn = (const float*)args.in[17]; P.ln_mix_g = (const float*)args.in[18]; P.ln_mix_b = (const float*)args.in[19];
    P.ln_ffn_g = (const float*)args.in[20]; P.ln_ffn_b = (const float*)args.in[21];
    volatile LAS unsigned* misc = (volatile LAS unsigned*)(lds + LDS_MISC);
    if (tid < 64) misc[tid] = 0u;
    __syncthreads();
    XcdBarrier bar; bar.bar = ctl + CW_BAR; bar.x = 0; bar.st = misc;
    if (!MK_PER_PHASE) bar = xcd_barrier_post(ctl + CW_BAR, misc);
    const int lo = args.ph_lo, hi = args.ph_hi;
#ifndef PH_MASK
#define PH_MASK 0x1FFFF
#endif
#define IN(k) ((((PH_MASK) >> (k)) & 1) && lo <= (k) && (k) < hi)
#define SEAM(k) do { if (IN(k) && IN((k) + 1)) xcd_barrier(bar); } while (0)
#define SEAM_PRE(k, W, PITCH) do { if (IN(k) && IN((k) + 1)) { const float* w_ = (W); const int p_ = (PITCH); xcd_barrier(bar, [=]() { ln_preload(lds, w_, p_, 64, 448); }); } } while (0)

    bf16* Wqkv = (bf16*)(ws + WS_WQKV); bf16* Wao = (bf16*)(ws + WS_WAO); bf16* Wsi = (bf16*)(ws + WS_WSI); bf16* Wso = (bf16*)(ws + WS_WSO);
    bf16* XBA = (bf16*)(ws + WS_XBA); bf16* XBB = (bf16*)(ws + WS_XBB); bf16* MIXB = (bf16*)(ws + WS_X1);
    unsigned char* PROJ = ws + WS_BIG; bf16* ZX = (bf16*)(ws + WS_BIG); bf16* XA = (bf16*)(ws + WS_XA); bf16* CBG = (bf16*)(ws + WS_CBG); unsigned char* HB8 = ws + WS_HB; unsigned char* XQ = ws + WS_XQ; unsigned char* YS = ws + WS_YS;
    unsigned char* OG = ws + WS_OG; unsigned char* YB = ws + WS_OG;
    float* rope = (float*)(ws + WS_ROPE); float* gates = (float*)(ws + WS_GATES); float* DT = (float*)(ws + WS_DT); int* lists = (int*)(ws + WS_LIST); float* LSE = (float*)(ws + WS_LSE); float* SSQ = (float*)(ws + WS_LSE);

    if (IN(0)) { p0_prologue(lds, P, ws, G, vcu); }
    SEAM(0);


#define MOE_BLOCK(LAYER, PB) do { \
    unsigned* counts = ctl + CW_CNT + 64 * (LAYER); \
    if (IN((PB) + 0)) { \
        if ((LAYER) == 0) ln_phase<0, 1, true, false, true>(lds, (const bf16*)P.x, MIXB, nullptr, nullptr, P.ln_mix_g, P.ln_mix_b, nullptr, XBB, P.w_router, NE, P.b_router, gates, lists, counts, nullptr, G, vcu, XQ);   \
        else ln_phase<0, 1, true, false>(lds, XBA, MIXB, nullptr, nullptr, P.ln_mix_g + (LAYER) * DM, P.ln_mix_b + (LAYER) * DM, nullptr, XBB, \
                             P.w_router + (size_t)(LAYER) * DM * NE, NE, P.b_router + (LAYER) * NE, gates, lists, counts, nullptr, G, vcu, XQ); } \
    SEAM((PB) + 0); \
    if (IN((PB) + 1)) { \
        const int NB = moe_tables(lds, counts); \
        LAS int* tab = (LAS int*)(lds + LDS_TAB); LAS unsigned short* toks = (LAS unsigned short*)(lds + LDS_AUX); \
        const int NU = NB * 8; \
        const int nun = (vcu < NU) ? ((NU - vcu + G - 1) / G) : 0; \
        for (int idx = tid; idx < nun * 256 && idx < 17 * 256; idx += 512) { const int i = idx >> 8, row = idx & 255; const int L = i * G + vcu; const int rb = L >> 3; const int e = tab[128 + rb]; \
            const int r0 = (rb - tab[e]) * 256, cnt = tab[64 + e]; int si = r0 + row; si = si < cnt ? si : cnt - 1; toks[idx] = (unsigned short)(lists[(size_t)e * 32768 + si] >> 2); } \
        LAS unsigned* btab = (LAS unsigned*)(lds + LDS_SLOT); \
        for (int idx = tid; idx < nun * 128 && idx < 17 * 128; idx += 512) { const int i = idx >> 7, cp = idx & 127; const int L = i * G + vcu; const int rb = L >> 3, pn = L & 7; const int e = tab[128 + rb]; \
            const float* bsrc = P.b_up + ((size_t)(LAYER) * 32 + e) * 2048 + ((cp < 64) ? (pn * 128 + 2 * cp) : (1024 + pn * 128 + 2 * (cp - 64))); btab[idx] = pk2(bsrc[0], bsrc[1]); } \
        __syncthreads(); \
        pg8::MoeOrder<true> S; S.A = (const char*)XQ; S.Bt = (const char*)(ws + WS_WUP + (size_t)(LAYER) * 32 * 2048 * 1024); S.K = DM / 2;   S.N = 2048; S.nN = 8; S.G = G; S.c = vcu; S.NU = NU; S.tab = tab; S.toks = toks; \
        pg8::EpiUp E{HB8, btab}; \
        if ((LAYER) == 0) { pg8::HostCvt H; H.w_up = P.w_up + (size_t)32 * 1024 * 2048; H.w_dn = P.w_dn + (size_t)32 * 1024 * 1024; H.wt_up = ws + WS_WUP + (size_t)32 * 2048 * 1024; H.wt_dn = ws + WS_WDN + (size_t)32 * 1024 * 1024; \
            H.base = 0; H.limit = 49152; H.G = G; H.c = vcu;   \
            pg8::gemm_phase<true>(lds, DM / 2, S, E, H); } \
        else { pg8::HostNone H; pg8::gemm_phase<true>(lds, DM / 2, S, E, H); } } \
    SEAM((PB) + 1); \
    if (IN((PB) + 2)) { \
        const int NB = moe_tables(lds, counts); \
        LAS int* tab = (LAS int*)(lds + LDS_TAB); LAS int* slots = (LAS int*)(lds + LDS_SLOT); LAS unsigned* dbtab = (LAS unsigned*)(lds + LDS_AUX); \
        { const int NU = NB * 4; const int nun = (vcu < NU) ? ((NU - vcu + G - 1) / G) : 0; \
          for (int idx = tid; idx < nun * 256 && idx < 9 * 256; idx += 512) { const int i = idx >> 8, row = idx & 255; const int L = i * G + vcu; const int rb = L >> 2; const int e = tab[128 + rb]; \
              const int si = (rb - tab[e]) * 256 + row; slots[idx] = (si < tab[64 + e]) ? lists[(size_t)e * 32768 + si] : -1; } \
          for (int idx = tid; idx < nun * 128 && idx < 9 * 128; idx += 512) { const int i = idx >> 7, cp = idx & 127; const int L = i * G + vcu; const int rb = L >> 2, pn = L & 3; const int e = tab[128 + rb]; \
              const float* bsrc = P.b_dn + ((size_t)(LAYER) * 32 + e) * 1024 + pn * 256 + 2 * cp; dbtab[idx] = pk2(bsrc[0], bsrc[1]); } \
          __syncthreads(); } \
        pg8::MoeOrder<false> S; S.A = (const char*)HB8; S.Bt = (const char*)(ws + WS_WDN + (size_t)(LAYER) * 32 * 1024 * 1024); S.K = DM / 2; S.N = 1024; S.nN = 4; S.G = G; S.c = vcu; S.NU = NB * 4; S.tab = tab; S.toks = nullptr; \
        pg8::EpiDown E{YS, dbtab, slots}; \
        if ((LAYER) == 0) { pg8::HostCvt H; H.w_up = P.w_up + (size_t)32 * 1024 * 2048; H.w_dn = P.w_dn + (size_t)32 * 1024 * 1024; H.wt_up = ws + WS_WUP + (size_t)32 * 2048 * 1024; H.wt_dn = ws + WS_WDN + (size_t)32 * 1024 * 1024; \
            H.base = NB * 64; H.limit = 49152; H.G = G; H.c = vcu;   \
            pg8::gemm_phase<true>(lds, DM / 2, S, E, H); \
            } \
        else { pg8::HostNone H; pg8::gemm_phase<true>(lds, DM / 2, S, E, H); } } \
    if ((LAYER) == 0) SEAM_PRE((PB) + 2, P.ssm_w_in + NZX, SSM_PITCH); else SEAM((PB) + 2); \
    if (IN((PB) + 3)) { \
        if ((LAYER) == 0) ln_phase<1, 2, true, false>(lds, XBB, nullptr, YS, gates, P.ln_ffn_g, P.ln_ffn_b, nullptr, XBA, P.ssm_w_in + NZX, SSM_PITCH, P.dt_bias, nullptr, nullptr, nullptr, DT, G, vcu, ws + WS_XQ0); \
        else ln_phase<1, 0, false, true>(lds, XBB, nullptr, YS, gates, P.ln_ffn_g + DM, P.ln_ffn_b + DM, args.out, nullptr, nullptr, 0, nullptr, nullptr, nullptr, nullptr, nullptr, G, vcu); } \
    } while (0)

    if (IN(1)) { pg8::DenseOrder S; S.init(ws + WS_XQ0, Wqkv, T, NQKV, DM / 2, G, bx); pg8::EpiQKV E{PROJ, rope, 1.0f / (Q8_X * Q8_W)};
        pg8::HostCvt H; H.w_up = P.w_up; H.w_dn = P.w_dn; H.wt_up = ws + WS_WUP; H.wt_dn = ws + WS_WDN; H.base = 0; H.limit = 2 * HOSTED_ITEMS; H.G = G; H.c = bx;
        pg8::gemm_phase<true>(lds, DM / 2, S, E, H); }
    SEAM(1);
    if (IN(2)) attn_phase(lds, PROJ, OG, LSE, G, vcu);
    SEAM(2);
    if (IN(3)) combine_phase(OG, LSE, ws + WS_OB, G, vcu);
    SEAM(3);
    if (IN(4)) { pg8::DenseOrder S; S.init(ws + WS_OB, Wao, T, DM, DM / 2, G, bx); pg8::EpiBf16 E{MIXB, DM, 1.0f / (Q8_O * Q8_W)}; pg8::HostNone H; pg8::gemm_phase<true>(lds, DM / 2, S, E, H); }
    SEAM_PRE(4, P.w_router, NE);
    MOE_BLOCK(0, 5);
    SEAM(8);
    if (IN(9)) { pg8::DenseOrder S; S.init(ws + WS_XQ0, Wsi, T, NZX, DM / 2, G, bx); pg8::EpiBf16 E{ZX, NZX, 1.0f / (Q8_X * Q8_W)}; pg8::HostNone H; pg8::gemm_phase<true>(lds, DM / 2, S, E, H); }
    SEAM(9);
    if (IN(10)) {
        convcb_phase(lds, ZX, P.conv_w, P.conv_b, XA, CBG, G, vcu); }
    SEAM(10);
    if (IN(11)) ssd_phase(lds, ZX, XA, CBG, DT, P.a_log, P.d_skip, YB, SSQ, G, vcu);
    SEAM(11);
    if (IN(12)) { pg8::DenseOrder S; S.init(YB, Wso, T, DM, DI / 2, G, bx);
        LAS float* stab = (LAS float*)(lds + LDS_AUX);
        for (int i = 0; i < 4; ++i) { pg8::Unit uu; if (!S.next(i, uu)) break;
            for (int idx = tid; idx < 1024; idx += 512) { const int rl = idx >> 2, g = idx & 3; const float* sp = SSQ + (size_t)(uu.pm * 256 + rl) * 32 + g * 8;
                const f32x4 a = *(const f32x4*)sp, b4 = *(const f32x4*)(sp + 4); const float sum = ((a[0] + a[1]) + (a[2] + a[3])) + ((b4[0] + b4[1]) + (b4[2] + b4[3]));
                stab[(i * 256 + rl) * 4 + g] = __builtin_amdgcn_rsqf(sum * (1.0f / 512.0f) + RMS_EPS); } }
        __syncthreads();
        pg8::EpiRms E{MIXB, DM, stab}; pg8::HostNone H; pg8::gemm_phase<true>(lds, DI / 2, S, E, H); }
    SEAM_PRE(12, P.w_router + (size_t)DM * NE, NE);
    MOE_BLOCK(1, 13);
#undef IN
#undef SEAM
#undef MOE_BLOCK
}

constexpr int NPHASE = 17;
extern "C" void kernel_launch(void* const* d_in, const int* in_sizes, int n_in, void* d_out, int out_size, void* d_ws, size_t ws_size, hipStream_t stream) {
    static int grid = 0;
    if (grid == 0) {
        if (n_in != 22 || in_sizes[0] != T * DM || out_size != T * DM || ws_size < WS_END) { fprintf(stderr, "kernel_launch: unexpected shapes / workspace (n_in %d, in0 %d, out %d, ws %zu, need %zu)\n", n_in, n_in > 0 ? in_sizes[0] : -1, out_size, ws_size, (size_t)WS_END); grid = -1; return; }
        int dev = 0, cus = 0;
        if (hipGetDevice(&dev) != hipSuccess || hipDeviceGetAttribute(&cus, hipDeviceAttributeMultiprocessorCount, dev) != hipSuccess) { fprintf(stderr, "kernel_launch: device query failed\n"); grid = -1; return; }
        if (hipFuncSetAttribute((const void*)fwd_kernel, hipFuncAttributeMaxDynamicSharedMemorySize, LDS_BYTES) != hipSuccess) { fprintf(stderr, "kernel_launch: hipFuncSetAttribute failed\n"); grid = -1; return; }
        int per_cu = 0;
        if (hipOccupancyMaxActiveBlocksPerMultiprocessor(&per_cu, (const void*)fwd_kernel, 512, LDS_BYTES) != hipSuccess || per_cu < 1) fprintf(stderr, "kernel_launch: occupancy query reports %d\n", per_cu);
        (void)hipGetLastError();
        grid = cus;
        if (grid < 256) { fprintf(stderr, "kernel_launch: built for >= 256 CUs, got %d\n", grid); }
        if (grid > 256) grid = 256;
    }
    if (grid < 0) return;
    if (hipMemsetAsync((char*)d_ws + WS_CTL, 0, CTL_ZERO_BYTES, stream) != hipSuccess) { fprintf(stderr, "kernel_launch: memset failed\n"); return; }
    Args a{};
    for (int i = 0; i < 22; ++i) a.in[i] = d_in[i];
    a.out = (float*)d_out; a.ws = (unsigned char*)d_ws;
#if MK_PER_PHASE
    for (int p = 0; p < NPHASE; ++p) { a.ph_lo = p; a.ph_hi = p + 1; hipLaunchKernelGGL(fwd_kernel, dim3(grid), dim3(512), LDS_BYTES, stream, a); }
#else
    a.ph_lo = 0; a.ph_hi = NPHASE;
    hipLaunchKernelGGL(fwd_kernel, dim3(grid), dim3(512), LDS_BYTES, stream, a);
#endif
    const hipError_t le = hipPeekAtLastError();
    if (le != hipSuccess) fprintf(stderr, "kernel_launch: launch failed: %s\n", hipGetErrorName(le));
}
```

```cpp
#include <hip/hip_runtime.h>
#include <cstdio>
#include <cstdint>

#ifndef MK_PER_PHASE
#define MK_PER_PHASE 0
#endif

#define GAS __attribute__((address_space(1)))
#define LAS __attribute__((address_space(3)))
typedef unsigned short bf16;
typedef short bf16x8 __attribute__((ext_vector_type(8)));
typedef float f32x4 __attribute__((ext_vector_type(4)));
typedef float f32x2 __attribute__((ext_vector_type(2)));
typedef unsigned u32x4 __attribute__((ext_vector_type(4)));
typedef unsigned u32x2 __attribute__((ext_vector_type(2)));

constexpr int BATCH = 8, SEQ = 4096, DM = 1024, T = BATCH * SEQ;
constexpr int NQKV = 9216;
constexpr int NZX = 5120, SSM_PITCH = 5152, DI = 2048;
constexpr int NE = 32;
constexpr float LN_EPS = 1e-5f, RMS_EPS = 1e-5f, ALPHA = 1.41421356237309505f;
constexpr float QSCALE = 0.12751743082459868f;
constexpr float LN2F = 0.6931471805599453f;

constexpr size_t MiB = 1u << 20;
constexpr size_t WS_CTL = 0, CTL_ZERO_BYTES = 128 * 1024;
constexpr size_t WS_ROPE = 1 * MiB;
constexpr size_t WS_GATES = 5 * MiB;
constexpr size_t WS_DT = 6 * MiB;
constexpr size_t WS_LIST = 10 * MiB;
constexpr size_t WS_LSE = 14 * MiB;
constexpr size_t WS_WQKV = 18 * MiB;
constexpr size_t WS_WAO = 36 * MiB;
constexpr size_t WS_WSI = 38 * MiB;
constexpr size_t WS_WSO = 48 * MiB;
constexpr size_t WS_WUP = 52 * MiB;
constexpr size_t WS_XQ = 180 * MiB;
constexpr size_t WS_XQ0 = 212 * MiB;
constexpr size_t WS_WDN = 308 * MiB;
constexpr size_t WS_XBA = 436 * MiB;
constexpr size_t WS_XBB = 500 * MiB;
constexpr size_t WS_X1 = 564 * MiB;
constexpr size_t WS_BIG = 692 * MiB;
constexpr size_t WS_XA = 1012 * MiB;
constexpr size_t WS_CBG = 1204 * MiB;
constexpr size_t WS_HB = WS_BIG;
constexpr size_t WS_YS = 964 * MiB;
constexpr size_t WS_OG = 1268 * MiB;
constexpr size_t WS_OB = 1460 * MiB;
constexpr size_t WS_END = 1524 * MiB;
constexpr int CW_BAR = 4096;
constexpr int CW_CNT = 16384;
constexpr int CW_CVT = 20000;
#ifndef CVT_Q_UP
#define CVT_Q_UP 5
#endif
#ifndef CVT_Q_DN
#define CVT_Q_DN 5
#endif

constexpr int LDS_AUX = 131072;
constexpr int LDS_TAB = 131072 + 17 * 512;
constexpr int LDS_SLOT = LDS_TAB + 2688;
constexpr int LDS_SM = 147456;
constexpr int LDS_MISC = 155648;
constexpr int LDS_BYTES = 156672;

__device__ __forceinline__ float bf2f(unsigned short b) { return __uint_as_float(((unsigned)b) << 16); }
__device__ __forceinline__ float bflo(unsigned w) { return __uint_as_float(w << 16); }
__device__ __forceinline__ float bfhi(unsigned w) { return __uint_as_float(w & 0xffff0000u); }
typedef __bf16 bf16x2_t __attribute__((ext_vector_type(2)));
constexpr float Q8_X = 8.0f, Q8_W = 256.0f, Q8_H = 8.0f, Q8_O = 32.0f, Q8_Y = 32.0f, Q8_Q = 64.0f, Q8_K = 8.0f, Q8_V = 8.0f, Q8_YS = 16.0f;
__device__ __forceinline__ unsigned pk4_f8(float a, float b, float c, float d, float sc) {
    a = __builtin_fminf(__builtin_fmaxf(a * sc, -448.f), 448.f); b = __builtin_fminf(__builtin_fmaxf(b * sc, -448.f), 448.f);
    c = __builtin_fminf(__builtin_fmaxf(c * sc, -448.f), 448.f); d = __builtin_fminf(__builtin_fmaxf(d * sc, -448.f), 448.f);
    int p = __builtin_amdgcn_cvt_pk_fp8_f32(a, b, 0, false); p = __builtin_amdgcn_cvt_pk_fp8_f32(c, d, p, true); return (unsigned)p; }
__device__ __forceinline__ unsigned pk2(float lo, float hi) { const f32x2 v = {lo, hi}; const bf16x2_t b = __builtin_convertvector(v, bf16x2_t); return __builtin_bit_cast(unsigned, b); }
__device__ __forceinline__ float wave_sum(float v) {
#pragma unroll
    for (int o = 1; o < 64; o <<= 1) v += __shfl_xor(v, o);
    return v;
}
constexpr int P256 = 272, P512 = 528;
__device__ __forceinline__ int swz256(int row, int bc) { return row * P256 + bc; }
__device__ __forceinline__ int swz512(int row, int bc) { return row * P512 + bc; }
__device__ __forceinline__ bf16x8 as_bf16x8(u32x4 v) { return __builtin_bit_cast(bf16x8, v); }
__device__ __forceinline__ f32x4 mfma16(bf16x8 a, bf16x8 b, f32x4 c) { return __builtin_amdgcn_mfma_f32_16x16x32_bf16(a, b, c, 0, 0, 0); }
__device__ __forceinline__ void lds_barrier() { asm volatile("s_waitcnt lgkmcnt(0)" ::: "memory"); __builtin_amdgcn_s_barrier(); asm volatile("" ::: "memory"); }
__device__ __forceinline__ float silu_f(float v) { return v * __builtin_amdgcn_rcpf(1.0f + __expf(-v)); }

#define XB_TMO      128
#define XB_XCNT(j)  (256  + 64 * (j))
#define XB_XSUB(j)  (1280 + 64 * (j))
#define XB_XGEN(j)  (2304 + 64 * (j))
#define XB_TOP      3328
#define XB_TOPGEN   3392
#define XCD_BAR_WORDS 3456
#define XB_SPIN_CAP (1u << 18)
__device__ __forceinline__ unsigned xb_ld(unsigned* p)              { return __hip_atomic_load(p, __ATOMIC_RELAXED, __HIP_MEMORY_SCOPE_AGENT); }
__device__ __forceinline__ unsigned xb_add(unsigned* p, unsigned v) { return __hip_atomic_fetch_add(p, v, __ATOMIC_RELAXED, __HIP_MEMORY_SCOPE_AGENT); }
__device__ __forceinline__ unsigned xb_xcc_id() { return (unsigned)__builtin_amdgcn_s_getreg((3 << 11) | 20) & 0xFu; }
#define XB_SPIN(cond, bar) do { unsigned _sp = 0; while (cond) { __builtin_amdgcn_s_sleep(1); \
    if ((++_sp & 255u) == 0u) { if (xb_ld(&(bar)[XB_TMO])) break; if (_sp > XB_SPIN_CAP) { atomicAdd(&(bar)[XB_TMO], 1u); break; } } } } while (0)
struct XcdBarrier { unsigned* bar; unsigned x; volatile LAS unsigned* st; };
__device__ __forceinline__ XcdBarrier xcd_barrier_post(unsigned* bar, volatile LAS unsigned* st) {
    XcdBarrier b; b.bar = bar; b.x = xb_xcc_id(); b.st = st;
    if (threadIdx.x == 0) (void)xb_add(&bar[XB_XCNT(b.x)], 1u);
    return b;
}
__device__ __forceinline__ void xcd_barrier_complete(unsigned* bar, unsigned x, unsigned& nloc, unsigned& nx) {
    const unsigned G = gridDim.x * gridDim.y * gridDim.z;
    unsigned sum, cnt, mine, sp = 0u;
    for (;;) {
        sum = 0u; cnt = 0u; mine = 0u;
#pragma unroll
        for (unsigned j = 0; j < 16; ++j) { const unsigned c = xb_ld(&bar[XB_XCNT(j)]); sum += c; cnt += (c > 0u) ? 1u : 0u; mine = (j == x) ? c : mine; }
        if (sum == G) break;
        __builtin_amdgcn_s_sleep(1);
        if ((++sp & 255u) == 0u) { if (xb_ld(&bar[XB_TMO])) break; if (sp > XB_SPIN_CAP) { atomicAdd(&bar[XB_TMO], 1u); break; } }
    }
    nloc = mine > 0u ? mine : 1u; nx = cnt > 0u ? cnt : 1u;
}
struct NoWork { __device__ __forceinline__ void operator()() const {} };
template <class F = NoWork>
__device__ __forceinline__ void xcd_barrier(const XcdBarrier& b, const F& f = F()) {
    asm volatile("s_waitcnt vmcnt(0)" ::: "memory");
    __syncthreads();
    if (threadIdx.x >= 64) f();
    if (threadIdx.x == 0) {
        unsigned* bar = b.bar;
        __builtin_amdgcn_s_waitcnt(0);
        unsigned nloc = b.st[0], nx = b.st[1];
        if (nloc == 0u) { xcd_barrier_complete(bar, b.x, nloc, nx); b.st[0] = nloc; b.st[1] = nx; }
        const unsigned old = xb_add(&bar[XB_XSUB(b.x)], 1u);
        const unsigned gen = old / nloc;
        if (old + 1u == (gen + 1u) * nloc) {
            __builtin_amdgcn_fence(__ATOMIC_RELEASE, "agent");
            asm volatile("s_waitcnt vmcnt(0)" ::: "memory");
            const unsigned og = xb_add(&bar[XB_TOP], 1u);
            const unsigned tg = og / nx;
            if (og + 1u == (tg + 1u) * nx) xb_add(&bar[XB_TOPGEN], 1u);
            else XB_SPIN(xb_ld(&bar[XB_TOPGEN]) == tg, bar);
            __builtin_amdgcn_fence(__ATOMIC_ACQUIRE, "agent");
            xb_add(&bar[XB_XGEN(b.x)], 1u);
            asm volatile("s_waitcnt vmcnt(0)" ::: "memory");
        } else {
            XB_SPIN(xb_ld(&bar[XB_XGEN(b.x)]) == gen, bar);
            __builtin_amdgcn_fence(__ATOMIC_ACQUIRE, "agent");
            asm volatile("s_waitcnt vmcnt(0)" ::: "memory");
        }
    }
    __syncthreads();
}

namespace pg8 {
constexpr int BM = 256, BK = 64, HALF = 128, HTB = HALF * BK * 2, STAGE_BYTES = 8 * HTB, NXCD = 8, WGM = 4;
__host__ __device__ __forceinline__ int lds_byte(int r, int c) { const int st = (r >> 4) * 2 + (c >> 5), rr = r & 15, cc = c & 31, ob = rr * 64 + cc * 2; return st * 1024 + (ob ^ (((ob >> 9) & 1) << 5)); }
__host__ __device__ __forceinline__ void stage_rc(int b, int& R, int& C) { const int st = b / 1024, sb = b % 1024, swz = sb ^ (((sb >> 9) & 1) << 5); R = (st >> 1) * 16 + swz / 64; C = (st & 1) * 32 + (swz % 64) / 2; }
__host__ __device__ __forceinline__ int perm32(int rho) { const int n = rho >> 4, i = rho & 15; return 8 * (i >> 2) + 4 * n + (i & 3); }

struct Unit { int pm, pn, e, r0, cnt, ord; };
typedef int i32x8_t __attribute__((ext_vector_type(8))); typedef int i32x4_t __attribute__((ext_vector_type(4)));
__device__ __forceinline__ u32x4 pair16(const u32x2 X, const u32x2 Y) {
    const u32x2 s0 = __builtin_amdgcn_permlane16_swap(X.x, Y.x, false, false), s1 = __builtin_amdgcn_permlane16_swap(X.y, Y.y, false, false);
    return (u32x4){s0.x, s1.x, s0.y, s1.y};
}
__device__ __forceinline__ i32x8_t cat8(const bf16x8& a, const bf16x8& b) { return __builtin_shufflevector(__builtin_bit_cast(i32x4_t, a), __builtin_bit_cast(i32x4_t, b), 0, 1, 2, 3, 4, 5, 6, 7); }

struct DenseOrder {
    static constexpr bool GATHER_A = false;
    const char* A; const char* Bt; int K, nM, nN, nwg, G, c;
    __device__ __forceinline__ void init(const void* A_, const void* Bt_, int M, int N, int K_, int G_, int c_) { A = (const char*)A_; Bt = (const char*)Bt_; K = K_; nM = M / BM; nN = N / BM; nwg = nM * nN; G = G_; c = c_; }
    __device__ __forceinline__ bool next(int i, Unit& u) const {
        const long L = (long)i * G + c; if (L >= nwg) return false;
        int wgid = (int)L; { const int q = nwg / NXCD, r = nwg % NXCD, xcd = wgid % NXCD, off = wgid / NXCD; wgid = (xcd < r ? xcd * (q + 1) : r * (q + 1) + (xcd - r) * q) + off; }
        const int nig = WGM * nN, gid = wgid / nig, fm = gid * WGM, gsz = (nM - fm) < WGM ? (nM - fm) : WGM;
        u.pm = fm + ((wgid % nig) % gsz); u.pn = (wgid % nig) / gsz; u.e = 0; u.r0 = 0; u.cnt = 0; u.ord = i; return true;
    }
    __device__ __forceinline__ const char* a_base(const Unit& u) const { return A + (size_t)u.pm * ((size_t)BM * K * 2); }
    __device__ __forceinline__ const char* b_base(const Unit& u) const { return Bt + (size_t)u.pn * ((size_t)BM * K * 2); }
    __device__ __forceinline__ void a_offs(const Unit&, unsigned (&v)[2][2]) const {
#pragma unroll
        for (int i = 0; i < 2; ++i) { int R, C; stage_rc((int)threadIdx.x * 16 + i * 8192, R, C);
#pragma unroll
            for (int h = 0; h < 2; ++h) v[h][i] = (unsigned)((h * HALF + R) * K + C) * 2u; }
    }
};
template <bool GATHER> struct MoeOrder {
    static constexpr bool GATHER_A = GATHER;
    const char* A; const char* Bt; int K, N, nN, G, c, NU; const LAS int* tab; const LAS unsigned short* toks;
    __device__ __forceinline__ bool next(int i, Unit& u) const {
        const int L = i * G + c; if (L >= NU) return false;
        const int rb = L / nN; u.pn = L - rb * nN; u.pm = rb;
        const int e = __builtin_amdgcn_readfirstlane(tab[128 + rb]); u.e = e;
        u.r0 = (rb - __builtin_amdgcn_readfirstlane(tab[e])) * 256; u.cnt = __builtin_amdgcn_readfirstlane(tab[64 + e]); u.ord = i; return true;
    }
    __device__ __forceinline__ const char* a_base(const Unit& u) const { return GATHER ? A : A + (size_t)u.pm * ((size_t)BM * K * 2); }
    __device__ __forceinline__ const char* b_base(const Unit& u) const { return Bt + ((size_t)u.e * N + (size_t)u.pn * BM) * ((size_t)K * 2); }
    __device__ __forceinline__ void a_offs(const Unit& u, unsigned (&v)[2][2]) const {
#pragma unroll
        for (int i = 0; i < 2; ++i) { int R, C; stage_rc((int)threadIdx.x * 16 + i * 8192, R, C);
#pragma unroll
            for (int h = 0; h < 2; ++h) {
                if (GATHER) { const unsigned tok = toks[u.ord * 256 + h * HALF + R]; v[h][i] = (tok * (unsigned)K + (unsigned)C) * 2u; }
                else v[h][i] = (unsigned)((h * HALF + R) * K + C) * 2u; } }
    }
};


struct HostNone { struct Regs {}; __device__ __forceinline__ void issue(int, Regs&, f32x4 (&)[2][2][4][2]) const {} __device__ __forceinline__ void finish(const Regs&, const f32x4 (&)[2][2][4][2]) const {} };
struct HostCvt {
    const float* w_up; const float* w_dn; unsigned char* wt_up; unsigned char* wt_dn;
    int base, limit, G, c;
    struct Regs { unsigned char* dst; bool active; };
    __device__ __forceinline__ void issue(int ord, Regs& R, f32x4 (&acc)[2][2][4][2]) const {
        const int w = __builtin_amdgcn_readfirstlane((int)threadIdx.x >> 6), lane = threadIdx.x & 63, kq = lane >> 4, nq = lane & 15;
        const int hi = __builtin_amdgcn_readfirstlane(base + (ord * G + c) * 8 + w);
        R.active = hi < limit; R.dst = nullptr;
        if (R.active) {
            const float* W; int pitch, k0, n0, drow; unsigned char* WT;
            if (hi < 32768) { const int mat = hi >> 10, q = hi & 1023, kb = q >> 5, nb = q & 31; n0 = nb * 64; k0 = kb * 32; pitch = 2048; W = w_up + (size_t)mat * 1024 * 2048; WT = wt_up + (size_t)mat * 2048 * 1024;
                drow = ((n0 & 1023) >> 7) * 256 + (n0 >> 10) * 128 + (n0 & 127); }
            else { const int r = hi - 32768, mat = r >> 9, q = r & 511, kb = q >> 4, nb = q & 15; n0 = nb * 64; k0 = kb * 32; pitch = 1024; W = w_dn + (size_t)mat * 1024 * 1024; WT = wt_dn + (size_t)mat * 1024 * 1024; drow = n0; }
            const char* src = (const char*)(W + (size_t)k0 * pitch + n0); const unsigned voff = (unsigned)(kq * pitch + 4 * nq) * 4u;
#pragma unroll
            for (int i = 0; i < 8; ++i) acc[0][0][i >> 1][i & 1] = __builtin_nontemporal_load((const f32x4*)(src + (size_t)(4 * i) * pitch * 4 + voff));
            R.dst = WT + (size_t)(drow + 4 * nq + kq) * 1024 + k0;
        }
    }
    __device__ __forceinline__ void finish(const Regs& R, const f32x4 (&acc)[2][2][4][2]) const {
        if (R.active) {
            const int lane = threadIdx.x & 63;
            const unsigned sel1 = (lane & 16) ? 0x07030501u : 0x06020400u, sel2 = (lane & 32) ? 0x07060302u : 0x05040100u;
            unsigned o[8];
#pragma unroll
            for (int i = 0; i < 8; ++i) { const f32x4 v = acc[0][0][i >> 1][i & 1]; const unsigned d = pk4_f8(v[0], v[1], v[2], v[3], Q8_W);
                const u32x2 s1 = __builtin_amdgcn_permlane16_swap(d, d, false, false);
                const unsigned t1 = __builtin_amdgcn_perm(s1.y, s1.x, sel1);
                const u32x2 s2 = __builtin_amdgcn_permlane32_swap(t1, t1, false, false);
                o[i] = __builtin_amdgcn_perm(s2.y, s2.x, sel2); }
            *(u32x4*)R.dst = (u32x4){o[0], o[1], o[2], o[3]}; *(u32x4*)(R.dst + 16) = (u32x4){o[4], o[5], o[6], o[7]};
        }
    }
};

template <bool F8 = false, class Epi, class Sched, class Host>
__device__ __forceinline__ void gemm_phase(LAS unsigned char* lds, const int K, const Sched& S, const Epi& E, const Host& H) {
    const int tid = threadIdx.x, wid = __builtin_amdgcn_readfirstlane(tid >> 6), lane = tid & 63, wr = wid >> 2, wc = wid & 3, fr = lane & 15, fq = lane >> 4;
    const int nt = K / BK;
    unsigned voffB[2];
#pragma unroll
    for (int i = 0; i < 2; ++i) { int R, C; stage_rc(tid * 16 + i * 8192, R, C); const int Rb = Epi::PERM ? ((R & ~31) + perm32(R & 31)) : R; voffB[i] = (unsigned)(Rb * K + C) * 2u; }
    const size_t kstep = (size_t)(BK * 2);
    const size_t hstep = (size_t)HALF * K * 2;
    const unsigned ldsw = (unsigned)wid * 1024u;
    const int aoff = lds_byte(wr * 64 + fr, fq * 8), boff = lds_byte(wc * 32 + fr, fq * 8);
#define PG8_SA(b, h) (((b) * 2 + (h)) * HTB)
#define PG8_SB(b, h) ((4 + (b) * 2 + (h)) * HTB)
#define PG8_STAGE(bufoff, gbase, voff) do { _Pragma("unroll") for (int _i = 0; _i < 2; ++_i) \
        __builtin_amdgcn_global_load_lds((const unsigned*)((const char*)(gbase) + (voff)[_i]), (LAS unsigned*)(lds + (bufoff) + ldsw + _i * 8192), 16, 0, 0); } while (0)
#define PG8_LDA(dst, b, h) do { _Pragma("unroll") for (int m = 0; m < 4; ++m) _Pragma("unroll") for (int k = 0; k < 2; ++k) dst[m][k] = *(const LAS bf16x8*)(lds + PG8_SA(b, h) + aoff + m * 2048 + k * 1024); } while (0)
#define PG8_LDB(dst, b, h) do { _Pragma("unroll") for (int n = 0; n < 2; ++n) _Pragma("unroll") for (int k = 0; k < 2; ++k) dst[n][k] = *(const LAS bf16x8*)(lds + PG8_SB(b, h) + boff + n * 2048 + k * 1024); } while (0)
#define PG8_MMA(ai, bj, At, Bt) do { __builtin_amdgcn_s_setprio(1); _Pragma("unroll") for (int m = 0; m < 4; ++m) _Pragma("unroll") for (int n = 0; n < 2; ++n) { \
        if constexpr (F8) { const i32x8_t b8_ = cat8(Bt[n][0], Bt[n][1]), a8_ = cat8(At[m][0], At[m][1]); asm volatile("v_mfma_f32_16x16x128_f8f6f4 %0, %1, %2, %0" : "+v"(acc[ai][bj][m][n]) : "v"(b8_), "v"(a8_)); } \
        else { _Pragma("unroll") for (int k = 0; k < 2; ++k) acc[ai][bj][m][n] = __builtin_amdgcn_mfma_f32_16x16x32_bf16(Bt[n][k], At[m][k], acc[ai][bj][m][n], 0, 0, 0); } } __builtin_amdgcn_s_setprio(0); } while (0)
#define PG8_WAIT_V(n) asm volatile("s_waitcnt vmcnt(" #n ")" ::: "memory")
#define PG8_WAIT_L(n) asm volatile("s_waitcnt lgkmcnt(" #n ")" ::: "memory")
#define PG8_BAR __builtin_amdgcn_s_barrier()
#define PG8_SCHED __builtin_amdgcn_sched_barrier(0)
    Unit cur, nxt; int ui = 0;
    if (!S.next(0, cur)) return;
    f32x4 acc[2][2][4][2];
#pragma unroll
    for (int a = 0; a < 2; ++a)
#pragma unroll
        for (int b = 0; b < 2; ++b)
#pragma unroll
            for (int m = 0; m < 4; ++m)
#pragma unroll
                for (int n = 0; n < 2; ++n) acc[a][b][m][n] = (f32x4){0.f, 0.f, 0.f, 0.f};
    bf16x8 At[4][2], B0[2][2], B1[2][2];
    constexpr bool GA = Sched::GATHER_A;
    unsigned vA[2][2], nvA[2][2];
    S.a_offs(cur, vA);
    const size_t ah = GA ? 0 : hstep;
#define PG8_VA1 (GA ? vA[1] : vA[0])
    const char* cA = S.a_base(cur); const char* cB = S.b_base(cur);
    PG8_STAGE(PG8_SB(0, 0), cB, voffB); PG8_STAGE(PG8_SB(0, 1), cB + hstep, voffB); PG8_STAGE(PG8_SA(0, 0), cA, vA[0]); PG8_STAGE(PG8_SA(0, 1), cA + ah, PG8_VA1);
    if (wr == 1) PG8_BAR;
    PG8_WAIT_V(2); PG8_BAR;
    PG8_STAGE(PG8_SB(1, 0), cB + kstep, voffB); PG8_STAGE(PG8_SA(1, 0), cA + kstep, vA[0]); PG8_STAGE(PG8_SB(1, 1), cB + hstep + kstep, voffB);
    PG8_WAIT_V(6); PG8_BAR;
    for (;;) {
        const bool has_next = S.next(ui + 1, nxt);
        const char* nA = cA; const char* nB = cB;
#pragma unroll
        for (int h = 0; h < 2; ++h)
#pragma unroll
            for (int i = 0; i < 2; ++i) nvA[h][i] = vA[h][i];
        if (has_next) { nA = S.a_base(nxt); nB = S.b_base(nxt); if constexpr (GA) S.a_offs(nxt, nvA); }
        constexpr int NGRP = Epi::RESCALE ? 4 : 1; const int tper = nt / NGRP;
        for (int gq = 0; gq < NGRP; ++gq) {
        if constexpr (Epi::RESCALE) { if (gq > 0) { if constexpr (F8) asm volatile("s_nop 15\n\ts_nop 15" ::: "memory"); E.rescale(acc, cur, gq, wr, fr); } }
#pragma unroll 1
        for (int t = gq * tper; t < (gq + 1) * tper; t += 2) {
            const bool last = (t == nt - 2);
            const char* a1 = cA + (size_t)(t + 1) * kstep;
            const char* a2 = last ? nA : cA + (size_t)(t + 2) * kstep; const char* b2 = last ? nB : cB + (size_t)(t + 2) * kstep;
            const char* a3 = a2 + kstep; const char* b3 = b2 + kstep;
            unsigned w0[2], w1[2];
#pragma unroll
            for (int i = 0; i < 2; ++i) { if constexpr (GA) { w0[i] = last ? nvA[0][i] : vA[0][i]; w1[i] = last ? nvA[1][i] : vA[1][i]; } else { w0[i] = vA[0][i]; w1[i] = vA[0][i]; } }
            PG8_LDB(B0, 0, 0); PG8_LDB(B1, 0, 1); PG8_SCHED; PG8_LDA(At, 0, 0); PG8_STAGE(PG8_SA(1, 1), a1 + ah, PG8_VA1);
            PG8_WAIT_V(8); PG8_WAIT_L(0); PG8_BAR; PG8_MMA(0, 0, At, B0); PG8_MMA(0, 1, At, B1); PG8_BAR; PG8_SCHED;
            PG8_LDA(At, 0, 1); PG8_STAGE(PG8_SB(0, 0), b2, voffB); PG8_STAGE(PG8_SB(0, 1), b2 + hstep, voffB); PG8_STAGE(PG8_SA(0, 0), a2, w0);
            PG8_WAIT_V(8); PG8_WAIT_L(0); PG8_BAR; PG8_MMA(1, 0, At, B0); PG8_MMA(1, 1, At, B1); PG8_BAR; PG8_SCHED;
            PG8_LDB(B0, 1, 0); PG8_LDB(B1, 1, 1); PG8_SCHED; PG8_LDA(At, 1, 0); PG8_STAGE(PG8_SA(0, 1), a2 + ah, w1);
            PG8_WAIT_V(8); PG8_WAIT_L(0); PG8_BAR; PG8_MMA(0, 0, At, B0); PG8_MMA(0, 1, At, B1); PG8_BAR; PG8_SCHED;
            PG8_LDA(At, 1, 1); PG8_STAGE(PG8_SB(1, 0), b3, voffB); PG8_STAGE(PG8_SB(1, 1), b3 + hstep, voffB); PG8_STAGE(PG8_SA(1, 0), a3, w0);
            PG8_WAIT_V(8); PG8_WAIT_L(0); PG8_BAR; PG8_MMA(1, 0, At, B0); PG8_MMA(1, 1, At, B1); PG8_BAR; PG8_SCHED;
        }
        }
        if (wr == 0) PG8_BAR;
        if constexpr (F8) asm volatile("s_nop 15\n\ts_nop 15" ::: "memory");
        E(acc, cur, wr, wc, fr, fq, 0);
        __builtin_amdgcn_sched_barrier(0); asm volatile("" ::: "memory");
        typename Host::Regs hr; H.issue(cur.ord, hr, acc);
        __builtin_amdgcn_sched_barrier(0); asm volatile("" ::: "memory");
        E(acc, cur, wr, wc, fr, fq, 1);
        __builtin_amdgcn_sched_barrier(0);
        H.finish(hr, acc);
        if (!has_next) break;
#pragma unroll
        for (int a = 0; a < 2; ++a)
#pragma unroll
            for (int b = 0; b < 2; ++b)
#pragma unroll
                for (int m = 0; m < 4; ++m)
#pragma unroll
                    for (int n = 0; n < 2; ++n) acc[a][b][m][n] = (f32x4){0.f, 0.f, 0.f, 0.f};
        cur = nxt; cA = nA; cB = nB; ++ui;
#pragma unroll
        for (int h = 0; h < 2; ++h)
#pragma unroll
            for (int i = 0; i < 2; ++i) vA[h][i] = nvA[h][i];
        if (wr == 1) PG8_BAR;
    }
    PG8_WAIT_V(0);
    PG8_BAR;
#undef PG8_VA1
#undef PG8_SA
#undef PG8_SB
#undef PG8_STAGE
#undef PG8_LDA
#undef PG8_LDB
#undef PG8_MMA
#undef PG8_WAIT_V
#undef PG8_WAIT_L
#undef PG8_BAR
#undef PG8_SCHED
}

struct EpiF32 {
    static constexpr bool PERM = false; static constexpr bool RESCALE = false;
    float* C; int ldc;
    __device__ __forceinline__ void operator()(const f32x4 (&acc)[2][2][4][2], const Unit& u, int wr, int wc, int fr, int fq, const int ai) const {
        const int row0 = u.pm * BM + wr * 64 + fr, col0 = u.pn * BM + wc * 32 + 4 * fq;

#pragma unroll
            for (int m = 0; m < 4; ++m) { float* rowp = C + (size_t)(row0 + ai * HALF + m * 16) * ldc + col0;
#pragma unroll
                for (int bj = 0; bj < 2; ++bj)
#pragma unroll
                    for (int n = 0; n < 2; ++n) *(f32x4*)(rowp + bj * HALF + n * 16) = acc[ai][bj][m][n]; }
    }
};
struct EpiBf16 {
    static constexpr bool PERM = true; static constexpr bool RESCALE = false;
    bf16* O; int ldc; float sc;
    __device__ __forceinline__ void operator()(const f32x4 (&acc)[2][2][4][2], const Unit& u, int wr, int wc, int fr, int fq, const int ai) const {
        const int row0 = u.pm * BM + wr * 64 + fr, col0 = u.pn * BM + wc * 32 + 8 * fq;

#pragma unroll
            for (int m = 0; m < 4; ++m) { bf16* rowp = O + (size_t)(row0 + ai * HALF + m * 16) * ldc + col0;
#pragma unroll
                for (int bj = 0; bj < 2; ++bj) { const f32x4 v0 = acc[ai][bj][m][0] * sc, v1 = acc[ai][bj][m][1] * sc;
                    u32x4 w; w.x = pk2(v0[0], v0[1]); w.y = pk2(v0[2], v0[3]); w.z = pk2(v1[0], v1[1]); w.w = pk2(v1[2], v1[3]);
                    __builtin_nontemporal_store(w, (u32x4*)(rowp + bj * HALF)); } }
    }
};
struct EpiRms {
    static constexpr bool PERM = true; static constexpr bool RESCALE = true;
    bf16* O; int ldc; const LAS float* stab;
    __device__ __forceinline__ void rescale(f32x4 (&acc)[2][2][4][2], const Unit& u, int g, int wr, int fr) const {
        const LAS float* tb = stab + (u.ord * 256 + wr * 64 + fr) * 4 + g;
#pragma unroll
        for (int ai = 0; ai < 2; ++ai)
#pragma unroll
            for (int m = 0; m < 4; ++m) { const LAS float* p = tb + (ai * HALF + m * 16) * 4; const float ratio = p[-1] * __builtin_amdgcn_rcpf(p[0]);
#pragma unroll
                for (int bj = 0; bj < 2; ++bj)
#pragma unroll
                    for (int n = 0; n < 2; ++n) acc[ai][bj][m][n] = acc[ai][bj][m][n] * ratio; }
    }
    __device__ __forceinline__ void operator()(const f32x4 (&acc)[2][2][4][2], const Unit& u, int wr, int wc, int fr, int fq, const int ai) const {
        const int row0 = u.pm * BM + wr * 64 + fr, col0 = u.pn * BM + wc * 32 + 8 * fq;
        const LAS float* tb = stab + (u.ord * 256 + wr * 64 + fr) * 4 + 3;

#pragma unroll
            for (int m = 0; m < 4; ++m) { const int row = row0 + ai * HALF + m * 16; const float s3 = tb[(ai * HALF + m * 16) * 4] * (1.0f / (Q8_YS * Q8_W)); bf16* rowp = (bf16*)((char*)O + (unsigned)((row * ldc + col0) * 2));
#pragma unroll
                for (int bj = 0; bj < 2; ++bj) { const f32x4 v0 = acc[ai][bj][m][0] * s3, v1 = acc[ai][bj][m][1] * s3;
                    u32x4 w; w.x = pk2(v0[0], v0[1]); w.y = pk2(v0[2], v0[3]); w.z = pk2(v1[0], v1[1]); w.w = pk2(v1[2], v1[3]);
                    __builtin_nontemporal_store(w, (u32x4*)(rowp + bj * HALF)); } }
    }
};
struct EpiQKV {
    static constexpr bool PERM = true; static constexpr bool RESCALE = false;
    unsigned char* O; const float* rope; float ds;
    __device__ __forceinline__ void operator()(const f32x4 (&acc)[2][2][4][2], const Unit& u, int wr, int wc, int fr, int fq, const int ai) const {
        const int row0 = u.pm * BM + wr * 64 + fr;
        const int col_t = u.pn * BM;
        const int s = (col_t % 3072) >> 10;
        const float sc = ((s == 0) ? QSCALE * Q8_Q : ((s == 1) ? Q8_K : Q8_V)) * ds;
        const int gq = col_t / 3072, lg = 2 * gq, dlm = (1 << lg) - 1, mat0 = gq * 24 + s * 8 + ((col_t & 1023) >> 7);
        const bool rot = (s < 2) && (fq == 0);
        {
#pragma unroll
            for (int mp = 0; mp < 2; ++mp) {
                u32x2 wv[2][2];
#pragma unroll
                for (int r = 0; r < 2; ++r) { const int m = 2 * mp + r; const int row = row0 + ai * HALF + m * 16;
                    f32x4 cs = (f32x4){1.f, 1.f, 1.f, 1.f}, sn = (f32x4){0.f, 0.f, 0.f, 0.f};
                    if (rot) { const float* rp = rope + (size_t)row * 32 + 4 * wc; cs = *(const f32x4*)rp; sn = *(const f32x4*)(rp + 16); }
#pragma unroll
                    for (int bj = 0; bj < 2; ++bj) {
                        f32x4 v0 = acc[ai][bj][m][0], v1 = acc[ai][bj][m][1];
                        if (rot) { const f32x4 a0 = v0 * cs - v1 * sn, a1 = v1 * cs + v0 * sn; v0 = a0; v1 = a1; }
                        wv[r][bj].x = pk4_f8(v0[0], v0[1], v0[2], v0[3], sc); wv[r][bj].y = pk4_f8(v1[0], v1[1], v1[2], v1[3], sc); } }
                const int row = row0 + ai * HALF + (2 * mp + (fq & 1)) * 16;
                const int tt = row & (SEQ - 1), rowp = (row & ~(SEQ - 1)) + ((tt & (dlm)) << (12 - lg)) + (tt >> lg);
#pragma unroll
                for (int bj = 0; bj < 2; ++bj)
                    *(u32x4*)(O + ((size_t)(mat0 + bj) * T + rowp) * 128 + wc * 32 + 8 * (fq & ~1)) = pair16(wv[0][bj], wv[1][bj]);
            }
        }
    }
};
struct EpiUp {
    static constexpr bool PERM = true; static constexpr bool RESCALE = false;
    unsigned char* HB; const LAS unsigned* btab;
    __device__ __forceinline__ void operator()(const f32x4 (&acc)[2][2][4][2], const Unit& u, int wr, int wc, int fr, int fq, const int ai) const {
        const int row0 = u.pm * BM + wr * 64 + fr, col0 = u.pn * HALF + wc * 32 + 8 * fq;
        const LAS unsigned* bp = btab + u.ord * 128 + (wc * 32 + 8 * fq) / 2;
        const u32x4 gw = *(const LAS u32x4*)bp, uw = *(const LAS u32x4*)(bp + 64);
        f32x2 bg[4], bu[4];
#pragma unroll
        for (int i = 0; i < 4; ++i) { bg[i] = (f32x2){bflo(gw[i]), bfhi(gw[i])}; bu[i] = (f32x2){bflo(uw[i]), bfhi(uw[i])}; }
        constexpr float DS = 1.0f / (Q8_X * Q8_W), KE = -1.702f * 1.4426950408889634f;

            u32x2 wv[4];
#pragma unroll
            for (int m = 0; m < 4; ++m) {
                f32x2 o[4];
#pragma unroll
                for (int i = 0; i < 4; ++i) { const int n = i >> 1, j = 2 * (i & 1);
                    f32x2 gt = (f32x2){acc[ai][0][m][n][j], acc[ai][0][m][n][j + 1]} * DS + bg[i];
                    f32x2 up = (f32x2){acc[ai][1][m][n][j], acc[ai][1][m][n][j + 1]} * DS + bu[i];
                    gt[0] = fminf(gt[0], 7.0f); gt[1] = fminf(gt[1], 7.0f);
                    up[0] = __builtin_amdgcn_fmed3f(up[0], -7.0f, 7.0f); up[1] = __builtin_amdgcn_fmed3f(up[1], -7.0f, 7.0f);
                    f32x2 e = gt * KE; e[0] = __builtin_amdgcn_exp2f(e[0]); e[1] = __builtin_amdgcn_exp2f(e[1]);
                    e = e + 1.0f; e[0] = __builtin_amdgcn_rcpf(e[0]); e[1] = __builtin_amdgcn_rcpf(e[1]);
                    o[i] = (up * Q8_H + Q8_H) * (gt * e); }
                { int p0 = __builtin_amdgcn_cvt_pk_fp8_f32(o[0][0], o[0][1], 0, false); p0 = __builtin_amdgcn_cvt_pk_fp8_f32(o[1][0], o[1][1], p0, true);
                  int p1 = __builtin_amdgcn_cvt_pk_fp8_f32(o[2][0], o[2][1], 0, false); p1 = __builtin_amdgcn_cvt_pk_fp8_f32(o[3][0], o[3][1], p1, true); wv[m].x = (unsigned)p0; wv[m].y = (unsigned)p1; }
            }
#pragma unroll
            for (int mp = 0; mp < 2; ++mp)
                *(u32x4*)(HB + (size_t)(row0 + ai * HALF + (2 * mp + (fq & 1)) * 16) * 1024 + (col0 - 8 * (fq & 1))) = pair16(wv[2 * mp], wv[2 * mp + 1]);
    }
};
struct EpiDown {
    static constexpr bool PERM = true; static constexpr bool RESCALE = false;
    unsigned char* YS; const LAS unsigned* btab; const LAS int* slots;
    __device__ __forceinline__ void operator()(const f32x4 (&acc)[2][2][4][2], const Unit& u, int wr, int wc, int fr, int fq, const int ai) const {
        const int col0 = u.pn * BM + wc * 32 + 8 * fq;
        const LAS unsigned* bp = btab + u.ord * 128 + (wc * 32 + 8 * fq) / 2;
        f32x4 bv[2][2];
#pragma unroll
        for (int bj = 0; bj < 2; ++bj) { const u32x4 bw = *(const LAS u32x4*)(bp + bj * 64);
            bv[bj][0] = (f32x4){bflo(bw.x), bfhi(bw.x), bflo(bw.y), bfhi(bw.y)}; bv[bj][1] = (f32x4){bflo(bw.z), bfhi(bw.z), bflo(bw.w), bfhi(bw.w)}; }

#pragma unroll
            for (int mp = 0; mp < 2; ++mp) {
                const int slot = slots[u.ord * 256 + ai * HALF + wr * 64 + (2 * mp + (fq & 1)) * 16 + fr];
#pragma unroll
                for (int bj = 0; bj < 2; ++bj) { u32x2 wv[2];
#pragma unroll
                    for (int r = 0; r < 2; ++r) { const int m = 2 * mp + r; const f32x4 v0 = acc[ai][bj][m][0] * (1.0f / (Q8_H * Q8_W)) + bv[bj][0], v1 = acc[ai][bj][m][1] * (1.0f / (Q8_H * Q8_W)) + bv[bj][1];
                        wv[r].x = pk4_f8(v0[0], v0[1], v0[2], v0[3], Q8_Y); wv[r].y = pk4_f8(v1[0], v1[1], v1[2], v1[3], Q8_Y); }
                    const u32x4 d = pair16(wv[0], wv[1]);
                    if (slot >= 0) *(u32x4*)(YS + (size_t)slot * 1024 + (col0 - 8 * (fq & 1)) + bj * HALF) = d; }
            }
    }
};
}

struct TrItem { const float* W; const float* kscale; bf16* WT; int pitch, K, k0, n0, dstrow0, q8, hperm; };
__device__ __forceinline__ void tr_load(const TrItem& d, f32x4 (&ld)[16], int lane) {
    const int kq = lane >> 4, nq = lane & 15;
    const float* src = d.W + (size_t)(d.k0 + kq) * d.pitch + d.n0 + 4 * nq;
#pragma unroll
    for (int i = 0; i < 16; ++i) ld[i] = __builtin_nontemporal_load((const f32x4*)(src + (size_t)(4 * i) * d.pitch));
}
__device__ __forceinline__ void tr_finish(const TrItem& d, const f32x4 (&ld)[16], LAS float* scr, int lane) {
    const int kq = lane >> 4, nq = lane & 15;
#pragma unroll
    for (int i = 0; i < 16; ++i) { f32x4 v = ld[i]; if (d.kscale) v = v * d.kscale[d.k0 + 4 * i + kq]; LAS float* p = scr + (4 * i + kq) * 65 + 4 * nq; p[0] = v[0]; p[1] = v[1]; p[2] = v[2]; p[3] = v[3]; }
    asm volatile("s_waitcnt lgkmcnt(0)" ::: "memory");
    const int c = lane & 7;
    if (d.q8) {
#pragma unroll
        for (int j = 0; j < 8; ++j) { const int n = j * 8 + (lane >> 3); const LAS float* s = scr + (8 * c) * 65 + n;
            u32x2 o; o.x = pk4_f8(s[0 * 65], s[1 * 65], s[2 * 65], s[3 * 65], Q8_W); o.y = pk4_f8(s[4 * 65], s[5 * 65], s[6 * 65], s[7 * 65], Q8_W);
            int row = d.dstrow0 + n;
            if (d.hperm) { const int ng = d.n0 + n; if (((ng % 3072) >> 10) < 2) { const int dd = ng & 127;
                    const int pp = (dd < 32) ? (((dd & 15) >> 2) * 32 + (dd & 3) + 4 * (dd >> 4)) : (((dd - 32) / 24) * 32 + 8 + (dd - 32) % 24); row = (ng & ~127) + pp; } }
            *(u32x2*)((unsigned char*)d.WT + (size_t)row * d.K + d.k0 + 8 * c) = o; }
    } else {
#pragma unroll
    for (int j = 0; j < 8; ++j) { const int n = j * 8 + (lane >> 3); const LAS float* s = scr + (8 * c) * 65 + n;
        u32x4 o; o.x = pk2(s[0 * 65], s[1 * 65]); o.y = pk2(s[2 * 65], s[3 * 65]); o.z = pk2(s[4 * 65], s[5 * 65]); o.w = pk2(s[6 * 65], s[7 * 65]);
        *(u32x4*)(d.WT + (size_t)(d.dstrow0 + n) * d.K + d.k0 + 8 * c) = o; }
    }
    asm volatile("s_waitcnt lgkmcnt(0)" ::: "memory");
}
__constant__ float c_inv_freq[16] = {1.000000000e+00f, 4.403665960e-01f, 1.939227432e-01f, 8.539710194e-02f, 3.760603070e-02f, 1.656044088e-02f, 7.292664610e-03f, 3.211446106e-03f,
                                     1.414213562e-03f, 6.227724371e-04f, 2.742481884e-04f, 1.207697351e-04f, 5.318295734e-05f, 2.341999971e-05f, 1.031338525e-05f, 4.541670478e-06f};
__device__ __forceinline__ void sincos_reduced(float ang, float& sn, float& cs) {
    const double a = (double)ang;
    const double k = __builtin_rint(a * 0.15915494309189535);
    const double r = __builtin_fma(-k, 6.283185307179586, a) - k * 2.4492935982947064e-16;
    const float rf = (float)r;
    sn = __sinf(rf); cs = __cosf(rf);
}
struct Ptrs {
    const float *x; const int* pos; const float *attn_w_in, *attn_w_out, *ssm_w_in, *conv_w, *conv_b, *dt_bias, *a_log, *d_skip, *norm_w, *ssm_w_out;
    const float *w_router, *b_router, *w_up, *b_up, *w_dn, *b_dn, *ln_mix_g, *ln_mix_b, *ln_ffn_g, *ln_ffn_b;
};
constexpr int N1_UP = 32 * 16 * 32, N1_DN = 32 * 16 * 16, N1_ITEMS = N1_UP + N1_DN;
constexpr int HOSTED_ITEMS = 18432;
__device__ __forceinline__ TrItem moe1_item(const Ptrs& P, unsigned char* ws, int idx, int lay = 1) {
    TrItem d; d.kscale = nullptr; d.K = 1024; d.q8 = 1; d.hperm = 0;
    if (idx < N1_UP) { const int mat = 32 * lay + (idx >> 9), q = idx & 511, kb = q >> 5, nb = q & 31; const int n0 = nb * 64; const int bj = n0 >> 10, pn = (n0 & 1023) >> 7, cc = n0 & 127;
        d.W = P.w_up + (size_t)mat * 1024 * 2048; d.pitch = 2048; d.WT = (bf16*)(ws + WS_WUP + (size_t)mat * 2048 * 1024); d.k0 = kb * 64; d.n0 = n0; d.dstrow0 = pn * 256 + bj * 128 + cc; }
    else { const int r = idx - N1_UP, mat = 32 * lay + (r >> 8), q = r & 255, kb = q >> 4, nb = q & 15;
        d.W = P.w_dn + (size_t)mat * 1024 * 1024; d.pitch = 1024; d.WT = (bf16*)(ws + WS_WDN + (size_t)mat * 1024 * 1024); d.k0 = kb * 64; d.n0 = nb * 64; d.dstrow0 = nb * 64; }
    return d;
}
__device__ __forceinline__ void cvt_static(LAS unsigned char* lds, const Ptrs& P, unsigned char* ws, int first, int stride, int cnt) {
    const int lane = threadIdx.x & 63, w = __builtin_amdgcn_readfirstlane((int)threadIdx.x >> 6);
    LAS float* scr = (LAS float*)(lds + w * (65 * 64 * 4));
    if (cnt <= 0 || first >= N1_ITEMS) return;
    f32x4 la[16], lb[16]; TrItem da = moe1_item(P, ws, first), db = da; tr_load(da, la, lane);
    for (int i = 0;; i += 2) {
        const int ib = first + (i + 1) * stride; const bool hb = (i + 1 < cnt) && (ib < N1_ITEMS);
        if (hb) { db = moe1_item(P, ws, ib); tr_load(db, lb, lane); }
        tr_finish(da, la, scr, lane);
        if (!hb) break;
        const int ia = first + (i + 2) * stride; const bool ha = (i + 2 < cnt) && (ia < N1_ITEMS);
        if (ha) { da = moe1_item(P, ws, ia); tr_load(da, la, lane); }
        tr_finish(db, lb, scr, lane);
        if (!ha) break;
    }
}
__device__ __forceinline__ void cvt_plan(int NB, int G, int& rem_up, int& P_up, int& rem_dn, int& P_dn) {
    rem_up = (NB * 8) % G; const int n_iu = rem_up ? (G - rem_up) : 0; P_up = n_iu * 8 * CVT_Q_UP; if (P_up > N1_ITEMS) P_up = N1_ITEMS;
    rem_dn = (NB * 4) % G; const int n_id = rem_dn ? (G - rem_dn) : 0; P_dn = P_up + n_id * 8 * CVT_Q_DN; if (P_dn > N1_ITEMS) P_dn = N1_ITEMS;
}
__device__ __forceinline__ void p0_prologue(LAS unsigned char* lds, const Ptrs& P, unsigned char* ws, int G, int vcu) {
    const int tid = threadIdx.x, lane = tid & 63, w = __builtin_amdgcn_readfirstlane(tid >> 6);
    LAS float* scr = (LAS float*)(lds + w * (65 * 64 * 4));
    const int gw = vcu * 8 + w, NGW = G * 8;
    bf16* Wqkv = (bf16*)(ws + WS_WQKV); bf16* Wao = (bf16*)(ws + WS_WAO); bf16* Wsi = (bf16*)(ws + WS_WSI); bf16* Wso = (bf16*)(ws + WS_WSO);
    constexpr int I0 = 16 * 144, I1 = 16 * 16, I2 = 16 * 80, I3 = 32 * 16, I4 = 32 * 16 * 32, I5 = 32 * 16 * 16;
    constexpr int NITEMS = I0 + I1 + I2 + I3 + (N1_ITEMS - HOSTED_ITEMS);
    auto decode = [&](int it) -> TrItem {
        TrItem d; int r = it; d.kscale = nullptr; d.q8 = 0; d.hperm = 0;
        if (r < I0) { const int kb = r / 144, nb = r % 144; d.q8 = 1; d.hperm = 1; d.W = P.attn_w_in; d.pitch = NQKV; d.K = 1024; d.WT = Wqkv; d.k0 = kb * 64; d.n0 = nb * 64; d.dstrow0 = nb * 64; return d; } r -= I0;
        if (r < I1) { const int kb = r / 16, nb = r % 16; d.q8 = 1; d.W = P.attn_w_out; d.pitch = 1024; d.K = 1024; d.WT = Wao; d.k0 = kb * 64; d.n0 = nb * 64; d.dstrow0 = nb * 64; return d; } r -= I1;
        if (r < I2) { const int kb = r / 80, nb = r % 80; d.q8 = 1; d.W = P.ssm_w_in; d.pitch = SSM_PITCH; d.K = 1024; d.WT = Wsi; d.k0 = kb * 64; d.n0 = nb * 64; d.dstrow0 = nb * 64; return d; } r -= I2;
        if (r < I3) { const int kb = r / 16, nb = r % 16; d.q8 = 1; d.W = P.ssm_w_out; d.pitch = 1024; d.K = 2048; d.kscale = P.norm_w; d.WT = Wso; d.k0 = kb * 64; d.n0 = nb * 64; d.dstrow0 = nb * 64; return d; } r -= I3;
        return moe1_item(P, ws, r + HOSTED_ITEMS, 0);
    };
    if (gw < NITEMS) {
        f32x4 la[16], lb[16];
        TrItem da = decode(gw), db = da; tr_load(da, la, lane);
        for (int it = gw; it < NITEMS; it += 2 * NGW) {
            const bool hb = it + NGW < NITEMS;
            if (hb) { db = decode(it + NGW); tr_load(db, lb, lane); }
            tr_finish(da, la, scr, lane);
            if (!hb) break;
            const bool ha = it + 2 * NGW < NITEMS;
            if (ha) { da = decode(it + 2 * NGW); tr_load(da, la, lane); }
            tr_finish(db, lb, scr, lane);
            if (!ha) break;
        }
    }
    bf16* XBA = (bf16*)(ws + WS_XBA);
    for (int m0 = gw * 4; m0 < T; m0 += NGW * 4) {
        f32x4 v[4][4];
#pragma unroll
        for (int rr = 0; rr < 4; ++rr) { const f32x4* xr = (const f32x4*)(P.x + (size_t)(m0 + rr) * DM) + lane;
#pragma unroll
            for (int j = 0; j < 4; ++j) v[rr][j] = xr[64 * j]; }
#pragma unroll
        for (int rr = 0; rr < 4; ++rr) { u32x2* o = (u32x2*)(XBA + (size_t)(m0 + rr) * DM) + lane;
#pragma unroll
            for (int j = 0; j < 4; ++j) {
                *(unsigned*)(ws + WS_XQ0 + (size_t)(m0 + rr) * DM + 4 * lane + 256 * j) = pk4_f8(v[rr][j][0], v[rr][j][1], v[rr][j][2], v[rr][j][3], Q8_X); } }
    }
    float* rope = (float*)(ws + WS_ROPE);
    for (int idx = (vcu * 512 + tid); idx < T * 16; idx += G * 512) {
        const int tok = idx >> 4, i = idx & 15;
        const float ang = (float)P.pos[tok] * c_inv_freq[i];
        float sn, cs; sincos_reduced(ang, sn, cs);
        rope[(size_t)tok * 32 + i] = cs; rope[(size_t)tok * 32 + 16 + i] = sn;
    }
}

constexpr size_t PKOFF = (size_t)8 * T * 128;
__device__ __forceinline__ void attn_phase(LAS unsigned char* lds, const unsigned char* __restrict__ PROJ, unsigned char* __restrict__ OG, float* __restrict__ LSE, const int G, const int vcu) {
    const int tid = threadIdx.x, lane0 = tid & 63, w = __builtin_amdgcn_readfirstlane(tid >> 6);
    LAS unsigned char* Ks = lds; LAS unsigned char* Vt = lds + 2 * 128 * P256;
    constexpr int NU = BATCH * 3 * 8 * 32;
    const int per = (NU + G - 1) / G;
    const int u0 = vcu * per, u1 = (u0 + per < NU) ? (u0 + per) : NU;
    if (u0 >= u1) return;
    u32x4 kreg[2], vreg[2]; u32x4 qn[2];
    constexpr int PK8 = 144;
    unsigned long long mA = 0ull, mB = 0ull;
    { const int r16 = lane0 & 15, q4 = lane0 >> 4;
#pragma unroll
        for (int kt = 0; kt < 9; ++kt)
#pragma unroll
            for (int jj = 0; jj < 4; ++jj) { const int jr = 16 * kt + 4 * q4 + jj; const bool va = (jr >= r16) & (jr <= r16 + 128); const bool vb = va & (jr + 16 * w >= 128);
                mA |= (unsigned long long)va << (4 * kt + jj); mB |= (unsigned long long)vb << (4 * kt + jj); } }
    int pc = 0;
#define ATT_DECODE(U) const int bgh = (U) >> 5, sub = (U) & 31, h = bgh & 7, bg = bgh >> 3, g = bg % 3, b = bg / 3; \
        const int lg = (g == 0) ? 0 : ((g == 1) ? 2 : 4), dl = 1 << lg, nblk = 32 >> lg, r = sub >> (5 - lg), blk = sub & (nblk - 1); \
        const unsigned char* base_r = PROJ + ((size_t)(g * 24 + h) * T + (size_t)b * SEQ + (size_t)r * (SEQ >> lg)) * 128;
#define ATT_W2(X) pk2(X[0], X[1])
#define ATT_K16(V, LO, HI) do { _Pragma("unroll") for (int i_ = 0; i_ < 4; ++i_) { const f32x2 a_ = __builtin_amdgcn_cvt_pk_f32_fp8((int)(V)[i_], false), b_ = __builtin_amdgcn_cvt_pk_f32_fp8((int)(V)[i_], true); \
        if (i_ < 2) { (LO)[2 * i_] = ATT_W2(a_); (LO)[2 * i_ + 1] = ATT_W2(b_); } else { (HI)[2 * i_ - 4] = ATT_W2(a_); (HI)[2 * i_ - 3] = ATT_W2(b_); } } } while (0)
#define ATT_VT(V0, V1, C, JP, HALFSEL) do { _Pragma("unroll") for (int i_ = 0; i_ < 4; ++i_) { \
        const f32x2 a0_ = __builtin_amdgcn_cvt_pk_f32_fp8((int)(V0)[i_], false), b0_ = __builtin_amdgcn_cvt_pk_f32_fp8((int)(V0)[i_], true), a1_ = __builtin_amdgcn_cvt_pk_f32_fp8((int)(V1)[i_], false), b1_ = __builtin_amdgcn_cvt_pk_f32_fp8((int)(V1)[i_], true); \
        *(LAS unsigned*)(Vt + swz512(16 * (C) + 4 * i_ + 0, 256 * (HALFSEL) + 4 * (JP))) = pk2(a0_[0], a1_[0]); *(LAS unsigned*)(Vt + swz512(16 * (C) + 4 * i_ + 1, 256 * (HALFSEL) + 4 * (JP))) = pk2(a0_[1], a1_[1]); \
        *(LAS unsigned*)(Vt + swz512(16 * (C) + 4 * i_ + 2, 256 * (HALFSEL) + 4 * (JP))) = pk2(b0_[0], b1_[0]); *(LAS unsigned*)(Vt + swz512(16 * (C) + 4 * i_ + 3, 256 * (HALFSEL) + 4 * (JP))) = pk2(b0_[1], b1_[1]); } } while (0)
    {
        ATT_DECODE(u0)
        const int lane = lane0;
        const int jpv = 16 * (w >> 1) + (lane & 15), cv = 4 * (w & 1) + (lane >> 4);
        if (blk > 0) {
#pragma unroll
            for (int it = 0; it < 2; ++it) { const int item = it * 512 + tid, j = item >> 3, c = item & 7; const int ts = (blk - 1) * 128 + j;
                *(LAS u32x4*)(Ks + j * PK8 + 16 * c) = *(const u32x4*)(base_r + (size_t)ts * 128 + PKOFF + 16 * c); }
            { const int ts = (blk - 1) * 128 + 2 * jpv;
                const u32x4 v0 = *(const u32x4*)(base_r + (size_t)ts * 128 + 2 * PKOFF + 16 * cv), v1 = *(const u32x4*)(base_r + (size_t)(ts + 1) * 128 + 2 * PKOFF + 16 * cv);
                ATT_VT(v0, v1, cv, jpv, 0); }
        }
#pragma unroll
        for (int it = 0; it < 2; ++it) { const int item = it * 512 + tid, j = item >> 3, c = item & 7; kreg[it] = *(const u32x4*)(base_r + (size_t)(blk * 128 + j) * 128 + PKOFF + 16 * c); }
        { const int ts = blk * 128 + 2 * jpv;
            vreg[0] = *(const u32x4*)(base_r + (size_t)ts * 128 + 2 * PKOFF + 16 * cv); vreg[1] = *(const u32x4*)(base_r + (size_t)(ts + 1) * 128 + 2 * PKOFF + 16 * cv); }
        const int tq = blk * 128 + 16 * w + (lane & 15);
#pragma unroll
        for (int kk = 0; kk < 2; ++kk) qn[kk] = *(const u32x4*)(base_r + (size_t)tq * 128 + 64 * kk + 16 * (lane >> 4));
    }
    for (int u = u0; u < u1; ++u) {
        int lane = lane0; asm volatile("" : "+v"(lane));
        const int r16 = lane & 15, q4 = lane >> 4;
        ATT_DECODE(u)
        const int pp = pc; pc ^= 1;
        if (blk == 0) {
#pragma unroll
            for (int it = 0; it < 4; ++it) { const int item = it * 512 + tid, dd = item >> 4, c = item & 15; *(LAS u32x4*)(Vt + swz512(dd, 256 * pp + 16 * c)) = (u32x4){0u, 0u, 0u, 0u}; }
        }
#pragma unroll
        for (int it = 0; it < 2; ++it) { const int item = it * 512 + tid, j = item >> 3, c = item & 7; *(LAS u32x4*)(Ks + pc * (128 * P256) + j * PK8 + 16 * c) = kreg[it]; }
        { const int jpv = 16 * (w >> 1) + (lane & 15), cv = 4 * (w & 1) + (lane >> 4); ATT_VT(vreg[0], vreg[1], cv, jpv, pc); }
        const pg8::i32x8_t qf = __builtin_shufflevector(__builtin_bit_cast(pg8::i32x4_t, qn[0]), __builtin_bit_cast(pg8::i32x4_t, qn[1]), 0, 1, 2, 3, 4, 5, 6, 7);
        lds_barrier();
        if (u + 1 < u1) {
            const int un = u + 1;
            const int bgh2 = un >> 5, sub2 = un & 31, h2 = bgh2 & 7, bg2 = bgh2 >> 3, g2 = bg2 % 3, b2 = bg2 / 3;
            const int lg2 = (g2 == 0) ? 0 : ((g2 == 1) ? 2 : 4), nblk2 = 32 >> lg2, r2 = sub2 >> (5 - lg2), blk2 = sub2 & (nblk2 - 1);
            const unsigned char* base2 = PROJ + ((size_t)(g2 * 24 + h2) * T + (size_t)b2 * SEQ + (size_t)r2 * (SEQ >> lg2)) * 128;
#pragma unroll
            for (int it = 0; it < 2; ++it) { const int item = it * 512 + tid, j = item >> 3, c = item & 7; kreg[it] = *(const u32x4*)(base2 + (size_t)(blk2 * 128 + j) * 128 + PKOFF + 16 * c); }
            { const int jpv = 16 * (w >> 1) + (lane & 15), cv = 4 * (w & 1) + (lane >> 4); const int ts = blk2 * 128 + 2 * jpv;
                vreg[0] = *(const u32x4*)(base2 + (size_t)ts * 128 + 2 * PKOFF + 16 * cv); vreg[1] = *(const u32x4*)(base2 + (size_t)(ts + 1) * 128 + 2 * PKOFF + 16 * cv); }
            const int tq2 = blk2 * 128 + 16 * w + r16;
#pragma unroll
            for (int kk = 0; kk < 2; ++kk) qn[kk] = *(const u32x4*)(base2 + (size_t)tq2 * 128 + 64 * kk + 16 * q4);
        }
        f32x4 s[9];
#pragma unroll
        for (int kt = 0; kt < 9; ++kt) {
            const int ka = w + kt; const int hoff = ((ka < 8) ? pp : pc) * (128 * P256); const int row = 16 * (ka & 7) + r16;
            const u32x4 k0 = *(const LAS u32x4*)(Ks + hoff + row * PK8 + 16 * q4), k1 = *(const LAS u32x4*)(Ks + hoff + row * PK8 + 64 + 16 * q4);
            const pg8::i32x8_t kf = __builtin_shufflevector(__builtin_bit_cast(pg8::i32x4_t, k0), __builtin_bit_cast(pg8::i32x4_t, k1), 0, 1, 2, 3, 4, 5, 6, 7);
            s[kt] = __builtin_amdgcn_mfma_scale_f32_16x16x128_f8f6f4(kf, qf, (f32x4){0.f, 0.f, 0.f, 0.f}, 0, 0, 0, 0, 0, 0); }
        float mx = -INFINITY;
        const unsigned long long mk = (blk > 0) ? mA : mB; const unsigned mlo = (unsigned)mk, mhi = (unsigned)(mk >> 32);
#pragma unroll
        for (int kt = 0; kt < 9; ++kt)
#pragma unroll
            for (int jj = 0; jj < 4; ++jj) { const int bit = 4 * kt + jj; const bool valid = bit < 32 ? ((mlo >> bit) & 1u) : ((mhi >> (bit - 32)) & 1u);
                s[kt][jj] = valid ? s[kt][jj] : -INFINITY; mx = fmaxf(mx, s[kt][jj]); }
        mx = fmaxf(mx, __shfl_xor(mx, 16)); mx = fmaxf(mx, __shfl_xor(mx, 32));
        float ls = 0.f;
#pragma unroll
        for (int kt = 0; kt < 9; ++kt)
#pragma unroll
            for (int jj = 0; jj < 4; ++jj) { const float p = __builtin_amdgcn_exp2f((s[kt][jj] - mx) * (1.0f / (Q8_Q * Q8_K))); s[kt][jj] = p; ls += p; }
        ls += __shfl_xor(ls, 16); ls += __shfl_xor(ls, 32);
        f32x4 o[8];
#pragma unroll
        for (int dt = 0; dt < 8; ++dt) o[dt] = (f32x4){0.f, 0.f, 0.f, 0.f};
#pragma unroll
        for (int kp = 0; kp < 5; ++kp) {
            u32x4 pw; pw.x = pk2(s[2 * kp][0], s[2 * kp][1]); pw.y = pk2(s[2 * kp][2], s[2 * kp][3]);
            if (kp < 4) { pw.z = pk2(s[2 * kp + 1][0], s[2 * kp + 1][1]); pw.w = pk2(s[2 * kp + 1][2], s[2 * kp + 1][3]); } else { pw.z = 0u; pw.w = 0u; }
            const bf16x8 pf = as_bf16x8(pw);
            const int ka0 = w + 2 * kp, ka1 = ka0 + 1;
            const int c0 = 256 * ((ka0 < 8) ? pp : pc) + 2 * (16 * (ka0 & 7) + 4 * q4), c1 = 256 * ((ka1 < 8) ? pp : pc) + 2 * (16 * (ka1 & 7) + 4 * q4);
#pragma unroll
            for (int dt = 0; dt < 8; ++dt) { const int dd = 16 * dt + r16;
                const u32x2 lo = *(const LAS u32x2*)(Vt + swz512(dd, c0));
                u32x2 hi = (u32x2){0u, 0u}; if (kp < 4) hi = *(const LAS u32x2*)(Vt + swz512(dd, c1));
                const u32x4 av = (u32x4){lo.x, lo.y, hi.x, hi.y};
                o[dt] = mfma16(as_bf16x8(av), pf, o[dt]); }
        }
        const float inv = Q8_O / (ls * Q8_V);
        const int tq = blk * 128 + 16 * w + r16;
        const size_t tokq = (size_t)b * SEQ + (size_t)tq * dl + r;
        unsigned char* op = OG + ((size_t)g * T + tokq) * DM + h * 128 + 4 * q4;
#pragma unroll
        for (int dt = 0; dt < 8; ++dt) *(unsigned*)(op + 16 * dt) = pk4_f8(o[dt][0], o[dt][1], o[dt][2], o[dt][3], inv);
        if (q4 == 0) LSE[((size_t)g * T + tokq) * 8 + h] = (mx * (1.0f / (Q8_Q * Q8_K)) + __builtin_amdgcn_logf(ls)) * LN2F;
        lds_barrier();
    }
#undef ATT_DECODE
#undef ATT_W2
#undef ATT_K16
#undef ATT_VT
}

__device__ __forceinline__ void combine_phase(const unsigned char* __restrict__ OG, const float* __restrict__ LSE, unsigned char* __restrict__ OB, int G, int vcu) {
    const int tid = threadIdx.x, lane = tid & 63, w = tid >> 6;
    const int gw = vcu * 8 + w, NGW = G * 8;
    for (int row = gw; row < T; row += NGW) {
#pragma unroll
        for (int j = 0; j < 2; ++j) { const int col = 8 * lane + 512 * j, head = col >> 7;
            const float l0 = LSE[((size_t)0 * T + row) * 8 + head], l1 = LSE[((size_t)1 * T + row) * 8 + head], l2 = LSE[((size_t)2 * T + row) * 8 + head];
            const float m = fmaxf(l0, fmaxf(l1, l2)); float w0 = __expf(l0 - m), w1 = __expf(l1 - m), w2 = __expf(l2 - m); const float inv = 1.0f / (w0 + w1 + w2); w0 *= inv; w1 *= inv; w2 *= inv;
            const u32x2 a0 = *(const u32x2*)(OG + ((size_t)0 * T + row) * DM + col), a1 = *(const u32x2*)(OG + ((size_t)1 * T + row) * DM + col), a2 = *(const u32x2*)(OG + ((size_t)2 * T + row) * DM + col);
            float ov[8];
#pragma unroll
            for (int wd = 0; wd < 2; ++wd) {
                const f32x2 x0 = __builtin_amdgcn_cvt_pk_f32_fp8((int)a0[wd], false), x1 = __builtin_amdgcn_cvt_pk_f32_fp8((int)a1[wd], false), x2 = __builtin_amdgcn_cvt_pk_f32_fp8((int)a2[wd], false);
                const f32x2 y0 = __builtin_amdgcn_cvt_pk_f32_fp8((int)a0[wd], true), y1 = __builtin_amdgcn_cvt_pk_f32_fp8((int)a1[wd], true), y2 = __builtin_amdgcn_cvt_pk_f32_fp8((int)a2[wd], true);
                ov[4 * wd] = w0 * x0[0] + w1 * x1[0] + w2 * x2[0]; ov[4 * wd + 1] = w0 * x0[1] + w1 * x1[1] + w2 * x2[1]; ov[4 * wd + 2] = w0 * y0[0] + w1 * y1[0] + w2 * y2[0]; ov[4 * wd + 3] = w0 * y0[1] + w1 * y1[1] + w2 * y2[1]; }
            u32x2 o; o.x = pk4_f8(ov[0], ov[1], ov[2], ov[3], 1.0f); o.y = pk4_f8(ov[4], ov[5], ov[6], ov[7], 1.0f);
            *(u32x2*)(OB + (size_t)row * DM + col) = o; }
    }
}

__device__ __forceinline__ void ln_preload(LAS unsigned char* lds, const float* __restrict__ W32, int wpitch, int t0 = 0, int nthr = 512) {
    const int tid = (int)threadIdx.x - t0; LAS float* wl = (LAS float*)lds;
#pragma unroll 4
    for (int idx = tid; idx < 32768; idx += nthr) { const int k = idx >> 5, e = idx & 31; const int slot = (((k >> 8) * 4 + (k & 3)) * 64) + ((k >> 2) & 63);
        wl[slot * 36 + e] = W32[(size_t)k * wpitch + e]; }
}
template <int MIXSRC, int POST, bool WRITE_B, bool WRITE_F, bool XF32 = false>
__device__ __forceinline__ void ln_phase(LAS unsigned char* lds, const bf16* __restrict__ xres, const bf16* __restrict__ mixf, const unsigned char* __restrict__ YS, const float* __restrict__ gates_in,
                                         const float* __restrict__ gamma, const float* __restrict__ beta, float* outf, bf16* __restrict__ outb,
                                         const float* __restrict__ W32, int wpitch, const float* __restrict__ bias32, float* __restrict__ gates_out, int* __restrict__ lists, unsigned* counts, float* __restrict__ DTout,
                                         int G, int vcu, unsigned char* __restrict__ outq = nullptr) {
    const int tid = threadIdx.x, lane = tid & 63, w = __builtin_amdgcn_readfirstlane(tid >> 6);
    LAS float* wl = (LAS float*)lds;
    LAS int* sel_e = (LAS int*)(lds + LDS_SM); LAS int* sel_rk = sel_e + 512; LAS int* lcnt = sel_e + 1024; LAS int* gbase = sel_e + 1056;
    if (POST) {
        if (MK_PER_PHASE) ln_preload(lds, W32, wpitch);
        if (POST == 1 && tid < 32) lcnt[tid] = 0;
        __syncthreads();
    }
    int ebr = 0;
#pragma unroll
    for (int bb = 0; bb < 5; ++bb) ebr |= ((lane >> bb) & 1) << (4 - bb);
    float mybias = 0.f; if (POST) mybias = bias32[ebr];
    for (int chunk = vcu; chunk < T / 128; chunk += G) {
        u32x2 nxr[4], nmx[4]; f32x4 nxf[XF32 ? 4 : 1]; unsigned nys[4][4]; f32x4 ngv = (f32x4){0.f, 0.f, 0.f, 0.f};
        { const size_t row = (size_t)chunk * 128 + w * 16;
            if (MIXSRC == 1) ngv = *(const f32x4*)(gates_in + row * 4);
#pragma unroll
            for (int j = 0; j < 4; ++j) { if (XF32) nxf[XF32 ? j : 0] = *(const f32x4*)((const float*)xres + row * DM + 4 * lane + 256 * j); else nxr[j] = *(const u32x2*)(xres + row * DM + 4 * lane + 256 * j);
                if (MIXSRC == 0) nmx[j] = *(const u32x2*)(mixf + row * DM + 4 * lane + 256 * j);
                else {
#pragma unroll
                    for (int k = 0; k < 4; ++k) nys[j][k] = __builtin_nontemporal_load((const unsigned*)(YS + (row * 4 + k) * DM + 4 * lane + 256 * j)); } } }
        for (int pass = 0; pass < 16; ++pass) {
            const int rl = w * 16 + pass; const size_t row = (size_t)chunk * 128 + rl;
            asm volatile("" ::: "memory");
            int lo = lane; asm volatile("" : "+v"(lo));
            float xv[16];
            {
                f32x4 v[4]; float s = 0.f;
                const f32x4 gv = ngv * (MIXSRC == 1 ? 1.0f / Q8_Y : 1.0f);
#pragma unroll
                for (int j = 0; j < 4; ++j) {
                    f32x4 mix;
                    if (MIXSRC == 0) mix = (f32x4){bflo(nmx[j].x), bfhi(nmx[j].x), bflo(nmx[j].y), bfhi(nmx[j].y)};
                    else { mix = (f32x4){0.f, 0.f, 0.f, 0.f};
#pragma unroll
                        for (int k = 0; k < 4; ++k) { const f32x2 ylo = __builtin_amdgcn_cvt_pk_f32_fp8((int)nys[j][k], false), yhi = __builtin_amdgcn_cvt_pk_f32_fp8((int)nys[j][k], true);
                            mix[0] += gv[k] * ylo[0]; mix[1] += gv[k] * ylo[1]; mix[2] += gv[k] * yhi[0]; mix[3] += gv[k] * yhi[1]; } }
                    const f32x4 xr = XF32 ? nxf[XF32 ? j : 0] : (f32x4){bflo(nxr[j].x), bfhi(nxr[j].x), bflo(nxr[j].y), bfhi(nxr[j].y)};
                    v[j] = xr * ALPHA + mix; s += (v[j][0] + v[j][1]) + (v[j][2] + v[j][3]);
                }
                if (pass < 15) { const size_t nrow = row + 1;
                    if (MIXSRC == 1) ngv = *(const f32x4*)(gates_in + nrow * 4);
#pragma unroll
                    for (int j = 0; j < 4; ++j) { if (XF32) nxf[XF32 ? j : 0] = *(const f32x4*)((const float*)xres + nrow * DM + 4 * lo + 256 * j); else nxr[j] = *(const u32x2*)(xres + nrow * DM + 4 * lo + 256 * j);
                        if (MIXSRC == 0) nmx[j] = *(const u32x2*)(mixf + nrow * DM + 4 * lo + 256 * j);
                        else {
#pragma unroll
                            for (int k = 0; k < 4; ++k) nys[j][k] = __builtin_nontemporal_load((const unsigned*)(YS + (nrow * 4 + k) * DM + 4 * lo + 256 * j)); } } }
                const float mean = wave_sum(s) * (1.0f / DM); float s2 = 0.f;
#pragma unroll
                for (int j = 0; j < 4; ++j) { v[j] = v[j] - mean; s2 += (v[j][0] * v[j][0] + v[j][1] * v[j][1]) + (v[j][2] * v[j][2] + v[j][3] * v[j][3]); }
                const float rstd = 1.0f / sqrtf(wave_sum(s2) * (1.0f / DM) + LN_EPS);
#pragma unroll
                for (int j = 0; j < 4; ++j) { const f32x4 gm = *(const f32x4*)(gamma + 4 * lo + 256 * j), bt = *(const f32x4*)(beta + 4 * lo + 256 * j);
                    const f32x4 y = v[j] * rstd * gm + bt;
                    if (WRITE_F) __builtin_nontemporal_store(y, (f32x4*)(outf + row * DM + 4 * lo + 256 * j));
                    if (WRITE_B) { u32x2 q; q.x = pk2(y[0], y[1]); q.y = pk2(y[2], y[3]); *(u32x2*)(outb + row * DM + 4 * lo + 256 * j) = q; }
                    if (POST) *(unsigned*)(outq + row * DM + 4 * lo + 256 * j) = pk4_f8(y[0], y[1], y[2], y[3], Q8_X);
                    xv[4 * j + 0] = y[0]; xv[4 * j + 1] = y[1]; xv[4 * j + 2] = y[2]; xv[4 * j + 3] = y[3]; }
            }
            if (POST) {
                f32x2 acc2[16];
#pragma unroll
                for (int e = 0; e < 16; ++e) acc2[e] = (f32x2){0.f, 0.f};
#pragma unroll
                for (int jj = 0; jj < 16; ++jj) { const LAS float* wrow = wl + (jj * 64 + lane) * 36;
                    if ((jj & 1) == 0) asm volatile("" ::: "memory");
                    const f32x2 xx = (f32x2){xv[jj], xv[jj]};
#pragma unroll
                    for (int e4 = 0; e4 < 8; ++e4) { const f32x4 wv = *(const LAS f32x4*)(wrow + 4 * e4);
                        acc2[2 * e4] = acc2[2 * e4] + xx * (f32x2){wv[0], wv[1]}; acc2[2 * e4 + 1] = acc2[2 * e4 + 1] + xx * (f32x2){wv[2], wv[3]}; } }
                float acc0[32];
#pragma unroll
                for (int e = 0; e < 32; ++e) acc0[e] = acc2[e >> 1][e & 1];
#pragma unroll
                for (int bb = 0; bb < 5; ++bb) { const int hh = 16 >> bb; const unsigned um = ((lane >> bb) & 1) ? 0xffffffffu : 0u;
#pragma unroll
                    for (int i = 0; i < hh; ++i) { const unsigned l0 = __float_as_uint(acc0[i]), h0 = __float_as_uint(acc0[i + hh]);
                        const float k0 = __uint_as_float((h0 & um) | (l0 & ~um)), s0 = __uint_as_float((l0 & um) | (h0 & ~um)); acc0[i] = k0 + __shfl_xor(s0, 1 << bb); } }
                const float lg0 = acc0[0] + __shfl_xor(acc0[0], 32) + mybias;
                if (POST == 1) {
                    const unsigned ub = __float_as_uint(lg0); const unsigned uo = (ub & 0x80000000u) ? ~ub : (ub | 0x80000000u);
                    unsigned key = (uo & ~31u) | (unsigned)(31 - ebr);
                    float top0 = 0.f, myv = 0.f, esum = 0.f; int ek = 0;
#pragma unroll
                    for (int k = 0; k < 4; ++k) { unsigned bk = key;
#pragma unroll
                        for (int off = 1; off < 32; off <<= 1) { const unsigned ok = (unsigned)__shfl_xor((int)bk, off); bk = ok > bk ? ok : bk; }
                        const int be = 31 - (int)(__builtin_amdgcn_readfirstlane(bk) & 31u);
                        int wl_ = 0;
#pragma unroll
                        for (int bb = 0; bb < 5; ++bb) wl_ |= ((be >> bb) & 1) << (4 - bb);
                        const float bv = __uint_as_float(__builtin_amdgcn_readlane(__float_as_uint(lg0), wl_));
                        if (k == 0) top0 = bv;
                        const float ex = __expf(bv - top0); esum += ex;
                        myv = (lane == k) ? ex : myv; ek = (lane == k) ? be : ek; key = (ebr == be) ? 0u : key; }
                    if (lane < 4) {
                        gates_out[row * 4 + lane] = myv / esum;
                        const int rk = __hip_atomic_fetch_add(lcnt + ek, 1, __ATOMIC_RELAXED, __HIP_MEMORY_SCOPE_WORKGROUP);
                        sel_e[rl * 4 + lane] = ek; sel_rk[rl * 4 + lane] = rk; }
                } else {
                    if (lane < 32) { const float xx = lg0; const float y = __expf(-fabsf(xx)); const float l1p = (y < 1e-3f) ? (y - 0.5f * y * y) : __logf(1.0f + y);
                        DTout[row * 32 + ebr] = fmaxf(xx, 0.f) + l1p; }
                }
            }
        }
        if (POST == 1) {
            __syncthreads();
            if (tid < 32) gbase[tid] = (int)__hip_atomic_fetch_add(counts + tid, (unsigned)lcnt[tid], __ATOMIC_RELAXED, __HIP_MEMORY_SCOPE_AGENT);
            __syncthreads();
            { const int e = sel_e[tid]; lists[(size_t)e * 32768 + gbase[e] + sel_rk[tid]] = (chunk * 128 + (tid >> 2)) * 4 + (tid & 3); }
            __syncthreads();
            if (tid < 32) lcnt[tid] = 0;
            __syncthreads();
        }
    }
}

__device__ __forceinline__ void conv_item(const bf16* __restrict__ ZX, const float* __restrict__ conv_w, const float* __restrict__ conv_b, int tok0, int ch, u32x4 (&q)[8]) {
    const int sl = tok0 & (SEQ - 1);
    u32x4 raw[11];
#pragma unroll
    for (int i = 0; i < 11; ++i) { if (sl - 3 + i >= 0) raw[i] = *(const u32x4*)(ZX + (size_t)(tok0 - 3 + i) * NZX + 2048 + ch); else raw[i] = (u32x4){0u, 0u, 0u, 0u}; }
    f32x2 cw[4][4], cb[4];
#pragma unroll
    for (int k = 0; k < 4; ++k)
#pragma unroll
        for (int p = 0; p < 4; ++p) cw[k][p] = *(const f32x2*)(conv_w + (size_t)k * 3072 + ch + 2 * p);
#pragma unroll
    for (int p = 0; p < 4; ++p) cb[p] = *(const f32x2*)(conv_b + ch + 2 * p);
    f32x2 xin[11][4];
#pragma unroll
    for (int i = 0; i < 11; ++i)
#pragma unroll
        for (int p = 0; p < 4; ++p) xin[i][p] = (f32x2){bflo(raw[i][p]), bfhi(raw[i][p])};
#pragma unroll
    for (int t = 0; t < 8; ++t)
#pragma unroll
        for (int p = 0; p < 4; ++p) { f32x2 a = cb[p];
#pragma unroll
            for (int k = 0; k < 4; ++k) a = a + cw[k][p] * xin[t + k][p];
            q[t][p] = pk2(silu_f(a[0]), silu_f(a[1])); }
}
__device__ __forceinline__ void convcb_phase(LAS unsigned char* lds, const bf16* __restrict__ ZX, const float* __restrict__ conv_w, const float* __restrict__ conv_b, bf16* __restrict__ XA, bf16* __restrict__ CBG, int G, int vcu) {
    const int tid = threadIdx.x, lane = tid & 63, w = __builtin_amdgcn_readfirstlane(tid >> 6), r16 = lane & 15, q4 = lane >> 4;
    LAS unsigned char *Cs = lds, *Bs = lds + 128 * P256;
    for (int u = vcu; u < BATCH * 32; u += G) {
        const int tokc = u * 128;
        for (int it = 0; it < 8; ++it) { const int item = it * 512 + tid, cg = item & 255, tb = item >> 8;
            u32x4 q[8]; conv_item(ZX, conv_w, conv_b, tokc + 8 * tb, 8 * cg, q);
#pragma unroll
            for (int t = 0; t < 8; ++t) *(u32x4*)(XA + (size_t)(tokc + 8 * tb + t) * 3072 + 8 * cg) = q[t]; }
        for (int g = 0; g < 4; ++g) {
            { const int cgl = tid & 31, tb = tid >> 5; const int ch = (cgl < 16) ? (2048 + g * 128 + 8 * cgl) : (2560 + g * 128 + 8 * (cgl - 16));
                u32x4 q[8]; conv_item(ZX, conv_w, conv_b, tokc + 8 * tb, ch, q);
                LAS unsigned char* dst = (cgl < 16) ? Bs : Cs;
#pragma unroll
                for (int t = 0; t < 8; ++t) { *(u32x4*)(XA + (size_t)(tokc + 8 * tb + t) * 3072 + ch) = q[t]; *(LAS u32x4*)(dst + swz256(8 * tb + t, 16 * (cgl & 15))) = q[t]; } }
            __syncthreads();
            bf16x8 cf[4];
#pragma unroll
            for (int kk = 0; kk < 4; ++kk) cf[kk] = *(const LAS bf16x8*)(Cs + swz256(16 * w + r16, 64 * kk + 16 * q4));
            bf16* outp = CBG + ((size_t)u * 4 + g) * 16384 + (size_t)(16 * w + r16) * 128 + 4 * q4;
#pragma unroll
            for (int st = 0; st < 8; ++st) { f32x4 m = (f32x4){0.f, 0.f, 0.f, 0.f};
#pragma unroll
                for (int kk = 0; kk < 4; ++kk) { const bf16x8 a = *(const LAS bf16x8*)(Bs + swz256(16 * st + r16, 64 * kk + 16 * q4)); m = mfma16(a, cf[kk], m); }
                u32x2 q; q.x = pk2(m[0], m[1]); q.y = pk2(m[2], m[3]); *(u32x2*)(outp + 16 * st) = q; }
            __syncthreads();
        }
    }
}
__device__ __forceinline__ void ssd_phase(LAS unsigned char* lds, const bf16* __restrict__ ZX, const bf16* __restrict__ XA, const bf16* __restrict__ CBG, const float* __restrict__ DT,
                                          const float* __restrict__ a_log, const float* __restrict__ d_skip, unsigned char* __restrict__ Y, float* SSQ, int G, int vcu) {
    const int tid = threadIdx.x, lane = tid & 63, w = __builtin_amdgcn_readfirstlane(tid >> 6), r16_0 = lane & 15, q4_0 = lane >> 4;
    constexpr int SZ_BT = 128 * P256, SZ_XT = 64 * P256, O_XT = 2 * SZ_BT, O_PR = O_XT + 2 * SZ_XT, O_FA = O_PR + 2 * SZ_XT;
    LAS float* fa = (LAS float*)(lds + O_FA);
    for (int u = vcu; u < BATCH * 32; u += G) {
        const int b = u >> 5, h = u & 31, g = h >> 3;
        const float Ah = -__expf(a_log[h]); const float Dh = d_skip[h];
        f32x4 st[4];
#pragma unroll
        for (int pt = 0; pt < 4; ++pt) st[pt] = (f32x4){0.f, 0.f, 0.f, 0.f};
        const int jp = 16 * (w & 3) + (lane & 15);
        const unsigned voff = (unsigned)jp * 12288u + (unsigned)(lane >> 4) * 16u;
        int chb[3];
#pragma unroll
        for (int it = 0; it < 3; ++it) { const int gq = 2 * it + (w >> 2); chb[it] = 2 * ((it == 0) ? (h * 64 + 32 * gq) : (2048 + g * 128 + 32 * (gq - 2))); }
        const char* xab = (const char*)XA + (size_t)b * SEQ * 6144;
        const bf16* cbb = CBG + ((size_t)(b * 32) * 4 + g) * 16384;
        u32x4 pre[3][2]; float dn0 = 0.f, dn1 = 0.f; u32x2 cbr[8]; u32x4 cfr[4];
        {
#pragma unroll
            for (int it = 0; it < 3; ++it) { const char* sb = xab + chb[it]; pre[it][0] = *(const u32x4*)(sb + voff); pre[it][1] = *(const u32x4*)(sb + voff + 6144); }
            if (w == 0) { dn0 = DT[((size_t)b * SEQ + 2 * lane) * 32 + h]; dn1 = DT[((size_t)b * SEQ + 2 * lane + 1) * 32 + h]; }
        }
        for (int c = 0; c <= 32; ++c) {
            const int r16 = r16_0, q4 = q4_0;
            const int sb_ = c & 1;
            LAS unsigned char* BTn = lds + sb_ * SZ_BT; LAS unsigned char* xTn = lds + O_XT + sb_ * SZ_XT; LAS unsigned char* prn = lds + O_PR + sb_ * SZ_XT; LAS float* fan = fa + sb_ * 512;
            if (c >= 1) {
                const int cc = c - 1, cb_ = cc & 1; const int tok0 = b * SEQ + cc * 128;
                LAS unsigned char* BTs = lds + cb_ * SZ_BT; LAS unsigned char* xTs = lds + O_XT + cb_ * SZ_XT; LAS unsigned char* prevs = lds + O_PR + cb_ * SZ_XT;
                LAS float* acum = fa + cb_ * 512; LAS float* dtv = acum + 128; LAS float* wdec = acum + 256;
                const int l = 16 * w + r16;
                u32x2 zz[4];
#pragma unroll
                for (int pt = 0; pt < 4; ++pt) zz[pt] = *(const u32x2*)(ZX + ((size_t)tok0 + l) * NZX + h * 64 + 16 * pt + 4 * q4);
                const float al = acum[l];
                bf16x8 pf[4];
#pragma unroll
                for (int kp = 0; kp < 4; ++kp) {
                    const f32x4 as0 = *(const LAS f32x4*)(acum + 32 * kp + 4 * q4), ds0 = *(const LAS f32x4*)(dtv + 32 * kp + 4 * q4), as1 = *(const LAS f32x4*)(acum + 32 * kp + 16 + 4 * q4), ds1 = *(const LAS f32x4*)(dtv + 32 * kp + 16 + 4 * q4);
                    const u32x2 c0 = cbr[2 * kp], c1 = cbr[2 * kp + 1];
                    const float m0[4] = {bflo(c0.x), bfhi(c0.x), bflo(c0.y), bfhi(c0.y)}, m1[4] = {bflo(c1.x), bfhi(c1.x), bflo(c1.y), bfhi(c1.y)};
                    float mm[8];
#pragma unroll
                    for (int jj = 0; jj < 4; ++jj) { const int s_0 = 32 * kp + 4 * q4 + jj, s_1 = s_0 + 16;
                        mm[jj] = (s_0 <= l) ? m0[jj] * __expf(fminf(al - as0[jj], 0.f)) * ds0[jj] : 0.f; mm[4 + jj] = (s_1 <= l) ? m1[jj] * __expf(fminf(al - as1[jj], 0.f)) * ds1[jj] : 0.f; }
                    u32x4 pw; pw.x = pk2(mm[0], mm[1]); pw.y = pk2(mm[2], mm[3]); pw.z = pk2(mm[4], mm[5]); pw.w = pk2(mm[6], mm[7]); pf[kp] = as_bf16x8(pw); }
                f32x4 y[4];
#pragma unroll
                for (int pt = 0; pt < 4; ++pt) { y[pt] = (f32x4){0.f, 0.f, 0.f, 0.f};
#pragma unroll
                    for (int kk = 0; kk < 4; ++kk) { const bf16x8 a = *(const LAS bf16x8*)(prevs + swz256(16 * pt + r16, 64 * kk + 16 * q4)); y[pt] = mfma16(a, as_bf16x8(cfr[kk]), y[pt]); } }
                const float el = __expf(al);
#pragma unroll
                for (int pt = 0; pt < 4; ++pt) y[pt] = y[pt] * el;
#pragma unroll
                for (int kp = 0; kp < 4; ++kp)
#pragma unroll
                    for (int pt = 0; pt < 4; ++pt) { const u32x2 lo = *(const LAS u32x2*)(xTs + swz256(16 * pt + r16, 64 * kp + 8 * q4)), hi = *(const LAS u32x2*)(xTs + swz256(16 * pt + r16, 64 * kp + 32 + 8 * q4));
                        const u32x4 av = (u32x4){lo.x, lo.y, hi.x, hi.y}; y[pt] = mfma16(as_bf16x8(av), pf[kp], y[pt]); }
                if (c < 32) { const bf16* cp = cbb + (size_t)c * 65536 + (size_t)(16 * w + r16) * 128 + 4 * q4;
#pragma unroll
                    for (int i = 0; i < 8; ++i) cbr[i] = *(const u32x2*)(cp + 16 * i);
                    const bf16* ccp = XA + ((size_t)b * SEQ + c * 128 + 16 * w + r16) * 3072 + 2560 + g * 128 + 8 * q4;
#pragma unroll
                    for (int kk = 0; kk < 4; ++kk) cfr[kk] = *(const u32x4*)(ccp + 32 * kk); }
                { const size_t tok = (size_t)tok0 + l; float ssq = 0.f;
#pragma unroll
                    for (int pt = 0; pt < 4; ++pt) { const int p0 = 16 * pt + 4 * q4;
                        float ov[4];
#pragma unroll
                        for (int jj = 0; jj < 4; ++jj) { const float xvv = bf2f(*(const LAS unsigned short*)(xTs + swz256(p0 + jj, 2 * l)));
                            const unsigned zw = (jj < 2) ? zz[pt].x : zz[pt].y; const float zf = (jj & 1) ? bfhi(zw) : bflo(zw);
                            ov[jj] = (y[pt][jj] + Dh * xvv) * silu_f(zf); }
                        ssq += (ov[0] * ov[0] + ov[1] * ov[1]) + (ov[2] * ov[2] + ov[3] * ov[3]);
                        *(unsigned*)(Y + tok * DI + h * 64 + p0) = pk4_f8(ov[0], ov[1], ov[2], ov[3], Q8_YS); }
                    ssq += __shfl_xor(ssq, 16); ssq += __shfl_xor(ssq, 32);
                    if (q4 == 0) SSQ[tok * 32 + h] = ssq; }
                { const float dec = __expf(acum[384]);
#pragma unroll
                    for (int pt = 0; pt < 4; ++pt) st[pt] = st[pt] * dec;
#pragma unroll
                    for (int kk = 0; kk < 4; ++kk) { const u32x4 a = *(const LAS u32x4*)(BTs + swz256(16 * w + r16, 64 * kk + 16 * q4));
                        const f32x4 w0 = *(const LAS f32x4*)(wdec + 32 * kk + 8 * q4), w1 = *(const LAS f32x4*)(wdec + 32 * kk + 8 * q4 + 4);
                        u32x4 aw; aw.x = pk2(bflo(a.x) * w0[0], bfhi(a.x) * w0[1]); aw.y = pk2(bflo(a.y) * w0[2], bfhi(a.y) * w0[3]); aw.z = pk2(bflo(a.z) * w1[0], bfhi(a.z) * w1[1]); aw.w = pk2(bflo(a.w) * w1[2], bfhi(a.w) * w1[3]);
#pragma unroll
                        for (int pt = 0; pt < 4; ++pt) { const bf16x8 bfr = *(const LAS bf16x8*)(xTs + swz256(16 * pt + r16, 64 * kk + 16 * q4)); st[pt] = mfma16(as_bf16x8(aw), bfr, st[pt]); } } }
            } else {
                const bf16* cp = cbb + (size_t)(16 * w + r16) * 128 + 4 * q4;
#pragma unroll
                for (int i = 0; i < 8; ++i) cbr[i] = *(const u32x2*)(cp + 16 * i);
                const bf16* ccp = XA + ((size_t)b * SEQ + 16 * w + r16) * 3072 + 2560 + g * 128 + 8 * q4;
#pragma unroll
                for (int kk = 0; kk < 4; ++kk) cfr[kk] = *(const u32x4*)(ccp + 32 * kk);
            }
            if (c < 32) {
#pragma unroll
                for (int pt = 0; pt < 4; ++pt) { u32x2 q; q.x = pk2(st[pt][0], st[pt][1]); q.y = pk2(st[pt][2], st[pt][3]); *(LAS u32x2*)(prn + swz256(16 * pt + r16, 2 * (16 * w + 4 * q4))) = q; }
                if (w == 0) { const int t0 = 2 * lane; const float d0 = dn0, d1 = dn1;
                    const float a0 = d0 * Ah, a1 = d1 * Ah; const float sm = a0 + a1; float incl = sm;
#pragma unroll
                    for (int off = 1; off < 64; off <<= 1) { const float v = __shfl_up(incl, off); if (lane >= off) incl += v; }
                    const float c0 = (incl - sm) + a0, c1 = incl; const float tot = __shfl(incl, 63);
                    fan[t0] = c0; fan[t0 + 1] = c1; fan[128 + t0] = d0; fan[128 + t0 + 1] = d1; fan[256 + t0] = d0 * __expf(tot - c0); fan[256 + t0 + 1] = d1 * __expf(tot - c1); if (lane == 63) fan[384] = tot; }
#pragma unroll
                for (int it = 0; it < 3; ++it) { const int cgi = 4 * (2 * it + (w >> 2)) + (lane >> 4);
                    LAS unsigned char* dst = (it == 0) ? xTn : BTn; const int r0 = (it == 0) ? (8 * cgi) : (8 * (cgi - 8));
#pragma unroll
                    for (int i = 0; i < 8; ++i) { const unsigned a0 = pre[it][0][i >> 1], a1 = pre[it][1][i >> 1];
                        const unsigned lo = (i & 1) ? (a0 >> 16) : (a0 & 0xffffu), hi = (i & 1) ? (a1 & 0xffff0000u) : (a1 << 16);
                        *(LAS unsigned*)(dst + swz256(r0 + i, 4 * jp)) = lo | hi; } }
                if (c < 31) {
#pragma unroll
                    for (int it = 0; it < 3; ++it) { const char* sb = xab + (size_t)(c + 1) * (128 * 6144) + chb[it]; pre[it][0] = *(const u32x4*)(sb + voff); pre[it][1] = *(const u32x4*)(sb + voff + 6144); }
                    if (w == 0) { const size_t t1 = (size_t)b * SEQ + (c + 1) * 128; dn0 = DT[(t1 + 2 * lane) * 32 + h]; dn1 = DT[(t1 + 2 * lane + 1) * 32 + h]; }
                }
            }
            lds_barrier();
        }
    }
}
__device__ __forceinline__ void rmsnorm_phase(bf16* Y, int G, int vcu) {
    const int tid = threadIdx.x, lane = tid & 63, w = tid >> 6;
    const int gw = vcu * 8 + w, NGW = G * 8;
    for (int row = gw; row < T; row += NGW) {
        u32x4* rp = (u32x4*)(Y + (size_t)row * DI) + lane;
#pragma unroll
        for (int j = 0; j < 4; ++j) { const u32x4 a = rp[64 * j]; float f[8]; float ss = 0.f;
#pragma unroll
            for (int i = 0; i < 4; ++i) { f[2 * i] = bflo(a[i]); f[2 * i + 1] = bfhi(a[i]); ss += f[2 * i] * f[2 * i] + f[2 * i + 1] * f[2 * i + 1]; }
            const float sc = 1.0f / sqrtf(wave_sum(ss) * (1.0f / 512.0f) + RMS_EPS);
            u32x4 o;
#pragma unroll
            for (int i = 0; i < 4; ++i) o[i] = pk2(f[2 * i] * sc, f[2 * i + 1] * sc);
            rp[64 * j] = o; }
    }
}

__device__ __forceinline__ int moe_tables(LAS unsigned char* lds, const unsigned* counts) {
    const int tid = threadIdx.x;
    LAS int* tab = (LAS int*)(lds + LDS_TAB);
    if (tid < 32) tab[64 + tid] = (int)__hip_atomic_load(counts + tid, __ATOMIC_RELAXED, __HIP_MEMORY_SCOPE_AGENT);
    __syncthreads();
    if (tid == 0) { int pre = 0; for (int e = 0; e < 32; ++e) { tab[e] = pre; pre += (tab[64 + e] + 255) >> 8; } tab[32] = pre; }
    __syncthreads();
    const int NB = tab[32];
    for (int rb = tid; rb < NB; rb += 512) { int e = 0; while (e < 31 && tab[e + 1] <= rb) ++e; tab[128 + rb] = e; }
    __syncthreads();
    return NB;
}

struct Args { const void* in[22]; float* out; unsigned char* ws; int ph_lo, ph_hi; };
__global__ void __launch_bounds__(512, 2) fwd_kernel(Args args) {
    extern __shared__ __attribute__((aligned(16))) unsigned char lds_raw[];
    LAS unsigned char* lds = (LAS unsigned char*)lds_raw;
    const int tid = threadIdx.x;
    const int G = gridDim.x; const int bx = blockIdx.x; const int vcu = (G % 8 == 0) ? (bx % 8) * (G / 8) + bx / 8 : bx;
    unsigned char* ws = args.ws;
    unsigned* ctl = (unsigned*)(ws + WS_CTL);
    Ptrs P;
    P.x = (const float*)args.in[0]; P.pos = (const int*)args.in[1]; P.attn_w_in = (const float*)args.in[2]; P.attn_w_out = (const float*)args.in[3]; P.ssm_w_in = (const float*)args.in[4];
    P.conv_w = (const float*)args.in[5]; P.conv_b = (const float*)args.in[6]; P.dt_bias = (const float*)args.in[7]; P.a_log = (const float*)args.in[8]; P.d_skip = (const float*)args.in[9];
    P.norm_w = (const float*)args.in[10]; P.ssm_w_out = (const float*)args.in[11]; P.w_router = (const float*)args.in[12]; P.b_router = (const float*)args.in[13]; P.w_up = (const float*)args.in[14];
    P.b_up = (const float*)args.in[15]; P.w_dn = (const float*)args.in[16]; P.b_dn = (const float*)args.in[17]; P.ln_mix_g = (const float*)args.in[18]; P.ln_mix_b = (const float*)args.in[19];
    P.ln_ffn_g = (const float*)args.in[20]; P.ln_ffn_b = (const float*)args.in[21];
    volatile LAS unsigned* misc = (volatile LAS unsigned*)(lds + LDS_MISC);
    if (tid < 64) misc[tid] = 0u;
    __syncthreads();
    XcdBarrier bar; bar.bar = ctl + CW_BAR; bar.x = 0; bar.st = misc;
    if (!MK_PER_PHASE) bar = xcd_barrier_post(ctl + CW_BAR, misc);
    const int lo = args.ph_lo, hi = args.ph_hi;
#ifndef PH_MASK
#define PH_MASK 0x1FFFF
#endif
#define IN(k) ((((PH_MASK) >> (k)) & 1) && lo <= (k) && (k) < hi)
#define SEAM(k) do { if (IN(k) && IN((k) + 1)) xcd_barrier(bar); } while (0)
#define SEAM_PRE(k, W, PITCH) do { if (IN(k) && IN((k) + 1)) { const float* w_ = (W); const int p_ = (PITCH); xcd_barrier(bar, [=]() { ln_preload(lds, w_, p_, 64, 448); }); } } while (0)

    bf16* Wqkv = (bf16*)(ws + WS_WQKV); bf16* Wao = (bf16*)(ws + WS_WAO); bf16* Wsi = (bf16*)(ws + WS_WSI); bf16* Wso = (bf16*)(ws + WS_WSO);
    bf16* XBA = (bf16*)(ws + WS_XBA); bf16* XBB = (bf16*)(ws + WS_XBB); bf16* MIXB = (bf16*)(ws + WS_X1);
    unsigned char* PROJ = ws + WS_BIG; bf16* ZX = (bf16*)(ws + WS_BIG); bf16* XA = (bf16*)(ws + WS_XA); bf16* CBG = (bf16*)(ws + WS_CBG); unsigned char* HB8 = ws + WS_HB; unsigned char* XQ = ws + WS_XQ; unsigned char* YS = ws + WS_YS;
    unsigned char* OG = ws + WS_OG; unsigned char* YB = ws + WS_OG;
    float* rope = (float*)(ws + WS_ROPE); float* gates = (float*)(ws + WS_GATES); float* DT = (float*)(ws + WS_DT); int* lists = (int*)(ws + WS_LIST); float* LSE = (float*)(ws + WS_LSE); float* SSQ = (float*)(ws + WS_LSE);

    if (IN(0)) { p0_prologue(lds, P, ws, G, vcu); }
    SEAM(0);


#define MOE_BLOCK(LAYER, PB) do { \
    unsigned* counts = ctl + CW_CNT + 64 * (LAYER); \
    if (IN((PB) + 0)) { \
        if ((LAYER) == 0) ln_phase<0, 1, true, false, true>(lds, (const bf16*)P.x, MIXB, nullptr, nullptr, P.ln_mix_g, P.ln_mix_b, nullptr, XBB, P.w_router, NE, P.b_router, gates, lists, counts, nullptr, G, vcu, XQ);   \
        else ln_phase<0, 1, true, false>(lds, XBA, MIXB, nullptr, nullptr, P.ln_mix_g + (LAYER) * DM, P.ln_mix_b + (LAYER) * DM, nullptr, XBB, \
                             P.w_router + (size_t)(LAYER) * DM * NE, NE, P.b_router + (LAYER) * NE, gates, lists, counts, nullptr, G, vcu, XQ); } \
    SEAM((PB) + 0); \
    if (IN((PB) + 1)) { \
        const int NB = moe_tables(lds, counts); \
        LAS int* tab = (LAS int*)(lds + LDS_TAB); LAS unsigned short* toks = (LAS unsigned short*)(lds + LDS_AUX); \
        const int NU = NB * 8; \
        const int nun = (vcu < NU) ? ((NU - vcu + G - 1) / G) : 0; \
        for (int idx = tid; idx < nun * 256 && idx < 17 * 256; idx += 512) { const int i = idx >> 8, row = idx & 255; const int L = i * G + vcu; const int rb = L >> 3; const int e = tab[128 + rb]; \
            const int r0 = (rb - tab[e]) * 256, cnt = tab[64 + e]; int si = r0 + row; si = si < cnt ? si : cnt - 1; toks[idx] = (unsigned short)(lists[(size_t)e * 32768 + si] >> 2); } \
        LAS unsigned* btab = (LAS unsigned*)(lds + LDS_SLOT); \
        for (int idx = tid; idx < nun * 128 && idx < 17 * 128; idx += 512) { const int i = idx >> 7, cp = idx & 127; const int L = i * G + vcu; const int rb = L >> 3, pn = L & 7; const int e = tab[128 + rb]; \
            const float* bsrc = P.b_up + ((size_t)(LAYER) * 32 + e) * 2048 + ((cp < 64) ? (pn * 128 + 2 * cp) : (1024 + pn * 128 + 2 * (cp - 64))); btab[idx] = pk2(bsrc[0], bsrc[1]); } \
        __syncthreads(); \
        pg8::MoeOrder<true> S; S.A = (const char*)XQ; S.Bt = (const char*)(ws + WS_WUP + (size_t)(LAYER) * 32 * 2048 * 1024); S.K = DM / 2;   S.N = 2048; S.nN = 8; S.G = G; S.c = vcu; S.NU = NU; S.tab = tab; S.toks = toks; \
        pg8::EpiUp E{HB8, btab}; \
        if ((LAYER) == 0) { pg8::HostCvt H; H.w_up = P.w_up + (size_t)32 * 1024 * 2048; H.w_dn = P.w_dn + (size_t)32 * 1024 * 1024; H.wt_up = ws + WS_WUP + (size_t)32 * 2048 * 1024; H.wt_dn = ws + WS_WDN + (size_t)32 * 1024 * 1024; \
            H.base = 0; H.limit = 49152; H.G = G; H.c = vcu;   \
            pg8::gemm_phase<true>(lds, DM / 2, S, E, H); } \
        else { pg8::HostNone H; pg8::gemm_phase<true>(lds, DM / 2, S, E, H); } } \
    SEAM((PB) + 1); \
    if (IN((PB) + 2)) { \
        const int NB = moe_tables(lds, counts); \
        LAS int* tab = (LAS int*)(lds + LDS_TAB); LAS int* slots = (LAS int*)(lds + LDS_SLOT); LAS unsigned* dbtab = (LAS unsigned*)(lds + LDS_AUX); \
        { const int NU = NB * 4; const int nun = (vcu < NU) ? ((NU - vcu + G - 1) / G) : 0; \
          for (int idx = tid; idx < nun * 256 && idx < 9 * 256; idx += 512) { const int i = idx >> 8, row = idx & 255; const int L = i * G + vcu; const int rb = L >> 2; const int e = tab[128 + rb]; \
              const int si = (rb - tab[e]) * 256 + row; slots[idx] = (si < tab[64 + e]) ? lists[(size_t)e * 32768 + si] : -1; } \
          for (int idx = tid; idx < nun * 128 && idx < 9 * 128; idx += 512) { const int i = idx >> 7, cp = idx & 127; const int L = i * G + vcu; const int rb = L >> 2, pn = L & 3; const int e = tab[128 + rb]; \
              const float* bsrc = P.b_dn + ((size_t)(LAYER) * 32 + e) * 1024 + pn * 256 + 2 * cp; dbtab[idx] = pk2(bsrc[0], bsrc[1]); } \
          __syncthreads(); } \
        pg8::MoeOrder<false> S; S.A = (const char*)HB8; S.Bt = (const char*)(ws + WS_WDN + (size_t)(LAYER) * 32 * 1024 * 1024); S.K = DM / 2; S.N = 1024; S.nN = 4; S.G = G; S.c = vcu; S.NU = NB * 4; S.tab = tab; S.toks = nullptr; \
        pg8::EpiDown E{YS, dbtab, slots}; \
        if ((LAYER) == 0) { pg8::HostCvt H; H.w_up = P.w_up + (size_t)32 * 1024 * 2048; H.w_dn = P.w_dn + (size_t)32 * 1024 * 1024; H.wt_up = ws + WS_WUP + (size_t)32 * 2048 * 1024; H.wt_dn = ws + WS_WDN + (size_t)32 * 1024 * 1024; \
            H.base = NB * 64; H.limit = 49152; H.G = G; H.c = vcu;   \
            pg8::gemm_phase<true>(lds, DM / 2, S, E, H); \
            } \
        else { pg8::HostNone H; pg8::gemm_phase<true>(lds, DM / 2, S, E, H); } } \
    if ((LAYER) == 0) SEAM_PRE((PB) + 2, P.ssm_w_in + NZX, SSM_PITCH); else SEAM((PB) + 2); \
    if (IN((PB) + 3)) { \
        if ((LAYER) == 0) ln_phase<1, 2, true, false>(lds, XBB, nullptr, YS, gates, P.ln_ffn_g, P.ln_ffn_b, nullptr, XBA, P.ssm_w_in + NZX, SSM_PITCH, P.dt_bias, nullptr, nullptr, nullptr, DT, G, vcu, ws + WS_XQ0); \
        else ln_phase<1, 0, false, true>(lds, XBB, nullptr, YS, gates, P.ln_ffn_g + DM, P.ln_ffn_b + DM, args.out, nullptr, nullptr, 0, nullptr, nullptr, nullptr, nullptr, nullptr, G, vcu); } \
    } while (0)

    if (IN(1)) { pg8::DenseOrder S; S.init(ws + WS_XQ0, Wqkv, T, NQKV, DM / 2, G, bx); pg8::EpiQKV E{PROJ, rope, 1.0f / (Q8_X * Q8_W)};
        pg8::HostCvt H; H.w_up = P.w_up; H.w_dn = P.w_dn; H.wt_up = ws + WS_WUP; H.wt_dn = ws + WS_WDN; H.base = 0; H.limit = 2 * HOSTED_ITEMS; H.G = G; H.c = bx;
        pg8::gemm_phase<true>(lds, DM / 2, S, E, H); }
    SEAM(1);
    if (IN(2)) attn_phase(lds, PROJ, OG, LSE, G, vcu);
    SEAM(2);
    if (IN(3)) combine_phase(OG, LSE, ws + WS_OB, G, vcu);
    SEAM(3);
    if (IN(4)) { pg8::DenseOrder S; S.init(ws + WS_OB, Wao, T, DM, DM / 2, G, bx); pg8::EpiBf16 E{MIXB, DM, 1.0f / (Q8_O * Q8_W)}; pg8::HostNone H; pg8::gemm_phase<true>(lds, DM / 2, S, E, H); }
    SEAM_PRE(4, P.w_router, NE);
    MOE_BLOCK(0, 5);
    SEAM(8);
    if (IN(9)) { pg8::DenseOrder S; S.init(ws + WS_XQ0, Wsi, T, NZX, DM / 2, G, bx); pg8::EpiBf16 E{ZX, NZX, 1.0f / (Q8_X * Q8_W)}; pg8::HostNone H; pg8::gemm_phase<true>(lds, DM / 2, S, E, H); }
    SEAM(9);
    if (IN(10)) {
        convcb_phase(lds, ZX, P.conv_w, P.conv_b, XA, CBG, G, vcu); }
    SEAM(10);
    if (IN(11)) ssd_phase(lds, ZX, XA, CBG, DT, P.a_log, P.d_skip, YB, SSQ, G, vcu);
    SEAM(11);
    if (IN(12)) { pg8::DenseOrder S; S.init(YB, Wso, T, DM, DI / 2, G, bx);
        LAS float* stab = (LAS float*)(lds + LDS_AUX);
        for (int i = 0; i < 4; ++i) { pg8::Unit uu; if (!S.next(i, uu)) break;
            for (int idx = tid; idx < 1024; idx += 512) { const int rl = idx >> 2, g = idx & 3; const float* sp = SSQ + (size_t)(uu.pm * 256 + rl) * 32 + g * 8;
                const f32x4 a = *(const f32x4*)sp, b4 = *(const f32x4*)(sp + 4); const float sum = ((a[0] + a[1]) + (a[2] + a[3])) + ((b4[0] + b4[1]) + (b4[2] + b4[3]));
                stab[(i * 256 + rl) * 4 + g] = __builtin_amdgcn_rsqf(sum * (1.0f / 512.0f) + RMS_EPS); } }
        __syncthreads();
        pg8::EpiRms E{MIXB, DM, stab}; pg8::HostNone H; pg8::gemm_phase<true>(lds, DI / 2, S, E, H); }
    SEAM_PRE(12, P.w_router + (size_t)DM * NE, NE);
    MOE_BLOCK(1, 13);
#undef IN
#undef SEAM
#undef MOE_BLOCK
}

constexpr int NPHASE = 17;
extern "C" void kernel_launch(void* const* d_in, const int* in_sizes, int n_in, void* d_out, int out_size, void* d_ws, size_t ws_size, hipStream_t stream) {
    static int grid = 0;
    if (grid == 0) {
        if (n_in != 22 || in_sizes[0] != T * DM || out_size != T * DM || ws_size < WS_END) { fprintf(stderr, "kernel_launch: unexpected shapes / workspace (n_in %d, in0 %d, out %d, ws %zu, need %zu)\n", n_in, n_in > 0 ? in_sizes[0] : -1, out_size, ws_size, (size_t)WS_END); grid = -1; return; }
        int dev = 0, cus = 0;
        if (hipGetDevice(&dev) != hipSuccess || hipDeviceGetAttribute(&cus, hipDeviceAttributeMultiprocessorCount, dev) != hipSuccess) { fprintf(stderr, "kernel_launch: device query failed\n"); grid = -1; return; }
        if (hipFuncSetAttribute((const void*)fwd_kernel, hipFuncAttributeMaxDynamicSharedMemorySize, LDS_BYTES) != hipSuccess) { fprintf(stderr, "kernel_launch: hipFuncSetAttribute failed\n"); grid = -1; return; }
        int per_cu = 0;
        if (hipOccupancyMaxActiveBlocksPerMultiprocessor(&per_cu, (const void*)fwd_kernel, 512, LDS_BYTES) != hipSuccess || per_cu < 1) fprintf(stderr, "kernel_launch: occupancy query reports %d\n", per_cu);
        (void)hipGetLastError();
        grid = cus;
        if (grid < 256) { fprintf(stderr, "kernel_launch: built for >= 256 CUs, got %d\n", grid); }
        if (grid > 256) grid = 256;
    }
    if (grid < 0) return;
    if (hipMemsetAsync((char*)d_ws + WS_CTL, 0, CTL_ZERO_BYTES, stream) != hipSuccess) { fprintf(stderr, "kernel_launch: memset failed\n"); return; }
    Args a{};
    for (int i = 0; i < 22; ++i) a.in[i] = d_in[i];
    a.out = (float*)d_out; a.ws = (unsigned char*)d_ws;
#if MK_PER_PHASE
    for (int p = 0; p < NPHASE; ++p) { a.ph_lo = p; a.ph_hi = p + 1; hipLaunchKernelGGL(fwd_kernel, dim3(grid), dim3(512), LDS_BYTES, stream, a); }
#else
    a.ph_lo = 0; a.ph_hi = NPHASE;
    hipLaunchKernelGGL(fwd_kernel, dim3(grid), dim3(512), LDS_BYTES, stream, a);
#endif
    const hipError_t le = hipPeekAtLastError();
    if (le != hipSuccess) fprintf(stderr, "kernel_launch: launch failed: %s\n", hipGetErrorName(le));
}
```

```cpp
#include <hip/hip_runtime.h>
#include <cstdio>
#include <cstdint>

#ifndef MK_PER_PHASE
#define MK_PER_PHASE 0
#endif

#define GAS __attribute__((address_space(1)))
#define LAS __attribute__((address_space(3)))
typedef unsigned short bf16;
typedef short bf16x8 __attribute__((ext_vector_type(8)));
typedef float f32x4 __attribute__((ext_vector_type(4)));
typedef float f32x2 __attribute__((ext_vector_type(2)));
typedef unsigned u32x4 __attribute__((ext_vector_type(4)));
typedef unsigned u32x2 __attribute__((ext_vector_type(2)));

constexpr int BATCH = 8, SEQ = 4096, DM = 1024, T = BATCH * SEQ;
constexpr int NQKV = 9216;
constexpr int NZX = 5120, SSM_PITCH = 5152, DI = 2048;
constexpr int NE = 32;
constexpr float LN_EPS = 1e-5f, RMS_EPS = 1e-5f, ALPHA = 1.41421356237309505f;
constexpr float QSCALE = 0.12751743082459868f;
constexpr float LN2F = 0.6931471805599453f;

constexpr size_t MiB = 1u << 20;
constexpr size_t WS_CTL = 0, CTL_ZERO_BYTES = 128 * 1024;
constexpr size_t WS_ROPE = 1 * MiB;
constexpr size_t WS_GATES = 5 * MiB;
constexpr size_t WS_DT = 6 * MiB;
constexpr size_t WS_LIST = 10 * MiB;
constexpr size_t WS_LSE = 14 * MiB;
constexpr size_t WS_WQKV = 18 * MiB;
constexpr size_t WS_WAO = 36 * MiB;
constexpr size_t WS_WSI = 38 * MiB;
constexpr size_t WS_WSO = 48 * MiB;
constexpr size_t WS_WUP = 52 * MiB;
constexpr size_t WS_XQ = 180 * MiB;
constexpr size_t WS_XQ0 = 212 * MiB;
constexpr size_t WS_WDN = 308 * MiB;
constexpr size_t WS_XBA = 436 * MiB;
constexpr size_t WS_XBB = 500 * MiB;
constexpr size_t WS_X1 = 564 * MiB;
constexpr size_t WS_BIG = 692 * MiB;
constexpr size_t WS_XA = 1012 * MiB;
constexpr size_t WS_CBG = 1204 * MiB;
constexpr size_t WS_HB = WS_BIG;
constexpr size_t WS_YS = 964 * MiB;
constexpr size_t WS_OG = 1268 * MiB;
constexpr size_t WS_OB = 1460 * MiB;
constexpr size_t WS_END = 1524 * MiB;
constexpr int CW_BAR = 4096;
constexpr int CW_CNT = 16384;
constexpr int CW_CVT = 20000;
#ifndef CVT_Q_UP
#define CVT_Q_UP 5
#endif
#ifndef CVT_Q_DN
#define CVT_Q_DN 5
#endif

constexpr int LDS_AUX = 131072;
constexpr int LDS_TAB = 131072 + 17 * 512;
constexpr int LDS_SLOT = LDS_TAB + 2688;
constexpr int LDS_SM = 147456;
constexpr int LDS_MISC = 155648;
constexpr int LDS_BYTES = 156672;

__device__ __forceinline__ float bf2f(unsigned short b) { return __uint_as_float(((unsigned)b) << 16); }
__device__ __forceinline__ float bflo(unsigned w) { return __uint_as_float(w << 16); }
__device__ __forceinline__ float bfhi(unsigned w) { return __uint_as_float(w & 0xffff0000u); }
typedef __bf16 bf16x2_t __attribute__((ext_vector_type(2)));
constexpr float Q8_X = 8.0f, Q8_W = 256.0f, Q8_H = 8.0f, Q8_O = 32.0f, Q8_Y = 32.0f, Q8_Q = 64.0f, Q8_K = 8.0f, Q8_V = 8.0f, Q8_YS = 16.0f;
__device__ __forceinline__ unsigned pk4_f8(float a, float b, float c, float d, float sc) {
    a = __builtin_fminf(__builtin_fmaxf(a * sc, -448.f), 448.f); b = __builtin_fminf(__builtin_fmaxf(b * sc, -448.f), 448.f);
    c = __builtin_fminf(__builtin_fmaxf(c * sc, -448.f), 448.f); d = __builtin_fminf(__builtin_fmaxf(d * sc, -448.f), 448.f);
    int p = __builtin_amdgcn_cvt_pk_fp8_f32(a, b, 0, false); p = __builtin_amdgcn_cvt_pk_fp8_f32(c, d, p, true); return (unsigned)p; }
__device__ __forceinline__ unsigned pk2(float lo, float hi) { const f32x2 v = {lo, hi}; const bf16x2_t b = __builtin_convertvector(v, bf16x2_t); return __builtin_bit_cast(unsigned, b); }
__device__ __forceinline__ float wave_sum(float v) {
#pragma unroll
    for (int o = 1; o < 64; o <<= 1) v += __shfl_xor(v, o);
    return v;
}
constexpr int P256 = 272, P512 = 528;
__device__ __forceinline__ int swz256(int row, int bc) { return row * P256 + bc; }
__device__ __forceinline__ int swz512(int row, int bc) { return row * P512 + bc; }
__device__ __forceinline__ bf16x8 as_bf16x8(u32x4 v) { return __builtin_bit_cast(bf16x8, v); }
__device__ __forceinline__ f32x4 mfma16(bf16x8 a, bf16x8 b, f32x4 c) { return __builtin_amdgcn_mfma_f32_16x16x32_bf16(a, b, c, 0, 0, 0); }
__device__ __forceinline__ void lds_barrier() { asm volatile("s_waitcnt lgkmcnt(0)" ::: "memory"); __builtin_amdgcn_s_barrier(); asm volatile("" ::: "memory"); }
__device__ __forceinline__ float silu_f(float v) { return v * __builtin_amdgcn_rcpf(1.0f + __expf(-v)); }

__device__ __forceinline__ u32x4 tr4x4(unsigned d0, unsigned d1, unsigned d2, unsigned d3) {
    const u32x2 e01 = __builtin_amdgcn_permlane16_swap(d0, d1, false, false), e23 = __builtin_amdgcn_permlane16_swap(d2, d3, false, false);
    const u32x2 s0 = __builtin_amdgcn_permlane32_swap(e01.x, e23.x, false, false), s1 = __builtin_amdgcn_permlane32_swap(e01.y, e23.y, false, false);
    return (u32x4){s0.x, s1.x, s0.y, s1.y};
}

#define XB_TMO      128
#define XB_XCNT(j)  (256  + 64 * (j))
#define XB_XSUB(j)  (1280 + 64 * (j))
#define XB_XGEN(j)  (2304 + 64 * (j))
#define XB_TOP      3328
#define XB_TOPGEN   3392
#define XCD_BAR_WORDS 3456
#define XB_SPIN_CAP (1u << 18)
__device__ __forceinline__ unsigned xb_ld(unsigned* p)              { return __hip_atomic_load(p, __ATOMIC_RELAXED, __HIP_MEMORY_SCOPE_AGENT); }
__device__ __forceinline__ unsigned xb_add(unsigned* p, unsigned v) { return __hip_atomic_fetch_add(p, v, __ATOMIC_RELAXED, __HIP_MEMORY_SCOPE_AGENT); }
__device__ __forceinline__ unsigned xb_xcc_id() { return (unsigned)__builtin_amdgcn_s_getreg((3 << 11) | 20) & 0xFu; }
#define XB_SPIN(cond, bar) do { unsigned _sp = 0; while (cond) { __builtin_amdgcn_s_sleep(1); \
    if ((++_sp & 255u) == 0u) { if (xb_ld(&(bar)[XB_TMO])) break; if (_sp > XB_SPIN_CAP) { atomicAdd(&(bar)[XB_TMO], 1u); break; } } } } while (0)
struct XcdBarrier { unsigned* bar; unsigned x; volatile LAS unsigned* st; };
__device__ __forceinline__ XcdBarrier xcd_barrier_post(unsigned* bar, volatile LAS unsigned* st) {
    XcdBarrier b; b.bar = bar; b.x = xb_xcc_id(); b.st = st;
    if (threadIdx.x == 0) (void)xb_add(&bar[XB_XCNT(b.x)], 1u);
    return b;
}
__device__ __forceinline__ void xcd_barrier_complete(unsigned* bar, unsigned x, unsigned& nloc, unsigned& nx) {
    const unsigned G = gridDim.x * gridDim.y * gridDim.z;
    unsigned sum, cnt, mine, sp = 0u;
    for (;;) {
        sum = 0u; cnt = 0u; mine = 0u;
#pragma unroll
        for (unsigned j = 0; j < 16; ++j) { const unsigned c = xb_ld(&bar[XB_XCNT(j)]); sum += c; cnt += (c > 0u) ? 1u : 0u; mine = (j == x) ? c : mine; }
        if (sum == G) break;
        __builtin_amdgcn_s_sleep(1);
        if ((++sp & 255u) == 0u) { if (xb_ld(&bar[XB_TMO])) break; if (sp > XB_SPIN_CAP) { atomicAdd(&bar[XB_TMO], 1u); break; } }
    }
    nloc = mine > 0u ? mine : 1u; nx = cnt > 0u ? cnt : 1u;
}
struct NoWork { __device__ __forceinline__ void operator()() const {} };
template <class F = NoWork>
__device__ __forceinline__ void xcd_barrier(const XcdBarrier& b, const F& f = F()) {
    asm volatile("s_waitcnt vmcnt(0)" ::: "memory");
    __syncthreads();
    if (threadIdx.x >= 64) f();
    if (threadIdx.x == 0) {
        unsigned* bar = b.bar;
        __builtin_amdgcn_s_waitcnt(0);
        unsigned nloc = b.st[0], nx = b.st[1];
        if (nloc == 0u) { xcd_barrier_complete(bar, b.x, nloc, nx); b.st[0] = nloc; b.st[1] = nx; }
        const unsigned old = xb_add(&bar[XB_XSUB(b.x)], 1u);
        const unsigned gen = old / nloc;
        if (old + 1u == (gen + 1u) * nloc) {
            __builtin_amdgcn_fence(__ATOMIC_RELEASE, "agent");
            asm volatile("s_waitcnt vmcnt(0)" ::: "memory");
            const unsigned og = xb_add(&bar[XB_TOP], 1u);
            const unsigned tg = og / nx;
            if (og + 1u == (tg + 1u) * nx) xb_add(&bar[XB_TOPGEN], 1u);
            else XB_SPIN(xb_ld(&bar[XB_TOPGEN]) == tg, bar);
            __builtin_amdgcn_fence(__ATOMIC_ACQUIRE, "agent");
            xb_add(&bar[XB_XGEN(b.x)], 1u);
            asm volatile("s_waitcnt vmcnt(0)" ::: "memory");
        } else {
            XB_SPIN(xb_ld(&bar[XB_XGEN(b.x)]) == gen, bar);
            __builtin_amdgcn_fence(__ATOMIC_ACQUIRE, "agent");
            asm volatile("s_waitcnt vmcnt(0)" ::: "memory");
        }
    }
    __syncthreads();
}

namespace pg8 {
constexpr int BM = 256, BK = 64, HALF = 128, HTB = HALF * BK * 2, STAGE_BYTES = 8 * HTB, NXCD = 8, WGM = 4;
__host__ __device__ __forceinline__ int lds_byte(int r, int c) { const int st = (r >> 4) * 2 + (c >> 5), rr = r & 15, cc = c & 31, ob = rr * 64 + cc * 2; return st * 1024 + (ob ^ (((ob >> 9) & 1) << 5)); }
__host__ __device__ __forceinline__ void stage_rc(int b, int& R, int& C) { const int st = b / 1024, sb = b % 1024, swz = sb ^ (((sb >> 9) & 1) << 5); R = (st >> 1) * 16 + swz / 64; C = (st & 1) * 32 + (swz % 64) / 2; }
__host__ __device__ __forceinline__ int perm32(int rho) { const int n = rho >> 4, i = rho & 15; return 8 * (i >> 2) + 4 * n + (i & 3); }

struct Unit { int pm, pn, e, r0, cnt, ord; };
typedef int i32x8_t __attribute__((ext_vector_type(8))); typedef int i32x4_t __attribute__((ext_vector_type(4)));
__device__ __forceinline__ u32x4 pair16(const u32x2 X, const u32x2 Y) {
    const u32x2 s0 = __builtin_amdgcn_permlane16_swap(X.x, Y.x, false, false), s1 = __builtin_amdgcn_permlane16_swap(X.y, Y.y, false, false);
    return (u32x4){s0.x, s1.x, s0.y, s1.y};
}
__device__ __forceinline__ i32x8_t cat8(const bf16x8& a, const bf16x8& b) { return __builtin_shufflevector(__builtin_bit_cast(i32x4_t, a), __builtin_bit_cast(i32x4_t, b), 0, 1, 2, 3, 4, 5, 6, 7); }

struct DenseOrder {
    static constexpr bool GATHER_A = false;
    const char* A; const char* Bt; int K, nM, nN, nwg, G, c;
    __device__ __forceinline__ void init(const void* A_, const void* Bt_, int M, int N, int K_, int G_, int c_) { A = (const char*)A_; Bt = (const char*)Bt_; K = K_; nM = M / BM; nN = N / BM; nwg = nM * nN; G = G_; c = c_; }
    __device__ __forceinline__ bool next(int i, Unit& u) const {
        const long L = (long)i * G + c; if (L >= nwg) return false;
        int wgid = (int)L; { const int q = nwg / NXCD, r = nwg % NXCD, xcd = wgid % NXCD, off = wgid / NXCD; wgid = (xcd < r ? xcd * (q + 1) : r * (q + 1) + (xcd - r) * q) + off; }
        const int nig = WGM * nN, gid = wgid / nig, fm = gid * WGM, gsz = (nM - fm) < WGM ? (nM - fm) : WGM;
        u.pm = fm + ((wgid % nig) % gsz); u.pn = (wgid % nig) / gsz; u.e = 0; u.r0 = 0; u.cnt = 0; u.ord = i; return true;
    }
    __device__ __forceinline__ const char* a_base(const Unit& u) const { return A + (size_t)u.pm * ((size_t)BM * K * 2); }
    __device__ __forceinline__ const char* b_base(const Unit& u) const { return Bt + (size_t)u.pn * ((size_t)BM * K * 2); }
    __device__ __forceinline__ void a_offs(const Unit&, unsigned (&v)[2][2]) const {
#pragma unroll
        for (int i = 0; i < 2; ++i) { int R, C; stage_rc((int)threadIdx.x * 16 + i * 8192, R, C);
#pragma unroll
            for (int h = 0; h < 2; ++h) v[h][i] = (unsigned)((h * HALF + R) * K + C) * 2u; }
    }
};
template <bool GATHER> struct MoeOrder {
    static constexpr bool GATHER_A = GATHER;
    const char* A; const char* Bt; int K, N, nN, G, c, NU; const LAS int* tab; const LAS unsigned short* toks;
    __device__ __forceinline__ bool next(int i, Unit& u) const {
        const int L = i * G + c; if (L >= NU) return false;
        const int rb = L / nN; u.pn = L - rb * nN; u.pm = rb;
        const int e = __builtin_amdgcn_readfirstlane(tab[128 + rb]); u.e = e;
        u.r0 = (rb - __builtin_amdgcn_readfirstlane(tab[e])) * 256; u.cnt = __builtin_amdgcn_readfirstlane(tab[64 + e]); u.ord = i; return true;
    }
    __device__ __forceinline__ const char* a_base(const Unit& u) const { return GATHER ? A : A + (size_t)u.pm * ((size_t)BM * K * 2); }
    __device__ __forceinline__ const char* b_base(const Unit& u) const { return Bt + ((size_t)u.e * N + (size_t)u.pn * BM) * ((size_t)K * 2); }
    __device__ __forceinline__ void a_offs(const Unit& u, unsigned (&v)[2][2]) const {
#pragma unroll
        for (int i = 0; i < 2; ++i) { int R, C; stage_rc((int)threadIdx.x * 16 + i * 8192, R, C);
#pragma unroll
            for (int h = 0; h < 2; ++h) {
                if (GATHER) { const unsigned tok = toks[u.ord * 256 + h * HALF + R]; v[h][i] = (tok * (unsigned)K + (unsigned)C) * 2u; }
                else v[h][i] = (unsigned)((h * HALF + R) * K + C) * 2u; } }
    }
};


struct HostNone { struct Regs {}; __device__ __forceinline__ void issue(int, Regs&, f32x4 (&)[2][2][4][2]) const {} __device__ __forceinline__ void finish(const Regs&, const f32x4 (&)[2][2][4][2]) const {} };
struct HostCvt {
    const float* w_up; const float* w_dn; unsigned char* wt_up; unsigned char* wt_dn;
    int base, limit, G, c;
    struct Regs { unsigned char* dst; bool active; };
    __device__ __forceinline__ void issue(int ord, Regs& R, f32x4 (&acc)[2][2][4][2]) const {
        const int w = __builtin_amdgcn_readfirstlane((int)threadIdx.x >> 6), lane = threadIdx.x & 63, kq = lane >> 4, nq = lane & 15;
        const int hi = __builtin_amdgcn_readfirstlane(base + (ord * G + c) * 8 + w);
        R.active = hi < limit; R.dst = nullptr;
        if (R.active) {
            const float* W; int pitch, k0, n0, drow; unsigned char* WT;
            if (hi < 32768) { const int mat = hi >> 10, q = hi & 1023, kb = q >> 5, nb = q & 31; n0 = nb * 64; k0 = kb * 32; pitch = 2048; W = w_up + (size_t)mat * 1024 * 2048; WT = wt_up + (size_t)mat * 2048 * 1024;
                drow = ((n0 & 1023) >> 7) * 256 + (n0 >> 10) * 128 + (n0 & 127); }
            else { const int r = hi - 32768, mat = r >> 9, q = r & 511, kb = q >> 4, nb = q & 15; n0 = nb * 64; k0 = kb * 32; pitch = 1024; W = w_dn + (size_t)mat * 1024 * 1024; WT = wt_dn + (size_t)mat * 1024 * 1024; drow = n0; }
            const char* src = (const char*)(W + (size_t)k0 * pitch + n0); const unsigned voff = (unsigned)(kq * pitch + 4 * nq) * 4u;
#pragma unroll
            for (int i = 0; i < 8; ++i) acc[0][0][i >> 1][i & 1] = __builtin_nontemporal_load((const f32x4*)(src + (size_t)(4 * i) * pitch * 4 + voff));
            R.dst = WT + (size_t)(drow + 4 * nq + kq) * 1024 + k0;
        }
    }
    __device__ __forceinline__ void finish(const Regs& R, const f32x4 (&acc)[2][2][4][2]) const {
        if (R.active) {
            const int lane = threadIdx.x & 63;
            const unsigned sel1 = (lane & 16) ? 0x07030501u : 0x06020400u, sel2 = (lane & 32) ? 0x07060302u : 0x05040100u;
            unsigned o[8];
#pragma unroll
            for (int i = 0; i < 8; ++i) { const f32x4 v = acc[0][0][i >> 1][i & 1]; const unsigned d = pk4_f8(v[0], v[1], v[2], v[3], Q8_W);
                const u32x2 s1 = __builtin_amdgcn_permlane16_swap(d, d, false, false);
                const unsigned t1 = __builtin_amdgcn_perm(s1.y, s1.x, sel1);
                const u32x2 s2 = __builtin_amdgcn_permlane32_swap(t1, t1, false, false);
                o[i] = __builtin_amdgcn_perm(s2.y, s2.x, sel2); }
            *(u32x4*)R.dst = (u32x4){o[0], o[1], o[2], o[3]}; *(u32x4*)(R.dst + 16) = (u32x4){o[4], o[5], o[6], o[7]};
        }
    }
};

template <bool F8 = false, class Epi, class Sched, class Host>
__device__ __forceinline__ void gemm_phase(LAS unsigned char* lds, const int K, const Sched& S, const Epi& E, const Host& H) {
    const int tid = threadIdx.x, wid = __builtin_amdgcn_readfirstlane(tid >> 6), lane = tid & 63, wr = wid >> 2, wc = wid & 3, fr = lane & 15, fq = lane >> 4;
    const int nt = K / BK;
    unsigned voffB[2];
#pragma unroll
    for (int i = 0; i < 2; ++i) { int R, C; stage_rc(tid * 16 + i * 8192, R, C); const int Rb = Epi::PERM ? ((R & ~31) + perm32(R & 31)) : R; voffB[i] = (unsigned)(Rb * K + C) * 2u; }
    const size_t kstep = (size_t)(BK * 2);
    const size_t hstep = (size_t)HALF * K * 2;
    const unsigned ldsw = (unsigned)wid * 1024u;
    const int aoff = lds_byte(wr * 64 + fr, fq * 8), boff = lds_byte(wc * 32 + fr, fq * 8);
#define PG8_SA(b, h) (((b) * 2 + (h)) * HTB)
#define PG8_SB(b, h) ((4 + (b) * 2 + (h)) * HTB)
#define PG8_STAGE(bufoff, gbase, voff) do { _Pragma("unroll") for (int _i = 0; _i < 2; ++_i) \
        __builtin_amdgcn_global_load_lds((const unsigned*)((const char*)(gbase) + (voff)[_i]), (LAS unsigned*)(lds + (bufoff) + ldsw + _i * 8192), 16, 0, 0); } while (0)
#define PG8_LDA(dst, b, h) do { _Pragma("unroll") for (int m = 0; m < 4; ++m) _Pragma("unroll") for (int k = 0; k < 2; ++k) dst[m][k] = *(const LAS bf16x8*)(lds + PG8_SA(b, h) + aoff + m * 2048 + k * 1024); } while (0)
#define PG8_LDB(dst, b, h) do { _Pragma("unroll") for (int n = 0; n < 2; ++n) _Pragma("unroll") for (int k = 0; k < 2; ++k) dst[n][k] = *(const LAS bf16x8*)(lds + PG8_SB(b, h) + boff + n * 2048 + k * 1024); } while (0)
#define PG8_MMA(ai, bj, At, Bt) do { __builtin_amdgcn_s_setprio(1); _Pragma("unroll") for (int m = 0; m < 4; ++m) _Pragma("unroll") for (int n = 0; n < 2; ++n) { \
        if constexpr (F8) { const i32x8_t b8_ = cat8(Bt[n][0], Bt[n][1]), a8_ = cat8(At[m][0], At[m][1]); asm volatile("v_mfma_f32_16x16x128_f8f6f4 %0, %1, %2, %0" : "+v"(acc[ai][bj][m][n]) : "v"(b8_), "v"(a8_)); } \
        else { _Pragma("unroll") for (int k = 0; k < 2; ++k) acc[ai][bj][m][n] = __builtin_amdgcn_mfma_f32_16x16x32_bf16(Bt[n][k], At[m][k], acc[ai][bj][m][n], 0, 0, 0); } } __builtin_amdgcn_s_setprio(0); } while (0)
#define PG8_WAIT_V(n) asm volatile("s_waitcnt vmcnt(" #n ")" ::: "memory")
#define PG8_WAIT_L(n) asm volatile("s_waitcnt lgkmcnt(" #n ")" ::: "memory")
#define PG8_BAR __builtin_amdgcn_s_barrier()
#define PG8_SCHED __builtin_amdgcn_sched_barrier(0)
    Unit cur, nxt; int ui = 0;
    if (!S.next(0, cur)) return;
    f32x4 acc[2][2][4][2];
#pragma unroll
    for (int a = 0; a < 2; ++a)
#pragma unroll
        for (int b = 0; b < 2; ++b)
#pragma unroll
            for (int m = 0; m < 4; ++m)
#pragma unroll
                for (int n = 0; n < 2; ++n) acc[a][b][m][n] = (f32x4){0.f, 0.f, 0.f, 0.f};
    bf16x8 At[4][2], B0[2][2], B1[2][2];
    constexpr bool GA = Sched::GATHER_A;
    unsigned vA[2][2], nvA[2][2];
    S.a_offs(cur, vA);
    const size_t ah = GA ? 0 : hstep;
#define PG8_VA1 (GA ? vA[1] : vA[0])
    const char* cA = S.a_base(cur); const char* cB = S.b_base(cur);
    PG8_STAGE(PG8_SB(0, 0), cB, voffB); PG8_STAGE(PG8_SB(0, 1), cB + hstep, voffB); PG8_STAGE(PG8_SA(0, 0), cA, vA[0]); PG8_STAGE(PG8_SA(0, 1), cA + ah, PG8_VA1);
    if (wr == 1) PG8_BAR;
    PG8_WAIT_V(2); PG8_BAR;
    PG8_STAGE(PG8_SB(1, 0), cB + kstep, voffB); PG8_STAGE(PG8_SA(1, 0), cA + kstep, vA[0]); PG8_STAGE(PG8_SB(1, 1), cB + hstep + kstep, voffB);
    PG8_WAIT_V(6); PG8_BAR;
    for (;;) {
        const bool has_next = S.next(ui + 1, nxt);
        const char* nA = cA; const char* nB = cB;
#pragma unroll
        for (int h = 0; h < 2; ++h)
#pragma unroll
            for (int i = 0; i < 2; ++i) nvA[h][i] = vA[h][i];
        if (has_next) { nA = S.a_base(nxt); nB = S.b_base(nxt); if constexpr (GA) S.a_offs(nxt, nvA); }
        constexpr int NGRP = Epi::RESCALE ? 4 : 1; const int tper = nt / NGRP;
        for (int gq = 0; gq < NGRP; ++gq) {
        if constexpr (Epi::RESCALE) { if (gq > 0) { if constexpr (F8) asm volatile("s_nop 15\n\ts_nop 15" ::: "memory"); E.rescale(acc, cur, gq, wr, fr); } }
#pragma unroll 1
        for (int t = gq * tper; t < (gq + 1) * tper; t += 2) {
            const bool last = (t == nt - 2);
            const char* a1 = cA + (size_t)(t + 1) * kstep;
            const char* a2 = last ? nA : cA + (size_t)(t + 2) * kstep; const char* b2 = last ? nB : cB + (size_t)(t + 2) * kstep;
            const char* a3 = a2 + kstep; const char* b3 = b2 + kstep;
            unsigned w0[2], w1[2];
#pragma unroll
            for (int i = 0; i < 2; ++i) { if constexpr (GA) { w0[i] = last ? nvA[0][i] : vA[0][i]; w1[i] = last ? nvA[1][i] : vA[1][i]; } else { w0[i] = vA[0][i]; w1[i] = vA[0][i]; } }
            PG8_LDB(B0, 0, 0); PG8_LDB(B1, 0, 1); PG8_SCHED; PG8_LDA(At, 0, 0); PG8_STAGE(PG8_SA(1, 1), a1 + ah, PG8_VA1);
            PG8_WAIT_V(8); PG8_WAIT_L(0); PG8_BAR; PG8_MMA(0, 0, At, B0); PG8_MMA(0, 1, At, B1); PG8_BAR; PG8_SCHED;
            PG8_LDA(At, 0, 1); PG8_STAGE(PG8_SB(0, 0), b2, voffB); PG8_STAGE(PG8_SB(0, 1), b2 + hstep, voffB); PG8_STAGE(PG8_SA(0, 0), a2, w0);
            PG8_WAIT_V(8); PG8_WAIT_L(0); PG8_BAR; PG8_MMA(1, 0, At, B0); PG8_MMA(1, 1, At, B1); PG8_BAR; PG8_SCHED;
            PG8_LDB(B0, 1, 0); PG8_LDB(B1, 1, 1); PG8_SCHED; PG8_LDA(At, 1, 0); PG8_STAGE(PG8_SA(0, 1), a2 + ah, w1);
            PG8_WAIT_V(8); PG8_WAIT_L(0); PG8_BAR; PG8_MMA(0, 0, At, B0); PG8_MMA(0, 1, At, B1); PG8_BAR; PG8_SCHED;
            PG8_LDA(At, 1, 1); PG8_STAGE(PG8_SB(1, 0), b3, voffB); PG8_STAGE(PG8_SB(1, 1), b3 + hstep, voffB); PG8_STAGE(PG8_SA(1, 0), a3, w0);
            PG8_WAIT_V(8); PG8_WAIT_L(0); PG8_BAR; PG8_MMA(1, 0, At, B0); PG8_MMA(1, 1, At, B1); PG8_BAR; PG8_SCHED;
        }
        }
        if (wr == 0) PG8_BAR;
        if constexpr (F8) asm volatile("s_nop 15\n\ts_nop 15" ::: "memory");
        E(acc, cur, wr, wc, fr, fq, 0);
        __builtin_amdgcn_sched_barrier(0); asm volatile("" ::: "memory");
        typename Host::Regs hr; H.issue(cur.ord, hr, acc);
        __builtin_amdgcn_sched_barrier(0); asm volatile("" ::: "memory");
        E(acc, cur, wr, wc, fr, fq, 1);
        __builtin_amdgcn_sched_barrier(0);
        H.finish(hr, acc);
        if (!has_next) break;
#pragma unroll
        for (int a = 0; a < 2; ++a)
#pragma unroll
            for (int b = 0; b < 2; ++b)
#pragma unroll
                for (int m = 0; m < 4; ++m)
#pragma unroll
                    for (int n = 0; n < 2; ++n) acc[a][b][m][n] = (f32x4){0.f, 0.f, 0.f, 0.f};
        cur = nxt; cA = nA; cB = nB; ++ui;
#pragma unroll
        for (int h = 0; h < 2; ++h)
#pragma unroll
            for (int i = 0; i < 2; ++i) vA[h][i] = nvA[h][i];
        if (wr == 1) PG8_BAR;
    }
    PG8_WAIT_V(0);
    PG8_BAR;
#undef PG8_VA1
#undef PG8_SA
#undef PG8_SB
#undef PG8_STAGE
#undef PG8_LDA
#undef PG8_LDB
#undef PG8_MMA
#undef PG8_WAIT_V
#undef PG8_WAIT_L
#undef PG8_BAR
#undef PG8_SCHED
}

struct EpiF32 {
    static constexpr bool PERM = false; static constexpr bool RESCALE = false;
    float* C; int ldc;
    __device__ __forceinline__ void operator()(const f32x4 (&acc)[2][2][4][2], const Unit& u, int wr, int wc, int fr, int fq, const int ai) const {
        const int row0 = u.pm * BM + wr * 64 + fr, col0 = u.pn * BM + wc * 32 + 4 * fq;

#pragma unroll
            for (int m = 0; m < 4; ++m) { float* rowp = C + (size_t)(row0 + ai * HALF + m * 16) * ldc + col0;
#pragma unroll
                for (int bj = 0; bj < 2; ++bj)
#pragma unroll
                    for (int n = 0; n < 2; ++n) *(f32x4*)(rowp + bj * HALF + n * 16) = acc[ai][bj][m][n]; }
    }
};
struct EpiBf16 {
    static constexpr bool PERM = true; static constexpr bool RESCALE = false;
    bf16* O; int ldc; float sc;
    __device__ __forceinline__ void operator()(const f32x4 (&acc)[2][2][4][2], const Unit& u, int wr, int wc, int fr, int fq, const int ai) const {
        const int row0 = u.pm * BM + wr * 64 + fr, col0 = u.pn * BM + wc * 32 + 8 * fq;

#pragma unroll
            for (int m = 0; m < 4; ++m) { bf16* rowp = O + (size_t)(row0 + ai * HALF + m * 16) * ldc + col0;
#pragma unroll
                for (int bj = 0; bj < 2; ++bj) { const f32x4 v0 = acc[ai][bj][m][0] * sc, v1 = acc[ai][bj][m][1] * sc;
                    u32x4 w; w.x = pk2(v0[0], v0[1]); w.y = pk2(v0[2], v0[3]); w.z = pk2(v1[0], v1[1]); w.w = pk2(v1[2], v1[3]);
                    __builtin_nontemporal_store(w, (u32x4*)(rowp + bj * HALF)); } }
    }
};
struct EpiRms {
    static constexpr bool PERM = true; static constexpr bool RESCALE = true;
    bf16* O; int ldc; const LAS float* stab;
    __device__ __forceinline__ void rescale(f32x4 (&acc)[2][2][4][2], const Unit& u, int g, int wr, int fr) const {
        const LAS float* tb = stab + (u.ord * 256 + wr * 64 + fr) * 4 + g;
#pragma unroll
        for (int ai = 0; ai < 2; ++ai)
#pragma unroll
            for (int m = 0; m < 4; ++m) { const LAS float* p = tb + (ai * HALF + m * 16) * 4; const float ratio = p[-1] * __builtin_amdgcn_rcpf(p[0]);
#pragma unroll
                for (int bj = 0; bj < 2; ++bj)
#pragma unroll
                    for (int n = 0; n < 2; ++n) acc[ai][bj][m][n] = acc[ai][bj][m][n] * ratio; }
    }
    __device__ __forceinline__ void operator()(const f32x4 (&acc)[2][2][4][2], const Unit& u, int wr, int wc, int fr, int fq, const int ai) const {
        const int row0 = u.pm * BM + wr * 64 + fr, col0 = u.pn * BM + wc * 32 + 8 * fq;
        const LAS float* tb = stab + (u.ord * 256 + wr * 64 + fr) * 4 + 3;

#pragma unroll
            for (int m = 0; m < 4; ++m) { const int row = row0 + ai * HALF + m * 16; const float s3 = tb[(ai * HALF + m * 16) * 4] * (1.0f / (Q8_YS * Q8_W)); bf16* rowp = (bf16*)((char*)O + (unsigned)((row * ldc + col0) * 2));
#pragma unroll
                for (int bj = 0; bj < 2; ++bj) { const f32x4 v0 = acc[ai][bj][m][0] * s3, v1 = acc[ai][bj][m][1] * s3;
                    u32x4 w; w.x = pk2(v0[0], v0[1]); w.y = pk2(v0[2], v0[3]); w.z = pk2(v1[0], v1[1]); w.w = pk2(v1[2], v1[3]);
                    __builtin_nontemporal_store(w, (u32x4*)(rowp + bj * HALF)); } }
    }
};
struct EpiQKV {
    static constexpr bool PERM = true; static constexpr bool RESCALE = false;
    unsigned char* O; const float* rope; float ds;
    __device__ __forceinline__ void operator()(const f32x4 (&acc)[2][2][4][2], const Unit& u, int wr, int wc, int fr, int fq, const int ai) const {
        const int row0 = u.pm * BM + wr * 64 + fr;
        const int col_t = u.pn * BM;
        const int s = (col_t % 3072) >> 10;
        const float sc = ((s == 0) ? QSCALE * Q8_Q : ((s == 1) ? Q8_K : Q8_V)) * ds;
        const int gq = col_t / 3072, lg = 2 * gq, dlm = (1 << lg) - 1, mat0 = gq * 24 + s * 8 + ((col_t & 1023) >> 7);
        const bool rot = (s < 2) && (fq == 0);
        {
#pragma unroll
            for (int mp = 0; mp < 2; ++mp) {
                u32x2 wv[2][2];
#pragma unroll
                for (int r = 0; r < 2; ++r) { const int m = 2 * mp + r; const int row = row0 + ai * HALF + m * 16;
                    f32x4 cs = (f32x4){1.f, 1.f, 1.f, 1.f}, sn = (f32x4){0.f, 0.f, 0.f, 0.f};
                    if (rot) { const float* rp = rope + (size_t)row * 32 + 4 * wc; cs = *(const f32x4*)rp; sn = *(const f32x4*)(rp + 16); }
#pragma unroll
                    for (int bj = 0; bj < 2; ++bj) {
                        f32x4 v0 = acc[ai][bj][m][0], v1 = acc[ai][bj][m][1];
                        if (rot) { const f32x4 a0 = v0 * cs - v1 * sn, a1 = v1 * cs + v0 * sn; v0 = a0; v1 = a1; }
                        wv[r][bj].x = pk4_f8(v0[0], v0[1], v0[2], v0[3], sc); wv[r][bj].y = pk4_f8(v1[0], v1[1], v1[2], v1[3], sc); } }
                const int row = row0 + ai * HALF + (2 * mp + (fq & 1)) * 16;
                const int tt = row & (SEQ - 1), rowp = (row & ~(SEQ - 1)) + ((tt & (dlm)) << (12 - lg)) + (tt >> lg);
#pragma unroll
                for (int bj = 0; bj < 2; ++bj)
                    *(u32x4*)(O + ((size_t)(mat0 + bj) * T + rowp) * 128 + wc * 32 + 8 * (fq & ~1)) = pair16(wv[0][bj], wv[1][bj]);
            }
        }
    }
};
struct EpiUp {
    static constexpr bool PERM = true; static constexpr bool RESCALE = false;
    unsigned char* HB; const LAS unsigned* btab;
    __device__ __forceinline__ void operator()(const f32x4 (&acc)[2][2][4][2], const Unit& u, int wr, int wc, int fr, int fq, const int ai) const {
        const int row0 = u.pm * BM + wr * 64 + fr, col0 = u.pn * HALF + wc * 32 + 8 * fq;
        const LAS unsigned* bp = btab + u.ord * 128 + (wc * 32 + 8 * fq) / 2;
        const u32x4 gw = *(const LAS u32x4*)bp, uw = *(const LAS u32x4*)(bp + 64);
        f32x2 bg[4], bu[4];
#pragma unroll
        for (int i = 0; i < 4; ++i) { bg[i] = (f32x2){bflo(gw[i]), bfhi(gw[i])}; bu[i] = (f32x2){bflo(uw[i]), bfhi(uw[i])}; }
        constexpr float DS = 1.0f / (Q8_X * Q8_W), KE = -1.702f * 1.4426950408889634f;

            u32x2 wv[4];
#pragma unroll
            for (int m = 0; m < 4; ++m) {
                f32x2 o[4];
#pragma unroll
                for (int i = 0; i < 4; ++i) { const int n = i >> 1, j = 2 * (i & 1);
                    f32x2 gt = (f32x2){acc[ai][0][m][n][j], acc[ai][0][m][n][j + 1]} * DS + bg[i];
                    f32x2 up = (f32x2){acc[ai][1][m][n][j], acc[ai][1][m][n][j + 1]} * DS + bu[i];
                    gt[0] = fminf(gt[0], 7.0f); gt[1] = fminf(gt[1], 7.0f);
                    up[0] = __builtin_amdgcn_fmed3f(up[0], -7.0f, 7.0f); up[1] = __builtin_amdgcn_fmed3f(up[1], -7.0f, 7.0f);
                    f32x2 e = gt * KE; e[0] = __builtin_amdgcn_exp2f(e[0]); e[1] = __builtin_amdgcn_exp2f(e[1]);
                    e = e + 1.0f; e[0] = __builtin_amdgcn_rcpf(e[0]); e[1] = __builtin_amdgcn_rcpf(e[1]);
                    o[i] = (up * Q8_H + Q8_H) * (gt * e); }
                { int p0 = __builtin_amdgcn_cvt_pk_fp8_f32(o[0][0], o[0][1], 0, false); p0 = __builtin_amdgcn_cvt_pk_fp8_f32(o[1][0], o[1][1], p0, true);
                  int p1 = __builtin_amdgcn_cvt_pk_fp8_f32(o[2][0], o[2][1], 0, false); p1 = __builtin_amdgcn_cvt_pk_fp8_f32(o[3][0], o[3][1], p1, true); wv[m].x = (unsigned)p0; wv[m].y = (unsigned)p1; }
            }
#pragma unroll
            for (int mp = 0; mp < 2; ++mp)
                *(u32x4*)(HB + (size_t)(row0 + ai * HALF + (2 * mp + (fq & 1)) * 16) * 1024 + (col0 - 8 * (fq & 1))) = pair16(wv[2 * mp], wv[2 * mp + 1]);
    }
};
struct EpiDown {
    static constexpr bool PERM = true; static constexpr bool RESCALE = false;
    unsigned char* YS; const LAS unsigned* btab; const LAS int* slots;
    __device__ __forceinline__ void operator()(const f32x4 (&acc)[2][2][4][2], const Unit& u, int wr, int wc, int fr, int fq, const int ai) const {
        const int col0 = u.pn * BM + wc * 32 + 8 * fq;
        const LAS unsigned* bp = btab + u.ord * 128 + (wc * 32 + 8 * fq) / 2;
        f32x4 bv[2][2];
#pragma unroll
        for (int bj = 0; bj < 2; ++bj) { const u32x4 bw = *(const LAS u32x4*)(bp + bj * 64);
            bv[bj][0] = (f32x4){bflo(bw.x), bfhi(bw.x), bflo(bw.y), bfhi(bw.y)}; bv[bj][1] = (f32x4){bflo(bw.z), bfhi(bw.z), bflo(bw.w), bfhi(bw.w)}; }

#pragma unroll
            for (int mp = 0; mp < 2; ++mp) {
                const int slot = slots[u.ord * 256 + ai * HALF + wr * 64 + (2 * mp + (fq & 1)) * 16 + fr];
#pragma unroll
                for (int bj = 0; bj < 2; ++bj) { u32x2 wv[2];
#pragma unroll
                    for (int r = 0; r < 2; ++r) { const int m = 2 * mp + r; const f32x4 v0 = acc[ai][bj][m][0] * (1.0f / (Q8_H * Q8_W)) + bv[bj][0], v1 = acc[ai][bj][m][1] * (1.0f / (Q8_H * Q8_W)) + bv[bj][1];
                        wv[r].x = pk4_f8(v0[0], v0[1], v0[2], v0[3], Q8_Y); wv[r].y = pk4_f8(v1[0], v1[1], v1[2], v1[3], Q8_Y); }
                    const u32x4 d = pair16(wv[0], wv[1]);
                    if (slot >= 0) *(u32x4*)(YS + (size_t)slot * 1024 + (col0 - 8 * (fq & 1)) + bj * HALF) = d; }
            }
    }
};
}

struct TrItem { const float* W; const float* kscale; bf16* WT; int pitch, K, k0, n0, dstrow0, q8, hperm; };
__device__ __forceinline__ void tr_load(const TrItem& d, f32x4 (&ld)[16], int lane) {
    const int kq = lane >> 4, nq = lane & 15;
    const float* src = d.W + (size_t)(d.k0 + kq) * d.pitch + d.n0 + 4 * nq;
#pragma unroll
    for (int i = 0; i < 16; ++i) ld[i] = __builtin_nontemporal_load((const f32x4*)(src + (size_t)(4 * i) * d.pitch));
}
__device__ __forceinline__ void tr_finish(const TrItem& d, const f32x4 (&ld)[16], LAS float* scr, int lane) {
    const int kq = lane >> 4, nq = lane & 15;
#pragma unroll
    for (int i = 0; i < 16; ++i) { f32x4 v = ld[i]; if (d.kscale) v = v * d.kscale[d.k0 + 4 * i + kq]; LAS float* p = scr + (4 * i + kq) * 65 + 4 * nq; p[0] = v[0]; p[1] = v[1]; p[2] = v[2]; p[3] = v[3]; }
    asm volatile("s_waitcnt lgkmcnt(0)" ::: "memory");
    const int c = lane & 7;
    if (d.q8) {
#pragma unroll
        for (int j = 0; j < 8; ++j) { const int n = j * 8 + (lane >> 3); const LAS float* s = scr + (8 * c) * 65 + n;
            u32x2 o; o.x = pk4_f8(s[0 * 65], s[1 * 65], s[2 * 65], s[3 * 65], Q8_W); o.y = pk4_f8(s[4 * 65], s[5 * 65], s[6 * 65], s[7 * 65], Q8_W);
            int row = d.dstrow0 + n;
            if (d.hperm) { const int ng = d.n0 + n; if (((ng % 3072) >> 10) < 2) { const int dd = ng & 127;
                    const int pp = (dd < 32) ? (((dd & 15) >> 2) * 32 + (dd & 3) + 4 * (dd >> 4)) : (((dd - 32) / 24) * 32 + 8 + (dd - 32) % 24); row = (ng & ~127) + pp; } }
            *(u32x2*)((unsigned char*)d.WT + (size_t)row * d.K + d.k0 + 8 * c) = o; }
    } else {
#pragma unroll
    for (int j = 0; j < 8; ++j) { const int n = j * 8 + (lane >> 3); const LAS float* s = scr + (8 * c) * 65 + n;
        u32x4 o; o.x = pk2(s[0 * 65], s[1 * 65]); o.y = pk2(s[2 * 65], s[3 * 65]); o.z = pk2(s[4 * 65], s[5 * 65]); o.w = pk2(s[6 * 65], s[7 * 65]);
        *(u32x4*)(d.WT + (size_t)(d.dstrow0 + n) * d.K + d.k0 + 8 * c) = o; }
    }
    asm volatile("s_waitcnt lgkmcnt(0)" ::: "memory");
}
__constant__ float c_inv_freq[16] = {1.000000000e+00f, 4.403665960e-01f, 1.939227432e-01f, 8.539710194e-02f, 3.760603070e-02f, 1.656044088e-02f, 7.292664610e-03f, 3.211446106e-03f,
                                     1.414213562e-03f, 6.227724371e-04f, 2.742481884e-04f, 1.207697351e-04f, 5.318295734e-05f, 2.341999971e-05f, 1.031338525e-05f, 4.541670478e-06f};
__device__ __forceinline__ void sincos_reduced(float ang, float& sn, float& cs) {
    const double a = (double)ang;
    const double k = __builtin_rint(a * 0.15915494309189535);
    const double r = __builtin_fma(-k, 6.283185307179586, a) - k * 2.4492935982947064e-16;
    const float rf = (float)r;
    sn = __sinf(rf); cs = __cosf(rf);
}
struct Ptrs {
    const float *x; const int* pos; const float *attn_w_in, *attn_w_out, *ssm_w_in, *conv_w, *conv_b, *dt_bias, *a_log, *d_skip, *norm_w, *ssm_w_out;
    const float *w_router, *b_router, *w_up, *b_up, *w_dn, *b_dn, *ln_mix_g, *ln_mix_b, *ln_ffn_g, *ln_ffn_b;
};
constexpr int N1_UP = 32 * 16 * 32, N1_DN = 32 * 16 * 16, N1_ITEMS = N1_UP + N1_DN;
constexpr int HOSTED_ITEMS = 18432;
__device__ __forceinline__ TrItem moe1_item(const Ptrs& P, unsigned char* ws, int idx, int lay = 1) {
    TrItem d; d.kscale = nullptr; d.K = 1024; d.q8 = 1; d.hperm = 0;
    if (idx < N1_UP) { const int mat = 32 * lay + (idx >> 9), q = idx & 511, kb = q >> 5, nb = q & 31; const int n0 = nb * 64; const int bj = n0 >> 10, pn = (n0 & 1023) >> 7, cc = n0 & 127;
        d.W = P.w_up + (size_t)mat * 1024 * 2048; d.pitch = 2048; d.WT = (bf16*)(ws + WS_WUP + (size_t)mat * 2048 * 1024); d.k0 = kb * 64; d.n0 = n0; d.dstrow0 = pn * 256 + bj * 128 + cc; }
    else { const int r = idx - N1_UP, mat = 32 * lay + (r >> 8), q = r & 255, kb = q >> 4, nb = q & 15;
        d.W = P.w_dn + (size_t)mat * 1024 * 1024; d.pitch = 1024; d.WT = (bf16*)(ws + WS_WDN + (size_t)mat * 1024 * 1024); d.k0 = kb * 64; d.n0 = nb * 64; d.dstrow0 = nb * 64; }
    return d;
}
__device__ __forceinline__ void cvt_static(LAS unsigned char* lds, const Ptrs& P, unsigned char* ws, int first, int stride, int cnt) {
    const int lane = threadIdx.x & 63, w = __builtin_amdgcn_readfirstlane((int)threadIdx.x >> 6);
    LAS float* scr = (LAS float*)(lds + w * (65 * 64 * 4));
    if (cnt <= 0 || first >= N1_ITEMS) return;
    f32x4 la[16], lb[16]; TrItem da = moe1_item(P, ws, first), db = da; tr_load(da, la, lane);
    for (int i = 0;; i += 2) {
        const int ib = first + (i + 1) * stride; const bool hb = (i + 1 < cnt) && (ib < N1_ITEMS);
        if (hb) { db = moe1_item(P, ws, ib); tr_load(db, lb, lane); }
        tr_finish(da, la, scr, lane);
        if (!hb) break;
        const int ia = first + (i + 2) * stride; const bool ha = (i + 2 < cnt) && (ia < N1_ITEMS);
        if (ha) { da = moe1_item(P, ws, ia); tr_load(da, la, lane); }
        tr_finish(db, lb, scr, lane);
        if (!ha) break;
    }
}
__device__ __forceinline__ void cvt_plan(int NB, int G, int& rem_up, int& P_up, int& rem_dn, int& P_dn) {
    rem_up = (NB * 8) % G; const int n_iu = rem_up ? (G - rem_up) : 0; P_up = n_iu * 8 * CVT_Q_UP; if (P_up > N1_ITEMS) P_up = N1_ITEMS;
    rem_dn = (NB * 4) % G; const int n_id = rem_dn ? (G - rem_dn) : 0; P_dn = P_up + n_id * 8 * CVT_Q_DN; if (P_dn > N1_ITEMS) P_dn = N1_ITEMS;
}
__device__ __forceinline__ void p0_prologue(LAS unsigned char* lds, const Ptrs& P, unsigned char* ws, int G, int vcu) {
    const int tid = threadIdx.x, lane = tid & 63, w = __builtin_amdgcn_readfirstlane(tid >> 6);
    LAS float* scr = (LAS float*)(lds + w * (65 * 64 * 4));
    const int gw = vcu * 8 + w, NGW = G * 8;
    bf16* Wqkv = (bf16*)(ws + WS_WQKV); bf16* Wao = (bf16*)(ws + WS_WAO); bf16* Wsi = (bf16*)(ws + WS_WSI); bf16* Wso = (bf16*)(ws + WS_WSO);
    constexpr int I0 = 16 * 144, I1 = 16 * 16, I2 = 16 * 80, I3 = 32 * 16, I4 = 32 * 16 * 32, I5 = 32 * 16 * 16;
    constexpr int NITEMS = I0 + I1 + I2 + I3 + (N1_ITEMS - HOSTED_ITEMS);
    auto decode = [&](int it) -> TrItem {
        TrItem d; int r = it; d.kscale = nullptr; d.q8 = 0; d.hperm = 0;
        if (r < I0) { const int kb = r / 144, nb = r % 144; d.q8 = 1; d.hperm = 1; d.W = P.attn_w_in; d.pitch = NQKV; d.K = 1024; d.WT = Wqkv; d.k0 = kb * 64; d.n0 = nb * 64; d.dstrow0 = nb * 64; return d; } r -= I0;
        if (r < I1) { const int kb = r / 16, nb = r % 16; d.q8 = 1; d.W = P.attn_w_out; d.pitch = 1024; d.K = 1024; d.WT = Wao; d.k0 = kb * 64; d.n0 = nb * 64; d.dstrow0 = nb * 64; return d; } r -= I1;
        if (r < I2) { const int kb = r / 80, nb = r % 80; d.q8 = 1; d.W = P.ssm_w_in; d.pitch = SSM_PITCH; d.K = 1024; d.WT = Wsi; d.k0 = kb * 64; d.n0 = nb * 64; d.dstrow0 = nb * 64; return d; } r -= I2;
        if (r < I3) { const int kb = r / 16, nb = r % 16; d.q8 = 1; d.W = P.ssm_w_out; d.pitch = 1024; d.K = 2048; d.kscale = P.norm_w; d.WT = Wso; d.k0 = kb * 64; d.n0 = nb * 64; d.dstrow0 = nb * 64; return d; } r -= I3;
        return moe1_item(P, ws, r + HOSTED_ITEMS, 0);
    };
    if (gw < NITEMS) {
        f32x4 la[16], lb[16];
        TrItem da = decode(gw), db = da; tr_load(da, la, lane);
        for (int it = gw; it < NITEMS; it += 2 * NGW) {
            const bool hb = it + NGW < NITEMS;
            if (hb) { db = decode(it + NGW); tr_load(db, lb, lane); }
            tr_finish(da, la, scr, lane);
            if (!hb) break;
            const bool ha = it + 2 * NGW < NITEMS;
            if (ha) { da = decode(it + 2 * NGW); tr_load(da, la, lane); }
            tr_finish(db, lb, scr, lane);
            if (!ha) break;
        }
    }
    bf16* XBA = (bf16*)(ws + WS_XBA);
    for (int m0 = gw * 4; m0 < T; m0 += NGW * 4) {
        f32x4 v[4][4];
#pragma unroll
        for (int rr = 0; rr < 4; ++rr) { const f32x4* xr = (const f32x4*)(P.x + (size_t)(m0 + rr) * DM) + lane;
#pragma unroll
            for (int j = 0; j < 4; ++j) v[rr][j] = xr[64 * j]; }
#pragma unroll
        for (int rr = 0; rr < 4; ++rr) { u32x2* o = (u32x2*)(XBA + (size_t)(m0 + rr) * DM) + lane;
#pragma unroll
            for (int j = 0; j < 4; ++j) {
                *(unsigned*)(ws + WS_XQ0 + (size_t)(m0 + rr) * DM + 4 * lane + 256 * j) = pk4_f8(v[rr][j][0], v[rr][j][1], v[rr][j][2], v[rr][j][3], Q8_X); } }
    }
    float* rope = (float*)(ws + WS_ROPE);
    for (int idx = (vcu * 512 + tid); idx < T * 16; idx += G * 512) {
        const int tok = idx >> 4, i = idx & 15;
        const float ang = (float)P.pos[tok] * c_inv_freq[i];
        float sn, cs; sincos_reduced(ang, sn, cs);
        rope[(size_t)tok * 32 + i] = cs; rope[(size_t)tok * 32 + 16 + i] = sn;
    }
}

constexpr size_t PKOFF = (size_t)8 * T * 128;
__device__ __forceinline__ void attn_phase(LAS unsigned char* lds, const unsigned char* __restrict__ PROJ, unsigned char* __restrict__ OG, float* __restrict__ LSE, const int G, const int vcu) {
    const int tid = threadIdx.x, lane0 = tid & 63, w = __builtin_amdgcn_readfirstlane(tid >> 6);
    LAS unsigned char* Ks = lds; LAS unsigned char* Vt = lds + 2 * 128 * P256;
    constexpr int NU = BATCH * 3 * 8 * 32;
    const int per = (NU + G - 1) / G;
    const int u0 = vcu * per, u1 = (u0 + per < NU) ? (u0 + per) : NU;
    if (u0 >= u1) return;
    u32x4 kreg[2], vreg[2]; u32x4 qn[2];
    constexpr int PK8 = 144;
    unsigned long long mA = 0ull, mB = 0ull;
    { const int r16 = lane0 & 15, q4 = lane0 >> 4;
#pragma unroll
        for (int kt = 0; kt < 9; ++kt)
#pragma unroll
            for (int jj = 0; jj < 4; ++jj) { const int jr = 16 * kt + 4 * q4 + jj; const bool va = (jr >= r16) & (jr <= r16 + 128); const bool vb = va & (jr + 16 * w >= 128);
                mA |= (unsigned long long)va << (4 * kt + jj); mB |= (unsigned long long)vb << (4 * kt + jj); } }
    int pc = 0;
#define ATT_DECODE(U) const int bgh = (U) >> 5, sub = (U) & 31, h = bgh & 7, bg = bgh >> 3, g = bg % 3, b = bg / 3; \
        const int lg = (g == 0) ? 0 : ((g == 1) ? 2 : 4), dl = 1 << lg, nblk = 32 >> lg, r = sub >> (5 - lg), blk = sub & (nblk - 1); \
        const unsigned char* base_r = PROJ + ((size_t)(g * 24 + h) * T + (size_t)b * SEQ + (size_t)r * (SEQ >> lg)) * 128;
#define ATT_W2(X) pk2(X[0], X[1])
#define ATT_K16(V, LO, HI) do { _Pragma("unroll") for (int i_ = 0; i_ < 4; ++i_) { const f32x2 a_ = __builtin_amdgcn_cvt_pk_f32_fp8((int)(V)[i_], false), b_ = __builtin_amdgcn_cvt_pk_f32_fp8((int)(V)[i_], true); \
        if (i_ < 2) { (LO)[2 * i_] = ATT_W2(a_); (LO)[2 * i_ + 1] = ATT_W2(b_); } else { (HI)[2 * i_ - 4] = ATT_W2(a_); (HI)[2 * i_ - 3] = ATT_W2(b_); } } } while (0)
#define ATT_VT(V0, V1, C, JP, HALFSEL) do { _Pragma("unroll") for (int i_ = 0; i_ < 4; ++i_) { \
        const f32x2 a0_ = __builtin_amdgcn_cvt_pk_f32_fp8((int)(V0)[i_], false), b0_ = __builtin_amdgcn_cvt_pk_f32_fp8((int)(V0)[i_], true), a1_ = __builtin_amdgcn_cvt_pk_f32_fp8((int)(V1)[i_], false), b1_ = __builtin_amdgcn_cvt_pk_f32_fp8((int)(V1)[i_], true); \
        *(LAS unsigned*)(Vt + swz512(16 * (C) + 4 * i_ + 0, 256 * (HALFSEL) + 4 * (JP))) = pk2(a0_[0], a1_[0]); *(LAS unsigned*)(Vt + swz512(16 * (C) + 4 * i_ + 1, 256 * (HALFSEL) + 4 * (JP))) = pk2(a0_[1], a1_[1]); \
        *(LAS unsigned*)(Vt + swz512(16 * (C) + 4 * i_ + 2, 256 * (HALFSEL) + 4 * (JP))) = pk2(b0_[0], b1_[0]); *(LAS unsigned*)(Vt + swz512(16 * (C) + 4 * i_ + 3, 256 * (HALFSEL) + 4 * (JP))) = pk2(b0_[1], b1_[1]); } } while (0)
    {
        ATT_DECODE(u0)
        const int lane = lane0;
        const int jpv = 16 * (w >> 1) + (lane & 15), cv = 4 * (w & 1) + (lane >> 4);
        if (blk > 0) {
#pragma unroll
            for (int it = 0; it < 2; ++it) { const int item = it * 512 + tid, j = item >> 3, c = item & 7; const int ts = (blk - 1) * 128 + j;
                *(LAS u32x4*)(Ks + j * PK8 + 16 * c) = *(const u32x4*)(base_r + (size_t)ts * 128 + PKOFF + 16 * c); }
            { const int ts = (blk - 1) * 128 + 2 * jpv;
                const u32x4 v0 = *(const u32x4*)(base_r + (size_t)ts * 128 + 2 * PKOFF + 16 * cv), v1 = *(const u32x4*)(base_r + (size_t)(ts + 1) * 128 + 2 * PKOFF + 16 * cv);
                ATT_VT(v0, v1, cv, jpv, 0); }
        }
#pragma unroll
        for (int it = 0; it < 2; ++it) { const int item = it * 512 + tid, j = item >> 3, c = item & 7; kreg[it] = *(const u32x4*)(base_r + (size_t)(blk * 128 + j) * 128 + PKOFF + 16 * c); }
        { const int ts = blk * 128 + 2 * jpv;
            vreg[0] = *(const u32x4*)(base_r + (size_t)ts * 128 + 2 * PKOFF + 16 * cv); vreg[1] = *(const u32x4*)(base_r + (size_t)(ts + 1) * 128 + 2 * PKOFF + 16 * cv); }
        const int tq = blk * 128 + 16 * w + (lane & 15);
#pragma unroll
        for (int kk = 0; kk < 2; ++kk) qn[kk] = *(const u32x4*)(base_r + (size_t)tq * 128 + 64 * kk + 16 * (lane >> 4));
    }
    for (int u = u0; u < u1; ++u) {
        int lane = lane0; asm volatile("" : "+v"(lane));
        const int r16 = lane & 15, q4 = lane >> 4;
        ATT_DECODE(u)
        const int pp = pc; pc ^= 1;
        if (blk == 0) {
#pragma unroll
            for (int it = 0; it < 4; ++it) { const int item = it * 512 + tid, dd = item >> 4, c = item & 15; *(LAS u32x4*)(Vt + swz512(dd, 256 * pp + 16 * c)) = (u32x4){0u, 0u, 0u, 0u}; }
        }
#pragma unroll
        for (int it = 0; it < 2; ++it) { const int item = it * 512 + tid, j = item >> 3, c = item & 7; *(LAS u32x4*)(Ks + pc * (128 * P256) + j * PK8 + 16 * c) = kreg[it]; }
        { const int jpv = 16 * (w >> 1) + (lane & 15), cv = 4 * (w & 1) + (lane >> 4); ATT_VT(vreg[0], vreg[1], cv, jpv, pc); }
        const pg8::i32x8_t qf = __builtin_shufflevector(__builtin_bit_cast(pg8::i32x4_t, qn[0]), __builtin_bit_cast(pg8::i32x4_t, qn[1]), 0, 1, 2, 3, 4, 5, 6, 7);
        lds_barrier();
        if (u + 1 < u1) {
            const int un = u + 1;
            const int bgh2 = un >> 5, sub2 = un & 31, h2 = bgh2 & 7, bg2 = bgh2 >> 3, g2 = bg2 % 3, b2 = bg2 / 3;
            const int lg2 = (g2 == 0) ? 0 : ((g2 == 1) ? 2 : 4), nblk2 = 32 >> lg2, r2 = sub2 >> (5 - lg2), blk2 = sub2 & (nblk2 - 1);
            const unsigned char* base2 = PROJ + ((size_t)(g2 * 24 + h2) * T + (size_t)b2 * SEQ + (size_t)r2 * (SEQ >> lg2)) * 128;
#pragma unroll
            for (int it = 0; it < 2; ++it) { const int item = it * 512 + tid, j = item >> 3, c = item & 7; kreg[it] = *(const u32x4*)(base2 + (size_t)(blk2 * 128 + j) * 128 + PKOFF + 16 * c); }
            { const int jpv = 16 * (w >> 1) + (lane & 15), cv = 4 * (w & 1) + (lane >> 4); const int ts = blk2 * 128 + 2 * jpv;
                vreg[0] = *(const u32x4*)(base2 + (size_t)ts * 128 + 2 * PKOFF + 16 * cv); vreg[1] = *(const u32x4*)(base2 + (size_t)(ts + 1) * 128 + 2 * PKOFF + 16 * cv); }
            const int tq2 = blk2 * 128 + 16 * w + r16;
#pragma unroll
            for (int kk = 0; kk < 2; ++kk) qn[kk] = *(const u32x4*)(base2 + (size_t)tq2 * 128 + 64 * kk + 16 * q4);
        }
        f32x4 s[9];
#pragma unroll
        for (int kt = 0; kt < 9; ++kt) {
            const int ka = w + kt; const int hoff = ((ka < 8) ? pp : pc) * (128 * P256); const int row = 16 * (ka & 7) + r16;
            const u32x4 k0 = *(const LAS u32x4*)(Ks + hoff + row * PK8 + 16 * q4), k1 = *(const LAS u32x4*)(Ks + hoff + row * PK8 + 64 + 16 * q4);
            const pg8::i32x8_t kf = __builtin_shufflevector(__builtin_bit_cast(pg8::i32x4_t, k0), __builtin_bit_cast(pg8::i32x4_t, k1), 0, 1, 2, 3, 4, 5, 6, 7);
            s[kt] = __builtin_amdgcn_mfma_scale_f32_16x16x128_f8f6f4(kf, qf, (f32x4){0.f, 0.f, 0.f, 0.f}, 0, 0, 0, 0, 0, 0); }
        float mx = -INFINITY;
        const unsigned long long mk = (blk > 0) ? mA : mB; const unsigned mlo = (unsigned)mk, mhi = (unsigned)(mk >> 32);
#pragma unroll
        for (int kt = 0; kt < 9; ++kt)
#pragma unroll
            for (int jj = 0; jj < 4; ++jj) { const int bit = 4 * kt + jj; const bool valid = bit < 32 ? ((mlo >> bit) & 1u) : ((mhi >> (bit - 32)) & 1u);
                s[kt][jj] = valid ? s[kt][jj] : -INFINITY; mx = fmaxf(mx, s[kt][jj]); }
        mx = fmaxf(mx, __shfl_xor(mx, 16)); mx = fmaxf(mx, __shfl_xor(mx, 32));
        float ls = 0.f;
#pragma unroll
        for (int kt = 0; kt < 9; ++kt)
#pragma unroll
            for (int jj = 0; jj < 4; ++jj) { const float p = __builtin_amdgcn_exp2f((s[kt][jj] - mx) * (1.0f / (Q8_Q * Q8_K))); s[kt][jj] = p; ls += p; }
        ls += __shfl_xor(ls, 16); ls += __shfl_xor(ls, 32);
        f32x4 o[8];
#pragma unroll
        for (int dt = 0; dt < 8; ++dt) o[dt] = (f32x4){0.f, 0.f, 0.f, 0.f};
#pragma unroll
        for (int kp = 0; kp < 5; ++kp) {
            u32x4 pw; pw.x = pk2(s[2 * kp][0], s[2 * kp][1]); pw.y = pk2(s[2 * kp][2], s[2 * kp][3]);
            if (kp < 4) { pw.z = pk2(s[2 * kp + 1][0], s[2 * kp + 1][1]); pw.w = pk2(s[2 * kp + 1][2], s[2 * kp + 1][3]); } else { pw.z = 0u; pw.w = 0u; }
            const bf16x8 pf = as_bf16x8(pw);
            const int ka0 = w + 2 * kp, ka1 = ka0 + 1;
            const int c0 = 256 * ((ka0 < 8) ? pp : pc) + 2 * (16 * (ka0 & 7) + 4 * q4), c1 = 256 * ((ka1 < 8) ? pp : pc) + 2 * (16 * (ka1 & 7) + 4 * q4);
#pragma unroll
            for (int dt = 0; dt < 8; ++dt) { const int dd = 16 * dt + r16;
                const u32x2 lo = *(const LAS u32x2*)(Vt + swz512(dd, c0));
                u32x2 hi = (u32x2){0u, 0u}; if (kp < 4) hi = *(const LAS u32x2*)(Vt + swz512(dd, c1));
                const u32x4 av = (u32x4){lo.x, lo.y, hi.x, hi.y};
                o[dt] = mfma16(as_bf16x8(av), pf, o[dt]); }
        }
        const float inv = Q8_O / (ls * Q8_V);
        const int tq = blk * 128 + 16 * w + r16;
        const size_t tokq = (size_t)b * SEQ + (size_t)tq * dl + r;
        unsigned char* op = OG + ((size_t)g * T + tokq) * DM + h * 128 + 16 * q4;
#pragma unroll
        for (int a4 = 0; a4 < 2; ++a4) { unsigned oq[4];
#pragma unroll
            for (int i = 0; i < 4; ++i) oq[i] = pk4_f8(o[4 * a4 + i][0], o[4 * a4 + i][1], o[4 * a4 + i][2], o[4 * a4 + i][3], inv);
            *(u32x4*)(op + 64 * a4) = tr4x4(oq[0], oq[1], oq[2], oq[3]); }
        if (q4 == 0) LSE[((size_t)g * T + tokq) * 8 + h] = (mx * (1.0f / (Q8_Q * Q8_K)) + __builtin_amdgcn_logf(ls)) * LN2F;
        lds_barrier();
    }
#undef ATT_DECODE
#undef ATT_W2
#undef ATT_K16
#undef ATT_VT
}

__device__ __forceinline__ void combine_phase(const unsigned char* __restrict__ OG, const float* __restrict__ LSE, unsigned char* __restrict__ OB, int G, int vcu) {
    const int tid = threadIdx.x, lane = tid & 63, w = tid >> 6;
    const int gw = vcu * 8 + w, NGW = G * 8;
    for (int row = gw; row < T; row += NGW) {
#pragma unroll
        for (int j = 0; j < 2; ++j) { const int col = 8 * lane + 512 * j, head = col >> 7;
            const float l0 = LSE[((size_t)0 * T + row) * 8 + head], l1 = LSE[((size_t)1 * T + row) * 8 + head], l2 = LSE[((size_t)2 * T + row) * 8 + head];
            const float m = fmaxf(l0, fmaxf(l1, l2)); float w0 = __expf(l0 - m), w1 = __expf(l1 - m), w2 = __expf(l2 - m); const float inv = 1.0f / (w0 + w1 + w2); w0 *= inv; w1 *= inv; w2 *= inv;
            const u32x2 a0 = *(const u32x2*)(OG + ((size_t)0 * T + row) * DM + col), a1 = *(const u32x2*)(OG + ((size_t)1 * T + row) * DM + col), a2 = *(const u32x2*)(OG + ((size_t)2 * T + row) * DM + col);
            float ov[8];
#pragma unroll
            for (int wd = 0; wd < 2; ++wd) {
                const f32x2 x0 = __builtin_amdgcn_cvt_pk_f32_fp8((int)a0[wd], false), x1 = __builtin_amdgcn_cvt_pk_f32_fp8((int)a1[wd], false), x2 = __builtin_amdgcn_cvt_pk_f32_fp8((int)a2[wd], false);
                const f32x2 y0 = __builtin_amdgcn_cvt_pk_f32_fp8((int)a0[wd], true), y1 = __builtin_amdgcn_cvt_pk_f32_fp8((int)a1[wd], true), y2 = __builtin_amdgcn_cvt_pk_f32_fp8((int)a2[wd], true);
                ov[4 * wd] = w0 * x0[0] + w1 * x1[0] + w2 * x2[0]; ov[4 * wd + 1] = w0 * x0[1] + w1 * x1[1] + w2 * x2[1]; ov[4 * wd + 2] = w0 * y0[0] + w1 * y1[0] + w2 * y2[0]; ov[4 * wd + 3] = w0 * y0[1] + w1 * y1[1] + w2 * y2[1]; }
            u32x2 o; o.x = pk4_f8(ov[0], ov[1], ov[2], ov[3], 1.0f); o.y = pk4_f8(ov[4], ov[5], ov[6], ov[7], 1.0f);
            *(u32x2*)(OB + (size_t)row * DM + col) = o; }
    }
}

__device__ __forceinline__ void ln_preload(LAS unsigned char* lds, const float* __restrict__ W32, int wpitch, int t0 = 0, int nthr = 512) {
    const int tid = (int)threadIdx.x - t0; LAS float* wl = (LAS float*)lds;
#pragma unroll 4
    for (int idx = tid; idx < 32768; idx += nthr) { const int k = idx >> 5, e = idx & 31; const int slot = (((k >> 8) * 4 + (k & 3)) * 64) + ((k >> 2) & 63);
        wl[slot * 36 + e] = W32[(size_t)k * wpitch + e]; }
}
template <int MIXSRC, int POST, bool WRITE_B, bool WRITE_F, bool XF32 = false>
__device__ __forceinline__ void ln_phase(LAS unsigned char* lds, const bf16* __restrict__ xres, const bf16* __restrict__ mixf, const unsigned char* __restrict__ YS, const float* __restrict__ gates_in,
                                         const float* __restrict__ gamma, const float* __restrict__ beta, float* outf, bf16* __restrict__ outb,
                                         const float* __restrict__ W32, int wpitch, const float* __restrict__ bias32, float* __restrict__ gates_out, int* __restrict__ lists, unsigned* counts, float* __restrict__ DTout,
                                         int G, int vcu, unsigned char* __restrict__ outq = nullptr) {
    const int tid = threadIdx.x, lane = tid & 63, w = __builtin_amdgcn_readfirstlane(tid >> 6);
    LAS float* wl = (LAS float*)lds;
    LAS int* sel_e = (LAS int*)(lds + LDS_SM); LAS int* sel_rk = sel_e + 512; LAS int* lcnt = sel_e + 1024; LAS int* gbase = sel_e + 1056;
    if (POST) {
        if (MK_PER_PHASE) ln_preload(lds, W32, wpitch);
        if (POST == 1 && tid < 32) lcnt[tid] = 0;
        __syncthreads();
    }
    int ebr = 0;
#pragma unroll
    for (int bb = 0; bb < 5; ++bb) ebr |= ((lane >> bb) & 1) << (4 - bb);
    float mybias = 0.f; if (POST) mybias = bias32[ebr];
    for (int chunk = vcu; chunk < T / 128; chunk += G) {
        u32x2 nxr[4], nmx[4]; f32x4 nxf[XF32 ? 4 : 1]; unsigned nys[4][4]; f32x4 ngv = (f32x4){0.f, 0.f, 0.f, 0.f};
        { const size_t row = (size_t)chunk * 128 + w * 16;
            if (MIXSRC == 1) ngv = *(const f32x4*)(gates_in + row * 4);
#pragma unroll
            for (int j = 0; j < 4; ++j) { if (XF32) nxf[XF32 ? j : 0] = *(const f32x4*)((const float*)xres + row * DM + 4 * lane + 256 * j); else nxr[j] = *(const u32x2*)(xres + row * DM + 4 * lane + 256 * j);
                if (MIXSRC == 0) nmx[j] = *(const u32x2*)(mixf + row * DM + 4 * lane + 256 * j);
                else {
#pragma unroll
                    for (int k = 0; k < 4; ++k) nys[j][k] = __builtin_nontemporal_load((const unsigned*)(YS + (row * 4 + k) * DM + 4 * lane + 256 * j)); } } }
        for (int pass = 0; pass < 16; ++pass) {
            const int rl = w * 16 + pass; const size_t row = (size_t)chunk * 128 + rl;
            asm volatile("" ::: "memory");
            int lo = lane; asm volatile("" : "+v"(lo));
            float xv[16];
            {
                f32x4 v[4]; float s = 0.f;
                const f32x4 gv = ngv * (MIXSRC == 1 ? 1.0f / Q8_Y : 1.0f);
#pragma unroll
                for (int j = 0; j < 4; ++j) {
                    f32x4 mix;
                    if (MIXSRC == 0) mix = (f32x4){bflo(nmx[j].x), bfhi(nmx[j].x), bflo(nmx[j].y), bfhi(nmx[j].y)};
                    else { mix = (f32x4){0.f, 0.f, 0.f, 0.f};
#pragma unroll
                        for (int k = 0; k < 4; ++k) { const f32x2 ylo = __builtin_amdgcn_cvt_pk_f32_fp8((int)nys[j][k], false), yhi = __builtin_amdgcn_cvt_pk_f32_fp8((int)nys[j][k], true);
                            mix[0] += gv[k] * ylo[0]; mix[1] += gv[k] * ylo[1]; mix[2] += gv[k] * yhi[0]; mix[3] += gv[k] * yhi[1]; } }
                    const f32x4 xr = XF32 ? nxf[XF32 ? j : 0] : (f32x4){bflo(nxr[j].x), bfhi(nxr[j].x), bflo(nxr[j].y), bfhi(nxr[j].y)};
                    v[j] = xr * ALPHA + mix; s += (v[j][0] + v[j][1]) + (v[j][2] + v[j][3]);
                }
                if (pass < 15) { const size_t nrow = row + 1;
                    if (MIXSRC == 1) ngv = *(const f32x4*)(gates_in + nrow * 4);
#pragma unroll
                    for (int j = 0; j < 4; ++j) { if (XF32) nxf[XF32 ? j : 0] = *(const f32x4*)((const float*)xres + nrow * DM + 4 * lo + 256 * j); else nxr[j] = *(const u32x2*)(xres + nrow * DM + 4 * lo + 256 * j);
                        if (MIXSRC == 0) nmx[j] = *(const u32x2*)(mixf + nrow * DM + 4 * lo + 256 * j);
                        else {
#pragma unroll
                            for (int k = 0; k < 4; ++k) nys[j][k] = __builtin_nontemporal_load((const unsigned*)(YS + (nrow * 4 + k) * DM + 4 * lo + 256 * j)); } } }
                const float mean = wave_sum(s) * (1.0f / DM); float s2 = 0.f;
#pragma unroll
                for (int j = 0; j < 4; ++j) { v[j] = v[j] - mean; s2 += (v[j][0] * v[j][0] + v[j][1] * v[j][1]) + (v[j][2] * v[j][2] + v[j][3] * v[j][3]); }
                const float rstd = 1.0f / sqrtf(wave_sum(s2) * (1.0f / DM) + LN_EPS);
#pragma unroll
                for (int j = 0; j < 4; ++j) { const f32x4 gm = *(const f32x4*)(gamma + 4 * lo + 256 * j), bt = *(const f32x4*)(beta + 4 * lo + 256 * j);
                    const f32x4 y = v[j] * rstd * gm + bt;
                    if (WRITE_F) __builtin_nontemporal_store(y, (f32x4*)(outf + row * DM + 4 * lo + 256 * j));
                    if (WRITE_B) { u32x2 q; q.x = pk2(y[0], y[1]); q.y = pk2(y[2], y[3]); *(u32x2*)(outb + row * DM + 4 * lo + 256 * j) = q; }
                    if (POST) *(unsigned*)(outq + row * DM + 4 * lo + 256 * j) = pk4_f8(y[0], y[1], y[2], y[3], Q8_X);
                    xv[4 * j + 0] = y[0]; xv[4 * j + 1] = y[1]; xv[4 * j + 2] = y[2]; xv[4 * j + 3] = y[3]; }
            }
            if (POST) {
                f32x2 acc2[16];
#pragma unroll
                for (int e = 0; e < 16; ++e) acc2[e] = (f32x2){0.f, 0.f};
#pragma unroll
                for (int jj = 0; jj < 16; ++jj) { const LAS float* wrow = wl + (jj * 64 + lane) * 36;
                    if ((jj & 1) == 0) asm volatile("" ::: "memory");
                    const f32x2 xx = (f32x2){xv[jj], xv[jj]};
#pragma unroll
                    for (int e4 = 0; e4 < 8; ++e4) { const f32x4 wv = *(const LAS f32x4*)(wrow + 4 * e4);
                        acc2[2 * e4] = acc2[2 * e4] + xx * (f32x2){wv[0], wv[1]}; acc2[2 * e4 + 1] = acc2[2 * e4 + 1] + xx * (f32x2){wv[2], wv[3]}; } }
                float acc0[32];
#pragma unroll
                for (int e = 0; e < 32; ++e) acc0[e] = acc2[e >> 1][e & 1];
#pragma unroll
                for (int bb = 0; bb < 5; ++bb) { const int hh = 16 >> bb; const unsigned um = ((lane >> bb) & 1) ? 0xffffffffu : 0u;
#pragma unroll
                    for (int i = 0; i < hh; ++i) { const unsigned l0 = __float_as_uint(acc0[i]), h0 = __float_as_uint(acc0[i + hh]);
                        const float k0 = __uint_as_float((h0 & um) | (l0 & ~um)), s0 = __uint_as_float((l0 & um) | (h0 & ~um)); acc0[i] = k0 + __shfl_xor(s0, 1 << bb); } }
                const float lg0 = acc0[0] + __shfl_xor(acc0[0], 32) + mybias;
                if (POST == 1) {
                    const unsigned ub = __float_as_uint(lg0); const unsigned uo = (ub & 0x80000000u) ? ~ub : (ub | 0x80000000u);
                    unsigned key = (uo & ~31u) | (unsigned)(31 - ebr);
                    float top0 = 0.f, myv = 0.f, esum = 0.f; int ek = 0;
#pragma unroll
                    for (int k = 0; k < 4; ++k) { unsigned bk = key;
#pragma unroll
                        for (int off = 1; off < 32; off <<= 1) { const unsigned ok = (unsigned)__shfl_xor((int)bk, off); bk = ok > bk ? ok : bk; }
                        const int be = 31 - (int)(__builtin_amdgcn_readfirstlane(bk) & 31u);
                        int wl_ = 0;
#pragma unroll
                        for (int bb = 0; bb < 5; ++bb) wl_ |= ((be >> bb) & 1) << (4 - bb);
                        const float bv = __uint_as_float(__builtin_amdgcn_readlane(__float_as_uint(lg0), wl_));
                        if (k == 0) top0 = bv;
                        const float ex = __expf(bv - top0); esum += ex;
                        myv = (lane == k) ? ex : myv; ek = (lane == k) ? be : ek; key = (ebr == be) ? 0u : key; }
                    if (lane < 4) {
                        gates_out[row * 4 + lane] = myv / esum;
                        const int rk = __hip_atomic_fetch_add(lcnt + ek, 1, __ATOMIC_RELAXED, __HIP_MEMORY_SCOPE_WORKGROUP);
                        sel_e[rl * 4 + lane] = ek; sel_rk[rl * 4 + lane] = rk; }
                } else {
                    if (lane < 32) { const float xx = lg0; const float y = __expf(-fabsf(xx)); const float l1p = (y < 1e-3f) ? (y - 0.5f * y * y) : __logf(1.0f + y);
                        DTout[row * 32 + ebr] = fmaxf(xx, 0.f) + l1p; }
                }
            }
        }
        if (POST == 1) {
            __syncthreads();
            if (tid < 32) gbase[tid] = (int)__hip_atomic_fetch_add(counts + tid, (unsigned)lcnt[tid], __ATOMIC_RELAXED, __HIP_MEMORY_SCOPE_AGENT);
            __syncthreads();
            { const int e = sel_e[tid]; lists[(size_t)e * 32768 + gbase[e] + sel_rk[tid]] = (chunk * 128 + (tid >> 2)) * 4 + (tid & 3); }
            __syncthreads();
            if (tid < 32) lcnt[tid] = 0;
            __syncthreads();
        }
    }
}

__device__ __forceinline__ void conv_item(const bf16* __restrict__ ZX, const float* __restrict__ conv_w, const float* __restrict__ conv_b, int tok0, int ch, u32x4 (&q)[8]) {
    const int sl = tok0 & (SEQ - 1);
    u32x4 raw[11];
#pragma unroll
    for (int i = 0; i < 11; ++i) { if (sl - 3 + i >= 0) raw[i] = *(const u32x4*)(ZX + (size_t)(tok0 - 3 + i) * NZX + 2048 + ch); else raw[i] = (u32x4){0u, 0u, 0u, 0u}; }
    f32x2 cw[4][4], cb[4];
#pragma unroll
    for (int k = 0; k < 4; ++k)
#pragma unroll
        for (int p = 0; p < 4; ++p) cw[k][p] = *(const f32x2*)(conv_w + (size_t)k * 3072 + ch + 2 * p);
#pragma unroll
    for (int p = 0; p < 4; ++p) cb[p] = *(const f32x2*)(conv_b + ch + 2 * p);
    f32x2 xin[11][4];
#pragma unroll
    for (int i = 0; i < 11; ++i)
#pragma unroll
        for (int p = 0; p < 4; ++p) xin[i][p] = (f32x2){bflo(raw[i][p]), bfhi(raw[i][p])};
#pragma unroll
    for (int t = 0; t < 8; ++t)
#pragma unroll
        for (int p = 0; p < 4; ++p) { f32x2 a = cb[p];
#pragma unroll
            for (int k = 0; k < 4; ++k) a = a + cw[k][p] * xin[t + k][p];
            q[t][p] = pk2(silu_f(a[0]), silu_f(a[1])); }
}
__device__ __forceinline__ void convcb_phase(LAS unsigned char* lds, const bf16* __restrict__ ZX, const float* __restrict__ conv_w, const float* __restrict__ conv_b, bf16* __restrict__ XA, bf16* __restrict__ CBG, int G, int vcu) {
    const int tid = threadIdx.x, lane = tid & 63, w = __builtin_amdgcn_readfirstlane(tid >> 6), r16 = lane & 15, q4 = lane >> 4;
    LAS unsigned char *Cs = lds, *Bs = lds + 128 * P256;
    for (int u = vcu; u < BATCH * 32; u += G) {
        const int tokc = u * 128;
        for (int it = 0; it < 8; ++it) { const int item = it * 512 + tid, cg = item & 255, tb = item >> 8;
            u32x4 q[8]; conv_item(ZX, conv_w, conv_b, tokc + 8 * tb, 8 * cg, q);
#pragma unroll
            for (int t = 0; t < 8; ++t) *(u32x4*)(XA + (size_t)(tokc + 8 * tb + t) * 3072 + 8 * cg) = q[t]; }
        for (int g = 0; g < 4; ++g) {
            { const int cgl = tid & 31, tb = tid >> 5; const int ch = (cgl < 16) ? (2048 + g * 128 + 8 * cgl) : (2560 + g * 128 + 8 * (cgl - 16));
                u32x4 q[8]; conv_item(ZX, conv_w, conv_b, tokc + 8 * tb, ch, q);
                LAS unsigned char* dst = (cgl < 16) ? Bs : Cs;
#pragma unroll
                for (int t = 0; t < 8; ++t) { *(u32x4*)(XA + (size_t)(tokc + 8 * tb + t) * 3072 + ch) = q[t]; *(LAS u32x4*)(dst + swz256(8 * tb + t, 16 * (cgl & 15))) = q[t]; } }
            __syncthreads();
            bf16x8 cf[4];
#pragma unroll
            for (int kk = 0; kk < 4; ++kk) cf[kk] = *(const LAS bf16x8*)(Cs + swz256(16 * w + r16, 64 * kk + 16 * q4));
            bf16* outp = CBG + ((size_t)u * 4 + g) * 16384 + (size_t)(16 * w + r16) * 128 + 4 * q4;
#pragma unroll
            for (int st = 0; st < 8; ++st) { f32x4 m = (f32x4){0.f, 0.f, 0.f, 0.f};
#pragma unroll
                for (int kk = 0; kk < 4; ++kk) { const bf16x8 a = *(const LAS bf16x8*)(Bs + swz256(16 * st + r16, 64 * kk + 16 * q4)); m = mfma16(a, cf[kk], m); }
                u32x2 q; q.x = pk2(m[0], m[1]); q.y = pk2(m[2], m[3]); *(u32x2*)(outp + 16 * st) = q; }
            __syncthreads();
        }
    }
}
__device__ __forceinline__ void ssd_phase(LAS unsigned char* lds, const bf16* __restrict__ ZX, const bf16* __restrict__ XA, const bf16* __restrict__ CBG, const float* __restrict__ DT,
                                          const float* __restrict__ a_log, const float* __restrict__ d_skip, unsigned char* __restrict__ Y, float* SSQ, int G, int vcu) {
    const int tid = threadIdx.x, lane = tid & 63, w = __builtin_amdgcn_readfirstlane(tid >> 6), r16_0 = lane & 15, q4_0 = lane >> 4;
    constexpr int SZ_BT = 128 * P256, SZ_XT = 64 * P256, O_XT = 2 * SZ_BT, O_PR = O_XT + 2 * SZ_XT, O_FA = O_PR + 2 * SZ_XT;
    LAS float* fa = (LAS float*)(lds + O_FA);
    for (int u = vcu; u < BATCH * 32; u += G) {
        const int b = u >> 5, h = u & 31, g = h >> 3;
        const float Ah = -__expf(a_log[h]); const float Dh = d_skip[h];
        f32x4 st[4];
#pragma unroll
        for (int pt = 0; pt < 4; ++pt) st[pt] = (f32x4){0.f, 0.f, 0.f, 0.f};
        const int jp = 16 * (w & 3) + (lane & 15);
        const unsigned voff = (unsigned)jp * 12288u + (unsigned)(lane >> 4) * 16u;
        int chb[3];
#pragma unroll
        for (int it = 0; it < 3; ++it) { const int gq = 2 * it + (w >> 2); chb[it] = 2 * ((it == 0) ? (h * 64 + 32 * gq) : (2048 + g * 128 + 32 * (gq - 2))); }
        const char* xab = (const char*)XA + (size_t)b * SEQ * 6144;
        const bf16* cbb = CBG + ((size_t)(b * 32) * 4 + g) * 16384;
        u32x4 pre[3][2]; float dn0 = 0.f, dn1 = 0.f; u32x2 cbr[8]; u32x4 cfr[4];
        {
#pragma unroll
            for (int it = 0; it < 3; ++it) { const char* sb = xab + chb[it]; pre[it][0] = *(const u32x4*)(sb + voff); pre[it][1] = *(const u32x4*)(sb + voff + 6144); }
            if (w == 0) { dn0 = DT[((size_t)b * SEQ + 2 * lane) * 32 + h]; dn1 = DT[((size_t)b * SEQ + 2 * lane + 1) * 32 + h]; }
        }
        for (int c = 0; c <= 32; ++c) {
            const int r16 = r16_0, q4 = q4_0;
            const int sb_ = c & 1;
            LAS unsigned char* BTn = lds + sb_ * SZ_BT; LAS unsigned char* xTn = lds + O_XT + sb_ * SZ_XT; LAS unsigned char* prn = lds + O_PR + sb_ * SZ_XT; LAS float* fan = fa + sb_ * 512;
            if (c >= 1) {
                const int cc = c - 1, cb_ = cc & 1; const int tok0 = b * SEQ + cc * 128;
                LAS unsigned char* BTs = lds + cb_ * SZ_BT; LAS unsigned char* xTs = lds + O_XT + cb_ * SZ_XT; LAS unsigned char* prevs = lds + O_PR + cb_ * SZ_XT;
                LAS float* acum = fa + cb_ * 512; LAS float* dtv = acum + 128; LAS float* wdec = acum + 256;
                const int l = 16 * w + r16;
                u32x2 zz[4];
#pragma unroll
                for (int pt = 0; pt < 4; ++pt) zz[pt] = *(const u32x2*)(ZX + ((size_t)tok0 + l) * NZX + h * 64 + 16 * pt + 4 * q4);
                const float al = acum[l];
                bf16x8 pf[4];
#pragma unroll
                for (int kp = 0; kp < 4; ++kp) {
                    const f32x4 as0 = *(const LAS f32x4*)(acum + 32 * kp + 4 * q4), ds0 = *(const LAS f32x4*)(dtv + 32 * kp + 4 * q4), as1 = *(const LAS f32x4*)(acum + 32 * kp + 16 + 4 * q4), ds1 = *(const LAS f32x4*)(dtv + 32 * kp + 16 + 4 * q4);
                    const u32x2 c0 = cbr[2 * kp], c1 = cbr[2 * kp + 1];
                    const float m0[4] = {bflo(c0.x), bfhi(c0.x), bflo(c0.y), bfhi(c0.y)}, m1[4] = {bflo(c1.x), bfhi(c1.x), bflo(c1.y), bfhi(c1.y)};
                    float mm[8];
#pragma unroll
                    for (int jj = 0; jj < 4; ++jj) { const int s_0 = 32 * kp + 4 * q4 + jj, s_1 = s_0 + 16;
                        mm[jj] = (s_0 <= l) ? m0[jj] * __expf(fminf(al - as0[jj], 0.f)) * ds0[jj] : 0.f; mm[4 + jj] = (s_1 <= l) ? m1[jj] * __expf(fminf(al - as1[jj], 0.f)) * ds1[jj] : 0.f; }
                    u32x4 pw; pw.x = pk2(mm[0], mm[1]); pw.y = pk2(mm[2], mm[3]); pw.z = pk2(mm[4], mm[5]); pw.w = pk2(mm[6], mm[7]); pf[kp] = as_bf16x8(pw); }
                f32x4 y[4];
#pragma unroll
                for (int pt = 0; pt < 4; ++pt) { y[pt] = (f32x4){0.f, 0.f, 0.f, 0.f};
#pragma unroll
                    for (int kk = 0; kk < 4; ++kk) { const bf16x8 a = *(const LAS bf16x8*)(prevs + swz256(16 * pt + r16, 64 * kk + 16 * q4)); y[pt] = mfma16(a, as_bf16x8(cfr[kk]), y[pt]); } }
                const float el = __expf(al);
#pragma unroll
                for (int pt = 0; pt < 4; ++pt) y[pt] = y[pt] * el;
#pragma unroll
                for (int kp = 0; kp < 4; ++kp)
#pragma unroll
                    for (int pt = 0; pt < 4; ++pt) { const u32x2 lo = *(const LAS u32x2*)(xTs + swz256(16 * pt + r16, 64 * kp + 8 * q4)), hi = *(const LAS u32x2*)(xTs + swz256(16 * pt + r16, 64 * kp + 32 + 8 * q4));
                        const u32x4 av = (u32x4){lo.x, lo.y, hi.x, hi.y}; y[pt] = mfma16(as_bf16x8(av), pf[kp], y[pt]); }
                if (c < 32) { const bf16* cp = cbb + (size_t)c * 65536 + (size_t)(16 * w + r16) * 128 + 4 * q4;
#pragma unroll
                    for (int i = 0; i < 8; ++i) cbr[i] = *(const u32x2*)(cp + 16 * i);
                    const bf16* ccp = XA + ((size_t)b * SEQ + c * 128 + 16 * w + r16) * 3072 + 2560 + g * 128 + 8 * q4;
#pragma unroll
                    for (int kk = 0; kk < 4; ++kk) cfr[kk] = *(const u32x4*)(ccp + 32 * kk); }
                { const size_t tok = (size_t)tok0 + l; float ssq = 0.f; unsigned yq[4];
#pragma unroll
                    for (int pt = 0; pt < 4; ++pt) { const int p0 = 16 * pt + 4 * q4;
                        float ov[4];
#pragma unroll
                        for (int jj = 0; jj < 4; ++jj) { const float xvv = bf2f(*(const LAS unsigned short*)(xTs + swz256(p0 + jj, 2 * l)));
                            const unsigned zw = (jj < 2) ? zz[pt].x : zz[pt].y; const float zf = (jj & 1) ? bfhi(zw) : bflo(zw);
                            ov[jj] = (y[pt][jj] + Dh * xvv) * silu_f(zf); }
                        ssq += (ov[0] * ov[0] + ov[1] * ov[1]) + (ov[2] * ov[2] + ov[3] * ov[3]);
                        yq[pt] = pk4_f8(ov[0], ov[1], ov[2], ov[3], Q8_YS); }
                    *(u32x4*)(Y + tok * DI + h * 64 + 16 * q4) = tr4x4(yq[0], yq[1], yq[2], yq[3]);
                    ssq += __shfl_xor(ssq, 16); ssq += __shfl_xor(ssq, 32);
                    if (q4 == 0) SSQ[tok * 32 + h] = ssq; }
                { const float dec = __expf(acum[384]);
#pragma unroll
                    for (int pt = 0; pt < 4; ++pt) st[pt] = st[pt] * dec;
#pragma unroll
                    for (int kk = 0; kk < 4; ++kk) { const u32x4 a = *(const LAS u32x4*)(BTs + swz256(16 * w + r16, 64 * kk + 16 * q4));
                        const f32x4 w0 = *(const LAS f32x4*)(wdec + 32 * kk + 8 * q4), w1 = *(const LAS f32x4*)(wdec + 32 * kk + 8 * q4 + 4);
                        u32x4 aw; aw.x = pk2(bflo(a.x) * w0[0], bfhi(a.x) * w0[1]); aw.y = pk2(bflo(a.y) * w0[2], bfhi(a.y) * w0[3]); aw.z = pk2(bflo(a.z) * w1[0], bfhi(a.z) * w1[1]); aw.w = pk2(bflo(a.w) * w1[2], bfhi(a.w) * w1[3]);
#pragma unroll
                        for (int pt = 0; pt < 4; ++pt) { const bf16x8 bfr = *(const LAS bf16x8*)(xTs + swz256(16 * pt + r16, 64 * kk + 16 * q4)); st[pt] = mfma16(as_bf16x8(aw), bfr, st[pt]); } } }
            } else {
                const bf16* cp = cbb + (size_t)(16 * w + r16) * 128 + 4 * q4;
#pragma unroll
                for (int i = 0; i < 8; ++i) cbr[i] = *(const u32x2*)(cp + 16 * i);
                const bf16* ccp = XA + ((size_t)b * SEQ + 16 * w + r16) * 3072 + 2560 + g * 128 + 8 * q4;
#pragma unroll
                for (int kk = 0; kk < 4; ++kk) cfr[kk] = *(const u32x4*)(ccp + 32 * kk);
            }
            if (c < 32) {
#pragma unroll
                for (int pt = 0; pt < 4; ++pt) { u32x2 q; q.x = pk2(st[pt][0], st[pt][1]); q.y = pk2(st[pt][2], st[pt][3]); *(LAS u32x2*)(prn + swz256(16 * pt + r16, 2 * (16 * w + 4 * q4))) = q; }
                if (w == 0) { const int t0 = 2 * lane; const float d0 = dn0, d1 = dn1;
                    const float a0 = d0 * Ah, a1 = d1 * Ah; const float sm = a0 + a1; float incl = sm;
#pragma unroll
                    for (int off = 1; off < 64; off <<= 1) { const float v = __shfl_up(incl, off); if (lane >= off) incl += v; }
                    const float c0 = (incl - sm) + a0, c1 = incl; const float tot = __shfl(incl, 63);
                    fan[t0] = c0; fan[t0 + 1] = c1; fan[128 + t0] = d0; fan[128 + t0 + 1] = d1; fan[256 + t0] = d0 * __expf(tot - c0); fan[256 + t0 + 1] = d1 * __expf(tot - c1); if (lane == 63) fan[384] = tot; }
#pragma unroll
                for (int it = 0; it < 3; ++it) { const int cgi = 4 * (2 * it + (w >> 2)) + (lane >> 4);
                    LAS unsigned char* dst = (it == 0) ? xTn : BTn; const int r0 = (it == 0) ? (8 * cgi) : (8 * (cgi - 8));
#pragma unroll
                    for (int i = 0; i < 8; ++i) { const unsigned a0 = pre[it][0][i >> 1], a1 = pre[it][1][i >> 1];
                        const unsigned lo = (i & 1) ? (a0 >> 16) : (a0 & 0xffffu), hi = (i & 1) ? (a1 & 0xffff0000u) : (a1 << 16);
                        *(LAS unsigned*)(dst + swz256(r0 + i, 4 * jp)) = lo | hi; } }
                if (c < 31) {
#pragma unroll
                    for (int it = 0; it < 3; ++it) { const char* sb = xab + (size_t)(c + 1) * (128 * 6144) + chb[it]; pre[it][0] = *(const u32x4*)(sb + voff); pre[it][1] = *(const u32x4*)(sb + voff + 6144); }
                    if (w == 0) { const size_t t1 = (size_t)b * SEQ + (c + 1) * 128; dn0 = DT[(t1 + 2 * lane) * 32 + h]; dn1 = DT[(t1 + 2 * lane + 1) * 32 + h]; }
                }
            }
            lds_barrier();
        }
    }
}
__device__ __forceinline__ void rmsnorm_phase(bf16* Y, int G, int vcu) {
    const int tid = threadIdx.x, lane = tid & 63, w = tid >> 6;
    const int gw = vcu * 8 + w, NGW = G * 8;
    for (int row = gw; row < T; row += NGW) {
        u32x4* rp = (u32x4*)(Y + (size_t)row * DI) + lane;
#pragma unroll
        for (int j = 0; j < 4; ++j) { const u32x4 a = rp[64 * j]; float f[8]; float ss = 0.f;
#pragma unroll
            for (int i = 0; i < 4; ++i) { f[2 * i] = bflo(a[i]); f[2 * i + 1] = bfhi(a[i]); ss += f[2 * i] * f[2 * i] + f[2 * i + 1] * f[2 * i + 1]; }
            const float sc = 1.0f / sqrtf(wave_sum(ss) * (1.0f / 512.0f) + RMS_EPS);
            u32x4 o;
#pragma unroll
            for (int i = 0; i < 4; ++i) o[i] = pk2(f[2 * i] * sc, f[2 * i + 1] * sc);
            rp[64 * j] = o; }
    }
}

__device__ __forceinline__ int moe_tables(LAS unsigned char* lds, const unsigned* counts) {
    const int tid = threadIdx.x;
    LAS int* tab = (LAS int*)(lds + LDS_TAB);
    if (tid < 32) tab[64 + tid] = (int)__hip_atomic_load(counts + tid, __ATOMIC_RELAXED, __HIP_MEMORY_SCOPE_AGENT);
    __syncthreads();
    if (tid == 0) { int pre = 0; for (int e = 0; e < 32; ++e) { tab[e] = pre; pre += (tab[64 + e] + 255) >> 8; } tab[32] = pre; }
    __syncthreads();
    const int NB = tab[32];
    for (int rb = tid; rb < NB; rb += 512) { int e = 0; while (e < 31 && tab[e + 1] <= rb) ++e; tab[128 + rb] = e; }
    __syncthreads();
    return NB;
}

struct Args { const void* in[22]; float* out; unsigned char* ws; int ph_lo, ph_hi; };
__global__ void __launch_bounds__(512, 2) fwd_kernel(Args args) {
    extern __shared__ __attribute__((aligned(16))) unsigned char lds_raw[];
    LAS unsigned char* lds = (LAS unsigned char*)lds_raw;
    const int tid = threadIdx.x;
    const int G = gridDim.x; const int bx = blockIdx.x; const int vcu = (G % 8 == 0) ? (bx % 8) * (G / 8) + bx / 8 : bx;
    unsigned char* ws = args.ws;
    unsigned* ctl = (unsigned*)(ws + WS_CTL);
    Ptrs P;
    P.x = (const float*)args.in[0]; P.pos = (const int*)args.in[1]; P.attn_w_in = (const float*)args.in[2]; P.attn_w_out = (const float*)args.in[3]; P.ssm_w_in = (const float*)args.in[4];
    P.conv_w = (const float*)args.in[5]; P.conv_b = (const float*)args.in[6]; P.dt_bias = (const float*)args.in[7]; P.a_log = (const float*)args.in[8]; P.d_skip = (const float*)args.in[9];
    P.norm_w = (const float*)args.in[10]; P.ssm_w_out = (const float*)args.in[11]; P.w_router = (const float*)args.in[12]; P.b_router = (const float*)args.in[13]; P.w_up = (const float*)args.in[14];
    P.b_up = (const float*)args.in[15]; P.w_dn = (const float*)args.in[16]; P.b_dn = (const float*)args.in[17]; P.ln_mix_g = (const float*)args.in[18]; P.ln_mix_b = (const float*)args.in[19];
    P.ln_ffn_g = (const float*)args.in[20]; P.ln_ffn_b = (const float*)args.in[21];
    volatile LAS unsigned* misc = (volatile LAS unsigned*)(lds + LDS_MISC);
    if (tid < 64) misc[tid] = 0u;
    __syncthreads();
    XcdBarrier bar; bar.bar = ctl + CW_BAR; bar.x = 0; bar.st = misc;
    if (!MK_PER_PHASE) bar = xcd_barrier_post(ctl + CW_BAR, misc);
    const int lo = args.ph_lo, hi = args.ph_hi;
#ifndef PH_MASK
#define PH_MASK 0x1FFFF
#endif
#define IN(k) ((((PH_MASK) >> (k)) & 1) && lo <= (k) && (k) < hi)
#define SEAM(k) do { if (IN(k) && IN((k) + 1)) xcd_barrier(bar); } while (0)
#define SEAM_PRE(k, W, PITCH) do { if (IN(k) && IN((k) + 1)) { const float* w_ = (W); const int p_ = (PITCH); xcd_barrier(bar, [=]() { ln_preload(lds, w_, p_, 64, 448); }); } } while (0)

    bf16* Wqkv = (bf16*)(ws + WS_WQKV); bf16* Wao = (bf16*)(ws + WS_WAO); bf16* Wsi = (bf16*)(ws + WS_WSI); bf16* Wso = (bf16*)(ws + WS_WSO);
    bf16* XBA = (bf16*)(ws + WS_XBA); bf16* XBB = (bf16*)(ws + WS_XBB); bf16* MIXB = (bf16*)(ws + WS_X1);
    unsigned char* PROJ = ws + WS_BIG; bf16* ZX = (bf16*)(ws + WS_BIG); bf16* XA = (bf16*)(ws + WS_XA); bf16* CBG = (bf16*)(ws + WS_CBG); unsigned char* HB8 = ws + WS_HB; unsigned char* XQ = ws + WS_XQ; unsigned char* YS = ws + WS_YS;
    unsigned char* OG = ws + WS_OG; unsigned char* YB = ws + WS_OG;
    float* rope = (float*)(ws + WS_ROPE); float* gates = (float*)(ws + WS_GATES); float* DT = (float*)(ws + WS_DT); int* lists = (int*)(ws + WS_LIST); float* LSE = (float*)(ws + WS_LSE); float* SSQ = (float*)(ws + WS_LSE);

    if (IN(0)) { p0_prologue(lds, P, ws, G, vcu); }
    SEAM(0);


#define MOE_BLOCK(LAYER, PB) do { \
    unsigned* counts = ctl + CW_CNT + 64 * (LAYER); \
    if (IN((PB) + 0)) { \
        if ((LAYER) == 0) ln_phase<0, 1, true, false, true>(lds, (const bf16*)P.x, MIXB, nullptr, nullptr, P.ln_mix_g, P.ln_mix_b, nullptr, XBB, P.w_router, NE, P.b_router, gates, lists, counts, nullptr, G, vcu, XQ);   \
        else ln_phase<0, 1, true, false>(lds, XBA, MIXB, nullptr, nullptr, P.ln_mix_g + (LAYER) * DM, P.ln_mix_b + (LAYER) * DM, nullptr, XBB, \
                             P.w_router + (size_t)(LAYER) * DM * NE, NE, P.b_router + (LAYER) * NE, gates, lists, counts, nullptr, G, vcu, XQ); } \
    SEAM((PB) + 0); \
    if (IN((PB) + 1)) { \
        const int NB = moe_tables(lds, counts); \
        LAS int* tab = (LAS int*)(lds + LDS_TAB); LAS unsigned short* toks = (LAS unsigned short*)(lds + LDS_AUX); \
        const int NU = NB * 8; \
        const int nun = (vcu < NU) ? ((NU - vcu + G - 1) / G) : 0; \
        for (int idx = tid; idx < nun * 256 && idx < 17 * 256; idx += 512) { const int i = idx >> 8, row = idx & 255; const int L = i * G + vcu; const int rb = L >> 3; const int e = tab[128 + rb]; \
            const int r0 = (rb - tab[e]) * 256, cnt = tab[64 + e]; int si = r0 + row; si = si < cnt ? si : cnt - 1; toks[idx] = (unsigned short)(lists[(size_t)e * 32768 + si] >> 2); } \
        LAS unsigned* btab = (LAS unsigned*)(lds + LDS_SLOT); \
        for (int idx = tid; idx < nun * 128 && idx < 17 * 128; idx += 512) { const int i = idx >> 7, cp = idx & 127; const int L = i * G + vcu; const int rb = L >> 3, pn = L & 7; const int e = tab[128 + rb]; \
            const float* bsrc = P.b_up + ((size_t)(LAYER) * 32 + e) * 2048 + ((cp < 64) ? (pn * 128 + 2 * cp) : (1024 + pn * 128 + 2 * (cp - 64))); btab[idx] = pk2(bsrc[0], bsrc[1]); } \
        __syncthreads(); \
        pg8::MoeOrder<true> S; S.A = (const char*)XQ; S.Bt = (const char*)(ws + WS_WUP + (size_t)(LAYER) * 32 * 2048 * 1024); S.K = DM / 2;   S.N = 2048; S.nN = 8; S.G = G; S.c = vcu; S.NU = NU; S.tab = tab; S.toks = toks; \
        pg8::EpiUp E{HB8, btab}; \
        if ((LAYER) == 0) { pg8::HostCvt H; H.w_up = P.w_up + (size_t)32 * 1024 * 2048; H.w_dn = P.w_dn + (size_t)32 * 1024 * 1024; H.wt_up = ws + WS_WUP + (size_t)32 * 2048 * 1024; H.wt_dn = ws + WS_WDN + (size_t)32 * 1024 * 1024; \
            H.base = 0; H.limit = 49152; H.G = G; H.c = vcu;   \
            pg8::gemm_phase<true>(lds, DM / 2, S, E, H); } \
        else { pg8::HostNone H; pg8::gemm_phase<true>(lds, DM / 2, S, E, H); } } \
    SEAM((PB) + 1); \
    if (IN((PB) + 2)) { \
        const int NB = moe_tables(lds, counts); \
        LAS int* tab = (LAS int*)(lds + LDS_TAB); LAS int* slots = (LAS int*)(lds + LDS_SLOT); LAS unsigned* dbtab = (LAS unsigned*)(lds + LDS_AUX); \
        { const int NU = NB * 4; const int nun = (vcu < NU) ? ((NU - vcu + G - 1) / G) : 0; \
          for (int idx = tid; idx < nun * 256 && idx < 9 * 256; idx += 512) { const int i = idx >> 8, row = idx & 255; const int L = i * G + vcu; const int rb = L >> 2; const int e = tab[128 + rb]; \
              const int si = (rb - tab[e]) * 256 + row; slots[idx] = (si < tab[64 + e]) ? lists[(size_t)e * 32768 + si] : -1; } \
          for (int idx = tid; idx < nun * 128 && idx < 9 * 128; idx += 512) { const int i = idx >> 7, cp = idx & 127; const int L = i * G + vcu; const int rb = L >> 2, pn = L & 3; const int e = tab[128 + rb]; \
              const float* bsrc = P.b_dn + ((size_t)(LAYER) * 32 + e) * 1024 + pn * 256 + 2 * cp; dbtab[idx] = pk2(bsrc[0], bsrc[1]); } \
          __syncthreads(); } \
        pg8::MoeOrder<false> S; S.A = (const char*)HB8; S.Bt = (const char*)(ws + WS_WDN + (size_t)(LAYER) * 32 * 1024 * 1024); S.K = DM / 2; S.N = 1024; S.nN = 4; S.G = G; S.c = vcu; S.NU = NB * 4; S.tab = tab; S.toks = nullptr; \
        pg8::EpiDown E{YS, dbtab, slots}; \
        if ((LAYER) == 0) { pg8::HostCvt H; H.w_up = P.w_up + (size_t)32 * 1024 * 2048; H.w_dn = P.w_dn + (size_t)32 * 1024 * 1024; H.wt_up = ws + WS_WUP + (size_t)32 * 2048 * 1024; H.wt_dn = ws + WS_WDN + (size_t)32 * 1024 * 1024; \
            H.base = NB * 64; H.limit = 49152; H.G = G; H.c = vcu;   \
            pg8::gemm_phase<true>(lds, DM / 2, S, E, H); \
            } \
        else { pg8::HostNone H; pg8::gemm_phase<true>(lds, DM / 2, S, E, H); } } \
    if ((LAYER) == 0) SEAM_PRE((PB) + 2, P.ssm_w_in + NZX, SSM_PITCH); else SEAM((PB) + 2); \
    if (IN((PB) + 3)) { \
        if ((LAYER) == 0) ln_phase<1, 2, true, false>(lds, XBB, nullptr, YS, gates, P.ln_ffn_g, P.ln_ffn_b, nullptr, XBA, P.ssm_w_in + NZX, SSM_PITCH, P.dt_bias, nullptr, nullptr, nullptr, DT, G, vcu, ws + WS_XQ0); \
        else ln_phase<1, 0, false, true>(lds, XBB, nullptr, YS, gates, P.ln_ffn_g + DM, P.ln_ffn_b + DM, args.out, nullptr, nullptr, 0, nullptr, nullptr, nullptr, nullptr, nullptr, G, vcu); } \
    } while (0)

    if (IN(1)) { pg8::DenseOrder S; S.init(ws + WS_XQ0, Wqkv, T, NQKV, DM / 2, G, bx); pg8::EpiQKV E{PROJ, rope, 1.0f / (Q8_X * Q8_W)};
        pg8::HostCvt H; H.w_up = P.w_up; H.w_dn = P.w_dn; H.wt_up = ws + WS_WUP; H.wt_dn = ws + WS_WDN; H.base = 0; H.limit = 2 * HOSTED_ITEMS; H.G = G; H.c = bx;
        pg8::gemm_phase<true>(lds, DM / 2, S, E, H); }
    SEAM(1);
    if (IN(2)) attn_phase(lds, PROJ, OG, LSE, G, vcu);
    SEAM(2);
    if (IN(3)) combine_phase(OG, LSE, ws + WS_OB, G, vcu);
    SEAM(3);
    if (IN(4)) { pg8::DenseOrder S; S.init(ws + WS_OB, Wao, T, DM, DM / 2, G, bx); pg8::EpiBf16 E{MIXB, DM, 1.0f / (Q8_O * Q8_W)}; pg8::HostNone H; pg8::gemm_phase<true>(lds, DM / 2, S, E, H); }
    SEAM_PRE(4, P.w_router, NE);
    MOE_BLOCK(0, 5);
    SEAM(8);
    if (IN(9)) { pg8::DenseOrder S; S.init(ws + WS_XQ0, Wsi, T, NZX, DM / 2, G, bx); pg8::EpiBf16 E{ZX, NZX, 1.0f / (Q8_X * Q8_W)}; pg8::HostNone H; pg8::gemm_phase<true>(lds, DM / 2, S, E, H); }
    SEAM(9);
    if (IN(10)) {
        convcb_phase(lds, ZX, P.conv_w, P.conv_b, XA, CBG, G, vcu); }
    SEAM(10);
    if (IN(11)) ssd_phase(lds, ZX, XA, CBG, DT, P.a_log, P.d_skip, YB, SSQ, G, vcu);
    SEAM(11);
    if (IN(12)) { pg8::DenseOrder S; S.init(YB, Wso, T, DM, DI / 2, G, bx);
        LAS float* stab = (LAS float*)(lds + LDS_AUX);
        for (int i = 0; i < 4; ++i) { pg8::Unit uu; if (!S.next(i, uu)) break;
            for (int idx = tid; idx < 1024; idx += 512) { const int rl = idx >> 2, g = idx & 3; const float* sp = SSQ + (size_t)(uu.pm * 256 + rl) * 32 + g * 8;
                const f32x4 a = *(const f32x4*)sp, b4 = *(const f32x4*)(sp + 4); const float sum = ((a[0] + a[1]) + (a[2] + a[3])) + ((b4[0] + b4[1]) + (b4[2] + b4[3]));
                stab[(i * 256 + rl) * 4 + g] = __builtin_amdgcn_rsqf(sum * (1.0f / 512.0f) + RMS_EPS); } }
        __syncthreads();
        pg8::EpiRms E{MIXB, DM, stab}; pg8::HostNone H; pg8::gemm_phase<true>(lds, DI / 2, S, E, H); }
    SEAM_PRE(12, P.w_router + (size_t)DM * NE, NE);
    MOE_BLOCK(1, 13);
#undef IN
#undef SEAM
#undef MOE_BLOCK
}

constexpr int NPHASE = 17;
extern "C" void kernel_launch(void* const* d_in, const int* in_sizes, int n_in, void* d_out, int out_size, void* d_ws, size_t ws_size, hipStream_t stream) {
    static int grid = 0;
    if (grid == 0) {
        if (n_in != 22 || in_sizes[0] != T * DM || out_size != T * DM || ws_size < WS_END) { fprintf(stderr, "kernel_launch: unexpected shapes / workspace (n_in %d, in0 %d, out %d, ws %zu, need %zu)\n", n_in, n_in > 0 ? in_sizes[0] : -1, out_size, ws_size, (size_t)WS_END); grid = -1; return; }
        int dev = 0, cus = 0;
        if (hipGetDevice(&dev) != hipSuccess || hipDeviceGetAttribute(&cus, hipDeviceAttributeMultiprocessorCount, dev) != hipSuccess) { fprintf(stderr, "kernel_launch: device query failed\n"); grid = -1; return; }
        if (hipFuncSetAttribute((const void*)fwd_kernel, hipFuncAttributeMaxDynamicSharedMemorySize, LDS_BYTES) != hipSuccess) { fprintf(stderr, "kernel_launch: hipFuncSetAttribute failed\n"); grid = -1; return; }
        int per_cu = 0;
        if (hipOccupancyMaxActiveBlocksPerMultiprocessor(&per_cu, (const void*)fwd_kernel, 512, LDS_BYTES) != hipSuccess || per_cu < 1) fprintf(stderr, "kernel_launch: occupancy query reports %d\n", per_cu);
        (void)hipGetLastError();
        grid = cus;
        if (grid < 256) { fprintf(stderr, "kernel_launch: built for >= 256 CUs, got %d\n", grid); }
        if (grid > 256) grid = 256;
    }
    if (grid < 0) return;
    if (hipMemsetAsync((char*)d_ws + WS_CTL, 0, CTL_ZERO_BYTES, stream) != hipSuccess) { fprintf(stderr, "kernel_launch: memset failed\n"); return; }
    Args a{};
    for (int i = 0; i < 22; ++i) a.in[i] = d_in[i];
    a.out = (float*)d_out; a.ws = (unsigned char*)d_ws;
#if MK_PER_PHASE
    for (int p = 0; p < NPHASE; ++p) { a.ph_lo = p; a.ph_hi = p + 1; hipLaunchKernelGGL(fwd_kernel, dim3(grid), dim3(512), LDS_BYTES, stream, a); }
#else
    a.ph_lo = 0; a.ph_hi = NPHASE;
    hipLaunchKernelGGL(fwd_kernel, dim3(grid), dim3(512), LDS_BYTES, stream, a);
#endif
    const hipError_t le = hipPeekAtLastError();
    if (le != hipSuccess) fprintf(stderr, "kernel_launch: launch failed: %s\n", hipGetErrorName(le));
}
```

```cpp
#include <hip/hip_runtime.h>
#include <cstdio>
#include <cstdint>

#ifndef MK_PER_PHASE
#define MK_PER_PHASE 0
#endif

#define GAS __attribute__((address_space(1)))
#define LAS __attribute__((address_space(3)))
typedef unsigned short bf16;
typedef short bf16x8 __attribute__((ext_vector_type(8)));
typedef float f32x4 __attribute__((ext_vector_type(4)));
typedef float f32x2 __attribute__((ext_vector_type(2)));
typedef unsigned u32x4 __attribute__((ext_vector_type(4)));
typedef unsigned u32x2 __attribute__((ext_vector_type(2)));

constexpr int BATCH = 8, SEQ = 4096, DM = 1024, T = BATCH * SEQ;
constexpr int NQKV = 9216;
constexpr int NZX = 5120, SSM_PITCH = 5152, DI = 2048;
constexpr int NE = 32;
constexpr float LN_EPS = 1e-5f, RMS_EPS = 1e-5f, ALPHA = 1.41421356237309505f;
constexpr float QSCALE = 0.12751743082459868f;
constexpr float LN2F = 0.6931471805599453f;

constexpr size_t MiB = 1u << 20;
constexpr size_t WS_CTL = 0, CTL_ZERO_BYTES = 128 * 1024;
constexpr size_t WS_ROPE = 1 * MiB;
constexpr size_t WS_GATES = 5 * MiB;
constexpr size_t WS_DT = 6 * MiB;
constexpr size_t WS_LIST = 10 * MiB;
constexpr size_t WS_LSE = 14 * MiB;
constexpr size_t WS_WQKV = 18 * MiB;
constexpr size_t WS_WAO = 36 * MiB;
constexpr size_t WS_WSI = 38 * MiB;
constexpr size_t WS_WSO = 48 * MiB;
constexpr size_t WS_WUP = 52 * MiB;
constexpr size_t WS_XQ = 180 * MiB;
constexpr size_t WS_XQ0 = 212 * MiB;
constexpr size_t WS_WDN = 308 * MiB;
constexpr size_t WS_XBA = 436 * MiB;
constexpr size_t WS_XBB = 500 * MiB;
constexpr size_t WS_X1 = 564 * MiB;
constexpr size_t WS_BIG = 692 * MiB;
constexpr size_t WS_XA = 1012 * MiB;
constexpr size_t WS_CBG = 1204 * MiB;
constexpr size_t WS_HB = WS_BIG;
constexpr size_t WS_YS = 964 * MiB;
constexpr size_t WS_OG = 1268 * MiB;
constexpr size_t WS_OB = 1460 * MiB;
constexpr size_t WS_END = 1524 * MiB;
constexpr int CW_BAR = 4096;
constexpr int CW_CNT = 16384;
constexpr int CW_CVT = 20000;
#ifndef CVT_Q_UP
#define CVT_Q_UP 5
#endif
#ifndef CVT_Q_DN
#define CVT_Q_DN 5
#endif

constexpr int LDS_AUX = 131072;
constexpr int LDS_TAB = 131072 + 17 * 512;
constexpr int LDS_SLOT = LDS_TAB + 2688;
constexpr int LDS_SM = 147456;
constexpr int LDS_MISC = 155648;
constexpr int LDS_BYTES = 156672;

__device__ __forceinline__ float bf2f(unsigned short b) { return __uint_as_float(((unsigned)b) << 16); }
__device__ __forceinline__ float bflo(unsigned w) { return __uint_as_float(w << 16); }
__device__ __forceinline__ float bfhi(unsigned w) { return __uint_as_float(w & 0xffff0000u); }
typedef __bf16 bf16x2_t __attribute__((ext_vector_type(2)));
constexpr float Q8_X = 8.0f, Q8_W = 256.0f, Q8_H = 8.0f, Q8_O = 32.0f, Q8_Y = 32.0f, Q8_Q = 64.0f, Q8_K = 8.0f, Q8_V = 8.0f, Q8_YS = 16.0f;
__device__ __forceinline__ unsigned pk4_f8(float a, float b, float c, float d, float sc) {
    a = __builtin_fminf(__builtin_fmaxf(a * sc, -448.f), 448.f); b = __builtin_fminf(__builtin_fmaxf(b * sc, -448.f), 448.f);
    c = __builtin_fminf(__builtin_fmaxf(c * sc, -448.f), 448.f); d = __builtin_fminf(__builtin_fmaxf(d * sc, -448.f), 448.f);
    int p = __builtin_amdgcn_cvt_pk_fp8_f32(a, b, 0, false); p = __builtin_amdgcn_cvt_pk_fp8_f32(c, d, p, true); return (unsigned)p; }
__device__ __forceinline__ unsigned pk2(float lo, float hi) { const f32x2 v = {lo, hi}; const bf16x2_t b = __builtin_convertvector(v, bf16x2_t); return __builtin_bit_cast(unsigned, b); }
__device__ __forceinline__ float wave_sum(float v) {
#pragma unroll
    for (int o = 1; o < 64; o <<= 1) v += __shfl_xor(v, o);
    return v;
}
constexpr int P256 = 272, P512 = 528;
__device__ __forceinline__ int swz256(int row, int bc) { return row * P256 + bc; }
__device__ __forceinline__ int swz512(int row, int bc) { return row * P512 + bc; }
__device__ __forceinline__ bf16x8 as_bf16x8(u32x4 v) { return __builtin_bit_cast(bf16x8, v); }
__device__ __forceinline__ f32x4 mfma16(bf16x8 a, bf16x8 b, f32x4 c) { return __builtin_amdgcn_mfma_f32_16x16x32_bf16(a, b, c, 0, 0, 0); }
__device__ __forceinline__ void lds_barrier() { asm volatile("s_waitcnt lgkmcnt(0)" ::: "memory"); __builtin_amdgcn_s_barrier(); asm volatile("" ::: "memory"); }
__device__ __forceinline__ float silu_f(float v) { return v * __builtin_amdgcn_rcpf(1.0f + __expf(-v)); }

__device__ __forceinline__ u32x4 tr4x4(unsigned d0, unsigned d1, unsigned d2, unsigned d3) {
    const u32x2 e01 = __builtin_amdgcn_permlane16_swap(d0, d1, false, false), e23 = __builtin_amdgcn_permlane16_swap(d2, d3, false, false);
    const u32x2 s0 = __builtin_amdgcn_permlane32_swap(e01.x, e23.x, false, false), s1 = __builtin_amdgcn_permlane32_swap(e01.y, e23.y, false, false);
    return (u32x4){s0.x, s1.x, s0.y, s1.y};
}

#define XB_TMO      128
#define XB_XCNT(j)  (256  + 64 * (j))
#define XB_XSUB(j)  (1280 + 64 * (j))
#define XB_XGEN(j)  (2304 + 64 * (j))
#define XB_TOP      3328
#define XB_TOPGEN   3392
#define XCD_BAR_WORDS 3456
#define XB_SPIN_CAP (1u << 18)
__device__ __forceinline__ unsigned xb_ld(unsigned* p)              { return __hip_atomic_load(p, __ATOMIC_RELAXED, __HIP_MEMORY_SCOPE_AGENT); }
__device__ __forceinline__ unsigned xb_add(unsigned* p, unsigned v) { return __hip_atomic_fetch_add(p, v, __ATOMIC_RELAXED, __HIP_MEMORY_SCOPE_AGENT); }
__device__ __forceinline__ unsigned xb_xcc_id() { return (unsigned)__builtin_amdgcn_s_getreg((3 << 11) | 20) & 0xFu; }
#define XB_SPIN(cond, bar) do { unsigned _sp = 0; while (cond) { __builtin_amdgcn_s_sleep(1); \
    if ((++_sp & 255u) == 0u) { if (xb_ld(&(bar)[XB_TMO])) break; if (_sp > XB_SPIN_CAP) { atomicAdd(&(bar)[XB_TMO], 1u); break; } } } } while (0)
struct XcdBarrier { unsigned* bar; unsigned x; volatile LAS unsigned* st; };
__device__ __forceinline__ XcdBarrier xcd_barrier_post(unsigned* bar, volatile LAS unsigned* st) {
    XcdBarrier b; b.bar = bar; b.x = xb_xcc_id(); b.st = st;
    if (threadIdx.x == 0) (void)xb_add(&bar[XB_XCNT(b.x)], 1u);
    return b;
}
__device__ __forceinline__ void xcd_barrier_complete(unsigned* bar, unsigned x, unsigned& nloc, unsigned& nx) {
    const unsigned G = gridDim.x * gridDim.y * gridDim.z;
    unsigned sum, cnt, mine, sp = 0u;
    for (;;) {
        sum = 0u; cnt = 0u; mine = 0u;
#pragma unroll
        for (unsigned j = 0; j < 16; ++j) { const unsigned c = xb_ld(&bar[XB_XCNT(j)]); sum += c; cnt += (c > 0u) ? 1u : 0u; mine = (j == x) ? c : mine; }
        if (sum == G) break;
        __builtin_amdgcn_s_sleep(1);
        if ((++sp & 255u) == 0u) { if (xb_ld(&bar[XB_TMO])) break; if (sp > XB_SPIN_CAP) { atomicAdd(&bar[XB_TMO], 1u); break; } }
    }
    nloc = mine > 0u ? mine : 1u; nx = cnt > 0u ? cnt : 1u;
}
struct NoWork { __device__ __forceinline__ void operator()() const {} };
template <class F = NoWork>
__device__ __forceinline__ void xcd_barrier(const XcdBarrier& b, const F& f = F()) {
    asm volatile("s_waitcnt vmcnt(0)" ::: "memory");
    __syncthreads();
    if (threadIdx.x >= 64) f();
    if (threadIdx.x == 0) {
        unsigned* bar = b.bar;
        __builtin_amdgcn_s_waitcnt(0);
        unsigned nloc = b.st[0], nx = b.st[1];
        if (nloc == 0u) { xcd_barrier_complete(bar, b.x, nloc, nx); b.st[0] = nloc; b.st[1] = nx; }
        const unsigned old = xb_add(&bar[XB_XSUB(b.x)], 1u);
        const unsigned gen = old / nloc;
        if (old + 1u == (gen + 1u) * nloc) {
            __builtin_amdgcn_fence(__ATOMIC_RELEASE, "agent");
            asm volatile("s_waitcnt vmcnt(0)" ::: "memory");
            const unsigned og = xb_add(&bar[XB_TOP], 1u);
            const unsigned tg = og / nx;
            if (og + 1u == (tg + 1u) * nx) xb_add(&bar[XB_TOPGEN], 1u);
            else XB_SPIN(xb_ld(&bar[XB_TOPGEN]) == tg, bar);
            __builtin_amdgcn_fence(__ATOMIC_ACQUIRE, "agent");
            xb_add(&bar[XB_XGEN(b.x)], 1u);
            asm volatile("s_waitcnt vmcnt(0)" ::: "memory");
        } else {
            XB_SPIN(xb_ld(&bar[XB_XGEN(b.x)]) == gen, bar);
            __builtin_amdgcn_fence(__ATOMIC_ACQUIRE, "agent");
            asm volatile("s_waitcnt vmcnt(0)" ::: "memory");
        }
    }
    __syncthreads();
}

namespace pg8 {
constexpr int BM = 256, BK = 64, HALF = 128, HTB = HALF * BK * 2, STAGE_BYTES = 8 * HTB, NXCD = 8, WGM = 4;
__host__ __device__ __forceinline__ int lds_byte(int r, int c) { const int st = (r >> 4) * 2 + (c >> 5), rr = r & 15, cc = c & 31, ob = rr * 64 + cc * 2; return st * 1024 + (ob ^ (((ob >> 9) & 1) << 5)); }
__host__ __device__ __forceinline__ void stage_rc(int b, int& R, int& C) { const int st = b / 1024, sb = b % 1024, swz = sb ^ (((sb >> 9) & 1) << 5); R = (st >> 1) * 16 + swz / 64; C = (st & 1) * 32 + (swz % 64) / 2; }
__host__ __device__ __forceinline__ int perm32(int rho) { const int n = rho >> 4, i = rho & 15; return 8 * (i >> 2) + 4 * n + (i & 3); }

struct Unit { int pm, pn, e, r0, cnt, ord; };
typedef int i32x8_t __attribute__((ext_vector_type(8))); typedef int i32x4_t __attribute__((ext_vector_type(4)));
__device__ __forceinline__ u32x4 pair16(const u32x2 X, const u32x2 Y) {
    const u32x2 s0 = __builtin_amdgcn_permlane16_swap(X.x, Y.x, false, false), s1 = __builtin_amdgcn_permlane16_swap(X.y, Y.y, false, false);
    return (u32x4){s0.x, s1.x, s0.y, s1.y};
}
__device__ __forceinline__ i32x8_t cat8(const bf16x8& a, const bf16x8& b) { return __builtin_shufflevector(__builtin_bit_cast(i32x4_t, a), __builtin_bit_cast(i32x4_t, b), 0, 1, 2, 3, 4, 5, 6, 7); }

struct DenseOrder {
    static constexpr bool GATHER_A = false;
    const char* A; const char* Bt; int K, nM, nN, nwg, G, c;
    __device__ __forceinline__ void init(const void* A_, const void* Bt_, int M, int N, int K_, int G_, int c_) { A = (const char*)A_; Bt = (const char*)Bt_; K = K_; nM = M / BM; nN = N / BM; nwg = nM * nN; G = G_; c = c_; }
    __device__ __forceinline__ bool next(int i, Unit& u) const {
        const long L = (long)i * G + c; if (L >= nwg) return false;
        int wgid = (int)L; { const int q = nwg / NXCD, r = nwg % NXCD, xcd = wgid % NXCD, off = wgid / NXCD; wgid = (xcd < r ? xcd * (q + 1) : r * (q + 1) + (xcd - r) * q) + off; }
        const int nig = WGM * nN, gid = wgid / nig, fm = gid * WGM, gsz = (nM - fm) < WGM ? (nM - fm) : WGM;
        u.pm = fm + ((wgid % nig) % gsz); u.pn = (wgid % nig) / gsz; u.e = 0; u.r0 = 0; u.cnt = 0; u.ord = i; return true;
    }
    __device__ __forceinline__ const char* a_base(const Unit& u) const { return A + (size_t)u.pm * ((size_t)BM * K * 2); }
    __device__ __forceinline__ const char* b_base(const Unit& u) const { return Bt + (size_t)u.pn * ((size_t)BM * K * 2); }
    __device__ __forceinline__ void a_offs(const Unit&, unsigned (&v)[2][2]) const {
#pragma unroll
        for (int i = 0; i < 2; ++i) { int R, C; stage_rc((int)threadIdx.x * 16 + i * 8192, R, C);
#pragma unroll
            for (int h = 0; h < 2; ++h) v[h][i] = (unsigned)((h * HALF + R) * K + C) * 2u; }
    }
};
template <bool GATHER> struct MoeOrder {
    static constexpr bool GATHER_A = GATHER;
    const char* A; const char* Bt; int K, N, nN, G, c, NU; const LAS int* tab; const LAS unsigned short* toks;
    __device__ __forceinline__ bool next(int i, Unit& u) const {
        const int L = i * G + c; if (L >= NU) return false;
        const int rb = L / nN; u.pn = L - rb * nN; u.pm = rb;
        const int e = __builtin_amdgcn_readfirstlane(tab[128 + rb]); u.e = e;
        u.r0 = (rb - __builtin_amdgcn_readfirstlane(tab[e])) * 256; u.cnt = __builtin_amdgcn_readfirstlane(tab[64 + e]); u.ord = i; return true;
    }
    __device__ __forceinline__ const char* a_base(const Unit& u) const { return GATHER ? A : A + (size_t)u.pm * ((size_t)BM * K * 2); }
    __device__ __forceinline__ const char* b_base(const Unit& u) const { return Bt + ((size_t)u.e * N + (size_t)u.pn * BM) * ((size_t)K * 2); }
    __device__ __forceinline__ void a_offs(const Unit& u, unsigned (&v)[2][2]) const {
#pragma unroll
        for (int i = 0; i < 2; ++i) { int R, C; stage_rc((int)threadIdx.x * 16 + i * 8192, R, C);
#pragma unroll
            for (int h = 0; h < 2; ++h) {
                if (GATHER) { const unsigned tok = toks[u.ord * 256 + h * HALF + R]; v[h][i] = (tok * (unsigned)K + (unsigned)C) * 2u; }
                else v[h][i] = (unsigned)((h * HALF + R) * K + C) * 2u; } }
    }
};


struct HostNone { struct Regs {}; __device__ __forceinline__ void issue(int, Regs&, f32x4 (&)[2][2][4][2]) const {} __device__ __forceinline__ void finish(const Regs&, const f32x4 (&)[2][2][4][2]) const {} };
struct HostCvt {
    const float* w_up; const float* w_dn; unsigned char* wt_up; unsigned char* wt_dn;
    int base, limit, G, c;
    struct Regs { unsigned char* dst; bool active; };
    __device__ __forceinline__ void issue(int ord, Regs& R, f32x4 (&acc)[2][2][4][2]) const {
        const int w = __builtin_amdgcn_readfirstlane((int)threadIdx.x >> 6), lane = threadIdx.x & 63, kq = lane >> 4, nq = lane & 15;
        const int hi = __builtin_amdgcn_readfirstlane(base + (ord * G + c) * 8 + w);
        R.active = hi < limit; R.dst = nullptr;
        if (R.active) {
            const float* W; int pitch, k0, n0, drow; unsigned char* WT;
            if (hi < 32768) { const int mat = hi >> 10, q = hi & 1023, kb = q >> 5, nb = q & 31; n0 = nb * 64; k0 = kb * 32; pitch = 2048; W = w_up + (size_t)mat * 1024 * 2048; WT = wt_up + (size_t)mat * 2048 * 1024;
                drow = ((n0 & 1023) >> 7) * 256 + (n0 >> 10) * 128 + (n0 & 127); }
            else { const int r = hi - 32768, mat = r >> 9, q = r & 511, kb = q >> 4, nb = q & 15; n0 = nb * 64; k0 = kb * 32; pitch = 1024; W = w_dn + (size_t)mat * 1024 * 1024; WT = wt_dn + (size_t)mat * 1024 * 1024; drow = n0; }
            const char* src = (const char*)(W + (size_t)k0 * pitch + n0); const unsigned voff = (unsigned)(kq * pitch + 4 * nq) * 4u;
#pragma unroll
            for (int i = 0; i < 8; ++i) acc[0][0][i >> 1][i & 1] = __builtin_nontemporal_load((const f32x4*)(src + (size_t)(4 * i) * pitch * 4 + voff));
            R.dst = WT + (size_t)(drow + 4 * nq + kq) * 1024 + k0;
        }
    }
    __device__ __forceinline__ void finish(const Regs& R, const f32x4 (&acc)[2][2][4][2]) const {
        if (R.active) {
            const int lane = threadIdx.x & 63;
            const unsigned sel1 = (lane & 16) ? 0x07030501u : 0x06020400u, sel2 = (lane & 32) ? 0x07060302u : 0x05040100u;
            unsigned o[8];
#pragma unroll
            for (int i = 0; i < 8; ++i) { const f32x4 v = acc[0][0][i >> 1][i & 1]; const unsigned d = pk4_f8(v[0], v[1], v[2], v[3], Q8_W);
                const u32x2 s1 = __builtin_amdgcn_permlane16_swap(d, d, false, false);
                const unsigned t1 = __builtin_amdgcn_perm(s1.y, s1.x, sel1);
                const u32x2 s2 = __builtin_amdgcn_permlane32_swap(t1, t1, false, false);
                o[i] = __builtin_amdgcn_perm(s2.y, s2.x, sel2); }
            *(u32x4*)R.dst = (u32x4){o[0], o[1], o[2], o[3]}; *(u32x4*)(R.dst + 16) = (u32x4){o[4], o[5], o[6], o[7]};
        }
    }
};

template <bool F8 = false, class Epi, class Sched, class Host>
__device__ __forceinline__ void gemm_phase(LAS unsigned char* lds, const int K, const Sched& S, const Epi& E, const Host& H) {
    const int tid = threadIdx.x, wid = __builtin_amdgcn_readfirstlane(tid >> 6), lane = tid & 63, wr = wid >> 2, wc = wid & 3, fr = lane & 15, fq = lane >> 4;
    const int nt = K / BK;
    unsigned voffB[2];
#pragma unroll
    for (int i = 0; i < 2; ++i) { int R, C; stage_rc(tid * 16 + i * 8192, R, C); const int Rb = Epi::PERM ? ((R & ~31) + perm32(R & 31)) : R; voffB[i] = (unsigned)(Rb * K + C) * 2u; }
    const size_t kstep = (size_t)(BK * 2);
    const size_t hstep = (size_t)HALF * K * 2;
    const unsigned ldsw = (unsigned)wid * 1024u;
    const int aoff = lds_byte(wr * 64 + fr, fq * 8), boff = lds_byte(wc * 32 + fr, fq * 8);
#define PG8_SA(b, h) (((b) * 2 + (h)) * HTB)
#define PG8_SB(b, h) ((4 + (b) * 2 + (h)) * HTB)
#define PG8_STAGE(bufoff, gbase, voff) do { _Pragma("unroll") for (int _i = 0; _i < 2; ++_i) \
        __builtin_amdgcn_global_load_lds((const unsigned*)((const char*)(gbase) + (voff)[_i]), (LAS unsigned*)(lds + (bufoff) + ldsw + _i * 8192), 16, 0, 0); } while (0)
#define PG8_LDA(dst, b, h) do { _Pragma("unroll") for (int m = 0; m < 4; ++m) _Pragma("unroll") for (int k = 0; k < 2; ++k) dst[m][k] = *(const LAS bf16x8*)(lds + PG8_SA(b, h) + aoff + m * 2048 + k * 1024); } while (0)
#define PG8_LDB(dst, b, h) do { _Pragma("unroll") for (int n = 0; n < 2; ++n) _Pragma("unroll") for (int k = 0; k < 2; ++k) dst[n][k] = *(const LAS bf16x8*)(lds + PG8_SB(b, h) + boff + n * 2048 + k * 1024); } while (0)
#define PG8_MMA(ai, bj, At, Bt) do { __builtin_amdgcn_s_setprio(1); _Pragma("unroll") for (int m = 0; m < 4; ++m) _Pragma("unroll") for (int n = 0; n < 2; ++n) { \
        if constexpr (F8) { const i32x8_t b8_ = cat8(Bt[n][0], Bt[n][1]), a8_ = cat8(At[m][0], At[m][1]); asm volatile("v_mfma_f32_16x16x128_f8f6f4 %0, %1, %2, %0" : "+v"(acc[ai][bj][m][n]) : "v"(b8_), "v"(a8_)); } \
        else { _Pragma("unroll") for (int k = 0; k < 2; ++k) acc[ai][bj][m][n] = __builtin_amdgcn_mfma_f32_16x16x32_bf16(Bt[n][k], At[m][k], acc[ai][bj][m][n], 0, 0, 0); } } __builtin_amdgcn_s_setprio(0); } while (0)
#define PG8_WAIT_V(n) asm volatile("s_waitcnt vmcnt(" #n ")" ::: "memory")
#define PG8_WAIT_L(n) asm volatile("s_waitcnt lgkmcnt(" #n ")" ::: "memory")
#define PG8_BAR __builtin_amdgcn_s_barrier()
#define PG8_SCHED __builtin_amdgcn_sched_barrier(0)
    Unit cur, nxt; int ui = 0;
    if (!S.next(0, cur)) return;
    f32x4 acc[2][2][4][2];
#pragma unroll
    for (int a = 0; a < 2; ++a)
#pragma unroll
        for (int b = 0; b < 2; ++b)
#pragma unroll
            for (int m = 0; m < 4; ++m)
#pragma unroll
                for (int n = 0; n < 2; ++n) acc[a][b][m][n] = (f32x4){0.f, 0.f, 0.f, 0.f};
    bf16x8 At[4][2], B0[2][2], B1[2][2];
    constexpr bool GA = Sched::GATHER_A;
    unsigned vA[2][2], nvA[2][2];
    S.a_offs(cur, vA);
    const size_t ah = GA ? 0 : hstep;
#define PG8_VA1 (GA ? vA[1] : vA[0])
    const char* cA = S.a_base(cur); const char* cB = S.b_base(cur);
    PG8_STAGE(PG8_SB(0, 0), cB, voffB); PG8_STAGE(PG8_SB(0, 1), cB + hstep, voffB); PG8_STAGE(PG8_SA(0, 0), cA, vA[0]); PG8_STAGE(PG8_SA(0, 1), cA + ah, PG8_VA1);
    if (wr == 1) PG8_BAR;
    PG8_WAIT_V(2); PG8_BAR;
    PG8_STAGE(PG8_SB(1, 0), cB + kstep, voffB); PG8_STAGE(PG8_SA(1, 0), cA + kstep, vA[0]); PG8_STAGE(PG8_SB(1, 1), cB + hstep + kstep, voffB);
    PG8_WAIT_V(6); PG8_BAR;
    for (;;) {
        const bool has_next = S.next(ui + 1, nxt);
        const char* nA = cA; const char* nB = cB;
#pragma unroll
        for (int h = 0; h < 2; ++h)
#pragma unroll
            for (int i = 0; i < 2; ++i) nvA[h][i] = vA[h][i];
        if (has_next) { nA = S.a_base(nxt); nB = S.b_base(nxt); if constexpr (GA) S.a_offs(nxt, nvA); }
        constexpr int NGRP = Epi::RESCALE ? 4 : 1; const int tper = nt / NGRP;
        for (int gq = 0; gq < NGRP; ++gq) {
        if constexpr (Epi::RESCALE) { if (gq > 0) { if constexpr (F8) asm volatile("s_nop 15\n\ts_nop 15" ::: "memory"); E.rescale(acc, cur, gq, wr, fr); } }
#pragma unroll 1
        for (int t = gq * tper; t < (gq + 1) * tper; t += 2) {
            const bool last = (t == nt - 2);
            const char* a1 = cA + (size_t)(t + 1) * kstep;
            const char* a2 = last ? nA : cA + (size_t)(t + 2) * kstep; const char* b2 = last ? nB : cB + (size_t)(t + 2) * kstep;
            const char* a3 = a2 + kstep; const char* b3 = b2 + kstep;
            unsigned w0[2], w1[2];
#pragma unroll
            for (int i = 0; i < 2; ++i) { if constexpr (GA) { w0[i] = last ? nvA[0][i] : vA[0][i]; w1[i] = last ? nvA[1][i] : vA[1][i]; } else { w0[i] = vA[0][i]; w1[i] = vA[0][i]; } }
            PG8_LDB(B0, 0, 0); PG8_LDB(B1, 0, 1); PG8_SCHED; PG8_LDA(At, 0, 0); PG8_STAGE(PG8_SA(1, 1), a1 + ah, PG8_VA1);
            PG8_WAIT_V(8); PG8_WAIT_L(0); PG8_BAR; PG8_MMA(0, 0, At, B0); PG8_MMA(0, 1, At, B1); PG8_BAR; PG8_SCHED;
            PG8_LDA(At, 0, 1); PG8_STAGE(PG8_SB(0, 0), b2, voffB); PG8_STAGE(PG8_SB(0, 1), b2 + hstep, voffB); PG8_STAGE(PG8_SA(0, 0), a2, w0);
            PG8_WAIT_V(8); PG8_WAIT_L(0); PG8_BAR; PG8_MMA(1, 0, At, B0); PG8_MMA(1, 1, At, B1); PG8_BAR; PG8_SCHED;
            PG8_LDB(B0, 1, 0); PG8_LDB(B1, 1, 1); PG8_SCHED; PG8_LDA(At, 1, 0); PG8_STAGE(PG8_SA(0, 1), a2 + ah, w1);
            PG8_WAIT_V(8); PG8_WAIT_L(0); PG8_BAR; PG8_MMA(0, 0, At, B0); PG8_MMA(0, 1, At, B1); PG8_BAR; PG8_SCHED;
            PG8_LDA(At, 1, 1); PG8_STAGE(PG8_SB(1, 0), b3, voffB); PG8_STAGE(PG8_SB(1, 1), b3 + hstep, voffB); PG8_STAGE(PG8_SA(1, 0), a3, w0);
            PG8_WAIT_V(8); PG8_WAIT_L(0); PG8_BAR; PG8_MMA(1, 0, At, B0); PG8_MMA(1, 1, At, B1); PG8_BAR; PG8_SCHED;
        }
        }
        if (wr == 0) PG8_BAR;
        if constexpr (F8) asm volatile("s_nop 15\n\ts_nop 15" ::: "memory");
        E(acc, cur, wr, wc, fr, fq, 0);
        __builtin_amdgcn_sched_barrier(0); asm volatile("" ::: "memory");
        typename Host::Regs hr; H.issue(cur.ord, hr, acc);
        __builtin_amdgcn_sched_barrier(0); asm volatile("" ::: "memory");
        E(acc, cur, wr, wc, fr, fq, 1);
        __builtin_amdgcn_sched_barrier(0);
        H.finish(hr, acc);
        if (!has_next) break;
#pragma unroll
        for (int a = 0; a < 2; ++a)
#pragma unroll
            for (int b = 0; b < 2; ++b)
#pragma unroll
                for (int m = 0; m < 4; ++m)
#pragma unroll
                    for (int n = 0; n < 2; ++n) acc[a][b][m][n] = (f32x4){0.f, 0.f, 0.f, 0.f};
        cur = nxt; cA = nA; cB = nB; ++ui;
#pragma unroll
        for (int h = 0; h < 2; ++h)
#pragma unroll
            for (int i = 0; i < 2; ++i) vA[h][i] = nvA[h][i];
        if (wr == 1) PG8_BAR;
    }
    PG8_WAIT_V(0);
    PG8_BAR;
#undef PG8_VA1
#undef PG8_SA
#undef PG8_SB
#undef PG8_STAGE
#undef PG8_LDA
#undef PG8_LDB
#undef PG8_MMA
#undef PG8_WAIT_V
#undef PG8_WAIT_L
#undef PG8_BAR
#undef PG8_SCHED
}

struct EpiF32 {
    static constexpr bool PERM = false; static constexpr bool RESCALE = false;
    float* C; int ldc;
    __device__ __forceinline__ void operator()(const f32x4 (&acc)[2][2][4][2], const Unit& u, int wr, int wc, int fr, int fq, const int ai) const {
        const int row0 = u.pm * BM + wr * 64 + fr, col0 = u.pn * BM + wc * 32 + 4 * fq;

#pragma unroll
            for (int m = 0; m < 4; ++m) { float* rowp = C + (size_t)(row0 + ai * HALF + m * 16) * ldc + col0;
#pragma unroll
                for (int bj = 0; bj < 2; ++bj)
#pragma unroll
                    for (int n = 0; n < 2; ++n) *(f32x4*)(rowp + bj * HALF + n * 16) = acc[ai][bj][m][n]; }
    }
};
struct EpiBf16 {
    static constexpr bool PERM = true; static constexpr bool RESCALE = false;
    bf16* O; int ldc; float sc;
    __device__ __forceinline__ void operator()(const f32x4 (&acc)[2][2][4][2], const Unit& u, int wr, int wc, int fr, int fq, const int ai) const {
        const int row0 = u.pm * BM + wr * 64 + fr, col0 = u.pn * BM + wc * 32 + 8 * fq;

#pragma unroll
            for (int m = 0; m < 4; ++m) { bf16* rowp = O + (size_t)(row0 + ai * HALF + m * 16) * ldc + col0;
#pragma unroll
                for (int bj = 0; bj < 2; ++bj) { const f32x4 v0 = acc[ai][bj][m][0] * sc, v1 = acc[ai][bj][m][1] * sc;
                    u32x4 w; w.x = pk2(v0[0], v0[1]); w.y = pk2(v0[2], v0[3]); w.z = pk2(v1[0], v1[1]); w.w = pk2(v1[2], v1[3]);
                    __builtin_nontemporal_store(w, (u32x4*)(rowp + bj * HALF)); } }
    }
};
struct EpiRms {
    static constexpr bool PERM = true; static constexpr bool RESCALE = true;
    bf16* O; int ldc; const LAS float* stab;
    __device__ __forceinline__ void rescale(f32x4 (&acc)[2][2][4][2], const Unit& u, int g, int wr, int fr) const {
        const LAS float* tb = stab + (u.ord * 256 + wr * 64 + fr) * 4 + g;
#pragma unroll
        for (int ai = 0; ai < 2; ++ai)
#pragma unroll
            for (int m = 0; m < 4; ++m) { const LAS float* p = tb + (ai * HALF + m * 16) * 4; const float ratio = p[-1] * __builtin_amdgcn_rcpf(p[0]);
#pragma unroll
                for (int bj = 0; bj < 2; ++bj)
#pragma unroll
                    for (int n = 0; n < 2; ++n) acc[ai][bj][m][n] = acc[ai][bj][m][n] * ratio; }
    }
    __device__ __forceinline__ void operator()(const f32x4 (&acc)[2][2][4][2], const Unit& u, int wr, int wc, int fr, int fq, const int ai) const {
        const int row0 = u.pm * BM + wr * 64 + fr, col0 = u.pn * BM + wc * 32 + 8 * fq;
        const LAS float* tb = stab + (u.ord * 256 + wr * 64 + fr) * 4 + 3;

#pragma unroll
            for (int m = 0; m < 4; ++m) { const int row = row0 + ai * HALF + m * 16; const float s3 = tb[(ai * HALF + m * 16) * 4] * (1.0f / (Q8_YS * Q8_W)); bf16* rowp = (bf16*)((char*)O + (unsigned)((row * ldc + col0) * 2));
#pragma unroll
                for (int bj = 0; bj < 2; ++bj) { const f32x4 v0 = acc[ai][bj][m][0] * s3, v1 = acc[ai][bj][m][1] * s3;
                    u32x4 w; w.x = pk2(v0[0], v0[1]); w.y = pk2(v0[2], v0[3]); w.z = pk2(v1[0], v1[1]); w.w = pk2(v1[2], v1[3]);
                    __builtin_nontemporal_store(w, (u32x4*)(rowp + bj * HALF)); } }
    }
};
struct EpiQKV {
    static constexpr bool PERM = true; static constexpr bool RESCALE = false;
    unsigned char* O; const float* rope; float ds;
    __device__ __forceinline__ void operator()(const f32x4 (&acc)[2][2][4][2], const Unit& u, int wr, int wc, int fr, int fq, const int ai) const {
        const int row0 = u.pm * BM + wr * 64 + fr;
        const int col_t = u.pn * BM;
        const int s = (col_t % 3072) >> 10;
        const float sc = ((s == 0) ? QSCALE * Q8_Q : ((s == 1) ? Q8_K : Q8_V)) * ds;
        const int gq = col_t / 3072, lg = 2 * gq, dlm = (1 << lg) - 1, mat0 = gq * 24 + s * 8 + ((col_t & 1023) >> 7);
        const bool rot = (s < 2) && (fq == 0);
        {
#pragma unroll
            for (int mp = 0; mp < 2; ++mp) {
                u32x2 wv[2][2];
#pragma unroll
                for (int r = 0; r < 2; ++r) { const int m = 2 * mp + r; const int row = row0 + ai * HALF + m * 16;
                    f32x4 cs = (f32x4){1.f, 1.f, 1.f, 1.f}, sn = (f32x4){0.f, 0.f, 0.f, 0.f};
                    if (rot) { const float* rp = rope + (size_t)row * 32 + 4 * wc; cs = *(const f32x4*)rp; sn = *(const f32x4*)(rp + 16); }
#pragma unroll
                    for (int bj = 0; bj < 2; ++bj) {
                        f32x4 v0 = acc[ai][bj][m][0], v1 = acc[ai][bj][m][1];
                        if (rot) { const f32x4 a0 = v0 * cs - v1 * sn, a1 = v1 * cs + v0 * sn; v0 = a0; v1 = a1; }
                        wv[r][bj].x = pk4_f8(v0[0], v0[1], v0[2], v0[3], sc); wv[r][bj].y = pk4_f8(v1[0], v1[1], v1[2], v1[3], sc); } }
                const int row = row0 + ai * HALF + (2 * mp + (fq & 1)) * 16;
                const int tt = row & (SEQ - 1), rowp = (row & ~(SEQ - 1)) + ((tt & (dlm)) << (12 - lg)) + (tt >> lg);
#pragma unroll
                for (int bj = 0; bj < 2; ++bj)
                    *(u32x4*)(O + ((size_t)(mat0 + bj) * T + rowp) * 128 + wc * 32 + 8 * (fq & ~1)) = pair16(wv[0][bj], wv[1][bj]);
            }
        }
    }
};
struct EpiUp {
    static constexpr bool PERM = true; static constexpr bool RESCALE = false;
    unsigned char* HB; const LAS unsigned* btab;
    __device__ __forceinline__ void operator()(const f32x4 (&acc)[2][2][4][2], const Unit& u, int wr, int wc, int fr, int fq, const int ai) const {
        const int row0 = u.pm * BM + wr * 64 + fr, col0 = u.pn * HALF + wc * 32 + 8 * fq;
        const LAS unsigned* bp = btab + u.ord * 128 + (wc * 32 + 8 * fq) / 2;
        const u32x4 gw = *(const LAS u32x4*)bp, uw = *(const LAS u32x4*)(bp + 64);
        f32x2 bg[4], bu[4];
#pragma unroll
        for (int i = 0; i < 4; ++i) { bg[i] = (f32x2){bflo(gw[i]), bfhi(gw[i])}; bu[i] = (f32x2){bflo(uw[i]), bfhi(uw[i])}; }
        constexpr float DS = 1.0f / (Q8_X * Q8_W), KE = -1.702f * 1.4426950408889634f;

            u32x2 wv[4];
#pragma unroll
            for (int m = 0; m < 4; ++m) {
                f32x2 o[4];
#pragma unroll
                for (int i = 0; i < 4; ++i) { const int n = i >> 1, j = 2 * (i & 1);
                    f32x2 gt = (f32x2){acc[ai][0][m][n][j], acc[ai][0][m][n][j + 1]} * DS + bg[i];
                    f32x2 up = (f32x2){acc[ai][1][m][n][j], acc[ai][1][m][n][j + 1]} * DS + bu[i];
                    gt[0] = fminf(gt[0], 7.0f); gt[1] = fminf(gt[1], 7.0f);
                    up[0] = __builtin_amdgcn_fmed3f(up[0], -7.0f, 7.0f); up[1] = __builtin_amdgcn_fmed3f(up[1], -7.0f, 7.0f);
                    f32x2 e = gt * KE; e[0] = __builtin_amdgcn_exp2f(e[0]); e[1] = __builtin_amdgcn_exp2f(e[1]);
                    e = e + 1.0f; e[0] = __builtin_amdgcn_rcpf(e[0]); e[1] = __builtin_amdgcn_rcpf(e[1]);
                    o[i] = (up * Q8_H + Q8_H) * (gt * e); }
                { int p0 = __builtin_amdgcn_cvt_pk_fp8_f32(o[0][0], o[0][1], 0, false); p0 = __builtin_amdgcn_cvt_pk_fp8_f32(o[1][0], o[1][1], p0, true);
                  int p1 = __builtin_amdgcn_cvt_pk_fp8_f32(o[2][0], o[2][1], 0, false); p1 = __builtin_amdgcn_cvt_pk_fp8_f32(o[3][0], o[3][1], p1, true); wv[m].x = (unsigned)p0; wv[m].y = (unsigned)p1; }
            }
#pragma unroll
            for (int mp = 0; mp < 2; ++mp)
                *(u32x4*)(HB + (size_t)(row0 + ai * HALF + (2 * mp + (fq & 1)) * 16) * 1024 + (col0 - 8 * (fq & 1))) = pair16(wv[2 * mp], wv[2 * mp + 1]);
    }
};
struct EpiDown {
    static constexpr bool PERM = true; static constexpr bool RESCALE = false;
    unsigned char* YS; const LAS unsigned* btab; const LAS int* slots;
    __device__ __forceinline__ void operator()(const f32x4 (&acc)[2][2][4][2], const Unit& u, int wr, int wc, int fr, int fq, const int ai) const {
        const int col0 = u.pn * BM + wc * 32 + 8 * fq;
        const LAS unsigned* bp = btab + u.ord * 128 + (wc * 32 + 8 * fq) / 2;
        f32x4 bv[2][2];
#pragma unroll
        for (int bj = 0; bj < 2; ++bj) { const u32x4 bw = *(const LAS u32x4*)(bp + bj * 64);
            bv[bj][0] = (f32x4){bflo(bw.x), bfhi(bw.x), bflo(bw.y), bfhi(bw.y)}; bv[bj][1] = (f32x4){bflo(bw.z), bfhi(bw.z), bflo(bw.w), bfhi(bw.w)}; }

#pragma unroll
            for (int mp = 0; mp < 2; ++mp) {
                const int slot = slots[u.ord * 256 + ai * HALF + wr * 64 + (2 * mp + (fq & 1)) * 16 + fr];
#pragma unroll
                for (int bj = 0; bj < 2; ++bj) { u32x2 wv[2];
#pragma unroll
                    for (int r = 0; r < 2; ++r) { const int m = 2 * mp + r; const f32x4 v0 = acc[ai][bj][m][0] * (1.0f / (Q8_H * Q8_W)) + bv[bj][0], v1 = acc[ai][bj][m][1] * (1.0f / (Q8_H * Q8_W)) + bv[bj][1];
                        wv[r].x = pk4_f8(v0[0], v0[1], v0[2], v0[3], Q8_Y); wv[r].y = pk4_f8(v1[0], v1[1], v1[2], v1[3], Q8_Y); }
                    const u32x4 d = pair16(wv[0], wv[1]);
                    if (slot >= 0) *(u32x4*)(YS + (size_t)slot * 1024 + (col0 - 8 * (fq & 1)) + bj * HALF) = d; }
            }
    }
};
}

struct TrItem { const float* W; const float* kscale; bf16* WT; int pitch, K, k0, n0, dstrow0, q8, hperm; };
__device__ __forceinline__ void tr_load(const TrItem& d, f32x4 (&ld)[16], int lane) {
    const int kq = lane >> 4, nq = lane & 15;
    const float* src = d.W + (size_t)(d.k0 + kq) * d.pitch + d.n0 + 4 * nq;
#pragma unroll
    for (int i = 0; i < 16; ++i) ld[i] = __builtin_nontemporal_load((const f32x4*)(src + (size_t)(4 * i) * d.pitch));
}
__device__ __forceinline__ void tr_finish(const TrItem& d, const f32x4 (&ld)[16], LAS float* scr, int lane) {
    const int kq = lane >> 4, nq = lane & 15;
#pragma unroll
    for (int i = 0; i < 16; ++i) { f32x4 v = ld[i]; if (d.kscale) v = v * d.kscale[d.k0 + 4 * i + kq]; LAS float* p = scr + (4 * i + kq) * 65 + 4 * nq; p[0] = v[0]; p[1] = v[1]; p[2] = v[2]; p[3] = v[3]; }
    asm volatile("s_waitcnt lgkmcnt(0)" ::: "memory");
    const int c = lane & 7;
    if (d.q8) {
#pragma unroll
        for (int j = 0; j < 8; ++j) { const int n = j * 8 + (lane >> 3); const LAS float* s = scr + (8 * c) * 65 + n;
            u32x2 o; o.x = pk4_f8(s[0 * 65], s[1 * 65], s[2 * 65], s[3 * 65], Q8_W); o.y = pk4_f8(s[4 * 65], s[5 * 65], s[6 * 65], s[7 * 65], Q8_W);
            int row = d.dstrow0 + n;
            if (d.hperm == 2) { const int ng = d.n0 + n; if (ng < 2048) { const int dd = ng & 63; row = (ng & ~63) + 16 * ((dd >> 2) & 3) + 4 * (dd >> 4) + (dd & 3); } }
            if (d.hperm == 1) { const int ng = d.n0 + n; if (((ng % 3072) >> 10) < 2) { const int dd = ng & 127;
                    const int pp = (dd < 32) ? (((dd & 15) >> 2) * 32 + (dd & 3) + 4 * (dd >> 4)) : (((dd - 32) / 24) * 32 + 8 + (dd - 32) % 24); row = (ng & ~127) + pp; } }
            *(u32x2*)((unsigned char*)d.WT + (size_t)row * d.K + d.k0 + 8 * c) = o; }
    } else {
#pragma unroll
    for (int j = 0; j < 8; ++j) { const int n = j * 8 + (lane >> 3); const LAS float* s = scr + (8 * c) * 65 + n;
        u32x4 o; o.x = pk2(s[0 * 65], s[1 * 65]); o.y = pk2(s[2 * 65], s[3 * 65]); o.z = pk2(s[4 * 65], s[5 * 65]); o.w = pk2(s[6 * 65], s[7 * 65]);
        *(u32x4*)(d.WT + (size_t)(d.dstrow0 + n) * d.K + d.k0 + 8 * c) = o; }
    }
    asm volatile("s_waitcnt lgkmcnt(0)" ::: "memory");
}
__constant__ float c_inv_freq[16] = {1.000000000e+00f, 4.403665960e-01f, 1.939227432e-01f, 8.539710194e-02f, 3.760603070e-02f, 1.656044088e-02f, 7.292664610e-03f, 3.211446106e-03f,
                                     1.414213562e-03f, 6.227724371e-04f, 2.742481884e-04f, 1.207697351e-04f, 5.318295734e-05f, 2.341999971e-05f, 1.031338525e-05f, 4.541670478e-06f};
__device__ __forceinline__ void sincos_reduced(float ang, float& sn, float& cs) {
    const double a = (double)ang;
    const double k = __builtin_rint(a * 0.15915494309189535);
    const double r = __builtin_fma(-k, 6.283185307179586, a) - k * 2.4492935982947064e-16;
    const float rf = (float)r;
    sn = __sinf(rf); cs = __cosf(rf);
}
struct Ptrs {
    const float *x; const int* pos; const float *attn_w_in, *attn_w_out, *ssm_w_in, *conv_w, *conv_b, *dt_bias, *a_log, *d_skip, *norm_w, *ssm_w_out;
    const float *w_router, *b_router, *w_up, *b_up, *w_dn, *b_dn, *ln_mix_g, *ln_mix_b, *ln_ffn_g, *ln_ffn_b;
};
constexpr int N1_UP = 32 * 16 * 32, N1_DN = 32 * 16 * 16, N1_ITEMS = N1_UP + N1_DN;
constexpr int HOSTED_ITEMS = 18432;
__device__ __forceinline__ TrItem moe1_item(const Ptrs& P, unsigned char* ws, int idx, int lay = 1) {
    TrItem d; d.kscale = nullptr; d.K = 1024; d.q8 = 1; d.hperm = 0;
    if (idx < N1_UP) { const int mat = 32 * lay + (idx >> 9), q = idx & 511, kb = q >> 5, nb = q & 31; const int n0 = nb * 64; const int bj = n0 >> 10, pn = (n0 & 1023) >> 7, cc = n0 & 127;
        d.W = P.w_up + (size_t)mat * 1024 * 2048; d.pitch = 2048; d.WT = (bf16*)(ws + WS_WUP + (size_t)mat * 2048 * 1024); d.k0 = kb * 64; d.n0 = n0; d.dstrow0 = pn * 256 + bj * 128 + cc; }
    else { const int r = idx - N1_UP, mat = 32 * lay + (r >> 8), q = r & 255, kb = q >> 4, nb = q & 15;
        d.W = P.w_dn + (size_t)mat * 1024 * 1024; d.pitch = 1024; d.WT = (bf16*)(ws + WS_WDN + (size_t)mat * 1024 * 1024); d.k0 = kb * 64; d.n0 = nb * 64; d.dstrow0 = nb * 64; }
    return d;
}
__device__ __forceinline__ void cvt_static(LAS unsigned char* lds, const Ptrs& P, unsigned char* ws, int first, int stride, int cnt) {
    const int lane = threadIdx.x & 63, w = __builtin_amdgcn_readfirstlane((int)threadIdx.x >> 6);
    LAS float* scr = (LAS float*)(lds + w * (65 * 64 * 4));
    if (cnt <= 0 || first >= N1_ITEMS) return;
    f32x4 la[16], lb[16]; TrItem da = moe1_item(P, ws, first), db = da; tr_load(da, la, lane);
    for (int i = 0;; i += 2) {
        const int ib = first + (i + 1) * stride; const bool hb = (i + 1 < cnt) && (ib < N1_ITEMS);
        if (hb) { db = moe1_item(P, ws, ib); tr_load(db, lb, lane); }
        tr_finish(da, la, scr, lane);
        if (!hb) break;
        const int ia = first + (i + 2) * stride; const bool ha = (i + 2 < cnt) && (ia < N1_ITEMS);
        if (ha) { da = moe1_item(P, ws, ia); tr_load(da, la, lane); }
        tr_finish(db, lb, scr, lane);
        if (!ha) break;
    }
}
__device__ __forceinline__ void cvt_plan(int NB, int G, int& rem_up, int& P_up, int& rem_dn, int& P_dn) {
    rem_up = (NB * 8) % G; const int n_iu = rem_up ? (G - rem_up) : 0; P_up = n_iu * 8 * CVT_Q_UP; if (P_up > N1_ITEMS) P_up = N1_ITEMS;
    rem_dn = (NB * 4) % G; const int n_id = rem_dn ? (G - rem_dn) : 0; P_dn = P_up + n_id * 8 * CVT_Q_DN; if (P_dn > N1_ITEMS) P_dn = N1_ITEMS;
}
__device__ __forceinline__ void p0_prologue(LAS unsigned char* lds, const Ptrs& P, unsigned char* ws, int G, int vcu) {
    const int tid = threadIdx.x, lane = tid & 63, w = __builtin_amdgcn_readfirstlane(tid >> 6);
    LAS float* scr = (LAS float*)(lds + w * (65 * 64 * 4));
    const int gw = vcu * 8 + w, NGW = G * 8;
    bf16* Wqkv = (bf16*)(ws + WS_WQKV); bf16* Wao = (bf16*)(ws + WS_WAO); bf16* Wsi = (bf16*)(ws + WS_WSI); bf16* Wso = (bf16*)(ws + WS_WSO);
    constexpr int I0 = 16 * 144, I1 = 16 * 16, I2 = 16 * 80, I3 = 32 * 16, I4 = 32 * 16 * 32, I5 = 32 * 16 * 16;
    constexpr int NITEMS = I0 + I1 + I2 + I3 + (N1_ITEMS - HOSTED_ITEMS);
    auto decode = [&](int it) -> TrItem {
        TrItem d; int r = it; d.kscale = nullptr; d.q8 = 0; d.hperm = 0;
        if (r < I0) { const int kb = r / 144, nb = r % 144; d.q8 = 1; d.hperm = 1; d.W = P.attn_w_in; d.pitch = NQKV; d.K = 1024; d.WT = Wqkv; d.k0 = kb * 64; d.n0 = nb * 64; d.dstrow0 = nb * 64; return d; } r -= I0;
        if (r < I1) { const int kb = r / 16, nb = r % 16; d.q8 = 1; d.W = P.attn_w_out; d.pitch = 1024; d.K = 1024; d.WT = Wao; d.k0 = kb * 64; d.n0 = nb * 64; d.dstrow0 = nb * 64; return d; } r -= I1;
        if (r < I2) { const int kb = r / 80, nb = r % 80; d.q8 = 1; d.hperm = 2; d.W = P.ssm_w_in; d.pitch = SSM_PITCH; d.K = 1024; d.WT = Wsi; d.k0 = kb * 64; d.n0 = nb * 64; d.dstrow0 = nb * 64; return d; } r -= I2;
        if (r < I3) { const int kb = r / 16, nb = r % 16; d.q8 = 1; d.W = P.ssm_w_out; d.pitch = 1024; d.K = 2048; d.kscale = P.norm_w; d.WT = Wso; d.k0 = kb * 64; d.n0 = nb * 64; d.dstrow0 = nb * 64; return d; } r -= I3;
        return moe1_item(P, ws, r + HOSTED_ITEMS, 0);
    };
    if (gw < NITEMS) {
        f32x4 la[16], lb[16];
        TrItem da = decode(gw), db = da; tr_load(da, la, lane);
        for (int it = gw; it < NITEMS; it += 2 * NGW) {
            const bool hb = it + NGW < NITEMS;
            if (hb) { db = decode(it + NGW); tr_load(db, lb, lane); }
            tr_finish(da, la, scr, lane);
            if (!hb) break;
            const bool ha = it + 2 * NGW < NITEMS;
            if (ha) { da = decode(it + 2 * NGW); tr_load(da, la, lane); }
            tr_finish(db, lb, scr, lane);
            if (!ha) break;
        }
    }
    bf16* XBA = (bf16*)(ws + WS_XBA);
    for (int m0 = gw * 4; m0 < T; m0 += NGW * 4) {
        f32x4 v[4][4];
#pragma unroll
        for (int rr = 0; rr < 4; ++rr) { const f32x4* xr = (const f32x4*)(P.x + (size_t)(m0 + rr) * DM) + lane;
#pragma unroll
            for (int j = 0; j < 4; ++j) v[rr][j] = xr[64 * j]; }
#pragma unroll
        for (int rr = 0; rr < 4; ++rr) { u32x2* o = (u32x2*)(XBA + (size_t)(m0 + rr) * DM) + lane;
#pragma unroll
            for (int j = 0; j < 4; ++j) {
                *(unsigned*)(ws + WS_XQ0 + (size_t)(m0 + rr) * DM + 4 * lane + 256 * j) = pk4_f8(v[rr][j][0], v[rr][j][1], v[rr][j][2], v[rr][j][3], Q8_X); } }
    }
    float* rope = (float*)(ws + WS_ROPE);
    for (int idx = (vcu * 512 + tid); idx < T * 16; idx += G * 512) {
        const int tok = idx >> 4, i = idx & 15;
        const float ang = (float)P.pos[tok] * c_inv_freq[i];
        float sn, cs; sincos_reduced(ang, sn, cs);
        rope[(size_t)tok * 32 + i] = cs; rope[(size_t)tok * 32 + 16 + i] = sn;
    }
}

constexpr size_t PKOFF = (size_t)8 * T * 128;
__device__ __forceinline__ void attn_phase(LAS unsigned char* lds, const unsigned char* __restrict__ PROJ, unsigned char* __restrict__ OG, float* __restrict__ LSE, const int G, const int vcu) {
    const int tid = threadIdx.x, lane0 = tid & 63, w = __builtin_amdgcn_readfirstlane(tid >> 6);
    LAS unsigned char* Ks = lds; LAS unsigned char* Vt = lds + 2 * 128 * P256;
    constexpr int NU = BATCH * 3 * 8 * 32;
    const int per = (NU + G - 1) / G;
    const int u0 = vcu * per, u1 = (u0 + per < NU) ? (u0 + per) : NU;
    if (u0 >= u1) return;
    u32x4 kreg[2], vreg[2]; u32x4 qn[2];
    constexpr int PK8 = 144;
    unsigned long long mA = 0ull, mB = 0ull;
    { const int r16 = lane0 & 15, q4 = lane0 >> 4;
#pragma unroll
        for (int kt = 0; kt < 9; ++kt)
#pragma unroll
            for (int jj = 0; jj < 4; ++jj) { const int jr = 16 * kt + 4 * q4 + jj; const bool va = (jr >= r16) & (jr <= r16 + 128); const bool vb = va & (jr + 16 * w >= 128);
                mA |= (unsigned long long)va << (4 * kt + jj); mB |= (unsigned long long)vb << (4 * kt + jj); } }
    int pc = 0;
#define ATT_DECODE(U) const int bgh = (U) >> 5, sub = (U) & 31, h = bgh & 7, bg = bgh >> 3, g = bg % 3, b = bg / 3; \
        const int lg = (g == 0) ? 0 : ((g == 1) ? 2 : 4), dl = 1 << lg, nblk = 32 >> lg, r = sub >> (5 - lg), blk = sub & (nblk - 1); \
        const unsigned char* base_r = PROJ + ((size_t)(g * 24 + h) * T + (size_t)b * SEQ + (size_t)r * (SEQ >> lg)) * 128;
#define ATT_W2(X) pk2(X[0], X[1])
#define ATT_K16(V, LO, HI) do { _Pragma("unroll") for (int i_ = 0; i_ < 4; ++i_) { const f32x2 a_ = __builtin_amdgcn_cvt_pk_f32_fp8((int)(V)[i_], false), b_ = __builtin_amdgcn_cvt_pk_f32_fp8((int)(V)[i_], true); \
        if (i_ < 2) { (LO)[2 * i_] = ATT_W2(a_); (LO)[2 * i_ + 1] = ATT_W2(b_); } else { (HI)[2 * i_ - 4] = ATT_W2(a_); (HI)[2 * i_ - 3] = ATT_W2(b_); } } } while (0)
#define ATT_VT(V0, V1, C, JP, HALFSEL) do { _Pragma("unroll") for (int i_ = 0; i_ < 4; ++i_) { \
        const f32x2 a0_ = __builtin_amdgcn_cvt_pk_f32_fp8((int)(V0)[i_], false), b0_ = __builtin_amdgcn_cvt_pk_f32_fp8((int)(V0)[i_], true), a1_ = __builtin_amdgcn_cvt_pk_f32_fp8((int)(V1)[i_], false), b1_ = __builtin_amdgcn_cvt_pk_f32_fp8((int)(V1)[i_], true); \
        *(LAS unsigned*)(Vt + swz512(16 * (C) + 4 * i_ + 0, 256 * (HALFSEL) + 4 * (JP))) = pk2(a0_[0], a1_[0]); *(LAS unsigned*)(Vt + swz512(16 * (C) + 4 * i_ + 1, 256 * (HALFSEL) + 4 * (JP))) = pk2(a0_[1], a1_[1]); \
        *(LAS unsigned*)(Vt + swz512(16 * (C) + 4 * i_ + 2, 256 * (HALFSEL) + 4 * (JP))) = pk2(b0_[0], b1_[0]); *(LAS unsigned*)(Vt + swz512(16 * (C) + 4 * i_ + 3, 256 * (HALFSEL) + 4 * (JP))) = pk2(b0_[1], b1_[1]); } } while (0)
    {
        ATT_DECODE(u0)
        const int lane = lane0;
        const int jpv = 16 * (w >> 1) + (lane & 15), cv = 4 * (w & 1) + (lane >> 4);
        if (blk > 0) {
#pragma unroll
            for (int it = 0; it < 2; ++it) { const int item = it * 512 + tid, j = item >> 3, c = item & 7; const int ts = (blk - 1) * 128 + j;
                *(LAS u32x4*)(Ks + j * PK8 + 16 * c) = *(const u32x4*)(base_r + (size_t)ts * 128 + PKOFF + 16 * c); }
            { const int ts = (blk - 1) * 128 + 2 * jpv;
                const u32x4 v0 = *(const u32x4*)(base_r + (size_t)ts * 128 + 2 * PKOFF + 16 * cv), v1 = *(const u32x4*)(base_r + (size_t)(ts + 1) * 128 + 2 * PKOFF + 16 * cv);
                ATT_VT(v0, v1, cv, jpv, 0); }
        }
#pragma unroll
        for (int it = 0; it < 2; ++it) { const int item = it * 512 + tid, j = item >> 3, c = item & 7; kreg[it] = *(const u32x4*)(base_r + (size_t)(blk * 128 + j) * 128 + PKOFF + 16 * c); }
        { const int ts = blk * 128 + 2 * jpv;
            vreg[0] = *(const u32x4*)(base_r + (size_t)ts * 128 + 2 * PKOFF + 16 * cv); vreg[1] = *(const u32x4*)(base_r + (size_t)(ts + 1) * 128 + 2 * PKOFF + 16 * cv); }
        const int tq = blk * 128 + 16 * w + (lane & 15);
#pragma unroll
        for (int kk = 0; kk < 2; ++kk) qn[kk] = *(const u32x4*)(base_r + (size_t)tq * 128 + 64 * kk + 16 * (lane >> 4));
    }
    for (int u = u0; u < u1; ++u) {
        int lane = lane0; asm volatile("" : "+v"(lane));
        const int r16 = lane & 15, q4 = lane >> 4;
        ATT_DECODE(u)
        const int pp = pc; pc ^= 1;
        if (blk == 0) {
#pragma unroll
            for (int it = 0; it < 4; ++it) { const int item = it * 512 + tid, dd = item >> 4, c = item & 15; *(LAS u32x4*)(Vt + swz512(dd, 256 * pp + 16 * c)) = (u32x4){0u, 0u, 0u, 0u}; }
        }
#pragma unroll
        for (int it = 0; it < 2; ++it) { const int item = it * 512 + tid, j = item >> 3, c = item & 7; *(LAS u32x4*)(Ks + pc * (128 * P256) + j * PK8 + 16 * c) = kreg[it]; }
        { const int jpv = 16 * (w >> 1) + (lane & 15), cv = 4 * (w & 1) + (lane >> 4); ATT_VT(vreg[0], vreg[1], cv, jpv, pc); }
        const pg8::i32x8_t qf = __builtin_shufflevector(__builtin_bit_cast(pg8::i32x4_t, qn[0]), __builtin_bit_cast(pg8::i32x4_t, qn[1]), 0, 1, 2, 3, 4, 5, 6, 7);
        lds_barrier();
        if (u + 1 < u1) {
            const int un = u + 1;
            const int bgh2 = un >> 5, sub2 = un & 31, h2 = bgh2 & 7, bg2 = bgh2 >> 3, g2 = bg2 % 3, b2 = bg2 / 3;
            const int lg2 = (g2 == 0) ? 0 : ((g2 == 1) ? 2 : 4), nblk2 = 32 >> lg2, r2 = sub2 >> (5 - lg2), blk2 = sub2 & (nblk2 - 1);
            const unsigned char* base2 = PROJ + ((size_t)(g2 * 24 + h2) * T + (size_t)b2 * SEQ + (size_t)r2 * (SEQ >> lg2)) * 128;
#pragma unroll
            for (int it = 0; it < 2; ++it) { const int item = it * 512 + tid, j = item >> 3, c = item & 7; kreg[it] = *(const u32x4*)(base2 + (size_t)(blk2 * 128 + j) * 128 + PKOFF + 16 * c); }
            { const int jpv = 16 * (w >> 1) + (lane & 15), cv = 4 * (w & 1) + (lane >> 4); const int ts = blk2 * 128 + 2 * jpv;
                vreg[0] = *(const u32x4*)(base2 + (size_t)ts * 128 + 2 * PKOFF + 16 * cv); vreg[1] = *(const u32x4*)(base2 + (size_t)(ts + 1) * 128 + 2 * PKOFF + 16 * cv); }
            const int tq2 = blk2 * 128 + 16 * w + r16;
#pragma unroll
            for (int kk = 0; kk < 2; ++kk) qn[kk] = *(const u32x4*)(base2 + (size_t)tq2 * 128 + 64 * kk + 16 * q4);
        }
        f32x4 s[9];
#pragma unroll
        for (int kt = 0; kt < 9; ++kt) {
            const int ka = w + kt; const int hoff = ((ka < 8) ? pp : pc) * (128 * P256); const int row = 16 * (ka & 7) + r16;
            const u32x4 k0 = *(const LAS u32x4*)(Ks + hoff + row * PK8 + 16 * q4), k1 = *(const LAS u32x4*)(Ks + hoff + row * PK8 + 64 + 16 * q4);
            const pg8::i32x8_t kf = __builtin_shufflevector(__builtin_bit_cast(pg8::i32x4_t, k0), __builtin_bit_cast(pg8::i32x4_t, k1), 0, 1, 2, 3, 4, 5, 6, 7);
            s[kt] = __builtin_amdgcn_mfma_scale_f32_16x16x128_f8f6f4(kf, qf, (f32x4){0.f, 0.f, 0.f, 0.f}, 0, 0, 0, 0, 0, 0); }
        float mx = -INFINITY;
        const unsigned long long mk = (blk > 0) ? mA : mB; const unsigned mlo = (unsigned)mk, mhi = (unsigned)(mk >> 32);
#pragma unroll
        for (int kt = 0; kt < 9; ++kt)
#pragma unroll
            for (int jj = 0; jj < 4; ++jj) { const int bit = 4 * kt + jj; const bool valid = bit < 32 ? ((mlo >> bit) & 1u) : ((mhi >> (bit - 32)) & 1u);
                s[kt][jj] = valid ? s[kt][jj] : -INFINITY; mx = fmaxf(mx, s[kt][jj]); }
        mx = fmaxf(mx, __shfl_xor(mx, 16)); mx = fmaxf(mx, __shfl_xor(mx, 32));
        float ls = 0.f;
#pragma unroll
        for (int kt = 0; kt < 9; ++kt)
#pragma unroll
            for (int jj = 0; jj < 4; ++jj) { const float p = __builtin_amdgcn_exp2f((s[kt][jj] - mx) * (1.0f / (Q8_Q * Q8_K))); s[kt][jj] = p; ls += p; }
        ls += __shfl_xor(ls, 16); ls += __shfl_xor(ls, 32);
        f32x4 o[8];
#pragma unroll
        for (int dt = 0; dt < 8; ++dt) o[dt] = (f32x4){0.f, 0.f, 0.f, 0.f};
#pragma unroll
        for (int kp = 0; kp < 5; ++kp) {
            u32x4 pw; pw.x = pk2(s[2 * kp][0], s[2 * kp][1]); pw.y = pk2(s[2 * kp][2], s[2 * kp][3]);
            if (kp < 4) { pw.z = pk2(s[2 * kp + 1][0], s[2 * kp + 1][1]); pw.w = pk2(s[2 * kp + 1][2], s[2 * kp + 1][3]); } else { pw.z = 0u; pw.w = 0u; }
            const bf16x8 pf = as_bf16x8(pw);
            const int ka0 = w + 2 * kp, ka1 = ka0 + 1;
            const int c0 = 256 * ((ka0 < 8) ? pp : pc) + 2 * (16 * (ka0 & 7) + 4 * q4), c1 = 256 * ((ka1 < 8) ? pp : pc) + 2 * (16 * (ka1 & 7) + 4 * q4);
#pragma unroll
            for (int dt = 0; dt < 8; ++dt) { const int dd = 16 * dt + r16;
                const u32x2 lo = *(const LAS u32x2*)(Vt + swz512(dd, c0));
                u32x2 hi = (u32x2){0u, 0u}; if (kp < 4) hi = *(const LAS u32x2*)(Vt + swz512(dd, c1));
                const u32x4 av = (u32x4){lo.x, lo.y, hi.x, hi.y};
                o[dt] = mfma16(as_bf16x8(av), pf, o[dt]); }
        }
        const float inv = Q8_O / (ls * Q8_V);
        const int tq = blk * 128 + 16 * w + r16;
        const size_t tokq = (size_t)b * SEQ + (size_t)tq * dl + r;
        unsigned char* op = OG + ((size_t)g * T + tokq) * DM + h * 128 + 16 * q4;
#pragma unroll
        for (int a4 = 0; a4 < 2; ++a4) { unsigned oq[4];
#pragma unroll
            for (int i = 0; i < 4; ++i) oq[i] = pk4_f8(o[4 * a4 + i][0], o[4 * a4 + i][1], o[4 * a4 + i][2], o[4 * a4 + i][3], inv);
            *(u32x4*)(op + 64 * a4) = tr4x4(oq[0], oq[1], oq[2], oq[3]); }
        if (q4 == 0) LSE[((size_t)g * T + tokq) * 8 + h] = (mx * (1.0f / (Q8_Q * Q8_K)) + __builtin_amdgcn_logf(ls)) * LN2F;
        lds_barrier();
    }
#undef ATT_DECODE
#undef ATT_W2
#undef ATT_K16
#undef ATT_VT
}

__device__ __forceinline__ void combine_phase(const unsigned char* __restrict__ OG, const float* __restrict__ LSE, unsigned char* __restrict__ OB, int G, int vcu) {
    const int tid = threadIdx.x, lane = tid & 63, w = tid >> 6;
    const int gw = vcu * 8 + w, NGW = G * 8;
    for (int row = gw; row < T; row += NGW) {
#pragma unroll
        for (int j = 0; j < 2; ++j) { const int col = 8 * lane + 512 * j, head = col >> 7;
            const float l0 = LSE[((size_t)0 * T + row) * 8 + head], l1 = LSE[((size_t)1 * T + row) * 8 + head], l2 = LSE[((size_t)2 * T + row) * 8 + head];
            const float m = fmaxf(l0, fmaxf(l1, l2)); float w0 = __expf(l0 - m), w1 = __expf(l1 - m), w2 = __expf(l2 - m); const float inv = 1.0f / (w0 + w1 + w2); w0 *= inv; w1 *= inv; w2 *= inv;
            const u32x2 a0 = *(const u32x2*)(OG + ((size_t)0 * T + row) * DM + col), a1 = *(const u32x2*)(OG + ((size_t)1 * T + row) * DM + col), a2 = *(const u32x2*)(OG + ((size_t)2 * T + row) * DM + col);
            float ov[8];
#pragma unroll
            for (int wd = 0; wd < 2; ++wd) {
                const f32x2 x0 = __builtin_amdgcn_cvt_pk_f32_fp8((int)a0[wd], false), x1 = __builtin_amdgcn_cvt_pk_f32_fp8((int)a1[wd], false), x2 = __builtin_amdgcn_cvt_pk_f32_fp8((int)a2[wd], false);
                const f32x2 y0 = __builtin_amdgcn_cvt_pk_f32_fp8((int)a0[wd], true), y1 = __builtin_amdgcn_cvt_pk_f32_fp8((int)a1[wd], true), y2 = __builtin_amdgcn_cvt_pk_f32_fp8((int)a2[wd], true);
                ov[4 * wd] = w0 * x0[0] + w1 * x1[0] + w2 * x2[0]; ov[4 * wd + 1] = w0 * x0[1] + w1 * x1[1] + w2 * x2[1]; ov[4 * wd + 2] = w0 * y0[0] + w1 * y1[0] + w2 * y2[0]; ov[4 * wd + 3] = w0 * y0[1] + w1 * y1[1] + w2 * y2[1]; }
            u32x2 o; o.x = pk4_f8(ov[0], ov[1], ov[2], ov[3], 1.0f); o.y = pk4_f8(ov[4], ov[5], ov[6], ov[7], 1.0f);
            *(u32x2*)(OB + (size_t)row * DM + col) = o; }
    }
}

__device__ __forceinline__ void ln_preload(LAS unsigned char* lds, const float* __restrict__ W32, int wpitch, int t0 = 0, int nthr = 512) {
    const int tid = (int)threadIdx.x - t0; LAS float* wl = (LAS float*)lds;
#pragma unroll 4
    for (int idx = tid; idx < 32768; idx += nthr) { const int k = idx >> 5, e = idx & 31; const int slot = (((k >> 8) * 4 + (k & 3)) * 64) + ((k >> 2) & 63);
        wl[slot * 36 + e] = W32[(size_t)k * wpitch + e]; }
}
template <int MIXSRC, int POST, bool WRITE_B, bool WRITE_F, bool XF32 = false>
__device__ __forceinline__ void ln_phase(LAS unsigned char* lds, const bf16* __restrict__ xres, const bf16* __restrict__ mixf, const unsigned char* __restrict__ YS, const float* __restrict__ gates_in,
                                         const float* __restrict__ gamma, const float* __restrict__ beta, float* outf, bf16* __restrict__ outb,
                                         const float* __restrict__ W32, int wpitch, const float* __restrict__ bias32, float* __restrict__ gates_out, int* __restrict__ lists, unsigned* counts, float* __restrict__ DTout,
                                         int G, int vcu, unsigned char* __restrict__ outq = nullptr) {
    const int tid = threadIdx.x, lane = tid & 63, w = __builtin_amdgcn_readfirstlane(tid >> 6);
    LAS float* wl = (LAS float*)lds;
    LAS int* sel_e = (LAS int*)(lds + LDS_SM); LAS int* sel_rk = sel_e + 512; LAS int* lcnt = sel_e + 1024; LAS int* gbase = sel_e + 1056;
    if (POST) {
        if (MK_PER_PHASE) ln_preload(lds, W32, wpitch);
        if (POST == 1 && tid < 32) lcnt[tid] = 0;
        __syncthreads();
    }
    int ebr = 0;
#pragma unroll
    for (int bb = 0; bb < 5; ++bb) ebr |= ((lane >> bb) & 1) << (4 - bb);
    float mybias = 0.f; if (POST) mybias = bias32[ebr];
    for (int chunk = vcu; chunk < T / 128; chunk += G) {
        u32x2 nxr[4], nmx[4]; f32x4 nxf[XF32 ? 4 : 1]; unsigned nys[4][4]; f32x4 ngv = (f32x4){0.f, 0.f, 0.f, 0.f};
        { const size_t row = (size_t)chunk * 128 + w * 16;
            if (MIXSRC == 1) ngv = *(const f32x4*)(gates_in + row * 4);
#pragma unroll
            for (int j = 0; j < 4; ++j) { if (XF32) nxf[XF32 ? j : 0] = *(const f32x4*)((const float*)xres + row * DM + 4 * lane + 256 * j); else nxr[j] = *(const u32x2*)(xres + row * DM + 4 * lane + 256 * j);
                if (MIXSRC == 0) nmx[j] = *(const u32x2*)(mixf + row * DM + 4 * lane + 256 * j);
                else {
#pragma unroll
                    for (int k = 0; k < 4; ++k) nys[j][k] = __builtin_nontemporal_load((const unsigned*)(YS + (row * 4 + k) * DM + 4 * lane + 256 * j)); } } }
        for (int pass = 0; pass < 16; ++pass) {
            const int rl = w * 16 + pass; const size_t row = (size_t)chunk * 128 + rl;
            asm volatile("" ::: "memory");
            int lo = lane; asm volatile("" : "+v"(lo));
            float xv[16];
            {
                f32x4 v[4]; float s = 0.f;
                const f32x4 gv = ngv * (MIXSRC == 1 ? 1.0f / Q8_Y : 1.0f);
#pragma unroll
                for (int j = 0; j < 4; ++j) {
                    f32x4 mix;
                    if (MIXSRC == 0) mix = (f32x4){bflo(nmx[j].x), bfhi(nmx[j].x), bflo(nmx[j].y), bfhi(nmx[j].y)};
                    else { mix = (f32x4){0.f, 0.f, 0.f, 0.f};
#pragma unroll
                        for (int k = 0; k < 4; ++k) { const f32x2 ylo = __builtin_amdgcn_cvt_pk_f32_fp8((int)nys[j][k], false), yhi = __builtin_amdgcn_cvt_pk_f32_fp8((int)nys[j][k], true);
                            mix[0] += gv[k] * ylo[0]; mix[1] += gv[k] * ylo[1]; mix[2] += gv[k] * yhi[0]; mix[3] += gv[k] * yhi[1]; } }
                    const f32x4 xr = XF32 ? nxf[XF32 ? j : 0] : (f32x4){bflo(nxr[j].x), bfhi(nxr[j].x), bflo(nxr[j].y), bfhi(nxr[j].y)};
                    v[j] = xr * ALPHA + mix; s += (v[j][0] + v[j][1]) + (v[j][2] + v[j][3]);
                }
                if (pass < 15) { const size_t nrow = row + 1;
                    if (MIXSRC == 1) ngv = *(const f32x4*)(gates_in + nrow * 4);
#pragma unroll
                    for (int j = 0; j < 4; ++j) { if (XF32) nxf[XF32 ? j : 0] = *(const f32x4*)((const float*)xres + nrow * DM + 4 * lo + 256 * j); else nxr[j] = *(const u32x2*)(xres + nrow * DM + 4 * lo + 256 * j);
                        if (MIXSRC == 0) nmx[j] = *(const u32x2*)(mixf + nrow * DM + 4 * lo + 256 * j);
                        else {
#pragma unroll
                            for (int k = 0; k < 4; ++k) nys[j][k] = __builtin_nontemporal_load((const unsigned*)(YS + (nrow * 4 + k) * DM + 4 * lo + 256 * j)); } } }
                const float mean = wave_sum(s) * (1.0f / DM); float s2 = 0.f;
#pragma unroll
                for (int j = 0; j < 4; ++j) { v[j] = v[j] - mean; s2 += (v[j][0] * v[j][0] + v[j][1] * v[j][1]) + (v[j][2] * v[j][2] + v[j][3] * v[j][3]); }
                const float rstd = 1.0f / sqrtf(wave_sum(s2) * (1.0f / DM) + LN_EPS);
#pragma unroll
                for (int j = 0; j < 4; ++j) { const f32x4 gm = *(const f32x4*)(gamma + 4 * lo + 256 * j), bt = *(const f32x4*)(beta + 4 * lo + 256 * j);
                    const f32x4 y = v[j] * rstd * gm + bt;
                    if (WRITE_F) __builtin_nontemporal_store(y, (f32x4*)(outf + row * DM + 4 * lo + 256 * j));
                    if (WRITE_B) { u32x2 q; q.x = pk2(y[0], y[1]); q.y = pk2(y[2], y[3]); *(u32x2*)(outb + row * DM + 4 * lo + 256 * j) = q; }
                    if (POST) *(unsigned*)(outq + row * DM + 4 * lo + 256 * j) = pk4_f8(y[0], y[1], y[2], y[3], Q8_X);
                    xv[4 * j + 0] = y[0]; xv[4 * j + 1] = y[1]; xv[4 * j + 2] = y[2]; xv[4 * j + 3] = y[3]; }
            }
            if (POST) {
                f32x2 acc2[16];
#pragma unroll
                for (int e = 0; e < 16; ++e) acc2[e] = (f32x2){0.f, 0.f};
#pragma unroll
                for (int jj = 0; jj < 16; ++jj) { const LAS float* wrow = wl + (jj * 64 + lane) * 36;
                    if ((jj & 1) == 0) asm volatile("" ::: "memory");
                    const f32x2 xx = (f32x2){xv[jj], xv[jj]};
#pragma unroll
                    for (int e4 = 0; e4 < 8; ++e4) { const f32x4 wv = *(const LAS f32x4*)(wrow + 4 * e4);
                        acc2[2 * e4] = acc2[2 * e4] + xx * (f32x2){wv[0], wv[1]}; acc2[2 * e4 + 1] = acc2[2 * e4 + 1] + xx * (f32x2){wv[2], wv[3]}; } }
                float acc0[32];
#pragma unroll
                for (int e = 0; e < 32; ++e) acc0[e] = acc2[e >> 1][e & 1];
#pragma unroll
                for (int bb = 0; bb < 5; ++bb) { const int hh = 16 >> bb; const unsigned um = ((lane >> bb) & 1) ? 0xffffffffu : 0u;
#pragma unroll
                    for (int i = 0; i < hh; ++i) { const unsigned l0 = __float_as_uint(acc0[i]), h0 = __float_as_uint(acc0[i + hh]);
                        const float k0 = __uint_as_float((h0 & um) | (l0 & ~um)), s0 = __uint_as_float((l0 & um) | (h0 & ~um)); acc0[i] = k0 + __shfl_xor(s0, 1 << bb); } }
                const float lg0 = acc0[0] + __shfl_xor(acc0[0], 32) + mybias;
                if (POST == 1) {
                    const unsigned ub = __float_as_uint(lg0); const unsigned uo = (ub & 0x80000000u) ? ~ub : (ub | 0x80000000u);
                    unsigned key = (uo & ~31u) | (unsigned)(31 - ebr);
                    float top0 = 0.f, myv = 0.f, esum = 0.f; int ek = 0;
#pragma unroll
                    for (int k = 0; k < 4; ++k) { unsigned bk = key;
#pragma unroll
                        for (int off = 1; off < 32; off <<= 1) { const unsigned ok = (unsigned)__shfl_xor((int)bk, off); bk = ok > bk ? ok : bk; }
                        const int be = 31 - (int)(__builtin_amdgcn_readfirstlane(bk) & 31u);
                        int wl_ = 0;
#pragma unroll
                        for (int bb = 0; bb < 5; ++bb) wl_ |= ((be >> bb) & 1) << (4 - bb);
                        const float bv = __uint_as_float(__builtin_amdgcn_readlane(__float_as_uint(lg0), wl_));
                        if (k == 0) top0 = bv;
                        const float ex = __expf(bv - top0); esum += ex;
                        myv = (lane == k) ? ex : myv; ek = (lane == k) ? be : ek; key = (ebr == be) ? 0u : key; }
                    if (lane < 4) {
                        gates_out[row * 4 + lane] = myv / esum;
                        const int rk = __hip_atomic_fetch_add(lcnt + ek, 1, __ATOMIC_RELAXED, __HIP_MEMORY_SCOPE_WORKGROUP);
                        sel_e[rl * 4 + lane] = ek; sel_rk[rl * 4 + lane] = rk; }
                } else {
                    if (lane < 32) { const float xx = lg0; const float y = __expf(-fabsf(xx)); const float l1p = (y < 1e-3f) ? (y - 0.5f * y * y) : __logf(1.0f + y);
                        DTout[row * 32 + ebr] = fmaxf(xx, 0.f) + l1p; }
                }
            }
        }
        if (POST == 1) {
            __syncthreads();
            if (tid < 32) gbase[tid] = (int)__hip_atomic_fetch_add(counts + tid, (unsigned)lcnt[tid], __ATOMIC_RELAXED, __HIP_MEMORY_SCOPE_AGENT);
            __syncthreads();
            { const int e = sel_e[tid]; lists[(size_t)e * 32768 + gbase[e] + sel_rk[tid]] = (chunk * 128 + (tid >> 2)) * 4 + (tid & 3); }
            __syncthreads();
            if (tid < 32) lcnt[tid] = 0;
            __syncthreads();
        }
    }
}

__device__ __forceinline__ void conv_item(const bf16* __restrict__ ZX, const float* __restrict__ conv_w, const float* __restrict__ conv_b, int tok0, int ch, u32x4 (&q)[8]) {
    const int sl = tok0 & (SEQ - 1);
    u32x4 raw[11];
#pragma unroll
    for (int i = 0; i < 11; ++i) { if (sl - 3 + i >= 0) raw[i] = *(const u32x4*)(ZX + (size_t)(tok0 - 3 + i) * NZX + 2048 + ch); else raw[i] = (u32x4){0u, 0u, 0u, 0u}; }
    f32x2 cw[4][4], cb[4];
#pragma unroll
    for (int k = 0; k < 4; ++k)
#pragma unroll
        for (int p = 0; p < 4; ++p) cw[k][p] = *(const f32x2*)(conv_w + (size_t)k * 3072 + ch + 2 * p);
#pragma unroll
    for (int p = 0; p < 4; ++p) cb[p] = *(const f32x2*)(conv_b + ch + 2 * p);
    f32x2 xin[11][4];
#pragma unroll
    for (int i = 0; i < 11; ++i)
#pragma unroll
        for (int p = 0; p < 4; ++p) xin[i][p] = (f32x2){bflo(raw[i][p]), bfhi(raw[i][p])};
#pragma unroll
    for (int t = 0; t < 8; ++t)
#pragma unroll
        for (int p = 0; p < 4; ++p) { f32x2 a = cb[p];
#pragma unroll
            for (int k = 0; k < 4; ++k) a = a + cw[k][p] * xin[t + k][p];
            q[t][p] = pk2(silu_f(a[0]), silu_f(a[1])); }
}
__device__ __forceinline__ void convcb_phase(LAS unsigned char* lds, const bf16* __restrict__ ZX, const float* __restrict__ conv_w, const float* __restrict__ conv_b, bf16* __restrict__ XA, bf16* __restrict__ CBG, int G, int vcu) {
    const int tid = threadIdx.x, lane = tid & 63, w = __builtin_amdgcn_readfirstlane(tid >> 6), r16 = lane & 15, q4 = lane >> 4;
    LAS unsigned char *Cs = lds, *Bs = lds + 128 * P256;
    for (int u = vcu; u < BATCH * 32; u += G) {
        const int tokc = u * 128;
        for (int it = 0; it < 8; ++it) { const int item = it * 512 + tid, cg = item & 255, tb = item >> 8;
            u32x4 q[8]; conv_item(ZX, conv_w, conv_b, tokc + 8 * tb, 8 * cg, q);
#pragma unroll
            for (int t = 0; t < 8; ++t) *(u32x4*)(XA + (size_t)(tokc + 8 * tb + t) * 3072 + 8 * cg) = q[t]; }
        for (int g = 0; g < 4; ++g) {
            { const int cgl = tid & 31, tb = tid >> 5; const int ch = (cgl < 16) ? (2048 + g * 128 + 8 * cgl) : (2560 + g * 128 + 8 * (cgl - 16));
                u32x4 q[8]; conv_item(ZX, conv_w, conv_b, tokc + 8 * tb, ch, q);
                LAS unsigned char* dst = (cgl < 16) ? Bs : Cs;
#pragma unroll
                for (int t = 0; t < 8; ++t) { *(u32x4*)(XA + (size_t)(tokc + 8 * tb + t) * 3072 + ch) = q[t]; *(LAS u32x4*)(dst + swz256(8 * tb + t, 16 * (cgl & 15))) = q[t]; } }
            __syncthreads();
            bf16x8 cf[4];
#pragma unroll
            for (int kk = 0; kk < 4; ++kk) cf[kk] = *(const LAS bf16x8*)(Cs + swz256(16 * w + r16, 64 * kk + 16 * q4));
            bf16* outp = CBG + ((size_t)u * 4 + g) * 16384 + (size_t)(16 * w + r16) * 128 + 32 * q4;
            u32x2 cq[8];
#pragma unroll
            for (int st = 0; st < 8; ++st) { f32x4 m = (f32x4){0.f, 0.f, 0.f, 0.f};
#pragma unroll
                for (int kk = 0; kk < 4; ++kk) { const bf16x8 a = *(const LAS bf16x8*)(Bs + swz256(16 * st + r16, 64 * kk + 16 * q4)); m = mfma16(a, cf[kk], m); }
                cq[st].x = pk2(m[0], m[1]); cq[st].y = pk2(m[2], m[3]); }
#pragma unroll
            for (int i = 0; i < 4; ++i) *(u32x4*)(outp + 8 * i) = (u32x4){cq[2 * i].x, cq[2 * i].y, cq[2 * i + 1].x, cq[2 * i + 1].y};
            __syncthreads();
        }
    }
}
__device__ __forceinline__ void ssd_phase(LAS unsigned char* lds, const bf16* __restrict__ ZX, const bf16* __restrict__ XA, const bf16* __restrict__ CBG, const float* __restrict__ DT,
                                          const float* __restrict__ a_log, const float* __restrict__ d_skip, unsigned char* __restrict__ Y, float* SSQ, int G, int vcu) {
    const int tid = threadIdx.x, lane = tid & 63, w = __builtin_amdgcn_readfirstlane(tid >> 6), r16_0 = lane & 15, q4_0 = lane >> 4;
    constexpr int SZ_BT = 128 * P256, SZ_XT = 64 * P256, O_XT = 2 * SZ_BT, O_PR = O_XT + 2 * SZ_XT, O_FA = O_PR + 2 * SZ_XT;
    LAS float* fa = (LAS float*)(lds + O_FA);
    for (int u = vcu; u < BATCH * 32; u += G) {
        const int b = u >> 5, h = u & 31, g = h >> 3;
        const float Ah = -__expf(a_log[h]); const float Dh = d_skip[h];
        f32x4 st[4];
#pragma unroll
        for (int pt = 0; pt < 4; ++pt) st[pt] = (f32x4){0.f, 0.f, 0.f, 0.f};
        const int jp = 16 * (w & 3) + (lane & 15);
        const unsigned voff = (unsigned)jp * 12288u + (unsigned)(lane >> 4) * 16u;
        int chb[3];
#pragma unroll
        for (int it = 0; it < 3; ++it) { const int gq = 2 * it + (w >> 2); chb[it] = 2 * ((it == 0) ? (h * 64 + 32 * gq) : (2048 + g * 128 + 32 * (gq - 2))); }
        const char* xab = (const char*)XA + (size_t)b * SEQ * 6144;
        const bf16* cbb = CBG + ((size_t)(b * 32) * 4 + g) * 16384;
        u32x4 pre[3][2]; float dn0 = 0.f, dn1 = 0.f; u32x2 cbr[8]; u32x4 cfr[4];
        {
#pragma unroll
            for (int it = 0; it < 3; ++it) { const char* sb = xab + chb[it]; pre[it][0] = *(const u32x4*)(sb + voff); pre[it][1] = *(const u32x4*)(sb + voff + 6144); }
            if (w == 0) { dn0 = DT[((size_t)b * SEQ + 2 * lane) * 32 + h]; dn1 = DT[((size_t)b * SEQ + 2 * lane + 1) * 32 + h]; }
        }
        for (int c = 0; c <= 32; ++c) {
            const int r16 = r16_0, q4 = q4_0;
            const int sb_ = c & 1;
            LAS unsigned char* BTn = lds + sb_ * SZ_BT; LAS unsigned char* xTn = lds + O_XT + sb_ * SZ_XT; LAS unsigned char* prn = lds + O_PR + sb_ * SZ_XT; LAS float* fan = fa + sb_ * 512;
            if (c >= 1) {
                const int cc = c - 1, cb_ = cc & 1; const int tok0 = b * SEQ + cc * 128;
                LAS unsigned char* BTs = lds + cb_ * SZ_BT; LAS unsigned char* xTs = lds + O_XT + cb_ * SZ_XT; LAS unsigned char* prevs = lds + O_PR + cb_ * SZ_XT;
                LAS float* acum = fa + cb_ * 512; LAS float* dtv = acum + 128; LAS float* wdec = acum + 256;
                const int l = 16 * w + r16;
                u32x2 zz[4];
#pragma unroll
                for (int i = 0; i < 2; ++i) { const u32x4 t4 = *(const u32x4*)(ZX + ((size_t)tok0 + l) * NZX + h * 64 + 16 * q4 + 8 * i); zz[2 * i] = (u32x2){t4.x, t4.y}; zz[2 * i + 1] = (u32x2){t4.z, t4.w}; }
                const float al = acum[l];
                bf16x8 pf[4];
#pragma unroll
                for (int kp = 0; kp < 4; ++kp) {
                    const f32x4 as0 = *(const LAS f32x4*)(acum + 32 * kp + 4 * q4), ds0 = *(const LAS f32x4*)(dtv + 32 * kp + 4 * q4), as1 = *(const LAS f32x4*)(acum + 32 * kp + 16 + 4 * q4), ds1 = *(const LAS f32x4*)(dtv + 32 * kp + 16 + 4 * q4);
                    const u32x2 c0 = cbr[2 * kp], c1 = cbr[2 * kp + 1];
                    const float m0[4] = {bflo(c0.x), bfhi(c0.x), bflo(c0.y), bfhi(c0.y)}, m1[4] = {bflo(c1.x), bfhi(c1.x), bflo(c1.y), bfhi(c1.y)};
                    float mm[8];
#pragma unroll
                    for (int jj = 0; jj < 4; ++jj) { const int s_0 = 32 * kp + 4 * q4 + jj, s_1 = s_0 + 16;
                        mm[jj] = (s_0 <= l) ? m0[jj] * __expf(fminf(al - as0[jj], 0.f)) * ds0[jj] : 0.f; mm[4 + jj] = (s_1 <= l) ? m1[jj] * __expf(fminf(al - as1[jj], 0.f)) * ds1[jj] : 0.f; }
                    u32x4 pw; pw.x = pk2(mm[0], mm[1]); pw.y = pk2(mm[2], mm[3]); pw.z = pk2(mm[4], mm[5]); pw.w = pk2(mm[6], mm[7]); pf[kp] = as_bf16x8(pw); }
                f32x4 y[4];
#pragma unroll
                for (int pt = 0; pt < 4; ++pt) { y[pt] = (f32x4){0.f, 0.f, 0.f, 0.f};
#pragma unroll
                    for (int kk = 0; kk < 4; ++kk) { const bf16x8 a = *(const LAS bf16x8*)(prevs + swz256(16 * pt + r16, 64 * kk + 16 * q4)); y[pt] = mfma16(a, as_bf16x8(cfr[kk]), y[pt]); } }
                const float el = __expf(al);
#pragma unroll
                for (int pt = 0; pt < 4; ++pt) y[pt] = y[pt] * el;
#pragma unroll
                for (int kp = 0; kp < 4; ++kp)
#pragma unroll
                    for (int pt = 0; pt < 4; ++pt) { const u32x2 lo = *(const LAS u32x2*)(xTs + swz256(16 * pt + r16, 64 * kp + 8 * q4)), hi = *(const LAS u32x2*)(xTs + swz256(16 * pt + r16, 64 * kp + 32 + 8 * q4));
                        const u32x4 av = (u32x4){lo.x, lo.y, hi.x, hi.y}; y[pt] = mfma16(as_bf16x8(av), pf[kp], y[pt]); }
                if (c < 32) { const bf16* cp = cbb + (size_t)c * 65536 + (size_t)(16 * w + r16) * 128 + 32 * q4;
#pragma unroll
                    for (int i = 0; i < 4; ++i) { const u32x4 t4 = *(const u32x4*)(cp + 8 * i); cbr[2 * i] = (u32x2){t4.x, t4.y}; cbr[2 * i + 1] = (u32x2){t4.z, t4.w}; }
                    const bf16* ccp = XA + ((size_t)b * SEQ + c * 128 + 16 * w + r16) * 3072 + 2560 + g * 128 + 8 * q4;
#pragma unroll
                    for (int kk = 0; kk < 4; ++kk) cfr[kk] = *(const u32x4*)(ccp + 32 * kk); }
                { const size_t tok = (size_t)tok0 + l; float ssq = 0.f; unsigned yq[4];
#pragma unroll
                    for (int pt = 0; pt < 4; ++pt) { const int p0 = 16 * pt + 4 * q4;
                        float ov[4];
#pragma unroll
                        for (int jj = 0; jj < 4; ++jj) { const float xvv = bf2f(*(const LAS unsigned short*)(xTs + swz256(p0 + jj, 2 * l)));
                            const unsigned zw = (jj < 2) ? zz[pt].x : zz[pt].y; const float zf = (jj & 1) ? bfhi(zw) : bflo(zw);
                            ov[jj] = (y[pt][jj] + Dh * xvv) * silu_f(zf); }
                        ssq += (ov[0] * ov[0] + ov[1] * ov[1]) + (ov[2] * ov[2] + ov[3] * ov[3]);
                        yq[pt] = pk4_f8(ov[0], ov[1], ov[2], ov[3], Q8_YS); }
                    *(u32x4*)(Y + tok * DI + h * 64 + 16 * q4) = tr4x4(yq[0], yq[1], yq[2], yq[3]);
                    ssq += __shfl_xor(ssq, 16); ssq += __shfl_xor(ssq, 32);
                    if (q4 == 0) SSQ[tok * 32 + h] = ssq; }
                { const float dec = __expf(acum[384]);
#pragma unroll
                    for (int pt = 0; pt < 4; ++pt) st[pt] = st[pt] * dec;
#pragma unroll
                    for (int kk = 0; kk < 4; ++kk) { const u32x4 a = *(const LAS u32x4*)(BTs + swz256(16 * w + r16, 64 * kk + 16 * q4));
                        const f32x4 w0 = *(const LAS f32x4*)(wdec + 32 * kk + 8 * q4), w1 = *(const LAS f32x4*)(wdec + 32 * kk + 8 * q4 + 4);
                        u32x4 aw; aw.x = pk2(bflo(a.x) * w0[0], bfhi(a.x) * w0[1]); aw.y = pk2(bflo(a.y) * w0[2], bfhi(a.y) * w0[3]); aw.z = pk2(bflo(a.z) * w1[0], bfhi(a.z) * w1[1]); aw.w = pk2(bflo(a.w) * w1[2], bfhi(a.w) * w1[3]);
#pragma unroll
                        for (int pt = 0; pt < 4; ++pt) { const bf16x8 bfr = *(const LAS bf16x8*)(xTs + swz256(16 * pt + r16, 64 * kk + 16 * q4)); st[pt] = mfma16(as_bf16x8(aw), bfr, st[pt]); } } }
            } else {
                const bf16* cp = cbb + (size_t)(16 * w + r16) * 128 + 32 * q4;
#pragma unroll
                for (int i = 0; i < 4; ++i) { const u32x4 t4 = *(const u32x4*)(cp + 8 * i); cbr[2 * i] = (u32x2){t4.x, t4.y}; cbr[2 * i + 1] = (u32x2){t4.z, t4.w}; }
                const bf16* ccp = XA + ((size_t)b * SEQ + 16 * w + r16) * 3072 + 2560 + g * 128 + 8 * q4;
#pragma unroll
                for (int kk = 0; kk < 4; ++kk) cfr[kk] = *(const u32x4*)(ccp + 32 * kk);
            }
            if (c < 32) {
#pragma unroll
                for (int pt = 0; pt < 4; ++pt) { u32x2 q; q.x = pk2(st[pt][0], st[pt][1]); q.y = pk2(st[pt][2], st[pt][3]); *(LAS u32x2*)(prn + swz256(16 * pt + r16, 2 * (16 * w + 4 * q4))) = q; }
                if (w == 0) { const int t0 = 2 * lane; const float d0 = dn0, d1 = dn1;
                    const float a0 = d0 * Ah, a1 = d1 * Ah; const float sm = a0 + a1; float incl = sm;
#pragma unroll
                    for (int off = 1; off < 64; off <<= 1) { const float v = __shfl_up(incl, off); if (lane >= off) incl += v; }
                    const float c0 = (incl - sm) + a0, c1 = incl; const float tot = __shfl(incl, 63);
                    fan[t0] = c0; fan[t0 + 1] = c1; fan[128 + t0] = d0; fan[128 + t0 + 1] = d1; fan[256 + t0] = d0 * __expf(tot - c0); fan[256 + t0 + 1] = d1 * __expf(tot - c1); if (lane == 63) fan[384] = tot; }
#pragma unroll
                for (int it = 0; it < 3; ++it) { const int cgi = 4 * (2 * it + (w >> 2)) + (lane >> 4);
                    LAS unsigned char* dst = (it == 0) ? xTn : BTn; const int r0 = (it == 0) ? (8 * cgi) : (8 * (cgi - 8));
#pragma unroll
                    for (int i = 0; i < 8; ++i) { const unsigned a0 = pre[it][0][i >> 1], a1 = pre[it][1][i >> 1];
                        const unsigned lo = (i & 1) ? (a0 >> 16) : (a0 & 0xffffu), hi = (i & 1) ? (a1 & 0xffff0000u) : (a1 << 16);
                        *(LAS unsigned*)(dst + swz256(r0 + i, 4 * jp)) = lo | hi; } }
                if (c < 31) {
#pragma unroll
                    for (int it = 0; it < 3; ++it) { const char* sb = xab + (size_t)(c + 1) * (128 * 6144) + chb[it]; pre[it][0] = *(const u32x4*)(sb + voff); pre[it][1] = *(const u32x4*)(sb + voff + 6144); }
                    if (w == 0) { const size_t t1 = (size_t)b * SEQ + (c + 1) * 128; dn0 = DT[(t1 + 2 * lane) * 32 + h]; dn1 = DT[(t1 + 2 * lane + 1) * 32 + h]; }
                }
            }
            lds_barrier();
        }
    }
}
__device__ __forceinline__ void rmsnorm_phase(bf16* Y, int G, int vcu) {
    const int tid = threadIdx.x, lane = tid & 63, w = tid >> 6;
    const int gw = vcu * 8 + w, NGW = G * 8;
    for (int row = gw; row < T; row += NGW) {
        u32x4* rp = (u32x4*)(Y + (size_t)row * DI) + lane;
#pragma unroll
        for (int j = 0; j < 4; ++j) { const u32x4 a = rp[64 * j]; float f[8]; float ss = 0.f;
#pragma unroll
            for (int i = 0; i < 4; ++i) { f[2 * i] = bflo(a[i]); f[2 * i + 1] = bfhi(a[i]); ss += f[2 * i] * f[2 * i] + f[2 * i + 1] * f[2 * i + 1]; }
            const float sc = 1.0f / sqrtf(wave_sum(ss) * (1.0f / 512.0f) + RMS_EPS);
            u32x4 o;
#pragma unroll
            for (int i = 0; i < 4; ++i) o[i] = pk2(f[2 * i] * sc, f[2 * i + 1] * sc);
            rp[64 * j] = o; }
    }
}

__device__ __forceinline__ int moe_tables(LAS unsigned char* lds, const unsigned* counts) {
    const int tid = threadIdx.x;
    LAS int* tab = (LAS int*)(lds + LDS_TAB);
    if (tid < 32) tab[64 + tid] = (int)__hip_atomic_load(counts + tid, __ATOMIC_RELAXED, __HIP_MEMORY_SCOPE_AGENT);
    __syncthreads();
    if (tid == 0) { int pre = 0; for (int e = 0; e < 32; ++e) { tab[e] = pre; pre += (tab[64 + e] + 255) >> 8; } tab[32] = pre; }
    __syncthreads();
    const int NB = tab[32];
    for (int rb = tid; rb < NB; rb += 512) { int e = 0; while (e < 31 && tab[e + 1] <= rb) ++e; tab[128 + rb] = e; }
    __syncthreads();
    return NB;
}

struct Args { const void* in[22]; float* out; unsigned char* ws; int ph_lo, ph_hi; };
__global__ void __launch_bounds__(512, 2) fwd_kernel(Args args) {
    extern __shared__ __attribute__((aligned(16))) unsigned char lds_raw[];
    LAS unsigned char* lds = (LAS unsigned char*)lds_raw;
    const int tid = threadIdx.x;
    const int G = gridDim.x; const int bx = blockIdx.x; const int vcu = (G % 8 == 0) ? (bx % 8) * (G / 8) + bx / 8 : bx;
    unsigned char* ws = args.ws;
    unsigned* ctl = (unsigned*)(ws + WS_CTL);
    Ptrs P;
    P.x = (const float*)args.in[0]; P.pos = (const int*)args.in[1]; P.attn_w_in = (const float*)args.in[2]; P.attn_w_out = (const float*)args.in[3]; P.ssm_w_in = (const float*)args.in[4];
    P.conv_w = (const float*)args.in[5]; P.conv_b = (const float*)args.in[6]; P.dt_bias = (const float*)args.in[7]; P.a_log = (const float*)args.in[8]; P.d_skip = (const float*)args.in[9];
    P.norm_w = (const float*)args.in[10]; P.ssm_w_out = (const float*)args.in[11]; P.w_router = (const float*)args.in[12]; P.b_router = (const float*)args.in[13]; P.w_up = (const float*)args.in[14];
    P.b_up = (const float*)args.in[15]; P.w_dn = (const float*)args.in[16]; P.b_dn = (const float*)args.in[17]; P.ln_mix_g = (const float*)args.in[18]; P.ln_mix_b = (const float*)args.in[19];
    P.ln_ffn_g = (const float*)args.in[20]; P.ln_ffn_b = (const float*)args.in[21];
    volatile LAS unsigned* misc = (volatile LAS unsigned*)(lds + LDS_MISC);
    if (tid < 64) misc[tid] = 0u;
    __syncthreads();
    XcdBarrier bar; bar.bar = ctl + CW_BAR; bar.x = 0; bar.st = misc;
    if (!MK_PER_PHASE) bar = xcd_barrier_post(ctl + CW_BAR, misc);
    const int lo = args.ph_lo, hi = args.ph_hi;
#ifndef PH_MASK
#define PH_MASK 0x1FFFF
#endif
#define IN(k) ((((PH_MASK) >> (k)) & 1) && lo <= (k) && (k) < hi)
#define SEAM(k) do { if (IN(k) && IN((k) + 1)) xcd_barrier(bar); } while (0)
#define SEAM_PRE(k, W, PITCH) do { if (IN(k) && IN((k) + 1)) { const float* w_ = (W); const int p_ = (PITCH); xcd_barrier(bar, [=]() { ln_preload(lds, w_, p_, 64, 448); }); } } while (0)

    bf16* Wqkv = (bf16*)(ws + WS_WQKV); bf16* Wao = (bf16*)(ws + WS_WAO); bf16* Wsi = (bf16*)(ws + WS_WSI); bf16* Wso = (bf16*)(ws + WS_WSO);
    bf16* XBA = (bf16*)(ws + WS_XBA); bf16* XBB = (bf16*)(ws + WS_XBB); bf16* MIXB = (bf16*)(ws + WS_X1);
    unsigned char* PROJ = ws + WS_BIG; bf16* ZX = (bf16*)(ws + WS_BIG); bf16* XA = (bf16*)(ws + WS_XA); bf16* CBG = (bf16*)(ws + WS_CBG); unsigned char* HB8 = ws + WS_HB; unsigned char* XQ = ws + WS_XQ; unsigned char* YS = ws + WS_YS;
    unsigned char* OG = ws + WS_OG; unsigned char* YB = ws + WS_OG;
    float* rope = (float*)(ws + WS_ROPE); float* gates = (float*)(ws + WS_GATES); float* DT = (float*)(ws + WS_DT); int* lists = (int*)(ws + WS_LIST); float* LSE = (float*)(ws + WS_LSE); float* SSQ = (float*)(ws + WS_LSE);

    if (IN(0)) { p0_prologue(lds, P, ws, G, vcu); }
    SEAM(0);


#define MOE_BLOCK(LAYER, PB) do { \
    unsigned* counts = ctl + CW_CNT + 64 * (LAYER); \
    if (IN((PB) + 0)) { \
        if ((LAYER) == 0) ln_phase<0, 1, true, false, true>(lds, (const bf16*)P.x, MIXB, nullptr, nullptr, P.ln_mix_g, P.ln_mix_b, nullptr, XBB, P.w_router, NE, P.b_router, gates, lists, counts, nullptr, G, vcu, XQ);   \
        else ln_phase<0, 1, true, false>(lds, XBA, MIXB, nullptr, nullptr, P.ln_mix_g + (LAYER) * DM, P.ln_mix_b + (LAYER) * DM, nullptr, XBB, \
                             P.w_router + (size_t)(LAYER) * DM * NE, NE, P.b_router + (LAYER) * NE, gates, lists, counts, nullptr, G, vcu, XQ); } \
    SEAM((PB) + 0); \
    if (IN((PB) + 1)) { \
        const int NB = moe_tables(lds, counts); \
        LAS int* tab = (LAS int*)(lds + LDS_TAB); LAS unsigned short* toks = (LAS unsigned short*)(lds + LDS_AUX); \
        const int NU = NB * 8; \
        const int nun = (vcu < NU) ? ((NU - vcu + G - 1) / G) : 0; \
        for (int idx = tid; idx < nun * 256 && idx < 17 * 256; idx += 512) { const int i = idx >> 8, row = idx & 255; const int L = i * G + vcu; const int rb = L >> 3; const int e = tab[128 + rb]; \
            const int r0 = (rb - tab[e]) * 256, cnt = tab[64 + e]; int si = r0 + row; si = si < cnt ? si : cnt - 1; toks[idx] = (unsigned short)(lists[(size_t)e * 32768 + si] >> 2); } \
        LAS unsigned* btab = (LAS unsigned*)(lds + LDS_SLOT); \
        for (int idx = tid; idx < nun * 128 && idx < 17 * 128; idx += 512) { const int i = idx >> 7, cp = idx & 127; const int L = i * G + vcu; const int rb = L >> 3, pn = L & 7; const int e = tab[128 + rb]; \
            const float* bsrc = P.b_up + ((size_t)(LAYER) * 32 + e) * 2048 + ((cp < 64) ? (pn * 128 + 2 * cp) : (1024 + pn * 128 + 2 * (cp - 64))); btab[idx] = pk2(bsrc[0], bsrc[1]); } \
        __syncthreads(); \
        pg8::MoeOrder<true> S; S.A = (const char*)XQ; S.Bt = (const char*)(ws + WS_WUP + (size_t)(LAYER) * 32 * 2048 * 1024); S.K = DM / 2;   S.N = 2048; S.nN = 8; S.G = G; S.c = vcu; S.NU = NU; S.tab = tab; S.toks = toks; \
        pg8::EpiUp E{HB8, btab}; \
        if ((LAYER) == 0) { pg8::HostCvt H; H.w_up = P.w_up + (size_t)32 * 1024 * 2048; H.w_dn = P.w_dn + (size_t)32 * 1024 * 1024; H.wt_up = ws + WS_WUP + (size_t)32 * 2048 * 1024; H.wt_dn = ws + WS_WDN + (size_t)32 * 1024 * 1024; \
            H.base = 0; H.limit = 49152; H.G = G; H.c = vcu;   \
            pg8::gemm_phase<true>(lds, DM / 2, S, E, H); } \
        else { pg8::HostNone H; pg8::gemm_phase<true>(lds, DM / 2, S, E, H); } } \
    SEAM((PB) + 1); \
    if (IN((PB) + 2)) { \
        const int NB = moe_tables(lds, counts); \
        LAS int* tab = (LAS int*)(lds + LDS_TAB); LAS int* slots = (LAS int*)(lds + LDS_SLOT); LAS unsigned* dbtab = (LAS unsigned*)(lds + LDS_AUX); \
        { const int NU = NB * 4; const int nun = (vcu < NU) ? ((NU - vcu + G - 1) / G) : 0; \
          for (int idx = tid; idx < nun * 256 && idx < 9 * 256; idx += 512) { const int i = idx >> 8, row = idx & 255; const int L = i * G + vcu; const int rb = L >> 2; const int e = tab[128 + rb]; \
              const int si = (rb - tab[e]) * 256 + row; slots[idx] = (si < tab[64 + e]) ? lists[(size_t)e * 32768 + si] : -1; } \
          for (int idx = tid; idx < nun * 128 && idx < 9 * 128; idx += 512) { const int i = idx >> 7, cp = idx & 127; const int L = i * G + vcu; const int rb = L >> 2, pn = L & 3; const int e = tab[128 + rb]; \
              const float* bsrc = P.b_dn + ((size_t)(LAYER) * 32 + e) * 1024 + pn * 256 + 2 * cp; dbtab[idx] = pk2(bsrc[0], bsrc[1]); } \
          __syncthreads(); } \
        pg8::MoeOrder<false> S; S.A = (const char*)HB8; S.Bt = (const char*)(ws + WS_WDN + (size_t)(LAYER) * 32 * 1024 * 1024); S.K = DM / 2; S.N = 1024; S.nN = 4; S.G = G; S.c = vcu; S.NU = NB * 4; S.tab = tab; S.toks = nullptr; \
        pg8::EpiDown E{YS, dbtab, slots}; \
        if ((LAYER) == 0) { pg8::HostCvt H; H.w_up = P.w_up + (size_t)32 * 1024 * 2048; H.w_dn = P.w_dn + (size_t)32 * 1024 * 1024; H.wt_up = ws + WS_WUP + (size_t)32 * 2048 * 1024; H.wt_dn = ws + WS_WDN + (size_t)32 * 1024 * 1024; \
            H.base = NB * 64; H.limit = 49152; H.G = G; H.c = vcu;   \
            pg8::gemm_phase<true>(lds, DM / 2, S, E, H); \
            } \
        else { pg8::HostNone H; pg8::gemm_phase<true>(lds, DM / 2, S, E, H); } } \
    if ((LAYER) == 0) SEAM_PRE((PB) + 2, P.ssm_w_in + NZX, SSM_PITCH); else SEAM((PB) + 2); \
    if (IN((PB) + 3)) { \
        if ((LAYER) == 0) ln_phase<1, 2, true, false>(lds, XBB, nullptr, YS, gates, P.ln_ffn_g, P.ln_ffn_b, nullptr, XBA, P.ssm_w_in + NZX, SSM_PITCH, P.dt_bias, nullptr, nullptr, nullptr, DT, G, vcu, ws + WS_XQ0); \
        else ln_phase<1, 0, false, true>(lds, XBB, nullptr, YS, gates, P.ln_ffn_g + DM, P.ln_ffn_b + DM, args.out, nullptr, nullptr, 0, nullptr, nullptr, nullptr, nullptr, nullptr, G, vcu); } \
    } while (0)

    if (IN(1)) { pg8::DenseOrder S; S.init(ws + WS_XQ0, Wqkv, T, NQKV, DM / 2, G, bx); pg8::EpiQKV E{PROJ, rope, 1.0f / (Q8_X * Q8_W)};
        pg8::HostCvt H; H.w_up = P.w_up; H.w_dn = P.w_dn; H.wt_up = ws + WS_WUP; H.wt_dn = ws + WS_WDN; H.base = 0; H.limit = 2 * HOSTED_ITEMS; H.G = G; H.c = bx;
        pg8::gemm_phase<true>(lds, DM / 2, S, E, H); }
    SEAM(1);
    if (IN(2)) attn_phase(lds, PROJ, OG, LSE, G, vcu);
    SEAM(2);
    if (IN(3)) combine_phase(OG, LSE, ws + WS_OB, G, vcu);
    SEAM(3);
    if (IN(4)) { pg8::DenseOrder S; S.init(ws + WS_OB, Wao, T, DM, DM / 2, G, bx); pg8::EpiBf16 E{MIXB, DM, 1.0f / (Q8_O * Q8_W)}; pg8::HostNone H; pg8::gemm_phase<true>(lds, DM / 2, S, E, H); }
    SEAM_PRE(4, P.w_router, NE);
    MOE_BLOCK(0, 5);
    SEAM(8);
    if (IN(9)) { pg8::DenseOrder S; S.init(ws + WS_XQ0, Wsi, T, NZX, DM / 2, G, bx); pg8::EpiBf16 E{ZX, NZX, 1.0f / (Q8_X * Q8_W)}; pg8::HostNone H; pg8::gemm_phase<true>(lds, DM / 2, S, E, H); }
    SEAM(9);
    if (IN(10)) {
        convcb_phase(lds, ZX, P.conv_w, P.conv_b, XA, CBG, G, vcu); }
    SEAM(10);
    if (IN(11)) ssd_phase(lds, ZX, XA, CBG, DT, P.a_log, P.d_skip, YB, SSQ, G, vcu);
    SEAM(11);
    if (IN(12)) { pg8::DenseOrder S; S.init(YB, Wso, T, DM, DI / 2, G, bx);
        LAS float* stab = (LAS float*)(lds + LDS_AUX);
        for (int i = 0; i < 4; ++i) { pg8::Unit uu; if (!S.next(i, uu)) break;
            for (int idx = tid; idx < 1024; idx += 512) { const int rl = idx >> 2, g = idx & 3; const float* sp = SSQ + (size_t)(uu.pm * 256 + rl) * 32 + g * 8;
                const f32x4 a = *(const f32x4*)sp, b4 = *(const f32x4*)(sp + 4); const float sum = ((a[0] + a[1]) + (a[2] + a[3])) + ((b4[0] + b4[1]) + (b4[2] + b4[3]));
                stab[(i * 256 + rl) * 4 + g] = __builtin_amdgcn_rsqf(sum * (1.0f / 512.0f) + RMS_EPS); } }
        __syncthreads();
        pg8::EpiRms E{MIXB, DM, stab}; pg8::HostNone H; pg8::gemm_phase<true>(lds, DI / 2, S, E, H); }
    SEAM_PRE(12, P.w_router + (size_t)DM * NE, NE);
    MOE_BLOCK(1, 13);
#undef IN
#undef SEAM
#undef MOE_BLOCK
}

constexpr int NPHASE = 17;
extern "C" void kernel_launch(void* const* d_in, const int* in_sizes, int n_in, void* d_out, int out_size, void* d_ws, size_t ws_size, hipStream_t stream) {
    static int grid = 0;
    if (grid == 0) {
        if (n_in != 22 || in_sizes[0] != T * DM || out_size != T * DM || ws_size < WS_END) { fprintf(stderr, "kernel_launch: unexpected shapes / workspace (n_in %d, in0 %d, out %d, ws %zu, need %zu)\n", n_in, n_in > 0 ? in_sizes[0] : -1, out_size, ws_size, (size_t)WS_END); grid = -1; return; }
        int dev = 0, cus = 0;
        if (hipGetDevice(&dev) != hipSuccess || hipDeviceGetAttribute(&cus, hipDeviceAttributeMultiprocessorCount, dev) != hipSuccess) { fprintf(stderr, "kernel_launch: device query failed\n"); grid = -1; return; }
        if (hipFuncSetAttribute((const void*)fwd_kernel, hipFuncAttributeMaxDynamicSharedMemorySize, LDS_BYTES) != hipSuccess) { fprintf(stderr, "kernel_launch: hipFuncSetAttribute failed\n"); grid = -1; return; }
        int per_cu = 0;
        if (hipOccupancyMaxActiveBlocksPerMultiprocessor(&per_cu, (const void*)fwd_kernel, 512, LDS_BYTES) != hipSuccess || per_cu < 1) fprintf(stderr, "kernel_launch: occupancy query reports %d\n", per_cu);
        (void)hipGetLastError();
        grid = cus;
        if (grid < 256) { fprintf(stderr, "kernel_launch: built for >= 256 CUs, got %d\n", grid); }
        if (grid > 256) grid = 256;
    }
    if (grid < 0) return;
    if (hipMemsetAsync((char*)d_ws + WS_CTL, 0, CTL_ZERO_BYTES, stream) != hipSuccess) { fprintf(stderr, "kernel_launch: memset failed\n"); return; }
    Args a{};
    for (int i = 0; i < 22; ++i) a.in[i] = d_in[i];
    a.out = (float*)d_out; a.ws = (unsigned char*)d_ws;
#if MK_PER_PHASE
    for (int p = 0; p < NPHASE; ++p) { a.ph_lo = p; a.ph_hi = p + 1; hipLaunchKernelGGL(fwd_kernel, dim3(grid), dim3(512), LDS_BYTES, stream, a); }
#else
    a.ph_lo = 0; a.ph_hi = NPHASE;
    hipLaunchKernelGGL(fwd_kernel, dim3(grid), dim3(512), LDS_BYTES, stream, a);
#endif
    const hipError_t le = hipPeekAtLastError();
    if (le != hipSuccess) fprintf(stderr, "kernel_launch: launch failed: %s\n", hipGetErrorName(le));
}
```

```cpp
#include <hip/hip_runtime.h>
#include <cstdio>
#include <cstdint>

#ifndef MK_PER_PHASE
#define MK_PER_PHASE 0
#endif

#define GAS __attribute__((address_space(1)))
#define LAS __attribute__((address_space(3)))
typedef unsigned short bf16;
typedef short bf16x8 __attribute__((ext_vector_type(8)));
typedef float f32x4 __attribute__((ext_vector_type(4)));
typedef float f32x2 __attribute__((ext_vector_type(2)));
typedef unsigned u32x4 __attribute__((ext_vector_type(4)));
typedef unsigned u32x2 __attribute__((ext_vector_type(2)));

constexpr int BATCH = 8, SEQ = 4096, DM = 1024, T = BATCH * SEQ;
constexpr int NQKV = 9216;
constexpr int NZX = 5120, SSM_PITCH = 5152, DI = 2048;
constexpr int NE = 32;
constexpr float LN_EPS = 1e-5f, RMS_EPS = 1e-5f, ALPHA = 1.41421356237309505f;
constexpr float QSCALE = 0.12751743082459868f;
constexpr float LN2F = 0.6931471805599453f;

constexpr size_t MiB = 1u << 20;
constexpr size_t WS_CTL = 0, CTL_ZERO_BYTES = 128 * 1024;
constexpr size_t WS_ROPE = 1 * MiB;
constexpr size_t WS_GATES = 5 * MiB;
constexpr size_t WS_DT = 6 * MiB;
constexpr size_t WS_LIST = 10 * MiB;
constexpr size_t WS_LSE = 14 * MiB;
constexpr size_t WS_WQKV = 18 * MiB;
constexpr size_t WS_WAO = 36 * MiB;
constexpr size_t WS_WSI = 38 * MiB;
constexpr size_t WS_WSO = 48 * MiB;
constexpr size_t WS_WUP = 52 * MiB;
constexpr size_t WS_XQ = 180 * MiB;
constexpr size_t WS_XQ0 = 212 * MiB;
constexpr size_t WS_WDN = 308 * MiB;
constexpr size_t WS_XBA = 436 * MiB;
constexpr size_t WS_XBB = 500 * MiB;
constexpr size_t WS_X1 = 564 * MiB;
constexpr size_t WS_BIG = 692 * MiB;
constexpr size_t WS_XA = 1012 * MiB;
constexpr size_t WS_CBG = 1204 * MiB;
constexpr size_t WS_HB = WS_BIG;
constexpr size_t WS_YS = 964 * MiB;
constexpr size_t WS_OG = 1268 * MiB;
constexpr size_t WS_OB = 1460 * MiB;
constexpr size_t WS_END = 1524 * MiB;
constexpr int CW_BAR = 4096;
constexpr int CW_CNT = 16384;
constexpr int CW_CVT = 20000;
#ifndef CVT_Q_UP
#define CVT_Q_UP 5
#endif
#ifndef CVT_Q_DN
#define CVT_Q_DN 5
#endif

constexpr int LDS_AUX = 131072;
constexpr int LDS_TAB = 131072 + 17 * 512;
constexpr int LDS_SLOT = LDS_TAB + 2688;
constexpr int LDS_SM = 147456;
constexpr int LDS_MISC = 155648;
constexpr int LDS_BYTES = 156672;

__device__ __forceinline__ float bf2f(unsigned short b) { return __uint_as_float(((unsigned)b) << 16); }
__device__ __forceinline__ float bflo(unsigned w) { return __uint_as_float(w << 16); }
__device__ __forceinline__ float bfhi(unsigned w) { return __uint_as_float(w & 0xffff0000u); }
typedef __bf16 bf16x2_t __attribute__((ext_vector_type(2)));
constexpr float Q8_X = 8.0f, Q8_W = 256.0f, Q8_H = 8.0f, Q8_O = 32.0f, Q8_Y = 32.0f, Q8_Q = 64.0f, Q8_K = 8.0f, Q8_V = 8.0f, Q8_YS = 16.0f, Q8_BC = 8.0f;
__device__ __forceinline__ unsigned pk4_f8(float a, float b, float c, float d, float sc) {
    a = __builtin_fminf(__builtin_fmaxf(a * sc, -448.f), 448.f); b = __builtin_fminf(__builtin_fmaxf(b * sc, -448.f), 448.f);
    c = __builtin_fminf(__builtin_fmaxf(c * sc, -448.f), 448.f); d = __builtin_fminf(__builtin_fmaxf(d * sc, -448.f), 448.f);
    int p = __builtin_amdgcn_cvt_pk_fp8_f32(a, b, 0, false); p = __builtin_amdgcn_cvt_pk_fp8_f32(c, d, p, true); return (unsigned)p; }
__device__ __forceinline__ unsigned pk2(float lo, float hi) { const f32x2 v = {lo, hi}; const bf16x2_t b = __builtin_convertvector(v, bf16x2_t); return __builtin_bit_cast(unsigned, b); }
__device__ __forceinline__ float wave_sum(float v) {
#pragma unroll
    for (int o = 1; o < 64; o <<= 1) v += __shfl_xor(v, o);
    return v;
}
constexpr int P256 = 272, P512 = 528;
__device__ __forceinline__ int swz256(int row, int bc) { return row * P256 + bc; }
__device__ __forceinline__ int swz512(int row, int bc) { return row * P512 + bc; }
__device__ __forceinline__ bf16x8 as_bf16x8(u32x4 v) { return __builtin_bit_cast(bf16x8, v); }
__device__ __forceinline__ f32x4 mfma16(bf16x8 a, bf16x8 b, f32x4 c) { return __builtin_amdgcn_mfma_f32_16x16x32_bf16(a, b, c, 0, 0, 0); }
__device__ __forceinline__ void lds_barrier() { asm volatile("s_waitcnt lgkmcnt(0)" ::: "memory"); __builtin_amdgcn_s_barrier(); asm volatile("" ::: "memory"); }
__device__ __forceinline__ float silu_f(float v) { return v * __builtin_amdgcn_rcpf(1.0f + __expf(-v)); }

__device__ __forceinline__ u32x4 tr4x4(unsigned d0, unsigned d1, unsigned d2, unsigned d3) {
    const u32x2 e01 = __builtin_amdgcn_permlane16_swap(d0, d1, false, false), e23 = __builtin_amdgcn_permlane16_swap(d2, d3, false, false);
    const u32x2 s0 = __builtin_amdgcn_permlane32_swap(e01.x, e23.x, false, false), s1 = __builtin_amdgcn_permlane32_swap(e01.y, e23.y, false, false);
    return (u32x4){s0.x, s1.x, s0.y, s1.y};
}

#define XB_TMO      128
#define XB_XCNT(j)  (256  + 64 * (j))
#define XB_XSUB(j)  (1280 + 64 * (j))
#define XB_XGEN(j)  (2304 + 64 * (j))
#define XB_TOP      3328
#define XB_TOPGEN   3392
#define XCD_BAR_WORDS 3456
#define XB_SPIN_CAP (1u << 18)
__device__ __forceinline__ unsigned xb_ld(unsigned* p)              { return __hip_atomic_load(p, __ATOMIC_RELAXED, __HIP_MEMORY_SCOPE_AGENT); }
__device__ __forceinline__ unsigned xb_add(unsigned* p, unsigned v) { return __hip_atomic_fetch_add(p, v, __ATOMIC_RELAXED, __HIP_MEMORY_SCOPE_AGENT); }
__device__ __forceinline__ unsigned xb_xcc_id() { return (unsigned)__builtin_amdgcn_s_getreg((3 << 11) | 20) & 0xFu; }
#define XB_SPIN(cond, bar) do { unsigned _sp = 0; while (cond) { __builtin_amdgcn_s_sleep(1); \
    if ((++_sp & 255u) == 0u) { if (xb_ld(&(bar)[XB_TMO])) break; if (_sp > XB_SPIN_CAP) { atomicAdd(&(bar)[XB_TMO], 1u); break; } } } } while (0)
struct XcdBarrier { unsigned* bar; unsigned x; volatile LAS unsigned* st; };
__device__ __forceinline__ XcdBarrier xcd_barrier_post(unsigned* bar, volatile LAS unsigned* st) {
    XcdBarrier b; b.bar = bar; b.x = xb_xcc_id(); b.st = st;
    if (threadIdx.x == 0) (void)xb_add(&bar[XB_XCNT(b.x)], 1u);
    return b;
}
__device__ __forceinline__ void xcd_barrier_complete(unsigned* bar, unsigned x, unsigned& nloc, unsigned& nx) {
    const unsigned G = gridDim.x * gridDim.y * gridDim.z;
    unsigned sum, cnt, mine, sp = 0u;
    for (;;) {
        sum = 0u; cnt = 0u; mine = 0u;
#pragma unroll
        for (unsigned j = 0; j < 16; ++j) { const unsigned c = xb_ld(&bar[XB_XCNT(j)]); sum += c; cnt += (c > 0u) ? 1u : 0u; mine = (j == x) ? c : mine; }
        if (sum == G) break;
        __builtin_amdgcn_s_sleep(1);
        if ((++sp & 255u) == 0u) { if (xb_ld(&bar[XB_TMO])) break; if (sp > XB_SPIN_CAP) { atomicAdd(&bar[XB_TMO], 1u); break; } }
    }
    nloc = mine > 0u ? mine : 1u; nx = cnt > 0u ? cnt : 1u;
}
struct NoWork { __device__ __forceinline__ void operator()() const {} };
template <class F = NoWork>
__device__ __forceinline__ void xcd_barrier(const XcdBarrier& b, const F& f = F()) {
    asm volatile("s_waitcnt vmcnt(0)" ::: "memory");
    __syncthreads();
    if (threadIdx.x >= 64) f();
    if (threadIdx.x == 0) {
        unsigned* bar = b.bar;
        __builtin_amdgcn_s_waitcnt(0);
        unsigned nloc = b.st[0], nx = b.st[1];
        if (nloc == 0u) { xcd_barrier_complete(bar, b.x, nloc, nx); b.st[0] = nloc; b.st[1] = nx; }
        const unsigned old = xb_add(&bar[XB_XSUB(b.x)], 1u);
        const unsigned gen = old / nloc;
        if (old + 1u == (gen + 1u) * nloc) {
            __builtin_amdgcn_fence(__ATOMIC_RELEASE, "agent");
            asm volatile("s_waitcnt vmcnt(0)" ::: "memory");
            const unsigned og = xb_add(&bar[XB_TOP], 1u);
            const unsigned tg = og / nx;
            if (og + 1u == (tg + 1u) * nx) xb_add(&bar[XB_TOPGEN], 1u);
            else XB_SPIN(xb_ld(&bar[XB_TOPGEN]) == tg, bar);
            __builtin_amdgcn_fence(__ATOMIC_ACQUIRE, "agent");
            xb_add(&bar[XB_XGEN(b.x)], 1u);
            asm volatile("s_waitcnt vmcnt(0)" ::: "memory");
        } else {
            XB_SPIN(xb_ld(&bar[XB_XGEN(b.x)]) == gen, bar);
            __builtin_amdgcn_fence(__ATOMIC_ACQUIRE, "agent");
            asm volatile("s_waitcnt vmcnt(0)" ::: "memory");
        }
    }
    __syncthreads();
}

namespace pg8 {
constexpr int BM = 256, BK = 64, HALF = 128, HTB = HALF * BK * 2, STAGE_BYTES = 8 * HTB, NXCD = 8, WGM = 4;
__host__ __device__ __forceinline__ int lds_byte(int r, int c) { const int st = (r >> 4) * 2 + (c >> 5), rr = r & 15, cc = c & 31, ob = rr * 64 + cc * 2; return st * 1024 + (ob ^ (((ob >> 9) & 1) << 5)); }
__host__ __device__ __forceinline__ void stage_rc(int b, int& R, int& C) { const int st = b / 1024, sb = b % 1024, swz = sb ^ (((sb >> 9) & 1) << 5); R = (st >> 1) * 16 + swz / 64; C = (st & 1) * 32 + (swz % 64) / 2; }
__host__ __device__ __forceinline__ int perm32(int rho) { const int n = rho >> 4, i = rho & 15; return 8 * (i >> 2) + 4 * n + (i & 3); }

struct Unit { int pm, pn, e, r0, cnt, ord; };
typedef int i32x8_t __attribute__((ext_vector_type(8))); typedef int i32x4_t __attribute__((ext_vector_type(4)));
__device__ __forceinline__ u32x4 pair16(const u32x2 X, const u32x2 Y) {
    const u32x2 s0 = __builtin_amdgcn_permlane16_swap(X.x, Y.x, false, false), s1 = __builtin_amdgcn_permlane16_swap(X.y, Y.y, false, false);
    return (u32x4){s0.x, s1.x, s0.y, s1.y};
}
__device__ __forceinline__ i32x8_t cat8(const bf16x8& a, const bf16x8& b) { return __builtin_shufflevector(__builtin_bit_cast(i32x4_t, a), __builtin_bit_cast(i32x4_t, b), 0, 1, 2, 3, 4, 5, 6, 7); }

struct DenseOrder {
    static constexpr bool GATHER_A = false;
    const char* A; const char* Bt; int K, nM, nN, nwg, G, c;
    __device__ __forceinline__ void init(const void* A_, const void* Bt_, int M, int N, int K_, int G_, int c_) { A = (const char*)A_; Bt = (const char*)Bt_; K = K_; nM = M / BM; nN = N / BM; nwg = nM * nN; G = G_; c = c_; }
    __device__ __forceinline__ bool next(int i, Unit& u) const {
        const long L = (long)i * G + c; if (L >= nwg) return false;
        int wgid = (int)L; { const int q = nwg / NXCD, r = nwg % NXCD, xcd = wgid % NXCD, off = wgid / NXCD; wgid = (xcd < r ? xcd * (q + 1) : r * (q + 1) + (xcd - r) * q) + off; }
        const int nig = WGM * nN, gid = wgid / nig, fm = gid * WGM, gsz = (nM - fm) < WGM ? (nM - fm) : WGM;
        u.pm = fm + ((wgid % nig) % gsz); u.pn = (wgid % nig) / gsz; u.e = 0; u.r0 = 0; u.cnt = 0; u.ord = i; return true;
    }
    __device__ __forceinline__ const char* a_base(const Unit& u) const { return A + (size_t)u.pm * ((size_t)BM * K * 2); }
    __device__ __forceinline__ const char* b_base(const Unit& u) const { return Bt + (size_t)u.pn * ((size_t)BM * K * 2); }
    __device__ __forceinline__ void a_offs(const Unit&, unsigned (&v)[2][2]) const {
#pragma unroll
        for (int i = 0; i < 2; ++i) { int R, C; stage_rc((int)threadIdx.x * 16 + i * 8192, R, C);
#pragma unroll
            for (int h = 0; h < 2; ++h) v[h][i] = (unsigned)((h * HALF + R) * K + C) * 2u; }
    }
};
template <bool GATHER> struct MoeOrder {
    static constexpr bool GATHER_A = GATHER;
    const char* A; const char* Bt; int K, N, nN, G, c, NU; const LAS int* tab; const LAS unsigned short* toks;
    __device__ __forceinline__ bool next(int i, Unit& u) const {
        const int L = i * G + c; if (L >= NU) return false;
        const int rb = L / nN; u.pn = L - rb * nN; u.pm = rb;
        const int e = __builtin_amdgcn_readfirstlane(tab[128 + rb]); u.e = e;
        u.r0 = (rb - __builtin_amdgcn_readfirstlane(tab[e])) * 256; u.cnt = __builtin_amdgcn_readfirstlane(tab[64 + e]); u.ord = i; return true;
    }
    __device__ __forceinline__ const char* a_base(const Unit& u) const { return GATHER ? A : A + (size_t)u.pm * ((size_t)BM * K * 2); }
    __device__ __forceinline__ const char* b_base(const Unit& u) const { return Bt + ((size_t)u.e * N + (size_t)u.pn * BM) * ((size_t)K * 2); }
    __device__ __forceinline__ void a_offs(const Unit& u, unsigned (&v)[2][2]) const {
#pragma unroll
        for (int i = 0; i < 2; ++i) { int R, C; stage_rc((int)threadIdx.x * 16 + i * 8192, R, C);
#pragma unroll
            for (int h = 0; h < 2; ++h) {
                if (GATHER) { const unsigned tok = toks[u.ord * 256 + h * HALF + R]; v[h][i] = (tok * (unsigned)K + (unsigned)C) * 2u; }
                else v[h][i] = (unsigned)((h * HALF + R) * K + C) * 2u; } }
    }
};


struct HostNone { struct Regs {}; __device__ __forceinline__ void issue(int, Regs&, f32x4 (&)[2][2][4][2]) const {} __device__ __forceinline__ void finish(const Regs&, const f32x4 (&)[2][2][4][2]) const {} };
struct HostCvt {
    const float* w_up; const float* w_dn; unsigned char* wt_up; unsigned char* wt_dn;
    int base, limit, G, c;
    struct Regs { unsigned char* dst; bool active; };
    __device__ __forceinline__ void issue(int ord, Regs& R, f32x4 (&acc)[2][2][4][2]) const {
        const int w = __builtin_amdgcn_readfirstlane((int)threadIdx.x >> 6), lane = threadIdx.x & 63, kq = lane >> 4, nq = lane & 15;
        const int hi = __builtin_amdgcn_readfirstlane(base + (ord * G + c) * 8 + w);
        R.active = hi < limit; R.dst = nullptr;
        if (R.active) {
            const float* W; int pitch, k0, n0, drow; unsigned char* WT;
            if (hi < 32768) { const int mat = hi >> 10, q = hi & 1023, kb = q >> 5, nb = q & 31; n0 = nb * 64; k0 = kb * 32; pitch = 2048; W = w_up + (size_t)mat * 1024 * 2048; WT = wt_up + (size_t)mat * 2048 * 1024;
                drow = ((n0 & 1023) >> 7) * 256 + (n0 >> 10) * 128 + (n0 & 127); }
            else { const int r = hi - 32768, mat = r >> 9, q = r & 511, kb = q >> 4, nb = q & 15; n0 = nb * 64; k0 = kb * 32; pitch = 1024; W = w_dn + (size_t)mat * 1024 * 1024; WT = wt_dn + (size_t)mat * 1024 * 1024; drow = n0; }
            const char* src = (const char*)(W + (size_t)k0 * pitch + n0); const unsigned voff = (unsigned)(kq * pitch + 4 * nq) * 4u;
#pragma unroll
            for (int i = 0; i < 8; ++i) acc[0][0][i >> 1][i & 1] = __builtin_nontemporal_load((const f32x4*)(src + (size_t)(4 * i) * pitch * 4 + voff));
            R.dst = WT + (size_t)(drow + 4 * nq + kq) * 1024 + k0;
        }
    }
    __device__ __forceinline__ void finish(const Regs& R, const f32x4 (&acc)[2][2][4][2]) const {
        if (R.active) {
            const int lane = threadIdx.x & 63;
            const unsigned sel1 = (lane & 16) ? 0x07030501u : 0x06020400u, sel2 = (lane & 32) ? 0x07060302u : 0x05040100u;
            unsigned o[8];
#pragma unroll
            for (int i = 0; i < 8; ++i) { const f32x4 v = acc[0][0][i >> 1][i & 1]; const unsigned d = pk4_f8(v[0], v[1], v[2], v[3], Q8_W);
                const u32x2 s1 = __builtin_amdgcn_permlane16_swap(d, d, false, false);
                const unsigned t1 = __builtin_amdgcn_perm(s1.y, s1.x, sel1);
                const u32x2 s2 = __builtin_amdgcn_permlane32_swap(t1, t1, false, false);
                o[i] = __builtin_amdgcn_perm(s2.y, s2.x, sel2); }
#pragma unroll
            for (int i = 0; i < 4; ++i) { const u32x2 s = __builtin_amdgcn_permlane16_swap(o[i], o[4 + i], false, false); o[i] = s.x; o[4 + i] = s.y; }
            unsigned char* d2 = R.dst - ((lane >> 4) & 1) * 1024 + ((lane >> 4) & 1) * 16;
            *(u32x4*)d2 = (u32x4){o[0], o[1], o[2], o[3]}; *(u32x4*)(d2 + 1024) = (u32x4){o[4], o[5], o[6], o[7]};
        }
    }
};

struct HostDense {
    const float* w_si; const float* w_so; const float* w_ao; const float* norm_w; unsigned char* t_si; unsigned char* t_so; unsigned char* t_ao; int G, c, lo, hi;
    struct Regs { unsigned char* dst; const float* ks; int K; bool active; };
    __device__ __forceinline__ void issue(int ord, Regs& R, f32x4 (&acc)[2][2][4][2]) const {
        const int w = __builtin_amdgcn_readfirstlane((int)threadIdx.x >> 6), lane = threadIdx.x & 63, kq = lane >> 4, nq = lane & 15;
        const int j = __builtin_amdgcn_readfirstlane((ord * G + c) * 8 + w);
        R.active = j >= lo && j < hi; R.dst = nullptr; R.ks = nullptr; R.K = 1024;
        if (R.active) {
            const float* W; int pitch, kb, nb; unsigned char* WT; bool zperm = false;
            if (j < 2560) { kb = j / 80; nb = j % 80; W = w_si; pitch = 5152; WT = t_si; zperm = true; }
            else if (j < 3584) { const int r = j - 2560; kb = r >> 4; nb = r & 15; W = w_so; pitch = 1024; WT = t_so; R.K = 2048; R.ks = norm_w + kb * 32; }
            else { const int r = j - 3584; kb = r >> 4; nb = r & 15; W = w_ao; pitch = 1024; WT = t_ao; }
            const int k0 = kb * 32, n0 = nb * 64;
            const char* src = (const char*)(W + (size_t)k0 * pitch + n0); const unsigned voff = (unsigned)(kq * pitch + 4 * nq) * 4u;
#pragma unroll
            for (int i = 0; i < 8; ++i) acc[0][0][i >> 1][i & 1] = __builtin_nontemporal_load((const f32x4*)(src + (size_t)(4 * i) * pitch * 4 + voff));
            int row = n0 + 4 * nq + kq;
            if (zperm && row < 2048) { const int dd = row & 63; row = (row & ~63) + 16 * ((dd >> 2) & 3) + 4 * (dd >> 4) + (dd & 3); }
            R.dst = WT + (size_t)row * R.K + k0;
        }
    }
    __device__ __forceinline__ void finish(const Regs& R, const f32x4 (&acc)[2][2][4][2]) const {
        if (R.active) {
            const int lane = threadIdx.x & 63, kq = lane >> 4;
            const unsigned sel1 = (lane & 16) ? 0x07030501u : 0x06020400u, sel2 = (lane & 32) ? 0x07060302u : 0x05040100u;
            unsigned o[8];
#pragma unroll
            for (int i = 0; i < 8; ++i) { f32x4 v = acc[0][0][i >> 1][i & 1]; if (R.ks) v = v * R.ks[4 * i + kq];
                const unsigned d = pk4_f8(v[0], v[1], v[2], v[3], Q8_W);
                const u32x2 s1 = __builtin_amdgcn_permlane16_swap(d, d, false, false);
                const unsigned t1 = __builtin_amdgcn_perm(s1.y, s1.x, sel1);
                const u32x2 s2 = __builtin_amdgcn_permlane32_swap(t1, t1, false, false);
                o[i] = __builtin_amdgcn_perm(s2.y, s2.x, sel2); }
#pragma unroll
            for (int i = 0; i < 4; ++i) { const u32x2 s = __builtin_amdgcn_permlane16_swap(o[i], o[4 + i], false, false); o[i] = s.x; o[4 + i] = s.y; }
            unsigned char* d2 = R.dst - ((lane >> 4) & 1) * R.K + ((lane >> 4) & 1) * 16;
            *(u32x4*)d2 = (u32x4){o[0], o[1], o[2], o[3]}; *(u32x4*)(d2 + R.K) = (u32x4){o[4], o[5], o[6], o[7]};
        }
    }
};

template <bool F8 = false, class Epi, class Sched, class Host>
__device__ __forceinline__ void gemm_phase(LAS unsigned char* lds, const int K, const Sched& S, const Epi& E, const Host& H) {
    const int tid = threadIdx.x, wid = __builtin_amdgcn_readfirstlane(tid >> 6), lane = tid & 63, wr = wid >> 2, wc = wid & 3, fr = lane & 15, fq = lane >> 4;
    const int nt = K / BK;
    unsigned voffB[2];
#pragma unroll
    for (int i = 0; i < 2; ++i) { int R, C; stage_rc(tid * 16 + i * 8192, R, C); const int Rb = Epi::PERM ? ((R & ~31) + perm32(R & 31)) : R; voffB[i] = (unsigned)(Rb * K + C) * 2u; }
    const size_t kstep = (size_t)(BK * 2);
    const size_t hstep = (size_t)HALF * K * 2;
    const unsigned ldsw = (unsigned)wid * 1024u;
    const int aoff = lds_byte(wr * 64 + fr, fq * 8), boff = lds_byte(wc * 32 + fr, fq * 8);
#define PG8_SA(b, h) (((b) * 2 + (h)) * HTB)
#define PG8_SB(b, h) ((4 + (b) * 2 + (h)) * HTB)
#define PG8_STAGE(bufoff, gbase, voff) do { _Pragma("unroll") for (int _i = 0; _i < 2; ++_i) \
        __builtin_amdgcn_global_load_lds((const unsigned*)((const char*)(gbase) + (voff)[_i]), (LAS unsigned*)(lds + (bufoff) + ldsw + _i * 8192), 16, 0, 0); } while (0)
#define PG8_LDA(dst, b, h) do { _Pragma("unroll") for (int m = 0; m < 4; ++m) _Pragma("unroll") for (int k = 0; k < 2; ++k) dst[m][k] = *(const LAS bf16x8*)(lds + PG8_SA(b, h) + aoff + m * 2048 + k * 1024); } while (0)
#define PG8_LDB(dst, b, h) do { _Pragma("unroll") for (int n = 0; n < 2; ++n) _Pragma("unroll") for (int k = 0; k < 2; ++k) dst[n][k] = *(const LAS bf16x8*)(lds + PG8_SB(b, h) + boff + n * 2048 + k * 1024); } while (0)
#define PG8_MMA(ai, bj, At, Bt) do { _Pragma("unroll") for (int m = 0; m < 4; ++m) _Pragma("unroll") for (int n = 0; n < 2; ++n) { \
        if constexpr (F8) { const i32x8_t b8_ = cat8(Bt[n][0], Bt[n][1]), a8_ = cat8(At[m][0], At[m][1]); asm volatile("v_mfma_f32_16x16x128_f8f6f4 %0, %1, %2, %0" : "+v"(acc[ai][bj][m][n]) : "v"(b8_), "v"(a8_)); } \
        else { _Pragma("unroll") for (int k = 0; k < 2; ++k) acc[ai][bj][m][n] = __builtin_amdgcn_mfma_f32_16x16x32_bf16(Bt[n][k], At[m][k], acc[ai][bj][m][n], 0, 0, 0); } } } while (0)
#define PG8_WAIT_V(n) asm volatile("s_waitcnt vmcnt(" #n ")" ::: "memory")
#define PG8_WAIT_L(n) asm volatile("s_waitcnt lgkmcnt(" #n ")" ::: "memory")
#define PG8_BAR __builtin_amdgcn_s_barrier()
#define PG8_SCHED __builtin_amdgcn_sched_barrier(0)
    Unit cur, nxt; int ui = 0;
    if (!S.next(0, cur)) return;
    f32x4 acc[2][2][4][2];
#pragma unroll
    for (int a = 0; a < 2; ++a)
#pragma unroll
        for (int b = 0; b < 2; ++b)
#pragma unroll
            for (int m = 0; m < 4; ++m)
#pragma unroll
                for (int n = 0; n < 2; ++n) acc[a][b][m][n] = (f32x4){0.f, 0.f, 0.f, 0.f};
    bf16x8 At[4][2], B0[2][2], B1[2][2];
    constexpr bool GA = Sched::GATHER_A;
    unsigned vA[2][2], nvA[2][2];
    S.a_offs(cur, vA);
    const size_t ah = GA ? 0 : hstep;
#define PG8_VA1 (GA ? vA[1] : vA[0])
    const char* cA = S.a_base(cur); const char* cB = S.b_base(cur);
    PG8_STAGE(PG8_SB(0, 0), cB, voffB); PG8_STAGE(PG8_SB(0, 1), cB + hstep, voffB); PG8_STAGE(PG8_SA(0, 0), cA, vA[0]); PG8_STAGE(PG8_SA(0, 1), cA + ah, PG8_VA1);
    if (wr == 1) PG8_BAR;
    PG8_WAIT_V(2); PG8_BAR;
    PG8_STAGE(PG8_SB(1, 0), cB + kstep, voffB); PG8_STAGE(PG8_SA(1, 0), cA + kstep, vA[0]); PG8_STAGE(PG8_SB(1, 1), cB + hstep + kstep, voffB);
    PG8_WAIT_V(6); PG8_BAR;
    for (;;) {
        const bool has_next = S.next(ui + 1, nxt);
        const char* nA = cA; const char* nB = cB;
#pragma unroll
        for (int h = 0; h < 2; ++h)
#pragma unroll
            for (int i = 0; i < 2; ++i) nvA[h][i] = vA[h][i];
        if (has_next) { nA = S.a_base(nxt); nB = S.b_base(nxt); if constexpr (GA) S.a_offs(nxt, nvA); }
        constexpr int NGRP = Epi::RESCALE ? 4 : 1; const int tper = nt / NGRP;
        for (int gq = 0; gq < NGRP; ++gq) {
        if constexpr (Epi::RESCALE) { if (gq > 0) { if constexpr (F8) asm volatile("s_nop 15\n\ts_nop 15" ::: "memory"); E.rescale(acc, cur, gq, wr, fr); } }
#pragma unroll 1
        for (int t = gq * tper; t < (gq + 1) * tper; t += 2) {
            const bool last = (t == nt - 2);
            const char* a1 = cA + (size_t)(t + 1) * kstep;
            const char* a2 = last ? nA : cA + (size_t)(t + 2) * kstep; const char* b2 = last ? nB : cB + (size_t)(t + 2) * kstep;
            const char* a3 = a2 + kstep; const char* b3 = b2 + kstep;
            unsigned w0[2], w1[2];
#pragma unroll
            for (int i = 0; i < 2; ++i) { if constexpr (GA) { w0[i] = last ? nvA[0][i] : vA[0][i]; w1[i] = last ? nvA[1][i] : vA[1][i]; } else { w0[i] = vA[0][i]; w1[i] = vA[0][i]; } }
            PG8_LDB(B0, 0, 0); PG8_LDB(B1, 0, 1); PG8_SCHED; PG8_LDA(At, 0, 0); PG8_STAGE(PG8_SA(1, 1), a1 + ah, PG8_VA1);
            PG8_WAIT_V(8); PG8_WAIT_L(0); PG8_BAR; PG8_MMA(0, 0, At, B0); PG8_MMA(0, 1, At, B1); PG8_BAR; PG8_SCHED;
            PG8_LDA(At, 0, 1); PG8_STAGE(PG8_SB(0, 0), b2, voffB); PG8_STAGE(PG8_SB(0, 1), b2 + hstep, voffB); PG8_STAGE(PG8_SA(0, 0), a2, w0);
            PG8_WAIT_V(8); PG8_WAIT_L(0); PG8_BAR; PG8_MMA(1, 0, At, B0); PG8_MMA(1, 1, At, B1); PG8_BAR; PG8_SCHED;
            PG8_LDB(B0, 1, 0); PG8_LDB(B1, 1, 1); PG8_SCHED; PG8_LDA(At, 1, 0); PG8_STAGE(PG8_SA(0, 1), a2 + ah, w1);
            PG8_WAIT_V(8); PG8_WAIT_L(0); PG8_BAR; PG8_MMA(0, 0, At, B0); PG8_MMA(0, 1, At, B1); PG8_BAR; PG8_SCHED;
            PG8_LDA(At, 1, 1); PG8_STAGE(PG8_SB(1, 0), b3, voffB); PG8_STAGE(PG8_SB(1, 1), b3 + hstep, voffB); PG8_STAGE(PG8_SA(1, 0), a3, w0);
            PG8_WAIT_V(8); PG8_WAIT_L(0); PG8_BAR; PG8_MMA(1, 0, At, B0); PG8_MMA(1, 1, At, B1); PG8_BAR; PG8_SCHED;
        }
        }
        if (wr == 0) PG8_BAR;
        if constexpr (F8) asm volatile("s_nop 15\n\ts_nop 15" ::: "memory");
        E(acc, cur, wr, wc, fr, fq, 0);
        __builtin_amdgcn_sched_barrier(0); asm volatile("" ::: "memory");
        typename Host::Regs hr; H.issue(cur.ord, hr, acc);
        __builtin_amdgcn_sched_barrier(0); asm volatile("" ::: "memory");
        E(acc, cur, wr, wc, fr, fq, 1);
        __builtin_amdgcn_sched_barrier(0);
        H.finish(hr, acc);
        if (!has_next) break;
#pragma unroll
        for (int a = 0; a < 2; ++a)
#pragma unroll
            for (int b = 0; b < 2; ++b)
#pragma unroll
                for (int m = 0; m < 4; ++m)
#pragma unroll
                    for (int n = 0; n < 2; ++n) acc[a][b][m][n] = (f32x4){0.f, 0.f, 0.f, 0.f};
        cur = nxt; cA = nA; cB = nB; ++ui;
#pragma unroll
        for (int h = 0; h < 2; ++h)
#pragma unroll
            for (int i = 0; i < 2; ++i) vA[h][i] = nvA[h][i];
        if (wr == 1) PG8_BAR;
    }
    PG8_WAIT_V(0);
    PG8_BAR;
#undef PG8_VA1
#undef PG8_SA
#undef PG8_SB
#undef PG8_STAGE
#undef PG8_LDA
#undef PG8_LDB
#undef PG8_MMA
#undef PG8_WAIT_V
#undef PG8_WAIT_L
#undef PG8_BAR
#undef PG8_SCHED
}

struct EpiF32 {
    static constexpr bool PERM = false; static constexpr bool RESCALE = false;
    float* C; int ldc;
    __device__ __forceinline__ void operator()(const f32x4 (&acc)[2][2][4][2], const Unit& u, int wr, int wc, int fr, int fq, const int ai) const {
        const int row0 = u.pm * BM + wr * 64 + fr, col0 = u.pn * BM + wc * 32 + 4 * fq;

#pragma unroll
            for (int m = 0; m < 4; ++m) { float* rowp = C + (size_t)(row0 + ai * HALF + m * 16) * ldc + col0;
#pragma unroll
                for (int bj = 0; bj < 2; ++bj)
#pragma unroll
                    for (int n = 0; n < 2; ++n) *(f32x4*)(rowp + bj * HALF + n * 16) = acc[ai][bj][m][n]; }
    }
};
struct EpiBf16 {
    static constexpr bool PERM = true; static constexpr bool RESCALE = false;
    bf16* O; int ldc; float sc; int f8_pn;
    __device__ __forceinline__ void operator()(const f32x4 (&acc)[2][2][4][2], const Unit& u, int wr, int wc, int fr, int fq, const int ai) const {
        const int row0 = u.pm * BM + wr * 64 + fr, col0 = u.pn * BM + wc * 32 + 8 * fq;
        if (u.pn >= f8_pn) {
#pragma unroll
            for (int mp = 0; mp < 2; ++mp) { const int row = row0 + ai * HALF + (2 * mp + (fq & 1)) * 16;
                unsigned char* rp = (unsigned char*)(O + (size_t)row * ldc + f8_pn * BM) + (u.pn - f8_pn) * BM + wc * 32 + 8 * (fq & ~1);
#pragma unroll
                for (int bj = 0; bj < 2; ++bj) { u32x2 wv[2];
#pragma unroll
                    for (int r = 0; r < 2; ++r) { const f32x4 v0 = acc[ai][bj][2 * mp + r][0], v1 = acc[ai][bj][2 * mp + r][1];
                        wv[r].x = pk4_f8(v0[0], v0[1], v0[2], v0[3], sc * Q8_BC); wv[r].y = pk4_f8(v1[0], v1[1], v1[2], v1[3], sc * Q8_BC); }
                    *(u32x4*)(rp + bj * HALF) = pair16(wv[0], wv[1]); } }
            return; }

#pragma unroll
            for (int m = 0; m < 4; ++m) { bf16* rowp = O + (size_t)(row0 + ai * HALF + m * 16) * ldc + col0;
#pragma unroll
                for (int bj = 0; bj < 2; ++bj) { const f32x4 v0 = acc[ai][bj][m][0] * sc, v1 = acc[ai][bj][m][1] * sc;
                    u32x4 w; w.x = pk2(v0[0], v0[1]); w.y = pk2(v0[2], v0[3]); w.z = pk2(v1[0], v1[1]); w.w = pk2(v1[2], v1[3]);
                    __builtin_nontemporal_store(w, (u32x4*)(rowp + bj * HALF)); } }
    }
};
struct EpiRms {
    static constexpr bool PERM = true; static constexpr bool RESCALE = true;
    bf16* O; int ldc; const LAS float* stab;
    __device__ __forceinline__ void rescale(f32x4 (&acc)[2][2][4][2], const Unit& u, int g, int wr, int fr) const {
        const LAS float* tb = stab + (u.ord * 256 + wr * 64 + fr) * 4 + g;
#pragma unroll
        for (int ai = 0; ai < 2; ++ai)
#pragma unroll
            for (int m = 0; m < 4; ++m) { const LAS float* p = tb + (ai * HALF + m * 16) * 4; const float ratio = p[-1] * __builtin_amdgcn_rcpf(p[0]);
#pragma unroll
                for (int bj = 0; bj < 2; ++bj)
#pragma unroll
                    for (int n = 0; n < 2; ++n) acc[ai][bj][m][n] = acc[ai][bj][m][n] * ratio; }
    }
    __device__ __forceinline__ void operator()(const f32x4 (&acc)[2][2][4][2], const Unit& u, int wr, int wc, int fr, int fq, const int ai) const {
        const int row0 = u.pm * BM + wr * 64 + fr, col0 = u.pn * BM + wc * 32 + 8 * fq;
        const LAS float* tb = stab + (u.ord * 256 + wr * 64 + fr) * 4 + 3;

#pragma unroll
            for (int m = 0; m < 4; ++m) { const int row = row0 + ai * HALF + m * 16; const float s3 = tb[(ai * HALF + m * 16) * 4] * (1.0f / (Q8_YS * Q8_W)); bf16* rowp = (bf16*)((char*)O + (unsigned)((row * ldc + col0) * 2));
#pragma unroll
                for (int bj = 0; bj < 2; ++bj) { const f32x4 v0 = acc[ai][bj][m][0] * s3, v1 = acc[ai][bj][m][1] * s3;
                    u32x4 w; w.x = pk2(v0[0], v0[1]); w.y = pk2(v0[2], v0[3]); w.z = pk2(v1[0], v1[1]); w.w = pk2(v1[2], v1[3]);
                    __builtin_nontemporal_store(w, (u32x4*)(rowp + bj * HALF)); } }
    }
};
struct EpiQKV {
    static constexpr bool PERM = true; static constexpr bool RESCALE = false;
    unsigned char* O; const float* rope; float ds;
    __device__ __forceinline__ void operator()(const f32x4 (&acc)[2][2][4][2], const Unit& u, int wr, int wc, int fr, int fq, const int ai) const {
        const int row0 = u.pm * BM + wr * 64 + fr;
        const int col_t = u.pn * BM;
        const int s = (col_t % 3072) >> 10;
        const float sc = ((s == 0) ? QSCALE * Q8_Q : ((s == 1) ? Q8_K : Q8_V)) * ds;
        const int gq = col_t / 3072, lg = 2 * gq, dlm = (1 << lg) - 1, mat0 = gq * 24 + s * 8 + ((col_t & 1023) >> 7);
        const bool rot = (s < 2) && (fq == 0);
        {
#pragma unroll
            for (int mp = 0; mp < 2; ++mp) {
                u32x2 wv[2][2];
#pragma unroll
                for (int r = 0; r < 2; ++r) { const int m = 2 * mp + r; const int row = row0 + ai * HALF + m * 16;
                    f32x4 cs = (f32x4){1.f, 1.f, 1.f, 1.f}, sn = (f32x4){0.f, 0.f, 0.f, 0.f};
                    if (rot) { const float* rp = rope + (size_t)row * 32 + 4 * wc; cs = *(const f32x4*)rp; sn = *(const f32x4*)(rp + 16); }
#pragma unroll
                    for (int bj = 0; bj < 2; ++bj) {
                        f32x4 v0 = acc[ai][bj][m][0], v1 = acc[ai][bj][m][1];
                        if (rot) { const f32x4 a0 = v0 * cs - v1 * sn, a1 = v1 * cs + v0 * sn; v0 = a0; v1 = a1; }
                        wv[r][bj].x = pk4_f8(v0[0], v0[1], v0[2], v0[3], sc); wv[r][bj].y = pk4_f8(v1[0], v1[1], v1[2], v1[3], sc); } }
                const int row = row0 + ai * HALF + (2 * mp + (fq & 1)) * 16;
                const int tt = row & (SEQ - 1), rowp = (row & ~(SEQ - 1)) + ((tt & (dlm)) << (12 - lg)) + (tt >> lg);
#pragma unroll
                for (int bj = 0; bj < 2; ++bj)
                    *(u32x4*)(O + ((size_t)(mat0 + bj) * T + rowp) * 128 + wc * 32 + 8 * (fq & ~1)) = pair16(wv[0][bj], wv[1][bj]);
            }
        }
    }
};
struct EpiUp {
    static constexpr bool PERM = true; static constexpr bool RESCALE = false;
    unsigned char* HB; const LAS unsigned* btab;
    __device__ __forceinline__ void operator()(const f32x4 (&acc)[2][2][4][2], const Unit& u, int wr, int wc, int fr, int fq, const int ai) const {
        const int row0 = u.pm * BM + wr * 64 + fr, col0 = u.pn * HALF + wc * 32 + 8 * fq;
        const LAS unsigned* bp = btab + u.ord * 128 + (wc * 32 + 8 * fq) / 2;
        const u32x4 gw = *(const LAS u32x4*)bp, uw = *(const LAS u32x4*)(bp + 64);
        f32x2 bg[4], bu[4];
#pragma unroll
        for (int i = 0; i < 4; ++i) { bg[i] = (f32x2){bflo(gw[i]), bfhi(gw[i])}; bu[i] = (f32x2){bflo(uw[i]), bfhi(uw[i])}; }
        constexpr float DS = 1.0f / (Q8_X * Q8_W), KE = -1.702f * 1.4426950408889634f;

            u32x2 wv[4];
#pragma unroll
            for (int m = 0; m < 4; ++m) {
                f32x2 o[4];
#pragma unroll
                for (int i = 0; i < 4; ++i) { const int n = i >> 1, j = 2 * (i & 1);
                    f32x2 gt = (f32x2){acc[ai][0][m][n][j], acc[ai][0][m][n][j + 1]} * DS + bg[i];
                    f32x2 up = (f32x2){acc[ai][1][m][n][j], acc[ai][1][m][n][j + 1]} * DS + bu[i];
                    gt[0] = fminf(gt[0], 7.0f); gt[1] = fminf(gt[1], 7.0f);
                    up[0] = __builtin_amdgcn_fmed3f(up[0], -7.0f, 7.0f); up[1] = __builtin_amdgcn_fmed3f(up[1], -7.0f, 7.0f);
                    f32x2 e = gt * KE; e[0] = __builtin_amdgcn_exp2f(e[0]); e[1] = __builtin_amdgcn_exp2f(e[1]);
                    e = e + 1.0f; e[0] = __builtin_amdgcn_rcpf(e[0]); e[1] = __builtin_amdgcn_rcpf(e[1]);
                    o[i] = (up * Q8_H + Q8_H) * (gt * e); }
                { int p0 = __builtin_amdgcn_cvt_pk_fp8_f32(o[0][0], o[0][1], 0, false); p0 = __builtin_amdgcn_cvt_pk_fp8_f32(o[1][0], o[1][1], p0, true);
                  int p1 = __builtin_amdgcn_cvt_pk_fp8_f32(o[2][0], o[2][1], 0, false); p1 = __builtin_amdgcn_cvt_pk_fp8_f32(o[3][0], o[3][1], p1, true); wv[m].x = (unsigned)p0; wv[m].y = (unsigned)p1; }
            }
#pragma unroll
            for (int mp = 0; mp < 2; ++mp)
                *(u32x4*)(HB + (size_t)(row0 + ai * HALF + (2 * mp + (fq & 1)) * 16) * 1024 + (col0 - 8 * (fq & 1))) = pair16(wv[2 * mp], wv[2 * mp + 1]);
    }
};
struct EpiDown {
    static constexpr bool PERM = true; static constexpr bool RESCALE = false;
    unsigned char* YS; const LAS unsigned* btab; const LAS int* slots;
    __device__ __forceinline__ void operator()(const f32x4 (&acc)[2][2][4][2], const Unit& u, int wr, int wc, int fr, int fq, const int ai) const {
        const int col0 = u.pn * BM + wc * 32 + 8 * fq;
        const LAS unsigned* bp = btab + u.ord * 128 + (wc * 32 + 8 * fq) / 2;
        f32x4 bv[2][2];
#pragma unroll
        for (int bj = 0; bj < 2; ++bj) { const u32x4 bw = *(const LAS u32x4*)(bp + bj * 64);
            bv[bj][0] = (f32x4){bflo(bw.x), bfhi(bw.x), bflo(bw.y), bfhi(bw.y)}; bv[bj][1] = (f32x4){bflo(bw.z), bfhi(bw.z), bflo(bw.w), bfhi(bw.w)}; }

#pragma unroll
            for (int mp = 0; mp < 2; ++mp) {
                const int slot = slots[u.ord * 256 + ai * HALF + wr * 64 + (2 * mp + (fq & 1)) * 16 + fr];
#pragma unroll
                for (int bj = 0; bj < 2; ++bj) { u32x2 wv[2];
#pragma unroll
                    for (int r = 0; r < 2; ++r) { const int m = 2 * mp + r; const f32x4 v0 = acc[ai][bj][m][0] * (1.0f / (Q8_H * Q8_W)) + bv[bj][0], v1 = acc[ai][bj][m][1] * (1.0f / (Q8_H * Q8_W)) + bv[bj][1];
                        wv[r].x = pk4_f8(v0[0], v0[1], v0[2], v0[3], Q8_Y); wv[r].y = pk4_f8(v1[0], v1[1], v1[2], v1[3], Q8_Y); }
                    const u32x4 d = pair16(wv[0], wv[1]);
                    if (slot >= 0) *(u32x4*)(YS + (size_t)slot * 1024 + (col0 - 8 * (fq & 1)) + bj * HALF) = d; }
            }
    }
};
}

struct TrItem { const float* W; const float* kscale; bf16* WT; int pitch, K, k0, n0, dstrow0, q8, hperm; };
__device__ __forceinline__ void tr_load(const TrItem& d, f32x4 (&ld)[16], int lane) {
    const int kq = lane >> 4, nq = lane & 15;
    const float* src = d.W + (size_t)(d.k0 + kq) * d.pitch + d.n0 + 4 * nq;
#pragma unroll
    for (int i = 0; i < 16; ++i) ld[i] = __builtin_nontemporal_load((const f32x4*)(src + (size_t)(4 * i) * d.pitch));
}
__device__ __forceinline__ void tr_finish(const TrItem& d, const f32x4 (&ld)[16], LAS float* scr, int lane) {
    const int kq = lane >> 4, nq = lane & 15;
#pragma unroll
    for (int i = 0; i < 16; ++i) { f32x4 v = ld[i]; if (d.kscale) v = v * d.kscale[d.k0 + 4 * i + kq]; LAS float* p = scr + (4 * i + kq) * 65 + 4 * nq; p[0] = v[0]; p[1] = v[1]; p[2] = v[2]; p[3] = v[3]; }
    asm volatile("s_waitcnt lgkmcnt(0)" ::: "memory");
    const int c = lane & 7;
    if (d.q8) {
#pragma unroll
        for (int j = 0; j < 8; ++j) { const int n = j * 8 + (lane >> 3); const LAS float* s = scr + (8 * c) * 65 + n;
            u32x2 o; o.x = pk4_f8(s[0 * 65], s[1 * 65], s[2 * 65], s[3 * 65], Q8_W); o.y = pk4_f8(s[4 * 65], s[5 * 65], s[6 * 65], s[7 * 65], Q8_W);
            int row = d.dstrow0 + n;
            if (d.hperm == 2) { const int ng = d.n0 + n; if (ng < 2048) { const int dd = ng & 63; row = (ng & ~63) + 16 * ((dd >> 2) & 3) + 4 * (dd >> 4) + (dd & 3); } }
            if (d.hperm == 1) { const int ng = d.n0 + n; if (((ng % 3072) >> 10) < 2) { const int dd = ng & 127;
                    const int pp = (dd < 32) ? (((dd & 15) >> 2) * 32 + (dd & 3) + 4 * (dd >> 4)) : (((dd - 32) / 24) * 32 + 8 + (dd - 32) % 24); row = (ng & ~127) + pp; } }
            *(u32x2*)((unsigned char*)d.WT + (size_t)row * d.K + d.k0 + 8 * c) = o; }
    } else {
#pragma unroll
    for (int j = 0; j < 8; ++j) { const int n = j * 8 + (lane >> 3); const LAS float* s = scr + (8 * c) * 65 + n;
        u32x4 o; o.x = pk2(s[0 * 65], s[1 * 65]); o.y = pk2(s[2 * 65], s[3 * 65]); o.z = pk2(s[4 * 65], s[5 * 65]); o.w = pk2(s[6 * 65], s[7 * 65]);
        *(u32x4*)(d.WT + (size_t)(d.dstrow0 + n) * d.K + d.k0 + 8 * c) = o; }
    }
    asm volatile("s_waitcnt lgkmcnt(0)" ::: "memory");
}
__constant__ float c_inv_freq[16] = {1.000000000e+00f, 4.403665960e-01f, 1.939227432e-01f, 8.539710194e-02f, 3.760603070e-02f, 1.656044088e-02f, 7.292664610e-03f, 3.211446106e-03f,
                                     1.414213562e-03f, 6.227724371e-04f, 2.742481884e-04f, 1.207697351e-04f, 5.318295734e-05f, 2.341999971e-05f, 1.031338525e-05f, 4.541670478e-06f};
__device__ __forceinline__ void sincos_reduced(float ang, float& sn, float& cs) {
    const double a = (double)ang;
    const double k = __builtin_rint(a * 0.15915494309189535);
    const double r = __builtin_fma(-k, 6.283185307179586, a) - k * 2.4492935982947064e-16;
    const float rf = (float)r;
    sn = __sinf(rf); cs = __cosf(rf);
}
struct Ptrs {
    const float *x; const int* pos; const float *attn_w_in, *attn_w_out, *ssm_w_in, *conv_w, *conv_b, *dt_bias, *a_log, *d_skip, *norm_w, *ssm_w_out;
    const float *w_router, *b_router, *w_up, *b_up, *w_dn, *b_dn, *ln_mix_g, *ln_mix_b, *ln_ffn_g, *ln_ffn_b;
};
constexpr int N1_UP = 32 * 16 * 32, N1_DN = 32 * 16 * 16, N1_ITEMS = N1_UP + N1_DN;
constexpr int HOSTED_AT = 4096;
constexpr int HOSTED_AO = 2048;
constexpr int HOSTED_ITEMS = 18432;
__device__ __forceinline__ TrItem moe1_item(const Ptrs& P, unsigned char* ws, int idx, int lay = 1) {
    TrItem d; d.kscale = nullptr; d.K = 1024; d.q8 = 1; d.hperm = 0;
    if (idx < N1_UP) { const int mat = 32 * lay + (idx >> 9), q = idx & 511, kb = q >> 5, nb = q & 31; const int n0 = nb * 64; const int bj = n0 >> 10, pn = (n0 & 1023) >> 7, cc = n0 & 127;
        d.W = P.w_up + (size_t)mat * 1024 * 2048; d.pitch = 2048; d.WT = (bf16*)(ws + WS_WUP + (size_t)mat * 2048 * 1024); d.k0 = kb * 64; d.n0 = n0; d.dstrow0 = pn * 256 + bj * 128 + cc; }
    else { const int r = idx - N1_UP, mat = 32 * lay + (r >> 8), q = r & 255, kb = q >> 4, nb = q & 15;
        d.W = P.w_dn + (size_t)mat * 1024 * 1024; d.pitch = 1024; d.WT = (bf16*)(ws + WS_WDN + (size_t)mat * 1024 * 1024); d.k0 = kb * 64; d.n0 = nb * 64; d.dstrow0 = nb * 64; }
    return d;
}
__device__ __forceinline__ void cvt_static(LAS unsigned char* lds, const Ptrs& P, unsigned char* ws, int first, int stride, int cnt) {
    const int lane = threadIdx.x & 63, w = __builtin_amdgcn_readfirstlane((int)threadIdx.x >> 6);
    LAS float* scr = (LAS float*)(lds + w * (65 * 64 * 4));
    if (cnt <= 0 || first >= N1_ITEMS) return;
    f32x4 la[16], lb[16]; TrItem da = moe1_item(P, ws, first), db = da; tr_load(da, la, lane);
    for (int i = 0;; i += 2) {
        const int ib = first + (i + 1) * stride; const bool hb = (i + 1 < cnt) && (ib < N1_ITEMS);
        if (hb) { db = moe1_item(P, ws, ib); tr_load(db, lb, lane); }
        tr_finish(da, la, scr, lane);
        if (!hb) break;
        const int ia = first + (i + 2) * stride; const bool ha = (i + 2 < cnt) && (ia < N1_ITEMS);
        if (ha) { da = moe1_item(P, ws, ia); tr_load(da, la, lane); }
        tr_finish(db, lb, scr, lane);
        if (!ha) break;
    }
}
__device__ __forceinline__ void cvt_plan(int NB, int G, int& rem_up, int& P_up, int& rem_dn, int& P_dn) {
    rem_up = (NB * 8) % G; const int n_iu = rem_up ? (G - rem_up) : 0; P_up = n_iu * 8 * CVT_Q_UP; if (P_up > N1_ITEMS) P_up = N1_ITEMS;
    rem_dn = (NB * 4) % G; const int n_id = rem_dn ? (G - rem_dn) : 0; P_dn = P_up + n_id * 8 * CVT_Q_DN; if (P_dn > N1_ITEMS) P_dn = N1_ITEMS;
}
__device__ __forceinline__ void p0_prologue(LAS unsigned char* lds, const Ptrs& P, unsigned char* ws, int G, int vcu) {
    const int tid = threadIdx.x, lane = tid & 63, w = __builtin_amdgcn_readfirstlane(tid >> 6);
    LAS float* scr = (LAS float*)(lds + w * (65 * 64 * 4));
    const int gw = vcu * 8 + w, NGW = G * 8;
    bf16* Wqkv = (bf16*)(ws + WS_WQKV); bf16* Wao = (bf16*)(ws + WS_WAO); bf16* Wsi = (bf16*)(ws + WS_WSI); bf16* Wso = (bf16*)(ws + WS_WSO);
    constexpr int I0 = 16 * 144, I1 = 16 * 16, I2 = 16 * 80, I3 = 32 * 16, I4 = 32 * 16 * 32, I5 = 32 * 16 * 16;
    constexpr int NITEMS = I0 + 0 * (I1 + I2 + I3) + (N1_ITEMS - HOSTED_ITEMS - HOSTED_AO - HOSTED_AT);
    auto decode = [&](int it) -> TrItem {
        TrItem d; int r = it; d.kscale = nullptr; d.q8 = 0; d.hperm = 0;
        if (r < I0) { const int kb = r / 144, nb = r % 144; d.q8 = 1; d.hperm = 1; d.W = P.attn_w_in; d.pitch = NQKV; d.K = 1024; d.WT = Wqkv; d.k0 = kb * 64; d.n0 = nb * 64; d.dstrow0 = nb * 64; return d; } r -= I0;
        if (r < I1) { const int kb = r / 16, nb = r % 16; d.q8 = 1; d.W = P.attn_w_out; d.pitch = 1024; d.K = 1024; d.WT = Wao; d.k0 = kb * 64; d.n0 = nb * 64; d.dstrow0 = nb * 64; return d; } r -= I1;
        if (r < I2) { const int kb = r / 80, nb = r % 80; d.q8 = 1; d.hperm = 2; d.W = P.ssm_w_in; d.pitch = SSM_PITCH; d.K = 1024; d.WT = Wsi; d.k0 = kb * 64; d.n0 = nb * 64; d.dstrow0 = nb * 64; return d; } r -= I2;
        if (r < I3) { const int kb = r / 16, nb = r % 16; d.q8 = 1; d.W = P.ssm_w_out; d.pitch = 1024; d.K = 2048; d.kscale = P.norm_w; d.WT = Wso; d.k0 = kb * 64; d.n0 = nb * 64; d.dstrow0 = nb * 64; return d; } r -= I3;
        return moe1_item(P, ws, r + HOSTED_ITEMS + HOSTED_AO + HOSTED_AT, 0);
    };
    if (gw < NITEMS) {
        f32x4 la[16], lb[16];
        TrItem da = decode(gw), db = da; tr_load(da, la, lane);
        for (int it = gw; it < NITEMS; it += 2 * NGW) {
            const bool hb = it + NGW < NITEMS;
            if (hb) { db = decode(it + NGW); tr_load(db, lb, lane); }
            tr_finish(da, la, scr, lane);
            if (!hb) break;
            const bool ha = it + 2 * NGW < NITEMS;
            if (ha) { da = decode(it + 2 * NGW); tr_load(da, la, lane); }
            tr_finish(db, lb, scr, lane);
            if (!ha) break;
        }
    }
    bf16* XBA = (bf16*)(ws + WS_XBA);
    for (int m0 = gw * 4; m0 < T; m0 += NGW * 4) {
        f32x4 v[4][4];
#pragma unroll
        for (int rr = 0; rr < 4; ++rr) { const f32x4* xr = (const f32x4*)(P.x + (size_t)(m0 + rr) * DM) + lane;
#pragma unroll
            for (int j = 0; j < 4; ++j) v[rr][j] = xr[64 * j]; }
#pragma unroll
        for (int rr = 0; rr < 4; ++rr) { u32x2* o = (u32x2*)(XBA + (size_t)(m0 + rr) * DM) + lane;
#pragma unroll
            for (int j = 0; j < 4; ++j) {
                *(unsigned*)(ws + WS_XQ0 + (size_t)(m0 + rr) * DM + 4 * lane + 256 * j) = pk4_f8(v[rr][j][0], v[rr][j][1], v[rr][j][2], v[rr][j][3], Q8_X); } }
    }
    float* rope = (float*)(ws + WS_ROPE);
    for (int idx = (vcu * 512 + tid); idx < T * 16; idx += G * 512) {
        const int tok = idx >> 4, i = idx & 15;
        const float ang = (float)P.pos[tok] * c_inv_freq[i];
        float sn, cs; sincos_reduced(ang, sn, cs);
        rope[(size_t)tok * 32 + i] = cs; rope[(size_t)tok * 32 + 16 + i] = sn;
    }
}

constexpr size_t PKOFF = (size_t)8 * T * 128;
__device__ __forceinline__ void attn_phase(LAS unsigned char* lds, const unsigned char* __restrict__ PROJ, unsigned char* __restrict__ OG, float* __restrict__ LSE, const int G, const int vcu, const pg8::HostCvt& H) {
    const int tid = threadIdx.x, lane0 = tid & 63, w = __builtin_amdgcn_readfirstlane(tid >> 6);
    LAS unsigned char* Ks = lds; LAS unsigned char* Vt = lds + 2 * 128 * P256;
    constexpr int NU = BATCH * 3 * 8 * 32;
    const int per = (NU + G - 1) / G;
    const int u0 = vcu * per, u1 = (u0 + per < NU) ? (u0 + per) : NU;
    if (u0 >= u1) return;
    u32x4 kreg[2], vreg[2]; u32x4 qn[2];
    constexpr int PK8 = 144;
    unsigned long long mA = 0ull, mB = 0ull;
    { const int r16 = lane0 & 15, q4 = lane0 >> 4;
#pragma unroll
        for (int kt = 0; kt < 9; ++kt)
#pragma unroll
            for (int jj = 0; jj < 4; ++jj) { const int jr = 16 * kt + 4 * q4 + jj; const bool va = (jr >= r16) & (jr <= r16 + 128); const bool vb = va & (jr + 16 * w >= 128);
                mA |= (unsigned long long)va << (4 * kt + jj); mB |= (unsigned long long)vb << (4 * kt + jj); } }
    int pc = 0;
#define ATT_DECODE(U) const int bgh = (U) >> 5, sub = (U) & 31, h = bgh & 7, bg = bgh >> 3, g = bg % 3, b = bg / 3; \
        const int lg = (g == 0) ? 0 : ((g == 1) ? 2 : 4), dl = 1 << lg, nblk = 32 >> lg, r = sub >> (5 - lg), blk = sub & (nblk - 1); \
        const unsigned char* base_r = PROJ + ((size_t)(g * 24 + h) * T + (size_t)b * SEQ + (size_t)r * (SEQ >> lg)) * 128;
#define ATT_W2(X) pk2(X[0], X[1])
#define ATT_K16(V, LO, HI) do { _Pragma("unroll") for (int i_ = 0; i_ < 4; ++i_) { const f32x2 a_ = __builtin_amdgcn_cvt_pk_f32_fp8((int)(V)[i_], false), b_ = __builtin_amdgcn_cvt_pk_f32_fp8((int)(V)[i_], true); \
        if (i_ < 2) { (LO)[2 * i_] = ATT_W2(a_); (LO)[2 * i_ + 1] = ATT_W2(b_); } else { (HI)[2 * i_ - 4] = ATT_W2(a_); (HI)[2 * i_ - 3] = ATT_W2(b_); } } } while (0)
#define ATT_VT(V0, V1, C, JP, HALFSEL) do { _Pragma("unroll") for (int i_ = 0; i_ < 4; ++i_) { \
        const f32x2 a0_ = __builtin_amdgcn_cvt_pk_f32_fp8((int)(V0)[i_], false), b0_ = __builtin_amdgcn_cvt_pk_f32_fp8((int)(V0)[i_], true), a1_ = __builtin_amdgcn_cvt_pk_f32_fp8((int)(V1)[i_], false), b1_ = __builtin_amdgcn_cvt_pk_f32_fp8((int)(V1)[i_], true); \
        *(LAS unsigned*)(Vt + swz512(16 * (C) + 4 * i_ + 0, 256 * (HALFSEL) + 4 * (JP))) = pk2(a0_[0], a1_[0]); *(LAS unsigned*)(Vt + swz512(16 * (C) + 4 * i_ + 1, 256 * (HALFSEL) + 4 * (JP))) = pk2(a0_[1], a1_[1]); \
        *(LAS unsigned*)(Vt + swz512(16 * (C) + 4 * i_ + 2, 256 * (HALFSEL) + 4 * (JP))) = pk2(b0_[0], b1_[0]); *(LAS unsigned*)(Vt + swz512(16 * (C) + 4 * i_ + 3, 256 * (HALFSEL) + 4 * (JP))) = pk2(b0_[1], b1_[1]); } } while (0)
    {
        ATT_DECODE(u0)
        const int lane = lane0;
        const int jpv = 16 * (w >> 1) + (lane & 15), cv = 4 * (w & 1) + (lane >> 4);
        if (blk > 0) {
#pragma unroll
            for (int it = 0; it < 2; ++it) { const int item = it * 512 + tid, j = item >> 3, c = item & 7; const int ts = (blk - 1) * 128 + j;
                *(LAS u32x4*)(Ks + j * PK8 + 16 * c) = *(const u32x4*)(base_r + (size_t)ts * 128 + PKOFF + 16 * c); }
            { const int ts = (blk - 1) * 128 + 2 * jpv;
                const u32x4 v0 = *(const u32x4*)(base_r + (size_t)ts * 128 + 2 * PKOFF + 16 * cv), v1 = *(const u32x4*)(base_r + (size_t)(ts + 1) * 128 + 2 * PKOFF + 16 * cv);
                ATT_VT(v0, v1, cv, jpv, 0); }
        }
#pragma unroll
        for (int it = 0; it < 2; ++it) { const int item = it * 512 + tid, j = item >> 3, c = item & 7; kreg[it] = *(const u32x4*)(base_r + (size_t)(blk * 128 + j) * 128 + PKOFF + 16 * c); }
        { const int ts = blk * 128 + 2 * jpv;
            vreg[0] = *(const u32x4*)(base_r + (size_t)ts * 128 + 2 * PKOFF + 16 * cv); vreg[1] = *(const u32x4*)(base_r + (size_t)(ts + 1) * 128 + 2 * PKOFF + 16 * cv); }
        const int tq = blk * 128 + 16 * w + (lane & 15);
#pragma unroll
        for (int kk = 0; kk < 2; ++kk) qn[kk] = *(const u32x4*)(base_r + (size_t)tq * 128 + 64 * kk + 16 * (lane >> 4));
    }
    for (int u = u0; u < u1; ++u) {
        int lane = lane0; asm volatile("" : "+v"(lane));
        const int r16 = lane & 15, q4 = lane >> 4;
        ATT_DECODE(u)
        const int pp = pc; pc ^= 1;
        if (blk == 0) {
#pragma unroll
            for (int it = 0; it < 4; ++it) { const int item = it * 512 + tid, dd = item >> 4, c = item & 15; *(LAS u32x4*)(Vt + swz512(dd, 256 * pp + 16 * c)) = (u32x4){0u, 0u, 0u, 0u}; }
        }
#pragma unroll
        for (int it = 0; it < 2; ++it) { const int item = it * 512 + tid, j = item >> 3, c = item & 7; *(LAS u32x4*)(Ks + pc * (128 * P256) + j * PK8 + 16 * c) = kreg[it]; }
        { const int jpv = 16 * (w >> 1) + (lane & 15), cv = 4 * (w & 1) + (lane >> 4); ATT_VT(vreg[0], vreg[1], cv, jpv, pc); }
        const pg8::i32x8_t qf = __builtin_shufflevector(__builtin_bit_cast(pg8::i32x4_t, qn[0]), __builtin_bit_cast(pg8::i32x4_t, qn[1]), 0, 1, 2, 3, 4, 5, 6, 7);
        lds_barrier();
        if (u + 1 < u1) {
            const int un = u + 1;
            const int bgh2 = un >> 5, sub2 = un & 31, h2 = bgh2 & 7, bg2 = bgh2 >> 3, g2 = bg2 % 3, b2 = bg2 / 3;
            const int lg2 = (g2 == 0) ? 0 : ((g2 == 1) ? 2 : 4), nblk2 = 32 >> lg2, r2 = sub2 >> (5 - lg2), blk2 = sub2 & (nblk2 - 1);
            const unsigned char* base2 = PROJ + ((size_t)(g2 * 24 + h2) * T + (size_t)b2 * SEQ + (size_t)r2 * (SEQ >> lg2)) * 128;
#pragma unroll
            for (int it = 0; it < 2; ++it) { const int item = it * 512 + tid, j = item >> 3, c = item & 7; kreg[it] = *(const u32x4*)(base2 + (size_t)(blk2 * 128 + j) * 128 + PKOFF + 16 * c); }
            { const int jpv = 16 * (w >> 1) + (lane & 15), cv = 4 * (w & 1) + (lane >> 4); const int ts = blk2 * 128 + 2 * jpv;
                vreg[0] = *(const u32x4*)(base2 + (size_t)ts * 128 + 2 * PKOFF + 16 * cv); vreg[1] = *(const u32x4*)(base2 + (size_t)(ts + 1) * 128 + 2 * PKOFF + 16 * cv); }
            const int tq2 = blk2 * 128 + 16 * w + r16;
#pragma unroll
            for (int kk = 0; kk < 2; ++kk) qn[kk] = *(const u32x4*)(base2 + (size_t)tq2 * 128 + 64 * kk + 16 * q4);
        }
        f32x4 hacc[2][2][4][2]; pg8::HostCvt::Regs hr; H.issue(u - u0, hr, hacc);
        f32x4 s[9];
#pragma unroll
        for (int kt = 0; kt < 9; ++kt) {
            const int ka = w + kt; const int hoff = ((ka < 8) ? pp : pc) * (128 * P256); const int row = 16 * (ka & 7) + r16;
            const u32x4 k0 = *(const LAS u32x4*)(Ks + hoff + row * PK8 + 16 * q4), k1 = *(const LAS u32x4*)(Ks + hoff + row * PK8 + 64 + 16 * q4);
            const pg8::i32x8_t kf = __builtin_shufflevector(__builtin_bit_cast(pg8::i32x4_t, k0), __builtin_bit_cast(pg8::i32x4_t, k1), 0, 1, 2, 3, 4, 5, 6, 7);
            s[kt] = __builtin_amdgcn_mfma_scale_f32_16x16x128_f8f6f4(kf, qf, (f32x4){0.f, 0.f, 0.f, 0.f}, 0, 0, 0, 0, 0, 0); }
        float mx = -INFINITY;
        const unsigned long long mk = (blk > 0) ? mA : mB; const unsigned mlo = (unsigned)mk, mhi = (unsigned)(mk >> 32);
#pragma unroll
        for (int kt = 0; kt < 9; ++kt)
#pragma unroll
            for (int jj = 0; jj < 4; ++jj) { const int bit = 4 * kt + jj; const bool valid = bit < 32 ? ((mlo >> bit) & 1u) : ((mhi >> (bit - 32)) & 1u);
                s[kt][jj] = valid ? s[kt][jj] : -INFINITY; mx = fmaxf(mx, s[kt][jj]); }
        mx = fmaxf(mx, __shfl_xor(mx, 16)); mx = fmaxf(mx, __shfl_xor(mx, 32));
        float ls = 0.f;
#pragma unroll
        for (int kt = 0; kt < 9; ++kt)
#pragma unroll
            for (int jj = 0; jj < 4; ++jj) { const float p = __builtin_amdgcn_exp2f((s[kt][jj] - mx) * (1.0f / (Q8_Q * Q8_K))); s[kt][jj] = p; ls += p; }
        ls += __shfl_xor(ls, 16); ls += __shfl_xor(ls, 32);
        f32x4 o[8];
#pragma unroll
        for (int dt = 0; dt < 8; ++dt) o[dt] = (f32x4){0.f, 0.f, 0.f, 0.f};
#pragma unroll
        for (int kp = 0; kp < 5; ++kp) {
            u32x4 pw; pw.x = pk2(s[2 * kp][0], s[2 * kp][1]); pw.y = pk2(s[2 * kp][2], s[2 * kp][3]);
            if (kp < 4) { pw.z = pk2(s[2 * kp + 1][0], s[2 * kp + 1][1]); pw.w = pk2(s[2 * kp + 1][2], s[2 * kp + 1][3]); } else { pw.z = 0u; pw.w = 0u; }
            const bf16x8 pf = as_bf16x8(pw);
            const int ka0 = w + 2 * kp, ka1 = ka0 + 1;
            const int c0 = 256 * ((ka0 < 8) ? pp : pc) + 2 * (16 * (ka0 & 7) + 4 * q4), c1 = 256 * ((ka1 < 8) ? pp : pc) + 2 * (16 * (ka1 & 7) + 4 * q4);
#pragma unroll
            for (int dt = 0; dt < 8; ++dt) { const int dd = 16 * dt + r16;
                const u32x2 lo = *(const LAS u32x2*)(Vt + swz512(dd, c0));
                u32x2 hi = (u32x2){0u, 0u}; if (kp < 4) hi = *(const LAS u32x2*)(Vt + swz512(dd, c1));
                const u32x4 av = (u32x4){lo.x, lo.y, hi.x, hi.y};
                o[dt] = mfma16(as_bf16x8(av), pf, o[dt]); }
        }
        const float inv = Q8_O / (ls * Q8_V);
        const int tq = blk * 128 + 16 * w + r16;
        const size_t tokq = (size_t)b * SEQ + (size_t)tq * dl + r;
        unsigned char* op = OG + ((size_t)g * T + tokq) * DM + h * 128 + 16 * q4;
#pragma unroll
        for (int a4 = 0; a4 < 2; ++a4) { unsigned oq[4];
#pragma unroll
            for (int i = 0; i < 4; ++i) oq[i] = pk4_f8(o[4 * a4 + i][0], o[4 * a4 + i][1], o[4 * a4 + i][2], o[4 * a4 + i][3], inv);
            *(u32x4*)(op + 64 * a4) = tr4x4(oq[0], oq[1], oq[2], oq[3]); }
        if (q4 == 0) LSE[((size_t)g * T + tokq) * 8 + h] = (mx * (1.0f / (Q8_Q * Q8_K)) + __builtin_amdgcn_logf(ls)) * LN2F;
        H.finish(hr, hacc);
        lds_barrier();
    }
#undef ATT_DECODE
#undef ATT_W2
#undef ATT_K16
#undef ATT_VT
}

__device__ __forceinline__ void combine_phase(const unsigned char* __restrict__ OG, const float* __restrict__ LSE, unsigned char* __restrict__ OB, int G, int vcu) {
    const int tid = threadIdx.x, lane = tid & 63, w = tid >> 6;
    const int gw = vcu * 8 + w, NGW = G * 8;
    for (int row = gw; row < T; row += NGW) {
#pragma unroll
        for (int j = 0; j < 2; ++j) { const int col = 8 * lane + 512 * j, head = col >> 7;
            const float l0 = LSE[((size_t)0 * T + row) * 8 + head], l1 = LSE[((size_t)1 * T + row) * 8 + head], l2 = LSE[((size_t)2 * T + row) * 8 + head];
            const float m = fmaxf(l0, fmaxf(l1, l2)); float w0 = __expf(l0 - m), w1 = __expf(l1 - m), w2 = __expf(l2 - m); const float inv = 1.0f / (w0 + w1 + w2); w0 *= inv; w1 *= inv; w2 *= inv;
            const u32x2 a0 = *(const u32x2*)(OG + ((size_t)0 * T + row) * DM + col), a1 = *(const u32x2*)(OG + ((size_t)1 * T + row) * DM + col), a2 = *(const u32x2*)(OG + ((size_t)2 * T + row) * DM + col);
            float ov[8];
#pragma unroll
            for (int wd = 0; wd < 2; ++wd) {
                const f32x2 x0 = __builtin_amdgcn_cvt_pk_f32_fp8((int)a0[wd], false), x1 = __builtin_amdgcn_cvt_pk_f32_fp8((int)a1[wd], false), x2 = __builtin_amdgcn_cvt_pk_f32_fp8((int)a2[wd], false);
                const f32x2 y0 = __builtin_amdgcn_cvt_pk_f32_fp8((int)a0[wd], true), y1 = __builtin_amdgcn_cvt_pk_f32_fp8((int)a1[wd], true), y2 = __builtin_amdgcn_cvt_pk_f32_fp8((int)a2[wd], true);
                ov[4 * wd] = w0 * x0[0] + w1 * x1[0] + w2 * x2[0]; ov[4 * wd + 1] = w0 * x0[1] + w1 * x1[1] + w2 * x2[1]; ov[4 * wd + 2] = w0 * y0[0] + w1 * y1[0] + w2 * y2[0]; ov[4 * wd + 3] = w0 * y0[1] + w1 * y1[1] + w2 * y2[1]; }
            u32x2 o; o.x = pk4_f8(ov[0], ov[1], ov[2], ov[3], 1.0f); o.y = pk4_f8(ov[4], ov[5], ov[6], ov[7], 1.0f);
            *(u32x2*)(OB + (size_t)row * DM + col) = o; }
    }
}

__device__ __forceinline__ void ln_preload(LAS unsigned char* lds, const float* __restrict__ W32, int wpitch, int t0 = 0, int nthr = 512, bool map8 = false) {
    const int tid = (int)threadIdx.x - t0; LAS float* wl = (LAS float*)lds;
#pragma unroll 4
    for (int idx = tid; idx < 32768; idx += nthr) { const int k = idx >> 5, e = idx & 31; const int slot = map8 ? (((2 * (k >> 9) + ((k >> 2) & 1)) * 4 + (k & 3)) * 64 + ((k & 511) >> 3)) : ((((k >> 8) * 4 + (k & 3)) * 64) + ((k >> 2) & 63));
        wl[slot * 36 + e] = W32[(size_t)k * wpitch + e]; }
}
template <int MIXSRC, int POST, bool WRITE_B, bool WRITE_F, bool XF32 = false, bool MAP8 = false>
__device__ __forceinline__ void ln_phase(LAS unsigned char* lds, const bf16* __restrict__ xres, const bf16* __restrict__ mixf, const unsigned char* __restrict__ YS, const float* __restrict__ gates_in,
                                         const float* __restrict__ gamma, const float* __restrict__ beta, float* outf, bf16* __restrict__ outb,
                                         const float* __restrict__ W32, int wpitch, const float* __restrict__ bias32, float* __restrict__ gates_out, int* __restrict__ lists, unsigned* counts, float* __restrict__ DTout,
                                         int G, int vcu, unsigned char* __restrict__ outq = nullptr) {
    const int tid = threadIdx.x, lane = tid & 63, w = __builtin_amdgcn_readfirstlane(tid >> 6);
    LAS float* wl = (LAS float*)lds;
    LAS int* sel_e = (LAS int*)(lds + LDS_SM); LAS int* sel_rk = sel_e + 512; LAS int* lcnt = sel_e + 1024; LAS int* gbase = sel_e + 1056;
    if (POST) {
        if (MK_PER_PHASE) ln_preload(lds, W32, wpitch, 0, 512, MAP8);
        if (POST == 1 && tid < 32) lcnt[tid] = 0;
        __syncthreads();
    }
    int ebr = 0;
#pragma unroll
    for (int bb = 0; bb < 5; ++bb) ebr |= ((lane >> bb) & 1) << (4 - bb);
    float mybias = 0.f; if (POST) mybias = bias32[ebr];
    for (int chunk = vcu; chunk < T / 128; chunk += G) {
        u32x2 nxr[4], nmx[4]; f32x4 nxf[XF32 ? 4 : 1]; unsigned nys[4][4]; f32x4 ngv = (f32x4){0.f, 0.f, 0.f, 0.f};
        { const size_t row = (size_t)chunk * 128 + w * 16;
            if (MIXSRC == 1) ngv = *(const f32x4*)(gates_in + row * 4);
#pragma unroll
            for (int j = 0; j < 4; ++j) { if (XF32) nxf[XF32 ? j : 0] = *(const f32x4*)((const float*)xres + row * DM + (MAP8 ? 8 * lane + 512 * (j >> 1) + 4 * (j & 1) : 4 * lane + 256 * j)); else nxr[j] = (MIXSRC == 1) ? __builtin_nontemporal_load((const u32x2*)(xres + row * DM + (MAP8 ? 8 * lane + 512 * (j >> 1) + 4 * (j & 1) : 4 * lane + 256 * j))) : *(const u32x2*)(xres + row * DM + (MAP8 ? 8 * lane + 512 * (j >> 1) + 4 * (j & 1) : 4 * lane + 256 * j));
                if (MIXSRC == 0) nmx[j] = *(const u32x2*)(mixf + row * DM + (MAP8 ? 8 * lane + 512 * (j >> 1) + 4 * (j & 1) : 4 * lane + 256 * j));
                else {
#pragma unroll
                    for (int k = 0; k < 4; ++k) nys[j][k] = __builtin_nontemporal_load((const unsigned*)(YS + (row * 4 + k) * DM + (MAP8 ? 8 * lane + 512 * (j >> 1) + 4 * (j & 1) : 4 * lane + 256 * j))); } } }
        for (int pass = 0; pass < 16; ++pass) {
            const int rl = w * 16 + pass; const size_t row = (size_t)chunk * 128 + rl;
            asm volatile("" ::: "memory");
            int lo = lane; asm volatile("" : "+v"(lo));
            float xv[16];
            {
                f32x4 v[4]; float s = 0.f;
                const f32x4 gv = ngv * (MIXSRC == 1 ? 1.0f / Q8_Y : 1.0f);
#pragma unroll
                for (int j = 0; j < 4; ++j) {
                    f32x4 mix;
                    if (MIXSRC == 0) mix = (f32x4){bflo(nmx[j].x), bfhi(nmx[j].x), bflo(nmx[j].y), bfhi(nmx[j].y)};
                    else { mix = (f32x4){0.f, 0.f, 0.f, 0.f};
#pragma unroll
                        for (int k = 0; k < 4; ++k) { const f32x2 ylo = __builtin_amdgcn_cvt_pk_f32_fp8((int)nys[j][k], false), yhi = __builtin_amdgcn_cvt_pk_f32_fp8((int)nys[j][k], true);
                            mix[0] += gv[k] * ylo[0]; mix[1] += gv[k] * ylo[1]; mix[2] += gv[k] * yhi[0]; mix[3] += gv[k] * yhi[1]; } }
                    const f32x4 xr = XF32 ? nxf[XF32 ? j : 0] : (f32x4){bflo(nxr[j].x), bfhi(nxr[j].x), bflo(nxr[j].y), bfhi(nxr[j].y)};
                    v[j] = xr * ALPHA + mix; s += (v[j][0] + v[j][1]) + (v[j][2] + v[j][3]);
                }
                if (pass < 15) { const size_t nrow = row + 1;
                    if (MIXSRC == 1) ngv = *(const f32x4*)(gates_in + nrow * 4);
#pragma unroll
                    for (int j = 0; j < 4; ++j) { if (XF32) nxf[XF32 ? j : 0] = *(const f32x4*)((const float*)xres + nrow * DM + (MAP8 ? 8 * lo + 512 * (j >> 1) + 4 * (j & 1) : 4 * lo + 256 * j)); else nxr[j] = (MIXSRC == 1) ? __builtin_nontemporal_load((const u32x2*)(xres + nrow * DM + (MAP8 ? 8 * lo + 512 * (j >> 1) + 4 * (j & 1) : 4 * lo + 256 * j))) : *(const u32x2*)(xres + nrow * DM + (MAP8 ? 8 * lo + 512 * (j >> 1) + 4 * (j & 1) : 4 * lo + 256 * j));
                        if (MIXSRC == 0) nmx[j] = *(const u32x2*)(mixf + nrow * DM + (MAP8 ? 8 * lo + 512 * (j >> 1) + 4 * (j & 1) : 4 * lo + 256 * j));
                        else {
#pragma unroll
                            for (int k = 0; k < 4; ++k) nys[j][k] = __builtin_nontemporal_load((const unsigned*)(YS + (nrow * 4 + k) * DM + (MAP8 ? 8 * lo + 512 * (j >> 1) + 4 * (j & 1) : 4 * lo + 256 * j))); } } }
                const float mean = wave_sum(s) * (1.0f / DM); float s2 = 0.f;
#pragma unroll
                for (int j = 0; j < 4; ++j) { v[j] = v[j] - mean; s2 += (v[j][0] * v[j][0] + v[j][1] * v[j][1]) + (v[j][2] * v[j][2] + v[j][3] * v[j][3]); }
                const float rstd = 1.0f / sqrtf(wave_sum(s2) * (1.0f / DM) + LN_EPS);
#pragma unroll
                for (int j = 0; j < 4; ++j) { const f32x4 gm = *(const f32x4*)(gamma + (MAP8 ? 8 * lo + 512 * (j >> 1) + 4 * (j & 1) : 4 * lo + 256 * j)), bt = *(const f32x4*)(beta + (MAP8 ? 8 * lo + 512 * (j >> 1) + 4 * (j & 1) : 4 * lo + 256 * j));
                    const f32x4 y = v[j] * rstd * gm + bt;
                    if (WRITE_F) __builtin_nontemporal_store(y, (f32x4*)(outf + row * DM + (MAP8 ? 8 * lo + 512 * (j >> 1) + 4 * (j & 1) : 4 * lo + 256 * j)));
                    if (WRITE_B) { u32x2 q; q.x = pk2(y[0], y[1]); q.y = pk2(y[2], y[3]); *(u32x2*)(outb + row * DM + (MAP8 ? 8 * lo + 512 * (j >> 1) + 4 * (j & 1) : 4 * lo + 256 * j)) = q; }
                    if (POST) *(unsigned*)(outq + row * DM + (MAP8 ? 8 * lo + 512 * (j >> 1) + 4 * (j & 1) : 4 * lo + 256 * j)) = pk4_f8(y[0], y[1], y[2], y[3], Q8_X);
                    xv[4 * j + 0] = y[0]; xv[4 * j + 1] = y[1]; xv[4 * j + 2] = y[2]; xv[4 * j + 3] = y[3]; }
            }
            if (POST) {
                f32x2 acc2[16];
#pragma unroll
                for (int e = 0; e < 16; ++e) acc2[e] = (f32x2){0.f, 0.f};
#pragma unroll
                for (int jj = 0; jj < 16; ++jj) { const LAS float* wrow = wl + (jj * 64 + lane) * 36;
                    if ((jj & 1) == 0) asm volatile("" ::: "memory");
                    const f32x2 xx = (f32x2){xv[jj], xv[jj]};
#pragma unroll
                    for (int e4 = 0; e4 < 8; ++e4) { const f32x4 wv = *(const LAS f32x4*)(wrow + 4 * e4);
                        acc2[2 * e4] = acc2[2 * e4] + xx * (f32x2){wv[0], wv[1]}; acc2[2 * e4 + 1] = acc2[2 * e4 + 1] + xx * (f32x2){wv[2], wv[3]}; } }
                float acc0[32];
#pragma unroll
                for (int e = 0; e < 32; ++e) acc0[e] = acc2[e >> 1][e & 1];
#pragma unroll
                for (int bb = 0; bb < 5; ++bb) { const int hh = 16 >> bb; const unsigned um = ((lane >> bb) & 1) ? 0xffffffffu : 0u;
#pragma unroll
                    for (int i = 0; i < hh; ++i) { const unsigned l0 = __float_as_uint(acc0[i]), h0 = __float_as_uint(acc0[i + hh]);
                        const float k0 = __uint_as_float((h0 & um) | (l0 & ~um)), s0 = __uint_as_float((l0 & um) | (h0 & ~um)); acc0[i] = k0 + __shfl_xor(s0, 1 << bb); } }
                const float lg0 = acc0[0] + __shfl_xor(acc0[0], 32) + mybias;
                if (POST == 1) {
                    const unsigned ub = __float_as_uint(lg0); const unsigned uo = (ub & 0x80000000u) ? ~ub : (ub | 0x80000000u);
                    unsigned key = (uo & ~31u) | (unsigned)(31 - ebr);
                    float top0 = 0.f, myv = 0.f, esum = 0.f; int ek = 0;
#pragma unroll
                    for (int k = 0; k < 4; ++k) { unsigned bk = key;
#pragma unroll
                        for (int off = 1; off < 32; off <<= 1) { const unsigned ok = (unsigned)__shfl_xor((int)bk, off); bk = ok > bk ? ok : bk; }
                        const int be = 31 - (int)(__builtin_amdgcn_readfirstlane(bk) & 31u);
                        int wl_ = 0;
#pragma unroll
                        for (int bb = 0; bb < 5; ++bb) wl_ |= ((be >> bb) & 1) << (4 - bb);
                        const float bv = __uint_as_float(__builtin_amdgcn_readlane(__float_as_uint(lg0), wl_));
                        if (k == 0) top0 = bv;
                        const float ex = __expf(bv - top0); esum += ex;
                        myv = (lane == k) ? ex : myv; ek = (lane == k) ? be : ek; key = (ebr == be) ? 0u : key; }
                    if (lane < 4) {
                        gates_out[row * 4 + lane] = myv / esum;
                        const int rk = __hip_atomic_fetch_add(lcnt + ek, 1, __ATOMIC_RELAXED, __HIP_MEMORY_SCOPE_WORKGROUP);
                        sel_e[rl * 4 + lane] = ek; sel_rk[rl * 4 + lane] = rk; }
                } else {
                    if (lane < 32) { const float xx = lg0; const float y = __expf(-fabsf(xx)); const float l1p = (y < 1e-3f) ? (y - 0.5f * y * y) : __logf(1.0f + y);
                        DTout[row * 32 + ebr] = fmaxf(xx, 0.f) + l1p; }
                }
            }
        }
        if (POST == 1) {
            __syncthreads();
            if (tid < 32) gbase[tid] = (int)__hip_atomic_fetch_add(counts + tid, (unsigned)lcnt[tid], __ATOMIC_RELAXED, __HIP_MEMORY_SCOPE_AGENT);
            __syncthreads();
            { const int e = sel_e[tid]; lists[(size_t)e * 32768 + gbase[e] + sel_rk[tid]] = (chunk * 128 + (tid >> 2)) * 4 + (tid & 3); }
            __syncthreads();
            if (tid < 32) lcnt[tid] = 0;
            __syncthreads();
        }
    }
}

template <bool F8 = false>
__device__ __forceinline__ void conv_item(const bf16* __restrict__ ZX, const float* __restrict__ conv_w, const float* __restrict__ conv_b, int tok0, int ch, u32x4 (&q)[8]) {
    const int sl = tok0 & (SEQ - 1);
    u32x4 raw[11];
#pragma unroll
    for (int i = 0; i < 11; ++i) { if (sl - 3 + i >= 0) { if (F8) { const u32x2 t2 = *(const u32x2*)((const unsigned char*)(ZX + (size_t)(tok0 - 3 + i) * NZX + 4096) + (ch - 2048)); raw[i] = (u32x4){t2.x, t2.y, 0u, 0u}; }
            else raw[i] = *(const u32x4*)(ZX + (size_t)(tok0 - 3 + i) * NZX + 2048 + ch); } else raw[i] = (u32x4){0u, 0u, 0u, 0u}; }
    f32x2 cw[4][4], cb[4];
#pragma unroll
    for (int k = 0; k < 4; ++k)
#pragma unroll
        for (int p = 0; p < 4; ++p) cw[k][p] = *(const f32x2*)(conv_w + (size_t)k * 3072 + ch + 2 * p);
#pragma unroll
    for (int p = 0; p < 4; ++p) cb[p] = *(const f32x2*)(conv_b + ch + 2 * p);
    f32x2 xin[11][4];
#pragma unroll
    for (int i = 0; i < 11; ++i)
#pragma unroll
        for (int p = 0; p < 4; ++p) { if (F8) xin[i][p] = ((p & 1) ? __builtin_amdgcn_cvt_pk_f32_fp8((int)raw[i][p >> 1], true) : __builtin_amdgcn_cvt_pk_f32_fp8((int)raw[i][p >> 1], false)) * (1.0f / Q8_BC); else xin[i][p] = (f32x2){bflo(raw[i][p]), bfhi(raw[i][p])}; }
#pragma unroll
    for (int t = 0; t < 8; ++t)
#pragma unroll
        for (int p = 0; p < 4; ++p) { f32x2 a = cb[p];
#pragma unroll
            for (int k = 0; k < 4; ++k) a = a + cw[k][p] * xin[t + k][p];
            q[t][p] = pk2(silu_f(a[0]), silu_f(a[1])); }
}
__device__ __forceinline__ void convcb_phase(LAS unsigned char* lds, const bf16* __restrict__ ZX, const float* __restrict__ conv_w, const float* __restrict__ conv_b, bf16* __restrict__ XA, bf16* __restrict__ CBG, int G, int vcu) {
    const int tid = threadIdx.x, lane = tid & 63, w = __builtin_amdgcn_readfirstlane(tid >> 6), r16 = lane & 15, q4 = lane >> 4;
    LAS unsigned char *Cs = lds, *Bs = lds + 128 * P256;
    for (int u = vcu; u < BATCH * 32; u += G) {
        const int tokc = u * 128;
        for (int it = 0; it < 8; ++it) { const int item = it * 512 + tid, cg = item & 255, tb = item >> 8;
            u32x4 q[8]; conv_item(ZX, conv_w, conv_b, tokc + 8 * tb, 8 * cg, q);
#pragma unroll
            for (int t = 0; t < 8; ++t) *(u32x4*)(XA + (size_t)(tokc + 8 * tb + t) * 3072 + 8 * cg) = q[t]; }
        for (int g = 0; g < 4; ++g) {
            { const int cgl = tid & 31, tb = tid >> 5; const int ch = (cgl < 16) ? (2048 + g * 128 + 8 * cgl) : (2560 + g * 128 + 8 * (cgl - 16));
                u32x4 q[8]; conv_item<true>(ZX, conv_w, conv_b, tokc + 8 * tb, ch, q);
                LAS unsigned char* dst = (cgl < 16) ? Bs : Cs;
#pragma unroll
                for (int t = 0; t < 8; ++t) { *(u32x4*)(XA + (size_t)(tokc + 8 * tb + t) * 3072 + ch) = q[t]; *(LAS u32x4*)(dst + swz256(8 * tb + t, 16 * (cgl & 15))) = q[t]; } }
            __syncthreads();
            bf16x8 cf[4];
#pragma unroll
            for (int kk = 0; kk < 4; ++kk) cf[kk] = *(const LAS bf16x8*)(Cs + swz256(16 * w + r16, 64 * kk + 16 * q4));
            bf16* outp = CBG + ((size_t)u * 4 + g) * 16384 + (size_t)(16 * w + r16) * 128 + 32 * q4;
            u32x2 cq[8];
#pragma unroll
            for (int st = 0; st < 8; ++st) { f32x4 m = (f32x4){0.f, 0.f, 0.f, 0.f};
#pragma unroll
                for (int kk = 0; kk < 4; ++kk) { const bf16x8 a = *(const LAS bf16x8*)(Bs + swz256(16 * st + r16, 64 * kk + 16 * q4)); m = mfma16(a, cf[kk], m); }
                cq[st].x = pk2(m[0], m[1]); cq[st].y = pk2(m[2], m[3]); }
#pragma unroll
            for (int i = 0; i < 4; ++i) *(u32x4*)(outp + 8 * i) = (u32x4){cq[2 * i].x, cq[2 * i].y, cq[2 * i + 1].x, cq[2 * i + 1].y};
            __syncthreads();
        }
    }
}
__device__ __forceinline__ void ssd_phase(LAS unsigned char* lds, const bf16* __restrict__ ZX, const bf16* __restrict__ XA, const bf16* __restrict__ CBG, const float* __restrict__ DT,
                                          const float* __restrict__ a_log, const float* __restrict__ d_skip, unsigned char* __restrict__ Y, float* SSQ, int G, int vcu) {
    const int tid = threadIdx.x, lane = tid & 63, w = __builtin_amdgcn_readfirstlane(tid >> 6), r16_0 = lane & 15, q4_0 = lane >> 4;
    constexpr int SZ_BT = 128 * P256, SZ_XT = 64 * P256, O_XT = 2 * SZ_BT, O_PR = O_XT + 2 * SZ_XT, O_FA = O_PR + 2 * SZ_XT;
    LAS float* fa = (LAS float*)(lds + O_FA);
    for (int u = vcu; u < BATCH * 32; u += G) {
        const int b = u >> 5, h = u & 31, g = h >> 3;
        const float Ah = -__expf(a_log[h]); const float Dh = d_skip[h];
        f32x4 st[4];
#pragma unroll
        for (int pt = 0; pt < 4; ++pt) st[pt] = (f32x4){0.f, 0.f, 0.f, 0.f};
        const int jp = 16 * (w & 3) + (lane & 15);
        const unsigned voff = (unsigned)jp * 12288u + (unsigned)(lane >> 4) * 16u;
        int chb[3];
#pragma unroll
        for (int it = 0; it < 3; ++it) { const int gq = 2 * it + (w >> 2); chb[it] = 2 * ((it == 0) ? (h * 64 + 32 * gq) : (2048 + g * 128 + 32 * (gq - 2))); }
        const char* xab = (const char*)XA + (size_t)b * SEQ * 6144;
        const bf16* cbb = CBG + ((size_t)(b * 32) * 4 + g) * 16384;
        u32x4 pre[3][2]; float dn0 = 0.f, dn1 = 0.f; u32x2 cbr[8]; u32x4 cfr[4];
        {
#pragma unroll
            for (int it = 0; it < 3; ++it) { const char* sb = xab + chb[it]; pre[it][0] = *(const u32x4*)(sb + voff); pre[it][1] = *(const u32x4*)(sb + voff + 6144); }
            if (w == 0) { dn0 = DT[((size_t)b * SEQ + 2 * lane) * 32 + h]; dn1 = DT[((size_t)b * SEQ + 2 * lane + 1) * 32 + h]; }
        }
        for (int c = 0; c <= 32; ++c) {
            const int r16 = r16_0, q4 = q4_0;
            const int sb_ = c & 1;
            LAS unsigned char* BTn = lds + sb_ * SZ_BT; LAS unsigned char* xTn = lds + O_XT + sb_ * SZ_XT; LAS unsigned char* prn = lds + O_PR + sb_ * SZ_XT; LAS float* fan = fa + sb_ * 512;
            if (c >= 1) {
                const int cc = c - 1, cb_ = cc & 1; const int tok0 = b * SEQ + cc * 128;
                LAS unsigned char* BTs = lds + cb_ * SZ_BT; LAS unsigned char* xTs = lds + O_XT + cb_ * SZ_XT; LAS unsigned char* prevs = lds + O_PR + cb_ * SZ_XT;
                LAS float* acum = fa + cb_ * 512; LAS float* dtv = acum + 128; LAS float* wdec = acum + 256;
                const int l = 16 * w + r16;
                u32x2 zz[4];
#pragma unroll
                for (int i = 0; i < 2; ++i) { const u32x4 t4 = *(const u32x4*)(ZX + ((size_t)tok0 + l) * NZX + h * 64 + 16 * q4 + 8 * i); zz[2 * i] = (u32x2){t4.x, t4.y}; zz[2 * i + 1] = (u32x2){t4.z, t4.w}; }
                const float al = acum[l];
                bf16x8 pf[4];
#pragma unroll
                for (int kp = 0; kp < 4; ++kp) {
                    const f32x4 as0 = *(const LAS f32x4*)(acum + 32 * kp + 4 * q4), ds0 = *(const LAS f32x4*)(dtv + 32 * kp + 4 * q4), as1 = *(const LAS f32x4*)(acum + 32 * kp + 16 + 4 * q4), ds1 = *(const LAS f32x4*)(dtv + 32 * kp + 16 + 4 * q4);
                    const u32x2 c0 = cbr[2 * kp], c1 = cbr[2 * kp + 1];
                    const float m0[4] = {bflo(c0.x), bfhi(c0.x), bflo(c0.y), bfhi(c0.y)}, m1[4] = {bflo(c1.x), bfhi(c1.x), bflo(c1.y), bfhi(c1.y)};
                    float mm[8];
#pragma unroll
                    for (int jj = 0; jj < 4; ++jj) { const int s_0 = 32 * kp + 4 * q4 + jj, s_1 = s_0 + 16;
                        mm[jj] = (s_0 <= l) ? m0[jj] * __expf(fminf(al - as0[jj], 0.f)) * ds0[jj] : 0.f; mm[4 + jj] = (s_1 <= l) ? m1[jj] * __expf(fminf(al - as1[jj], 0.f)) * ds1[jj] : 0.f; }
                    u32x4 pw; pw.x = pk2(mm[0], mm[1]); pw.y = pk2(mm[2], mm[3]); pw.z = pk2(mm[4], mm[5]); pw.w = pk2(mm[6], mm[7]); pf[kp] = as_bf16x8(pw); }
                f32x4 y[4];
#pragma unroll
                for (int pt = 0; pt < 4; ++pt) { y[pt] = (f32x4){0.f, 0.f, 0.f, 0.f};
#pragma unroll
                    for (int kk = 0; kk < 4; ++kk) { const bf16x8 a = *(const LAS bf16x8*)(prevs + swz256(16 * pt + r16, 64 * kk + 16 * q4)); y[pt] = mfma16(a, as_bf16x8(cfr[kk]), y[pt]); } }
                const float el = __expf(al);
#pragma unroll
                for (int pt = 0; pt < 4; ++pt) y[pt] = y[pt] * el;
#pragma unroll
                for (int kp = 0; kp < 4; ++kp)
#pragma unroll
                    for (int pt = 0; pt < 4; ++pt) { const u32x2 lo = *(const LAS u32x2*)(xTs + swz256(16 * pt + r16, 64 * kp + 8 * q4)), hi = *(const LAS u32x2*)(xTs + swz256(16 * pt + r16, 64 * kp + 32 + 8 * q4));
                        const u32x4 av = (u32x4){lo.x, lo.y, hi.x, hi.y}; y[pt] = mfma16(as_bf16x8(av), pf[kp], y[pt]); }
                if (c < 32) { const bf16* cp = cbb + (size_t)c * 65536 + (size_t)(16 * w + r16) * 128 + 32 * q4;
#pragma unroll
                    for (int i = 0; i < 4; ++i) { const u32x4 t4 = *(const u32x4*)(cp + 8 * i); cbr[2 * i] = (u32x2){t4.x, t4.y}; cbr[2 * i + 1] = (u32x2){t4.z, t4.w}; }
                    const bf16* ccp = XA + ((size_t)b * SEQ + c * 128 + 16 * w + r16) * 3072 + 2560 + g * 128 + 8 * q4;
#pragma unroll
                    for (int kk = 0; kk < 4; ++kk) cfr[kk] = *(const u32x4*)(ccp + 32 * kk); }
                { const size_t tok = (size_t)tok0 + l; float ssq = 0.f; unsigned yq[4];
#pragma unroll
                    for (int pt = 0; pt < 4; ++pt) { const int p0 = 16 * pt + 4 * q4;
                        float ov[4];
#pragma unroll
                        for (int jj = 0; jj < 4; ++jj) { const float xvv = bf2f(*(const LAS unsigned short*)(xTs + swz256(p0 + jj, 2 * l)));
                            const unsigned zw = (jj < 2) ? zz[pt].x : zz[pt].y; const float zf = (jj & 1) ? bfhi(zw) : bflo(zw);
                            ov[jj] = (y[pt][jj] + Dh * xvv) * silu_f(zf); }
                        ssq += (ov[0] * ov[0] + ov[1] * ov[1]) + (ov[2] * ov[2] + ov[3] * ov[3]);
                        yq[pt] = pk4_f8(ov[0], ov[1], ov[2], ov[3], Q8_YS); }
                    *(u32x4*)(Y + tok * DI + h * 64 + 16 * q4) = tr4x4(yq[0], yq[1], yq[2], yq[3]);
                    ssq += __shfl_xor(ssq, 16); ssq += __shfl_xor(ssq, 32);
                    if (q4 == 0) SSQ[tok * 32 + h] = ssq; }
                { const float dec = __expf(acum[384]);
#pragma unroll
                    for (int pt = 0; pt < 4; ++pt) st[pt] = st[pt] * dec;
#pragma unroll
                    for (int kk = 0; kk < 4; ++kk) { const u32x4 a = *(const LAS u32x4*)(BTs + swz256(16 * w + r16, 64 * kk + 16 * q4));
                        const f32x4 w0 = *(const LAS f32x4*)(wdec + 32 * kk + 8 * q4), w1 = *(const LAS f32x4*)(wdec + 32 * kk + 8 * q4 + 4);
                        u32x4 aw; aw.x = pk2(bflo(a.x) * w0[0], bfhi(a.x) * w0[1]); aw.y = pk2(bflo(a.y) * w0[2], bfhi(a.y) * w0[3]); aw.z = pk2(bflo(a.z) * w1[0], bfhi(a.z) * w1[1]); aw.w = pk2(bflo(a.w) * w1[2], bfhi(a.w) * w1[3]);
#pragma unroll
                        for (int pt = 0; pt < 4; ++pt) { const bf16x8 bfr = *(const LAS bf16x8*)(xTs + swz256(16 * pt + r16, 64 * kk + 16 * q4)); st[pt] = mfma16(as_bf16x8(aw), bfr, st[pt]); } } }
            } else {
                const bf16* cp = cbb + (size_t)(16 * w + r16) * 128 + 32 * q4;
#pragma unroll
                for (int i = 0; i < 4; ++i) { const u32x4 t4 = *(const u32x4*)(cp + 8 * i); cbr[2 * i] = (u32x2){t4.x, t4.y}; cbr[2 * i + 1] = (u32x2){t4.z, t4.w}; }
                const bf16* ccp = XA + ((size_t)b * SEQ + 16 * w + r16) * 3072 + 2560 + g * 128 + 8 * q4;
#pragma unroll
                for (int kk = 0; kk < 4; ++kk) cfr[kk] = *(const u32x4*)(ccp + 32 * kk);
            }
            if (c < 32) {
#pragma unroll
                for (int pt = 0; pt < 4; ++pt) { u32x2 q; q.x = pk2(st[pt][0], st[pt][1]); q.y = pk2(st[pt][2], st[pt][3]); *(LAS u32x2*)(prn + swz256(16 * pt + r16, 2 * (16 * w + 4 * q4))) = q; }
                if (w == 0) { const int t0 = 2 * lane; const float d0 = dn0, d1 = dn1;
                    const float a0 = d0 * Ah, a1 = d1 * Ah; const float sm = a0 + a1; float incl = sm;
#pragma unroll
                    for (int off = 1; off < 64; off <<= 1) { const float v = __shfl_up(incl, off); if (lane >= off) incl += v; }
                    const float c0 = (incl - sm) + a0, c1 = incl; const float tot = __shfl(incl, 63);
                    fan[t0] = c0; fan[t0 + 1] = c1; fan[128 + t0] = d0; fan[128 + t0 + 1] = d1; fan[256 + t0] = d0 * __expf(tot - c0); fan[256 + t0 + 1] = d1 * __expf(tot - c1); if (lane == 63) fan[384] = tot; }
#pragma unroll
                for (int it = 0; it < 3; ++it) { const int cgi = 4 * (2 * it + (w >> 2)) + (lane >> 4);
                    LAS unsigned char* dst = (it == 0) ? xTn : BTn; const int r0 = (it == 0) ? (8 * cgi) : (8 * (cgi - 8));
#pragma unroll
                    for (int i = 0; i < 8; ++i) { const unsigned a0 = pre[it][0][i >> 1], a1 = pre[it][1][i >> 1];
                        const unsigned lo = (i & 1) ? (a0 >> 16) : (a0 & 0xffffu), hi = (i & 1) ? (a1 & 0xffff0000u) : (a1 << 16);
                        *(LAS unsigned*)(dst + swz256(r0 + i, 4 * jp)) = lo | hi; } }
                if (c < 31) {
#pragma unroll
                    for (int it = 0; it < 3; ++it) { const char* sb = xab + (size_t)(c + 1) * (128 * 6144) + chb[it]; pre[it][0] = *(const u32x4*)(sb + voff); pre[it][1] = *(const u32x4*)(sb + voff + 6144); }
                    if (w == 0) { const size_t t1 = (size_t)b * SEQ + (c + 1) * 128; dn0 = DT[(t1 + 2 * lane) * 32 + h]; dn1 = DT[(t1 + 2 * lane + 1) * 32 + h]; }
                }
            }
            lds_barrier();
        }
    }
}
__device__ __forceinline__ void rmsnorm_phase(bf16* Y, int G, int vcu) {
    const int tid = threadIdx.x, lane = tid & 63, w = tid >> 6;
    const int gw = vcu * 8 + w, NGW = G * 8;
    for (int row = gw; row < T; row += NGW) {
        u32x4* rp = (u32x4*)(Y + (size_t)row * DI) + lane;
#pragma unroll
        for (int j = 0; j < 4; ++j) { const u32x4 a = rp[64 * j]; float f[8]; float ss = 0.f;
#pragma unroll
            for (int i = 0; i < 4; ++i) { f[2 * i] = bflo(a[i]); f[2 * i + 1] = bfhi(a[i]); ss += f[2 * i] * f[2 * i] + f[2 * i + 1] * f[2 * i + 1]; }
            const float sc = 1.0f / sqrtf(wave_sum(ss) * (1.0f / 512.0f) + RMS_EPS);
            u32x4 o;
#pragma unroll
            for (int i = 0; i < 4; ++i) o[i] = pk2(f[2 * i] * sc, f[2 * i + 1] * sc);
            rp[64 * j] = o; }
    }
}

__device__ __forceinline__ int moe_tables(LAS unsigned char* lds, const unsigned* counts) {
    const int tid = threadIdx.x;
    LAS int* tab = (LAS int*)(lds + LDS_TAB);
    if (tid < 32) tab[64 + tid] = (int)__hip_atomic_load(counts + tid, __ATOMIC_RELAXED, __HIP_MEMORY_SCOPE_AGENT);
    __syncthreads();
    if (tid == 0) { int pre = 0; for (int e = 0; e < 32; ++e) { tab[e] = pre; pre += (tab[64 + e] + 255) >> 8; } tab[32] = pre; }
    __syncthreads();
    const int NB = tab[32];
    for (int rb = tid; rb < NB; rb += 512) { int e = 0; while (e < 31 && tab[e + 1] <= rb) ++e; tab[128 + rb] = e; }
    __syncthreads();
    return NB;
}

struct Args { const void* in[22]; float* out; unsigned char* ws; int ph_lo, ph_hi; };
__global__ void __launch_bounds__(512, 2) fwd_kernel(Args args) {
    extern __shared__ __attribute__((aligned(16))) unsigned char lds_raw[];
    LAS unsigned char* lds = (LAS unsigned char*)lds_raw;
    const int tid = threadIdx.x;
    const int G = gridDim.x; const int bx = blockIdx.x; const int vcu = (G % 8 == 0) ? (bx % 8) * (G / 8) + bx / 8 : bx;
    unsigned char* ws = args.ws;
    unsigned* ctl = (unsigned*)(ws + WS_CTL);
    Ptrs P;
    P.x = (const float*)args.in[0]; P.pos = (const int*)args.in[1]; P.attn_w_in = (const float*)args.in[2]; P.attn_w_out = (const float*)args.in[3]; P.ssm_w_in = (const float*)args.in[4];
    P.conv_w = (const float*)args.in[5]; P.conv_b = (const float*)args.in[6]; P.dt_bias = (const float*)args.in[7]; P.a_log = (const float*)args.in[8]; P.d_skip = (const float*)args.in[9];
    P.norm_w = (const float*)args.in[10]; P.ssm_w_out = (const float*)args.in[11]; P.w_router = (const float*)args.in[12]; P.b_router = (const float*)args.in[13]; P.w_up = (const float*)args.in[14];
    P.b_up = (const float*)args.in[15]; P.w_dn = (const float*)args.in[16]; P.b_dn = (const float*)args.in[17]; P.ln_mix_g = (const float*)args.in[18]; P.ln_mix_b = (const float*)args.in[19];
    P.ln_ffn_g = (const float*)args.in[20]; P.ln_ffn_b = (const float*)args.in[21];
    volatile LAS unsigned* misc = (volatile LAS unsigned*)(lds + LDS_MISC);
    if (tid < 64) misc[tid] = 0u;
    __syncthreads();
    XcdBarrier bar; bar.bar = ctl + CW_BAR; bar.x = 0; bar.st = misc;
    if (!MK_PER_PHASE) bar = xcd_barrier_post(ctl + CW_BAR, misc);
    const int lo = args.ph_lo, hi = args.ph_hi;
#ifndef PH_MASK
#define PH_MASK 0x1FFFF
#endif
#define IN(k) ((((PH_MASK) >> (k)) & 1) && lo <= (k) && (k) < hi)
#define SEAM(k) do { if (IN(k) && IN((k) + 1)) xcd_barrier(bar); } while (0)
#define SEAM_PRE(k, W, PITCH, M8) do { if (IN(k) && IN((k) + 1)) { const float* w_ = (W); const int p_ = (PITCH); xcd_barrier(bar, [=]() { ln_preload(lds, w_, p_, 64, 448, M8); }); } } while (0)

    bf16* Wqkv = (bf16*)(ws + WS_WQKV); bf16* Wao = (bf16*)(ws + WS_WAO); bf16* Wsi = (bf16*)(ws + WS_WSI); bf16* Wso = (bf16*)(ws + WS_WSO);
    bf16* XBA = (bf16*)(ws + WS_XBA); bf16* XBB = (bf16*)(ws + WS_XBB); bf16* MIXB = (bf16*)(ws + WS_X1);
    unsigned char* PROJ = ws + WS_BIG; bf16* ZX = (bf16*)(ws + WS_BIG); bf16* XA = (bf16*)(ws + WS_XA); bf16* CBG = (bf16*)(ws + WS_CBG); unsigned char* HB8 = ws + WS_HB; unsigned char* XQ = ws + WS_XQ; unsigned char* YS = ws + WS_YS;
    unsigned char* OG = ws + WS_OG; unsigned char* YB = ws + WS_OG;
    float* rope = (float*)(ws + WS_ROPE); float* gates = (float*)(ws + WS_GATES); float* DT = (float*)(ws + WS_DT); int* lists = (int*)(ws + WS_LIST); float* LSE = (float*)(ws + WS_LSE); float* SSQ = (float*)(ws + WS_LSE);

    if (IN(0)) { p0_prologue(lds, P, ws, G, vcu); }
    SEAM(0);


#define MOE_BLOCK(LAYER, PB) do { \
    unsigned* counts = ctl + CW_CNT + 64 * (LAYER); \
    if (IN((PB) + 0)) { \
        if ((LAYER) == 0) ln_phase<0, 1, true, false, true>(lds, (const bf16*)P.x, MIXB, nullptr, nullptr, P.ln_mix_g, P.ln_mix_b, nullptr, XBB, P.w_router, NE, P.b_router, gates, lists, counts, nullptr, G, vcu, XQ);   \
        else ln_phase<0, 1, true, false, false, true>(lds, XBA, MIXB, nullptr, nullptr, P.ln_mix_g + (LAYER) * DM, P.ln_mix_b + (LAYER) * DM, nullptr, XBB, \
                             P.w_router + (size_t)(LAYER) * DM * NE, NE, P.b_router + (LAYER) * NE, gates, lists, counts, nullptr, G, vcu, XQ); } \
    SEAM((PB) + 0); \
    if (IN((PB) + 1)) { \
        const int NB = moe_tables(lds, counts); \
        LAS int* tab = (LAS int*)(lds + LDS_TAB); LAS unsigned short* toks = (LAS unsigned short*)(lds + LDS_AUX); \
        const int NU = NB * 8; \
        const int nun = (vcu < NU) ? ((NU - vcu + G - 1) / G) : 0; \
        for (int idx = tid; idx < nun * 256 && idx < 17 * 256; idx += 512) { const int i = idx >> 8, row = idx & 255; const int L = i * G + vcu; const int rb = L >> 3; const int e = tab[128 + rb]; \
            const int r0 = (rb - tab[e]) * 256, cnt = tab[64 + e]; int si = r0 + row; si = si < cnt ? si : cnt - 1; toks[idx] = (unsigned short)(lists[(size_t)e * 32768 + si] >> 2); } \
        LAS unsigned* btab = (LAS unsigned*)(lds + LDS_SLOT); \
        for (int idx = tid; idx < nun * 128 && idx < 17 * 128; idx += 512) { const int i = idx >> 7, cp = idx & 127; const int L = i * G + vcu; const int rb = L >> 3, pn = L & 7; const int e = tab[128 + rb]; \
            const float* bsrc = P.b_up + ((size_t)(LAYER) * 32 + e) * 2048 + ((cp < 64) ? (pn * 128 + 2 * cp) : (1024 + pn * 128 + 2 * (cp - 64))); btab[idx] = pk2(bsrc[0], bsrc[1]); } \
        __syncthreads(); \
        pg8::MoeOrder<true> S; S.A = (const char*)XQ; S.Bt = (const char*)(ws + WS_WUP + (size_t)(LAYER) * 32 * 2048 * 1024); S.K = DM / 2;   S.N = 2048; S.nN = 8; S.G = G; S.c = vcu; S.NU = NU; S.tab = tab; S.toks = toks; \
        pg8::EpiUp E{HB8, btab}; \
        if ((LAYER) == 0) { pg8::HostCvt H; H.w_up = P.w_up + (size_t)32 * 1024 * 2048; H.w_dn = P.w_dn + (size_t)32 * 1024 * 1024; H.wt_up = ws + WS_WUP + (size_t)32 * 2048 * 1024; H.wt_dn = ws + WS_WDN + (size_t)32 * 1024 * 1024; \
            H.base = 0; H.limit = 49152; H.G = G; H.c = vcu;   \
            pg8::gemm_phase<true>(lds, DM / 2, S, E, H); } \
        else { pg8::HostNone H; pg8::gemm_phase<true>(lds, DM / 2, S, E, H); } } \
    SEAM((PB) + 1); \
    if (IN((PB) + 2)) { \
        const int NB = moe_tables(lds, counts); \
        LAS int* tab = (LAS int*)(lds + LDS_TAB); LAS int* slots = (LAS int*)(lds + LDS_SLOT); LAS unsigned* dbtab = (LAS unsigned*)(lds + LDS_AUX); \
        { const int NU = NB * 4; const int nun = (vcu < NU) ? ((NU - vcu + G - 1) / G) : 0; \
          for (int idx = tid; idx < nun * 256 && idx < 9 * 256; idx += 512) { const int i = idx >> 8, row = idx & 255; const int L = i * G + vcu; const int rb = L >> 2; const int e = tab[128 + rb]; \
              const int si = (rb - tab[e]) * 256 + row; slots[idx] = (si < tab[64 + e]) ? lists[(size_t)e * 32768 + si] : -1; } \
          for (int idx = tid; idx < nun * 128 && idx < 9 * 128; idx += 512) { const int i = idx >> 7, cp = idx & 127; const int L = i * G + vcu; const int rb = L >> 2, pn = L & 3; const int e = tab[128 + rb]; \
              const float* bsrc = P.b_dn + ((size_t)(LAYER) * 32 + e) * 1024 + pn * 256 + 2 * cp; dbtab[idx] = pk2(bsrc[0], bsrc[1]); } \
          __syncthreads(); } \
        pg8::MoeOrder<false> S; S.A = (const char*)HB8; S.Bt = (const char*)(ws + WS_WDN + (size_t)(LAYER) * 32 * 1024 * 1024); S.K = DM / 2; S.N = 1024; S.nN = 4; S.G = G; S.c = vcu; S.NU = NB * 4; S.tab = tab; S.toks = nullptr; \
        pg8::EpiDown E{YS, dbtab, slots}; \
        if ((LAYER) == 0) { pg8::HostCvt H; H.w_up = P.w_up + (size_t)32 * 1024 * 2048; H.w_dn = P.w_dn + (size_t)32 * 1024 * 1024; H.wt_up = ws + WS_WUP + (size_t)32 * 2048 * 1024; H.wt_dn = ws + WS_WDN + (size_t)32 * 1024 * 1024; \
            H.base = NB * 64; H.limit = 49152; H.G = G; H.c = vcu;   \
            pg8::gemm_phase<true>(lds, DM / 2, S, E, H); \
            } \
        else { pg8::HostNone H; pg8::gemm_phase<true>(lds, DM / 2, S, E, H); } } \
    if ((LAYER) == 0) SEAM_PRE((PB) + 2, P.ssm_w_in + NZX, SSM_PITCH, true); else SEAM((PB) + 2); \
    if (IN((PB) + 3)) { \
        if ((LAYER) == 0) ln_phase<1, 2, true, false, false, true>(lds, XBB, nullptr, YS, gates, P.ln_ffn_g, P.ln_ffn_b, nullptr, XBA, P.ssm_w_in + NZX, SSM_PITCH, P.dt_bias, nullptr, nullptr, nullptr, DT, G, vcu, ws + WS_XQ0); \
        else ln_phase<1, 0, false, true>(lds, XBB, nullptr, YS, gates, P.ln_ffn_g + DM, P.ln_ffn_b + DM, args.out, nullptr, nullptr, 0, nullptr, nullptr, nullptr, nullptr, nullptr, G, vcu); } \
    } while (0)

    if (IN(1)) { pg8::DenseOrder S; S.init(ws + WS_XQ0, Wqkv, T, NQKV, DM / 2, G, bx); pg8::EpiQKV E{PROJ, rope, 1.0f / (Q8_X * Q8_W)};
        pg8::HostDense H; H.w_si = P.ssm_w_in; H.w_so = P.ssm_w_out; H.w_ao = P.attn_w_out; H.norm_w = P.norm_w; H.t_si = (unsigned char*)Wsi; H.t_so = (unsigned char*)Wso; H.t_ao = (unsigned char*)Wao; H.G = G; H.c = bx; H.lo = 3584; H.hi = 4096;
        pg8::gemm_phase<true>(lds, DM / 2, S, E, H); }
    SEAM(1);
    if (IN(2)) { pg8::HostCvt H; H.w_up = P.w_up; H.w_dn = P.w_dn; H.wt_up = ws + WS_WUP; H.wt_dn = ws + WS_WDN; H.base = 0; H.limit = 49152; H.G = G; H.c = vcu;
        attn_phase(lds, PROJ, OG, LSE, G, vcu, H); }
    SEAM(2);
    if (IN(3)) combine_phase(OG, LSE, ws + WS_OB, G, vcu);
    SEAM(3);
    if (IN(4)) { pg8::DenseOrder S; S.init(ws + WS_OB, Wao, T, DM, DM / 2, G, bx); pg8::EpiBf16 E{MIXB, DM, 1.0f / (Q8_O * Q8_W), 1 << 20};
        pg8::HostDense H; H.w_si = P.ssm_w_in; H.w_so = P.ssm_w_out; H.w_ao = P.attn_w_out; H.norm_w = P.norm_w; H.t_si = (unsigned char*)Wsi; H.t_so = (unsigned char*)Wso; H.t_ao = (unsigned char*)Wao; H.G = G; H.c = bx; H.lo = 0; H.hi = 3584;
        pg8::gemm_phase<true>(lds, DM / 2, S, E, H); }
    SEAM_PRE(4, P.w_router, NE, false);
    MOE_BLOCK(0, 5);
    SEAM(8);
    if (IN(9)) { pg8::DenseOrder S; S.init(ws + WS_XQ0, Wsi, T, NZX, DM / 2, G, bx); pg8::EpiBf16 E{ZX, NZX, 1.0f / (Q8_X * Q8_W), 16}; pg8::HostNone H; pg8::gemm_phase<true>(lds, DM / 2, S, E, H); }
    SEAM(9);
    if (IN(10)) {
        convcb_phase(lds, ZX, P.conv_w, P.conv_b, XA, CBG, G, vcu); }
    SEAM(10);
    if (IN(11)) ssd_phase(lds, ZX, XA, CBG, DT, P.a_log, P.d_skip, YB, SSQ, G, vcu);
    SEAM(11);
    if (IN(12)) { pg8::DenseOrder S; S.init(YB, Wso, T, DM, DI / 2, G, bx);
        LAS float* stab = (LAS float*)(lds + LDS_AUX);
        for (int i = 0; i < 4; ++i) { pg8::Unit uu; if (!S.next(i, uu)) break;
            for (int idx = tid; idx < 1024; idx += 512) { const int rl = idx >> 2, g = idx & 3; const float* sp = SSQ + (size_t)(uu.pm * 256 + rl) * 32 + g * 8;
                const f32x4 a = *(const f32x4*)sp, b4 = *(const f32x4*)(sp + 4); const float sum = ((a[0] + a[1]) + (a[2] + a[3])) + ((b4[0] + b4[1]) + (b4[2] + b4[3]));
                stab[(i * 256 + rl) * 4 + g] = __builtin_amdgcn_rsqf(sum * (1.0f / 512.0f) + RMS_EPS); } }
        __syncthreads();
        pg8::EpiRms E{MIXB, DM, stab}; pg8::HostNone H; pg8::gemm_phase<true>(lds, DI / 2, S, E, H); }
    SEAM_PRE(12, P.w_router + (size_t)DM * NE, NE, true);
    MOE_BLOCK(1, 13);
#undef IN
#undef SEAM
#undef MOE_BLOCK
}

constexpr int NPHASE = 17;
extern "C" void kernel_launch(void* const* d_in, const int* in_sizes, int n_in, void* d_out, int out_size, void* d_ws, size_t ws_size, hipStream_t stream) {
    static int grid = 0;
    if (grid == 0) {
        if (n_in != 22 || in_sizes[0] != T * DM || out_size != T * DM || ws_size < WS_END) { fprintf(stderr, "kernel_launch: unexpected shapes / workspace (n_in %d, in0 %d, out %d, ws %zu, need %zu)\n", n_in, n_in > 0 ? in_sizes[0] : -1, out_size, ws_size, (size_t)WS_END); grid = -1; return; }
        int dev = 0, cus = 0;
        if (hipGetDevice(&dev) != hipSuccess || hipDeviceGetAttribute(&cus, hipDeviceAttributeMultiprocessorCount, dev) != hipSuccess) { fprintf(stderr, "kernel_launch: device query failed\n"); grid = -1; return; }
        if (hipFuncSetAttribute((const void*)fwd_kernel, hipFuncAttributeMaxDynamicSharedMemorySize, LDS_BYTES) != hipSuccess) { fprintf(stderr, "kernel_launch: hipFuncSetAttribute failed\n"); grid = -1; return; }
        int per_cu = 0;
        if (hipOccupancyMaxActiveBlocksPerMultiprocessor(&per_cu, (const void*)fwd_kernel, 512, LDS_BYTES) != hipSuccess || per_cu < 1) fprintf(stderr, "kernel_launch: occupancy query reports %d\n", per_cu);
        (void)hipGetLastError();
        grid = cus;
        if (grid < 256) { fprintf(stderr, "kernel_launch: built for >= 256 CUs, got %d\n", grid); }
        if (grid > 256) grid = 256;
    }
    if (grid < 0) return;
    if (hipMemsetAsync((char*)d_ws + WS_CTL, 0, CTL_ZERO_BYTES, stream) != hipSuccess) { fprintf(stderr, "kernel_launch: memset failed\n"); return; }
    Args a{};
    for (int i = 0; i < 22; ++i) a.in[i] = d_in[i];
    a.out = (float*)d_out; a.ws = (unsigned char*)d_ws;
#if MK_PER_PHASE
    for (int p = 0; p < NPHASE; ++p) { a.ph_lo = p; a.ph_hi = p + 1; hipLaunchKernelGGL(fwd_kernel, dim3(grid), dim3(512), LDS_BYTES, stream, a); }
#else
    a.ph_lo = 0; a.ph_hi = NPHASE;
    hipLaunchKernelGGL(fwd_kernel, dim3(grid), dim3(512), LDS_BYTES, stream, a);
#endif
    const hipError_t le = hipPeekAtLastError();
    if (le != hipSuccess) fprintf(stderr, "kernel_launch: launch failed: %s\n", hipGetErrorName(le));
}
```
